# Optimizing an MI355X kernel written in HIP

```python
import math
import jax, jax.numpy as jnp
from jax import lax
import numpy as np

D_MODEL = 1024
BATCH = 8
SEQ = 4096
DEPTH = 2

N_GROUPS = 4
GROUP_WIDTH = D_MODEL // N_GROUPS
HEADS_PER_GROUP = 4
HEAD_DIM = GROUP_WIDTH // HEADS_PER_GROUP
DIFF_QK_DIM = HEAD_DIM // 2
D_FF = 4 * D_MODEL
CHUNK = 64
Q_BLOCK = 128
CONV_WIDTH = 4
NORM_EPS = 1e-6
IN_WIDTHS = (GROUP_WIDTH,) * 4 + (GROUP_WIDTH,) * 3 + (GROUP_WIDTH,) * 4 + (HEADS_PER_GROUP,) + (GROUP_WIDTH,) * 4 + (HEADS_PER_GROUP,) * 2
IN_COLS = 15 * GROUP_WIDTH + 3 * HEADS_PER_GROUP

kernel_name = "hybrid_parallel_groups_hgrn2_diff_fox_mlstm"


def _rms(x, gain):
    xf = x.astype(jnp.float32)
    y = xf * lax.rsqrt(jnp.mean(xf * xf, axis=-1, keepdims=True) + NORM_EPS)
    return y * gain.astype(jnp.float32)


def _modulate(x, gain, shift, scale):
    return _rms(x, gain) * (1.0 + scale[:, None, :]) + shift[:, None, :]


def _split(z, widths):
    idx = np.cumsum(np.array(widths))[:-1].tolist()
    return jnp.split(z, idx, axis=-1)


def _heads(t):
    B, S, W = t.shape
    return t.reshape(B, S, W // HEAD_DIM, HEAD_DIM).transpose(0, 2, 1, 3)


def _unheads(t):
    B, Hh, S, d = t.shape
    return t.transpose(0, 2, 1, 3).reshape(B, S, Hh * d)


def _to_chunks(t):
    B, Hh, S = t.shape[:3]
    t = t.reshape((B, Hh, S // CHUNK, CHUNK) + t.shape[3:])
    return jnp.moveaxis(t, 2, 0)


def _from_chunks(t):
    t = jnp.moveaxis(t, 0, 2)
    B, Hh, N, C, d = t.shape
    return t.reshape(B, Hh, N * C, d)


def _hgrn2(q, f_pre, i, g, lb, norm_gain):
    f = lb + (1.0 - lb) * jax.nn.sigmoid(f_pre)
    k = 1.0 - f
    logf = jnp.log(f)
    qc, kc, vc, lc = (_to_chunks(_heads(t)) for t in (q, k, i, logf))
    causal = jnp.tril(jnp.ones((CHUNK, CHUNK), dtype=bool))

    def step(state, inp):
        qt, kt, vt, lt = inp
        b = jnp.cumsum(lt, axis=-2)
        diff = b[..., :, None, :] - b[..., None, :, :]
        decay = jnp.exp(jnp.where(causal[:, :, None], diff, -jnp.inf))
        a = jnp.einsum('bhtd,bhtsd,bhsd->bhts', qt, decay, kt)
        o = jnp.einsum('bhts,bhsv->bhtv', a, vt) + jnp.einsum('bhtd,bhdv->bhtv', qt * jnp.exp(b), state)
        b_last = b[..., -1:, :]
        state = jnp.exp(b_last[..., 0, :])[..., None] * state + jnp.einsum('bhsd,bhsv->bhdv', kt * jnp.exp(b_last - b), vt)
        return state, o

    B = q.shape[0]
    s0 = jnp.zeros((B, HEADS_PER_GROUP, HEAD_DIM, HEAD_DIM), jnp.float32)
    _, o = lax.scan(step, s0, (qc, kc, vc, lc))
    o = _from_chunks(o).transpose(0, 2, 1, 3)
    o = _rms(o, norm_gain).reshape(q.shape)
    return o * jax.nn.silu(g)


def _diff_attention(q, k, v, qn_gain, kn_gain, lam_vecs, sub_gain, layer_idx):
    B, S, _ = q.shape
    H = HEADS_PER_GROUP
    q = _rms(q.reshape(B, S, H, 2, DIFF_QK_DIM), qn_gain).transpose(0, 2, 3, 1, 4) * DIFF_QK_DIM ** -0.5
    k = _rms(k.reshape(B, S, H, 2, DIFF_QK_DIM), kn_gain).transpose(0, 2, 3, 1, 4)
    v = _heads(v)
    lam_init = 0.8 - 0.6 * math.exp(-0.3 * layer_idx)
    lam_vecs = lam_vecs.astype(jnp.float32)
    lam = jnp.exp(jnp.sum(lam_vecs[0] * lam_vecs[1])) - jnp.exp(jnp.sum(lam_vecs[2] * lam_vecs[3])) + lam_init
    slopes = 2.0 ** (-8.0 * jnp.arange(1, H + 1, dtype=jnp.float32) / H)
    pos = jnp.arange(S)

    def block(bi):
        qb = lax.dynamic_slice_in_dim(q, bi * Q_BLOCK, Q_BLOCK, axis=3)
        tq = bi * Q_BLOCK + jnp.arange(Q_BLOCK)
        dist = tq[:, None] - pos[None, :]
        bias = -slopes[:, None, None] * dist.astype(jnp.float32)
        logits = jnp.einsum('bhcqd,bhcsd->bhcqs', qb, k) + bias[None, :, None]
        logits = jnp.where(dist >= 0, logits, -jnp.inf)
        p = jax.nn.softmax(logits, axis=-1)
        w = p[:, :, 0] - lam * p[:, :, 1]
        return jnp.einsum('bhqs,bhsv->bhqv', w, v)

    o = lax.map(block, jnp.arange(S // Q_BLOCK))
    o = jnp.moveaxis(o, 0, 2).reshape(B, H, S, HEAD_DIM)
    o = _rms(o, sub_gain) * (1.0 - lam_init)
    return _unheads(o)


def _forgetting_attention(q, k, v, g, f_pre, qn_gain, kn_gain, f_bias):
    B, S, _ = q.shape
    q = _rms(_heads(q), qn_gain) * HEAD_DIM ** -0.5
    k = _rms(_heads(k), kn_gain)
    v = _heads(v)
    logf = jax.nn.log_sigmoid(f_pre + f_bias.astype(jnp.float32))
    F = jnp.cumsum(logf, axis=1).transpose(0, 2, 1)
    pos = jnp.arange(S)

    def block(bi):
        qb = lax.dynamic_slice_in_dim(q, bi * Q_BLOCK, Q_BLOCK, axis=2)
        Fq = lax.dynamic_slice_in_dim(F, bi * Q_BLOCK, Q_BLOCK, axis=2)
        tq = bi * Q_BLOCK + jnp.arange(Q_BLOCK)
        logits = jnp.einsum('bhqd,bhsd->bhqs', qb, k) + Fq[..., :, None] - F[..., None, :]
        logits = jnp.where(tq[:, None] >= pos[None, :], logits, -jnp.inf)
        p = jax.nn.softmax(logits, axis=-1)
        return jnp.einsum('bhqs,bhsv->bhqv', p, v)

    o = lax.map(block, jnp.arange(S // Q_BLOCK))
    o = jnp.moveaxis(o, 0, 2).reshape(B, HEADS_PER_GROUP, S, HEAD_DIM)
    return _unheads(o) * jax.nn.sigmoid(g)


def _mlstm(q, k, v, o_pre, i_pre, f_pre, conv_w, i_bias, f_bias):
    B, S, G = q.shape
    qk = jnp.concatenate([q, k], axis=-1)
    qk = lax.conv_general_dilated(qk, conv_w.astype(qk.dtype)[:, None, :], window_strides=(1,),
                                  padding=[(CONV_WIDTH - 1, 0)], dimension_numbers=('NWC', 'WIO', 'NWC'),
                                  feature_group_count=2 * G)
    qk = jax.nn.silu(qk)
    q, k = qk[..., :G], qk[..., G:]
    log_i = (i_pre + i_bias.astype(jnp.float32)).transpose(0, 2, 1)
    log_f = jax.nn.log_sigmoid(f_pre + f_bias.astype(jnp.float32)).transpose(0, 2, 1)
    qc = _to_chunks(_heads(q) * HEAD_DIM ** -0.5)
    kc = _to_chunks(_heads(k))
    vc = _to_chunks(_heads(v))
    ic = _to_chunks(log_i)
    fc = _to_chunks(log_f)
    causal = jnp.tril(jnp.ones((CHUNK, CHUNK), dtype=bool))

    def step(carry, inp):
        cmem, nvec, m = carry
        qt, kt, vt, it, lft = inp
        b = jnp.cumsum(lft, axis=-1)
        log_d = jnp.where(causal, b[..., :, None] - b[..., None, :] + it[..., None, :], -jnp.inf)
        inter = b + m[..., None]
        m_t = jnp.maximum(inter, jnp.max(log_d, axis=-1))
        d = jnp.exp(log_d - m_t[..., None])
        w_inter = jnp.exp(inter - m_t)
        s = jnp.einsum('bhtd,bhsd->bhts', qt, kt) * d
        num = jnp.einsum('bhts,bhsv->bhtv', s, vt) + w_inter[..., None] * jnp.einsum('bhtd,bhdv->bhtv', qt, cmem)
        den = jnp.sum(s, axis=-1) + w_inter * jnp.einsum('bhtd,bhd->bht', qt, nvec)
        h = num / jnp.maximum(jnp.abs(den), jnp.exp(-m_t))[..., None]
        b_last = b[..., -1]
        log_w = b_last[..., None] - b + it
        m_new = jnp.maximum(b_last + m, jnp.max(log_w, axis=-1))
        w = jnp.exp(log_w - m_new[..., None])
        decay = jnp.exp(b_last + m - m_new)
        cmem = decay[..., None, None] * cmem + jnp.einsum('bhs,bhsd,bhsv->bhdv', w, kt, vt)
        nvec = decay[..., None] * nvec + jnp.einsum('bhs,bhsd->bhd', w, kt)
        return (cmem, nvec, m_new), h

    H = HEADS_PER_GROUP
    init = (jnp.zeros((B, H, HEAD_DIM, HEAD_DIM), jnp.float32),
            jnp.zeros((B, H, HEAD_DIM), jnp.float32),
            jnp.zeros((B, H), jnp.float32))
    _, h = lax.scan(step, init, (qc, kc, vc, ic, fc))
    h = _unheads(_from_chunks(h))
    return jax.nn.sigmoid(o_pre) * h


def setup_inputs(seed: int = 0) -> dict:
    key = jax.random.key(seed)
    ks = jax.random.split(key, 24)
    D, G, H, L = D_MODEL, GROUP_WIDTH, HEADS_PER_GROUP, DEPTH
    nrm = jax.random.normal
    f32 = jnp.float32
    return {
        "x": nrm(ks[0], (BATCH, SEQ, D), f32),
        "c": nrm(ks[1], (BATCH, D), f32),
        "w_ada": nrm(ks[2], (L, D, 6 * D), f32) * 0.5 * D ** -0.5,
        "b_ada": 0.01 * nrm(ks[3], (L, 6 * D), f32),
        "norm_mix_gain": 1.0 + 0.05 * nrm(ks[4], (L, D), f32),
        "norm_ff_gain": 1.0 + 0.05 * nrm(ks[5], (L, D), f32),
        "w_in": nrm(ks[6], (L, D, IN_COLS), f32) * D ** -0.5,
        "w_out": nrm(ks[7], (L, D, D), f32) * D ** -0.5,
        "hg_lb_logits": 0.5 * nrm(ks[8], (L, G), f32),
        "hg_norm_gain": 1.0 + 0.05 * nrm(ks[9], (L, HEAD_DIM), f32),
        "diff_qn_gain": 1.0 + 0.05 * nrm(ks[10], (L, DIFF_QK_DIM), f32),
        "diff_kn_gain": 1.0 + 0.05 * nrm(ks[11], (L, DIFF_QK_DIM), f32),
        "diff_lambda": 0.1 * nrm(ks[12], (L, 4, DIFF_QK_DIM), f32),
        "diff_sub_gain": 1.0 + 0.05 * nrm(ks[13], (L, HEAD_DIM), f32),
        "fox_qn_gain": 1.0 + 0.05 * nrm(ks[14], (L, HEAD_DIM), f32),
        "fox_kn_gain": 1.0 + 0.05 * nrm(ks[15], (L, HEAD_DIM), f32),
        "fox_f_bias": jnp.linspace(1.0, 4.0, H, dtype=f32)[None, :] + 0.01 * nrm(ks[16], (L, H), f32),
        "mlstm_conv": nrm(ks[17], (L, CONV_WIDTH, 2 * G), f32) * CONV_WIDTH ** -0.5,
        "mlstm_i_bias": 0.01 * nrm(ks[18], (L, H), f32),
        "mlstm_f_bias": jnp.linspace(3.0, 6.0, H, dtype=f32)[None, :] + 0.01 * nrm(ks[19], (L, H), f32),
        "w_ff1": nrm(ks[20], (L, D, D_FF), f32) * D ** -0.5,
        "w_ff2": nrm(ks[21], (L, D_FF, D), f32) * D_FF ** -0.5,
    }


def reference(x, c, w_ada, b_ada, norm_mix_gain, norm_ff_gain, w_in, w_out, hg_lb_logits, hg_norm_gain,
              diff_qn_gain, diff_kn_gain, diff_lambda, diff_sub_gain, fox_qn_gain, fox_kn_gain, fox_f_bias,
              mlstm_conv, mlstm_i_bias, mlstm_f_bias, w_ff1, w_ff2):
    p_lb = jax.nn.softmax(hg_lb_logits.astype(jnp.float32), axis=0)
    lower_bounds = jnp.cumsum(p_lb, axis=0) - p_lb[0:1]
    c_act = jax.nn.silu(c.astype(jnp.float32))
    for l in range(DEPTH):
        mod = c_act @ w_ada[l] + b_ada[l]
        shift1, scale1, gate1, shift2, scale2, gate2 = jnp.split(mod, 6, axis=-1)

        h = _modulate(x, norm_mix_gain[l], shift1, scale1)
        z = (h @ w_in[l]).astype(jnp.float32)
        (hq, hf, hi, hg,
         dq, dk, dv,
         fq, fk, fv, fg, ff,
         mq, mk, mv, mo, mi, mf) = _split(z, IN_WIDTHS)
        y_a = _hgrn2(hq, hf, hi, hg, lower_bounds[l], hg_norm_gain[l])
        y_b = _diff_attention(dq, dk, dv, diff_qn_gain[l], diff_kn_gain[l], diff_lambda[l], diff_sub_gain[l], l)
        y_c = _forgetting_attention(fq, fk, fv, fg, ff, fox_qn_gain[l], fox_kn_gain[l], fox_f_bias[l])
        y_d = _mlstm(mq, mk, mv, mo, mi, mf, mlstm_conv[l], mlstm_i_bias[l], mlstm_f_bias[l])
        y = jnp.concatenate([y_a, y_b, y_c, y_d], axis=-1) @ w_out[l]
        x = x + (gate1[:, None, :] * y).astype(x.dtype)

        h = _modulate(x, norm_ff_gain[l], shift2, scale2)
        y = jnp.square(jax.nn.relu(h @ w_ff1[l])) @ w_ff2[l]
        x = x + (gate2[:, None, :] * y).astype(x.dtype)
    return x
```

```cpp
#include <hip/hip_runtime.h>
#include <cstdio>
#include <cstdint>
#include <cmath>
namespace pg8 {
#define PG8_LAS __attribute__((address_space(3)))
typedef unsigned short bf16_t;
typedef short bf16x8 __attribute__((ext_vector_type(8)));
typedef float f32x4 __attribute__((ext_vector_type(4)));
typedef unsigned u32x4 __attribute__((ext_vector_type(4)));
constexpr int BM = 256, BK = 64, HALF = 128, HTB = HALF * BK * 2  , STAGE_BYTES = 8 * HTB, NXCD = 8, WGM = 8;

__host__ __device__ __forceinline__ int lds_byte(int r, int c) { const int st = (r >> 4) * 2 + (c >> 5), rr = r & 15, cc = c & 31, ob = rr * 64 + cc * 2; return st * 1024 + (ob ^ (((ob >> 9) & 1) << 5)); }
__host__ __device__ __forceinline__ void stage_rc(int b, int& R, int& C) { const int st = b / 1024, sb = b % 1024, swz = sb ^ (((sb >> 9) & 1) << 5); R = (st >> 1) * 16 + swz / 64; C = (st & 1) * 32 + (swz % 64) / 2; }
__host__ __device__ __forceinline__ int perm32(int rho) { const int n = rho >> 4, i = rho & 15; return 8 * (i >> 2) + 4 * n + (i & 3); }

struct Unit { int pm, pn; };
struct Gemm { const bf16_t* A; const bf16_t* Bt; int M, N, K; };

struct StaticOrder {
    int nM, nN, nwg, G, c;
    __host__ __device__ void init(int M, int N, int G_, int c_) { nM = M / BM; nN = N / BM; nwg = nM * nN; G = G_; c = c_; }
    __host__ __device__ bool next(int i, Unit& u) const {
        const long L = (long)i * G + c; if (L >= nwg) return false;
        int wgid = (int)L; { const int q = nwg / NXCD, r = nwg % NXCD, xcd = wgid % NXCD, off = wgid / NXCD; wgid = (xcd < r ? xcd * (q + 1) : r * (q + 1) + (xcd - r) * q) + off; }
        const int nig = WGM * nN, gid = wgid / nig, fm = gid * WGM, gsz = (nM - fm) < WGM ? (nM - fm) : WGM;
        u.pm = fm + ((wgid % nig) % gsz); u.pn = (wgid % nig) / gsz; return true;
    }
    __device__ __forceinline__ void a_ready(const Unit&) const {}
    __device__ __forceinline__ void done(const Unit&) const {}
};

__device__ __forceinline__ unsigned cvt_pk_bf16(float lo, float hi) { unsigned r; asm volatile("v_cvt_pk_bf16_f32 %0, %1, %2" : "=v"(r) : "v"(lo), "v"(hi)); return r; }
template <int ACT> struct EpiBf16 {
    static constexpr bool PERM = true, AFTER_DRAIN = false;
    bf16_t* O; int ldc;
    __device__ __forceinline__ void operator()(const f32x4 (&acc)[2][2][4][2], const Unit& u, int wr, int wc, int fr, int fq) const {
        const int row0 = u.pm * BM + wr * 64 + fr; const int col0 = u.pn * BM + wc * 32 + 8 * fq;
#pragma unroll
        for (int ai = 0; ai < 2; ++ai)
#pragma unroll
            for (int m = 0; m < 4; ++m) { bf16_t* rowp = O + (size_t)(row0 + ai * HALF + m * 16) * ldc + col0;
#pragma unroll
                for (int bj = 0; bj < 2; ++bj) { f32x4 v0 = acc[ai][bj][m][0], v1 = acc[ai][bj][m][1];
                    if (ACT == 2) {
#pragma unroll
                        for (int e = 0; e < 4; ++e) { const float a = fmaxf(v0[e], 0.f), b = fmaxf(v1[e], 0.f); v0[e] = a * a; v1[e] = b * b; } }
                    u32x4 w; w.x = cvt_pk_bf16(v0[0], v0[1]); w.y = cvt_pk_bf16(v0[2], v0[3]); w.z = cvt_pk_bf16(v1[0], v1[1]); w.w = cvt_pk_bf16(v1[2], v1[3]);
                    *(u32x4*)(rowp + bj * HALF) = w; } }
    }
};
struct EpiResGate {
    static constexpr bool PERM = false, AFTER_DRAIN = false;
    const float* base; float* out; const float* gate;
    __device__ __forceinline__ void operator()(const f32x4 (&acc)[2][2][4][2], const Unit& u, int wr, int wc, int fr, int fq) const {
        const int col0 = u.pn * BM + wc * 32 + 4 * fq; const int b = (u.pm * BM) >> 12;
        const float* gp = gate + (size_t)b * 6144 + col0;
        f32x4 gv[2][2];
#pragma unroll
        for (int bj = 0; bj < 2; ++bj)
#pragma unroll
            for (int n = 0; n < 2; ++n) gv[bj][n] = *(const f32x4*)(gp + bj * HALF + n * 16);
#pragma unroll
        for (int ai = 0; ai < 2; ++ai)
#pragma unroll
            for (int m = 0; m < 4; ++m) { const size_t off = (size_t)(u.pm * BM + ai * HALF + wr * 64 + m * 16 + fr) * 1024 + col0;
#pragma unroll
                for (int bj = 0; bj < 2; ++bj)
#pragma unroll
                    for (int n = 0; n < 2; ++n) { const f32x4 bs = *(const f32x4*)(base + off + bj * HALF + n * 16);
                        *(f32x4*)(out + off + bj * HALF + n * 16) = bs + gv[bj][n] * acc[ai][bj][m][n]; } }
    }
};
template <class Epi, class Sched, bool ALIGN_EPI = false, bool SP2 = false>
__device__ __forceinline__ void gemm_phase(PG8_LAS unsigned char* lds, const Gemm g, const Sched& S, const Epi& E) {
    const int tid = threadIdx.x, wid = __builtin_amdgcn_readfirstlane(tid >> 6), lane = tid & 63, wr = wid >> 2, wc = wid & 3, fr = lane & 15, fq = lane >> 4;
    const int K = g.K, nt = K / BK;
    unsigned voffA[2], voffB[2];
#pragma unroll
    for (int i = 0; i < 2; ++i) { int R, C; stage_rc(tid * 16 + i * 8192, R, C); const int Rb = Epi::PERM ? ((R & ~31) + perm32(R & 31)) : R;
        voffA[i] = (unsigned)(R * K + C) * 2u; voffB[i] = (unsigned)(Rb * K + C) * 2u; }
    const size_t kstep = (size_t)(BK * 2);
    const size_t hstep = (size_t)HALF * K * 2;
    const size_t tstep = 2 * hstep;
    const unsigned ldsw = (unsigned)wid * 1024u;
    const int aoff = lds_byte(wr * 64 + fr, fq * 8), boff = lds_byte(wc * 32 + fr, fq * 8);
#define PG8_SA(b, h) (((b) * 2 + (h)) * HTB)
#define PG8_SB(b, h) ((4 + (b) * 2 + (h)) * HTB)
#define PG8_STAGE(bufoff, gbase, voff) do { _Pragma("unroll") for (int _i = 0; _i < 2; ++_i) \
        __builtin_amdgcn_global_load_lds((const unsigned*)((const char*)(gbase) + (voff)[_i]), (PG8_LAS unsigned*)(lds + (bufoff) + ldsw + _i * 8192), 16, 0, 0); } while (0)
#define PG8_LDA(dst, b, h) do { _Pragma("unroll") for (int m = 0; m < 4; ++m) _Pragma("unroll") for (int k = 0; k < 2; ++k) dst[m][k] = *(const PG8_LAS bf16x8*)(lds + PG8_SA(b, h) + aoff + m * 2048 + k * 1024); } while (0)
#define PG8_LDB(dst, b, h) do { _Pragma("unroll") for (int n = 0; n < 2; ++n) _Pragma("unroll") for (int k = 0; k < 2; ++k) dst[n][k] = *(const PG8_LAS bf16x8*)(lds + PG8_SB(b, h) + boff + n * 2048 + k * 1024); } while (0)
#define PG8_MMA(ai, bj, At, Bt) do { __builtin_amdgcn_s_setprio(1); _Pragma("unroll") for (int m = 0; m < 4; ++m) _Pragma("unroll") for (int n = 0; n < 2; ++n) _Pragma("unroll") for (int k = 0; k < 2; ++k) \
        acc[ai][bj][m][n] = __builtin_amdgcn_mfma_f32_16x16x32_bf16(Bt[n][k], At[m][k], acc[ai][bj][m][n], 0, 0, 0); __builtin_amdgcn_s_setprio(0); } while (0)
#define PG8_WAIT_V(n) asm volatile("s_waitcnt vmcnt(" #n ")" ::: "memory")
#define PG8_WAIT_L(n) asm volatile("s_waitcnt lgkmcnt(" #n ")" ::: "memory")
#define PG8_BAR __builtin_amdgcn_s_barrier()
#define PG8_SCHED __builtin_amdgcn_sched_barrier(0)
    Unit cur, nxt; int ui = 0;
    if (!S.next(0, cur)) return;
    f32x4 acc[2][2][4][2];
#pragma unroll
    for (int a = 0; a < 2; ++a)
#pragma unroll
        for (int b = 0; b < 2; ++b)
#pragma unroll
            for (int m = 0; m < 4; ++m)
#pragma unroll
                for (int n = 0; n < 2; ++n) acc[a][b][m][n] = (f32x4){0.f, 0.f, 0.f, 0.f};
    bf16x8 At[4][2], B0[2][2], B1[2][2];
    const char* cA = (const char*)g.A + (size_t)cur.pm * tstep; const char* cB = (const char*)g.Bt + (size_t)cur.pn * tstep;
    S.a_ready(cur);
    if constexpr (SP2) {
        PG8_STAGE(PG8_SB(0, 0), cB, voffB); PG8_STAGE(PG8_SB(0, 1), cB + hstep, voffB); PG8_STAGE(PG8_SA(0, 0), cA, voffA); PG8_STAGE(PG8_SA(0, 1), cA + hstep, voffA);
        if (wr == 1) PG8_BAR;
        PG8_WAIT_V(2); PG8_BAR;
        PG8_STAGE(PG8_SB(1, 0), cB + kstep, voffB); PG8_STAGE(PG8_SA(1, 0), cA + kstep, voffA); PG8_STAGE(PG8_SB(1, 1), cB + hstep + kstep, voffB);
        PG8_WAIT_V(6); PG8_BAR;
    } else {
        PG8_STAGE(PG8_SB(0, 0), cB, voffB); PG8_STAGE(PG8_SA(0, 0), cA, voffA); PG8_STAGE(PG8_SB(0, 1), cB + hstep, voffB); PG8_STAGE(PG8_SA(0, 1), cA + hstep, voffA);
        if (wr == 1) PG8_BAR;
        PG8_WAIT_V(4); PG8_BAR;
        PG8_STAGE(PG8_SB(1, 0), cB + kstep, voffB); PG8_STAGE(PG8_SA(1, 0), cA + kstep, voffA); PG8_STAGE(PG8_SB(1, 1), cB + hstep + kstep, voffB);
        PG8_WAIT_V(6); PG8_BAR;
    }
    for (;;) {
        const bool has_next = S.next(ui + 1, nxt);
        const char* nA = has_next ? (const char*)g.A + (size_t)nxt.pm * tstep : cA; const char* nB = has_next ? (const char*)g.Bt + (size_t)nxt.pn * tstep : cB;
        for (int t = 0; t < nt; t += 2) {
            const bool last = (t == nt - 2);
            const char* a1 = cA + (size_t)(t + 1) * kstep;
            const char* a2 = last ? nA : cA + (size_t)(t + 2) * kstep; const char* b2 = last ? nB : cB + (size_t)(t + 2) * kstep;
            const char* a3 = a2 + kstep; const char* b3 = b2 + kstep;
            if (last && has_next) S.a_ready(nxt);
            if constexpr (SP2) {
            PG8_LDB(B0, 0, 0); PG8_LDB(B1, 0, 1); PG8_SCHED; PG8_LDA(At, 0, 0); PG8_STAGE(PG8_SA(1, 1), a1 + hstep, voffA);
            PG8_WAIT_V(8); PG8_WAIT_L(0); PG8_BAR; PG8_MMA(0, 0, At, B0); PG8_MMA(0, 1, At, B1); PG8_BAR; PG8_SCHED;
            PG8_LDA(At, 0, 1); PG8_STAGE(PG8_SB(0, 0), b2, voffB); PG8_STAGE(PG8_SB(0, 1), b2 + hstep, voffB); PG8_STAGE(PG8_SA(0, 0), a2, voffA);
            PG8_WAIT_V(8); PG8_WAIT_L(0); PG8_BAR; PG8_MMA(1, 0, At, B0); PG8_MMA(1, 1, At, B1); PG8_BAR; PG8_SCHED;
            PG8_LDB(B0, 1, 0); PG8_LDB(B1, 1, 1); PG8_SCHED; PG8_LDA(At, 1, 0); PG8_STAGE(PG8_SA(0, 1), a2 + hstep, voffA);
            PG8_WAIT_V(8); PG8_WAIT_L(0); PG8_BAR; PG8_MMA(0, 0, At, B0); PG8_MMA(0, 1, At, B1); PG8_BAR; PG8_SCHED;
            PG8_LDA(At, 1, 1); PG8_STAGE(PG8_SB(1, 0), b3, voffB); PG8_STAGE(PG8_SB(1, 1), b3 + hstep, voffB); PG8_STAGE(PG8_SA(1, 0), a3, voffA);
            PG8_WAIT_V(8); PG8_WAIT_L(0); PG8_BAR; PG8_MMA(1, 0, At, B0); PG8_MMA(1, 1, At, B1); PG8_BAR; PG8_SCHED;
            } else {
            PG8_LDB(B0, 0, 0); PG8_SCHED; PG8_LDA(At, 0, 0); PG8_STAGE(PG8_SA(1, 1), a1 + hstep, voffA);
            PG8_WAIT_L(8); PG8_BAR; PG8_WAIT_L(0); PG8_MMA(0, 0, At, B0); PG8_BAR; PG8_SCHED;
            PG8_LDB(B1, 0, 1); PG8_STAGE(PG8_SB(0, 0), b2, voffB);
            PG8_BAR; PG8_WAIT_L(0); PG8_MMA(0, 1, At, B1); PG8_BAR;
            PG8_LDA(At, 0, 1); PG8_STAGE(PG8_SA(0, 0), a2, voffA);
            PG8_BAR; PG8_WAIT_L(0); PG8_MMA(1, 0, At, B0); PG8_BAR; PG8_SCHED;
            PG8_STAGE(PG8_SB(0, 1), b2 + hstep, voffB);
            PG8_WAIT_V(6); PG8_BAR; PG8_MMA(1, 1, At, B1); PG8_BAR;
            PG8_LDB(B0, 1, 0); PG8_SCHED; PG8_LDA(At, 1, 0); PG8_STAGE(PG8_SA(0, 1), a2 + hstep, voffA);
            PG8_WAIT_L(8); PG8_BAR; PG8_WAIT_L(0); PG8_MMA(0, 0, At, B0); PG8_BAR; PG8_SCHED;
            PG8_LDB(B1, 1, 1); PG8_STAGE(PG8_SB(1, 0), b3, voffB);
            PG8_BAR; PG8_WAIT_L(0); PG8_MMA(0, 1, At, B1); PG8_BAR;
            PG8_LDA(At, 1, 1); PG8_STAGE(PG8_SA(1, 0), a3, voffA);
            PG8_BAR; PG8_WAIT_L(0); PG8_MMA(1, 0, At, B0); PG8_BAR; PG8_SCHED;
            PG8_STAGE(PG8_SB(1, 1), b3 + hstep, voffB);
            PG8_WAIT_V(6); PG8_BAR; PG8_MMA(1, 1, At, B1); PG8_BAR;
            }
        }
        if constexpr (ALIGN_EPI) { if (wr == 0) PG8_BAR; }
        if constexpr (!Epi::AFTER_DRAIN) { E(acc, cur, wr, wc, fr, fq); S.done(cur); }
        if (!has_next) break;
#pragma unroll
        for (int a = 0; a < 2; ++a)
#pragma unroll
            for (int b = 0; b < 2; ++b)
#pragma unroll
                for (int m = 0; m < 4; ++m)
#pragma unroll
                    for (int n = 0; n < 2; ++n) acc[a][b][m][n] = (f32x4){0.f, 0.f, 0.f, 0.f};
        cur = nxt; cA = nA; cB = nB; ++ui;
        if constexpr (ALIGN_EPI) { if (wr == 1) PG8_BAR; }
    }
    PG8_WAIT_V(0);
    if constexpr (!ALIGN_EPI) { if (wr == 0) PG8_BAR; }
    PG8_BAR;
    if constexpr (Epi::AFTER_DRAIN) { E.fused(acc, cur, wr, wc, fr, fq, lds, wid, lane); S.done(cur); }
#undef PG8_SA
#undef PG8_SB
#undef PG8_STAGE
#undef PG8_LDA
#undef PG8_LDB
#undef PG8_MMA
#undef PG8_WAIT_V
#undef PG8_WAIT_L
#undef PG8_BAR
#undef PG8_SCHED
}
}
#define GAS __attribute__((address_space(1)))
#define LAS __attribute__((address_space(3)))
typedef unsigned short bf16;
typedef unsigned v4u __attribute__((ext_vector_type(4)));
typedef float f32x4 __attribute__((ext_vector_type(4)));
typedef short bf16x8 __attribute__((ext_vector_type(8)));
typedef GAS unsigned gu32;
typedef GAS unsigned long long gu64;
#define RLX_AGENT __ATOMIC_RELAXED, __HIP_MEMORY_SCOPE_AGENT
#define LDS_WAIT() asm volatile("s_waitcnt lgkmcnt(0)" ::: "memory")
#define VM_WAIT() asm volatile("s_waitcnt vmcnt(0)" ::: "memory")
__device__ __forceinline__ unsigned long long rt() { return __builtin_amdgcn_s_memrealtime(); }
__device__ __forceinline__ unsigned f2bf(float f) { unsigned u = __builtin_bit_cast(unsigned, f); return (u + 0x7fffu + ((u >> 16) & 1u)) >> 16; }
__device__ __forceinline__ unsigned pk2(float lo, float hi) { return f2bf(lo) | (f2bf(hi) << 16); }

#define XB_TMO      128
#define XB_XCNT(j)  (256  + 64 * (j))
#define XB_XSUB(j)  (1280 + 64 * (j))
#define XB_XGEN(j)  (2304 + 64 * (j))
#define XB_TOP      3328
#define XB_TOPGEN   3392
#define XCD_BAR_WORDS 3456
#define XB_SPIN_CAP (1u << 18)

__device__ __forceinline__ unsigned xb_ld(unsigned* p)              { return __hip_atomic_load(p, __ATOMIC_RELAXED, __HIP_MEMORY_SCOPE_AGENT); }
__device__ __forceinline__ unsigned xb_add(unsigned* p, unsigned v) { return __hip_atomic_fetch_add(p, v, __ATOMIC_RELAXED, __HIP_MEMORY_SCOPE_AGENT); }
__device__ __forceinline__ unsigned xb_xcc_id() { return (unsigned)__builtin_amdgcn_s_getreg((3 << 11) | 20) & 0xFu; }
#define XB_SPIN(cond, bar) do { unsigned _sp = 0; while (cond) { __builtin_amdgcn_s_sleep(1); \
    if ((++_sp & 255u) == 0u) { if (xb_ld(&(bar)[XB_TMO])) break; if (_sp > XB_SPIN_CAP) { atomicAdd(&(bar)[XB_TMO], 1u); break; } } } } while (0)

struct XcdBarrier {
    unsigned* bar; unsigned x;
    volatile LAS unsigned* st;
};

__device__ __forceinline__ XcdBarrier xcd_barrier_post(unsigned* bar, volatile LAS unsigned* st) {
    XcdBarrier b; b.bar = bar; b.x = xb_xcc_id(); b.st = st;
    if (threadIdx.x == 0) (void)xb_add(&bar[XB_XCNT(b.x)], 1u);
    return b;
}
__device__ __forceinline__ void xcd_barrier_complete(unsigned* bar, unsigned x, unsigned& nloc, unsigned& nx) {
    const unsigned G = gridDim.x * gridDim.y * gridDim.z;
    unsigned sum, cnt, mine, sp = 0u;
    for (;;) {
        sum = 0u; cnt = 0u; mine = 0u;
#pragma unroll
        for (unsigned j = 0; j < 16; ++j) { const unsigned c = xb_ld(&bar[XB_XCNT(j)]); sum += c; cnt += (c > 0u) ? 1u : 0u; mine = (j == x) ? c : mine; }
        if (sum == G) break;
        __builtin_amdgcn_s_sleep(1);
        if ((++sp & 255u) == 0u) { if (xb_ld(&bar[XB_TMO])) break; if (sp > XB_SPIN_CAP) { atomicAdd(&bar[XB_TMO], 1u); break; } }
    }
    nloc = mine > 0u ? mine : 1u; nx = cnt > 0u ? cnt : 1u;
}

__device__ __forceinline__ void xcd_barrier(const XcdBarrier& b) {
    asm volatile("s_waitcnt vmcnt(0)" ::: "memory");
    __syncthreads();
    if (threadIdx.x == 0) {
        unsigned* bar = b.bar;
        __builtin_amdgcn_s_waitcnt(0);
        unsigned nloc = b.st[0], nx = b.st[1];
        if (nloc == 0u) { xcd_barrier_complete(bar, b.x, nloc, nx); b.st[0] = nloc; b.st[1] = nx; }
        const unsigned old = xb_add(&bar[XB_XSUB(b.x)], 1u);
        const unsigned gen = old / nloc;
        if (old + 1u == (gen + 1u) * nloc) {
            __builtin_amdgcn_fence(__ATOMIC_RELEASE, "agent");
            asm volatile("s_waitcnt vmcnt(0)" ::: "memory");
            const unsigned og = xb_add(&bar[XB_TOP], 1u);
            const unsigned tg = og / nx;
            if (og + 1u == (tg + 1u) * nx) xb_add(&bar[XB_TOPGEN], 1u);
            else XB_SPIN(xb_ld(&bar[XB_TOPGEN]) == tg, bar);
            __builtin_amdgcn_fence(__ATOMIC_ACQUIRE, "agent");
            xb_add(&bar[XB_XGEN(b.x)], 1u);
            asm volatile("s_waitcnt vmcnt(0)" ::: "memory");
        } else {
            XB_SPIN(xb_ld(&bar[XB_XGEN(b.x)]) == gen, bar);
            __builtin_amdgcn_fence(__ATOMIC_ACQUIRE, "agent");
            asm volatile("s_waitcnt vmcnt(0)" ::: "memory");
        }
    }
    __syncthreads();
}
constexpr int NWAVES = 8;
constexpr int BATCH = 8, SEQ = 4096, D = 1024, FF = 4096, DEPTH = 2, T = BATCH * SEQ, NH = 4, HD = 64;
constexpr int INC = 3852, ZP = 3840, NMOD = 6 * D;
constexpr float EPS = 1e-6f;
constexpr int ZC_HQ = 0, ZC_HF = 256, ZC_HI = 512, ZC_HG = 768, ZC_DQ = 1024, ZC_DK = 1280, ZC_DV = 1536, ZC_FQ = 1792, ZC_FK = 2048, ZC_FV = 2304, ZC_FG = 2560, ZC_MQ = 2816, ZC_MK = 3072, ZC_MV = 3328, ZC_MO = 3584;
constexpr size_t MiB = 1u << 20;
constexpr size_t WS_CTL = 0, CTL_ZERO_BYTES = 1 * MiB;
constexpr size_t WS_MOD = 1 * MiB;
constexpr size_t WS_WG = 1 * MiB + 512 * 1024;
constexpr size_t WS_GATES = 2 * MiB;
constexpr size_t WS_FCUM = 4 * MiB;
constexpr size_t WS_WIN = 8 * MiB, WS_WOUT = 24 * MiB, WS_W1 = 28 * MiB, WS_W2 = 44 * MiB;
constexpr size_t WS_HN = 64 * MiB;
constexpr size_t WS_Z = 128 * MiB;
constexpr size_t WS_Y = 368 * MiB;
constexpr size_t WS_H = 128 * MiB;
constexpr size_t WS_END = 432 * MiB;
static_assert(WS_Z + (size_t)T * ZP * 2 <= WS_Y && WS_H + (size_t)T * FF * 2 <= WS_END && WS_Y + (size_t)T * D * 2 <= WS_END, "ws map");
constexpr int CW_TMO = 0, CW_BAR = 4096;
constexpr int RING_OFF = 0, RING_BYTES = 131072, LDSCTL_OFF = RING_BYTES, MISC_OFF = LDSCTL_OFF + 320, LDS_BYTES = 147456;
constexpr int PH_PRO = 0, PH_PER_LAYER = 7, NPH = 1 + 2 * PH_PER_LAYER;
constexpr int PL_NORM1 = 0, PL_INPROJ = 1, PL_MIX = 2, PL_OUTPROJ = 3, PL_NORM2 = 4, PL_FF1 = 5, PL_FF2 = 6;

struct Frame {
    LAS unsigned char* lds; volatile LAS unsigned* MISC; gu32* ctl;
    int tid, lane, wave, vcu, G;
};
__device__ __forceinline__ float wave_sum(float v) {
#pragma unroll
    for (int o = 1; o < 64; o <<= 1) v += __shfl_xor(v, o);
    return v;
}
__device__ __forceinline__ float bf2f(bf16 v) { return __builtin_bit_cast(float, (unsigned)v << 16); }
__device__ __forceinline__ float sigmoidf_(float x) { return 1.f / (1.f + __expf(-x)); }
__device__ __forceinline__ float logsigmoidf_(float x) { return fminf(x, 0.f) - log1pf(expf(-fabsf(x))); }

__device__ __forceinline__ void p0_transpose_item(const float* W, int K, int pitch, int nblk, bf16* WT, LAS float* scr, int item, int lane) {
    const int kb = item / nblk, nb = item % nblk, k0 = 64 * kb, n0 = 32 * nb;
#pragma unroll 8
    for (int i = 0; i < 32; ++i) { const int kk = 2 * i + (lane >> 5); scr[kk * 33 + (lane & 31)] = W[(size_t)(k0 + kk) * pitch + n0 + (lane & 31)]; }
    LDS_WAIT(); asm volatile("" ::: "memory");
    const int c = lane & 7;
#pragma unroll
    for (int j = 0; j < 4; ++j) { const int n = (lane >> 3) + 8 * j; const LAS float* s = scr + (8 * c) * 33 + n;
        v4u o; o.x = pk2(s[0 * 33], s[1 * 33]); o.y = pk2(s[2 * 33], s[3 * 33]); o.z = pk2(s[4 * 33], s[5 * 33]); o.w = pk2(s[6 * 33], s[7 * 33]);
        *(GAS v4u*)(WT + (size_t)(n0 + n) * K + k0 + 8 * c) = o; }
    LDS_WAIT(); asm volatile("" ::: "memory");
}

struct Args { const float* in[22]; float* out; unsigned char* ws; int ph_lo, ph_hi, li, pad; };

__device__ __forceinline__ void p0_prologue(Frame& F, const Args& A) {
    unsigned char* ws = A.ws;
    const float* c_in = A.in[1]; const float* w_ada = A.in[2]; const float* b_ada = A.in[3]; const float* w_in = A.in[6];
    float* mod = (float*)(ws + WS_MOD); float* wg = (float*)(ws + WS_WG);
    {
        LAS float* cact = (LAS float*)(F.lds); LAS float* red = (LAS float*)(F.lds + 32768);
        bool staged = false;
        for (int unit = blockIdx.x; unit < 192; unit += F.G) {
            if (!staged) { for (int i = F.tid; i < 8192; i += NWAVES * 64) { const int b = i >> 10, k = i & 1023; const float v = c_in[b * 1024 + k]; cact[k * 8 + b] = v / (1.f + expf(-v)); } staged = true; }
            __syncthreads();
            const int l = unit / 96, n0 = (unit % 96) * 64;
            const float* W = w_ada + (size_t)l * 1024 * NMOD + n0 + F.lane;
            float acc[8];
#pragma unroll
            for (int b = 0; b < 8; ++b) acc[b] = 0.f;
            const int k0 = F.wave * 128;
#pragma unroll 8
            for (int kk = 0; kk < 128; ++kk) { const int k = k0 + kk; const float w = W[(size_t)k * NMOD];
                const f32x4 c0 = *(const LAS f32x4*)(cact + k * 8), c1 = *(const LAS f32x4*)(cact + k * 8 + 4);
                acc[0] += w * c0[0]; acc[1] += w * c0[1]; acc[2] += w * c0[2]; acc[3] += w * c0[3]; acc[4] += w * c1[0]; acc[5] += w * c1[1]; acc[6] += w * c1[2]; acc[7] += w * c1[3]; }
#pragma unroll
            for (int b = 0; b < 8; ++b) red[(F.wave * 8 + b) * 64 + F.lane] = acc[b];
            __syncthreads();
            { const int b = F.tid >> 6, col = F.tid & 63; float s = b_ada[l * NMOD + n0 + col];
#pragma unroll
              for (int w = 0; w < 8; ++w) s += red[(w * 8 + b) * 64 + col];
              mod[(size_t)(l * 8 + b) * NMOD + n0 + col] = s; }
            __syncthreads();
        }
    }
    __syncthreads();
    for (int idx = blockIdx.x * (NWAVES * 64) + F.tid; idx < 2 * 12 * 1024; idx += F.G * NWAVES * 64) {
        const int l = idx / 12288, r = idx % 12288, j = r >> 10, k = r & 1023;
        const int col = (j < 4) ? 2816 + j : (j < 8 ? 3844 + (j - 4) : 3848 + (j - 8));
        wg[idx] = w_in[(size_t)l * 1024 * INC + (size_t)k * INC + col];
    }
    LAS float* scr = (LAS float*)(F.lds + RING_OFF + F.wave * 16384);
    const int gw = F.vcu * NWAVES + F.wave, NGW = F.G * NWAVES;
    constexpr int I_A = 16 * 88, I_B = 16 * 32, I_O = 16 * 32, I_1 = 16 * 128, I_2 = 64 * 32, I_L = I_A + I_B + I_O + I_1 + I_2;
    bf16* Win_t = (bf16*)(ws + WS_WIN); bf16* Wout_t = (bf16*)(ws + WS_WOUT); bf16* W1_t = (bf16*)(ws + WS_W1); bf16* W2_t = (bf16*)(ws + WS_W2);
    for (int it = gw; it < 2 * I_L; it += NGW) {
        const int l = it / I_L; int r = it % I_L;
        if (r < I_A) { p0_transpose_item(w_in + (size_t)l * 1024 * INC, 1024, INC, 88, Win_t + (size_t)l * ZP * 1024, scr, r, F.lane); continue; } r -= I_A;
        if (r < I_B) { p0_transpose_item(w_in + (size_t)l * 1024 * INC + 2820, 1024, INC, 32, Win_t + (size_t)l * ZP * 1024 + (size_t)2816 * 1024, scr, r, F.lane); continue; } r -= I_B;
        if (r < I_O) { p0_transpose_item(A.in[7] + (size_t)l * 1024 * 1024, 1024, 1024, 32, Wout_t + (size_t)l * 1024 * 1024, scr, r, F.lane); continue; } r -= I_O;
        if (r < I_1) { p0_transpose_item(A.in[20] + (size_t)l * 1024 * 4096, 1024, 4096, 128, W1_t + (size_t)l * 4096 * 1024, scr, r, F.lane); continue; } r -= I_1;
        p0_transpose_item(A.in[21] + (size_t)l * 4096 * 1024, 4096, 1024, 32, W2_t + (size_t)l * 1024 * 4096, scr, r, F.lane);
    }
}

__device__ __forceinline__ void norm_phase(Frame& F, const float* xsrc, const float* gain, const float* modl, int shift_slot, bf16* hn, const float* wg, float* gates) {
    LAS float* wgl = (LAS float*)(F.lds);
    if (wg) { for (int i = F.tid; i < 12 * 1024 / 4; i += NWAVES * 64) ((LAS f32x4*)wgl)[i] = ((const GAS f32x4*)wg)[i]; }
    __syncthreads();
    const int gw = F.vcu * NWAVES + F.wave, NGW = F.G * NWAVES;
    for (int m = gw; m < T; m += NGW) {
        const int b = m >> 12;
        const GAS f32x4* xr = (const GAS f32x4*)(xsrc + (size_t)m * D) + F.lane;
        f32x4 v[4]; float s = 0.f;
#pragma unroll
        for (int j = 0; j < 4; ++j) { v[j] = xr[64 * j]; s += (v[j].x * v[j].x + v[j].y * v[j].y) + (v[j].z * v[j].z + v[j].w * v[j].w); }
        const float rstd = 1.f / sqrtf(wave_sum(s) * (1.f / D) + EPS);
        const GAS f32x4* g4 = (const GAS f32x4*)gain + F.lane;
        const GAS f32x4* sh4 = (const GAS f32x4*)(modl + (size_t)b * NMOD + shift_slot * D) + F.lane;
        const GAS f32x4* sc4 = (const GAS f32x4*)(modl + (size_t)b * NMOD + (shift_slot + 1) * D) + F.lane;
        GAS unsigned long long* o8 = (GAS unsigned long long*)(hn + (size_t)m * D) + F.lane;
#pragma unroll
        for (int j = 0; j < 4; ++j) { const f32x4 g = g4[64 * j], sh = sh4[64 * j], sc = sc4[64 * j];
            v[j] = (v[j] * rstd) * g * (sc + 1.0f) + sh;
            o8[64 * j] = (unsigned long long)pk2(v[j].x, v[j].y) | ((unsigned long long)pk2(v[j].z, v[j].w) << 32); }
        if (wg) {
            float mine = 0.f;
#pragma unroll 1
            for (int g = 0; g < 12; ++g) { float d = 0.f;
#pragma unroll
                for (int j = 0; j < 4; ++j) { const f32x4 w = ((const LAS f32x4*)(wgl + g * 1024))[F.lane + 64 * j]; d += (v[j].x * w.x + v[j].y * w.y) + (v[j].z * w.z + v[j].w * w.w); }
                d = wave_sum(d); mine = (F.lane == g) ? d : mine; }
            if (F.lane < 12) gates[(size_t)m * 12 + F.lane] = mine;
        }
    }
}
__global__ void __launch_bounds__(NWAVES * 64, 2) mk_fwd(Args args) {
    extern __shared__ __attribute__((aligned(16))) unsigned char lds[];
    Frame F;
    F.lds = (LAS unsigned char*)lds; F.MISC = (volatile LAS unsigned*)(F.lds + MISC_OFF);
    F.tid = threadIdx.x; F.lane = F.tid & 63; F.wave = __builtin_amdgcn_readfirstlane(F.tid >> 6);
    F.G = gridDim.x; { const int bx = blockIdx.x; F.vcu = (F.G % 8 == 0) ? (bx % 8) * (F.G / 8) + bx / 8 : bx; }
    unsigned char* ws = args.ws;
    F.ctl = (gu32*)(ws + WS_CTL);
    for (int u = F.tid; u < (LDS_BYTES - LDSCTL_OFF) / 4; u += NWAVES * 64) ((LAS unsigned*)(F.lds + LDSCTL_OFF))[u] = 0u;
    __syncthreads();
    XcdBarrier bar = xcd_barrier_post((unsigned*)(F.ctl + CW_BAR) + args.li * XCD_BAR_WORDS, F.MISC + 8);
    const int lo = args.ph_lo, hi = args.ph_hi;
#define IN(k) (lo <= (k) && (k) < hi)
#define SEAM(k) do { if (IN(k) && IN((k) + 1)) xcd_barrier(bar); } while (0)
    float* mod = (float*)(ws + WS_MOD); float* wgw = (float*)(ws + WS_WG); float* gates = (float*)(ws + WS_GATES);
    bf16* HN = (bf16*)(ws + WS_HN); bf16* Z = (bf16*)(ws + WS_Z); bf16* Y = (bf16*)(ws + WS_Y); bf16* HB = (bf16*)(ws + WS_H);
    if (IN(PH_PRO)) { p0_prologue(F, args); }
    SEAM(PH_PRO);
#pragma unroll
    for (int l = 0; l < DEPTH; ++l) {
        const int pb = 1 + PH_PER_LAYER * l;
        const float* modl = mod + (size_t)l * 8 * NMOD;
        const float* xin = (l == 0) ? args.in[0] : args.out;
        if (IN(pb + PL_NORM1)) norm_phase(F, xin, args.in[4] + l * D, modl, 0, HN, wgw + (size_t)l * 12 * 1024, gates);
        SEAM(pb + PL_NORM1);
        if (IN(pb + PL_INPROJ)) {
            pg8::Gemm g{HN, (const bf16*)(ws + WS_WIN) + (size_t)l * ZP * 1024, T, ZP, D}; pg8::StaticOrder S; S.init(T, ZP, F.G, (int)blockIdx.x);
            pg8::EpiBf16<0> E{Z, ZP};
            pg8::gemm_phase<pg8::EpiBf16<0>, pg8::StaticOrder, true, true>(F.lds + RING_OFF, g, S, E);
        }
        SEAM(pb + PL_INPROJ);
        if (IN(pb + PL_MIX)) {   }
        SEAM(pb + PL_MIX);
        if (IN(pb + PL_OUTPROJ)) {
            pg8::Gemm g{Y, (const bf16*)(ws + WS_WOUT) + (size_t)l * 1024 * 1024, T, D, D}; pg8::StaticOrder S; S.init(T, D, F.G, (int)blockIdx.x);
            pg8::EpiResGate E{xin, args.out, modl + 2 * D};
            pg8::gemm_phase<pg8::EpiResGate, pg8::StaticOrder, true, true>(F.lds + RING_OFF, g, S, E);
        }
        SEAM(pb + PL_OUTPROJ);
        if (IN(pb + PL_NORM2)) norm_phase(F, args.out, args.in[5] + l * D, modl, 3, HN, nullptr, nullptr);
        SEAM(pb + PL_NORM2);
        if (IN(pb + PL_FF1)) {
            pg8::Gemm g{HN, (const bf16*)(ws + WS_W1) + (size_t)l * 4096 * 1024, T, FF, D}; pg8::StaticOrder S; S.init(T, FF, F.G, (int)blockIdx.x);
            pg8::EpiBf16<2> E{HB, FF};
            pg8::gemm_phase<pg8::EpiBf16<2>, pg8::StaticOrder, true, true>(F.lds + RING_OFF, g, S, E);
        }
        SEAM(pb + PL_FF1);
        if (IN(pb + PL_FF2)) {
            pg8::Gemm g{HB, (const bf16*)(ws + WS_W2) + (size_t)l * 1024 * 4096, T, D, FF}; pg8::StaticOrder S; S.init(T, D, F.G, (int)blockIdx.x);
            pg8::EpiResGate E{args.out, args.out, modl + 5 * D};
            pg8::gemm_phase<pg8::EpiResGate, pg8::StaticOrder, true, true>(F.lds + RING_OFF, g, S, E);
        }
        SEAM(pb + PL_FF2);
    }
#undef IN
#undef SEAM
}

__global__ void __launch_bounds__(64) fox_cumsum_k(const float* __restrict__ gates, const float* __restrict__ fbias, float* __restrict__ Fcum) {
    const int h = blockIdx.x & 3, b = blockIdx.x >> 2, lane = threadIdx.x; __shared__ float tot[64];
    const float fb = fbias[h]; const float* g = gates + (size_t)b * SEQ * 12 + h; const int base = lane * 64;
    float s = 0.f; for (int i = 0; i < 64; ++i) s += logsigmoidf_(g[(size_t)(base + i) * 12] + fb);
    tot[lane] = s; __syncthreads();
    float run = 0.f; for (int k = 0; k < lane; ++k) run += tot[k];
    float* Fo = Fcum + (size_t)(b * NH + h) * SEQ + base;
    for (int i = 0; i < 64; ++i) { run += logsigmoidf_(g[(size_t)(base + i) * 12] + fb); Fo[i] = run; }
}

constexpr int KST = 68;
__global__ void __launch_bounds__(64) naive_fox_k(const bf16* __restrict__ z, const float* __restrict__ Fcum, const float* __restrict__ qn, const float* __restrict__ kn, bf16* __restrict__ y) {
    const int qt = (SEQ / 64 - 1) - blockIdx.x, h = blockIdx.y, b = blockIdx.z, tid = threadIdx.x;
    __shared__ float Ks[64 * KST], Vs[64 * KST], Ss[64 * 64], Fs[64];
    const size_t row = (size_t)b * SEQ + qt * 64 + tid;
    float q[64];
    { const bf16* qp = z + row * ZP + ZC_FQ + h * 64; float ss = 0.f;
#pragma unroll
      for (int d = 0; d < 64; ++d) { q[d] = bf2f(qp[d]); ss += q[d] * q[d]; }
      const float r = 1.f / sqrtf(ss * (1.f / 64.f) + EPS) * 0.125f;
#pragma unroll
      for (int d = 0; d < 64; ++d) q[d] = q[d] * r * qn[d]; }
    const float* Fh = Fcum + (size_t)(b * NH + h) * SEQ; const float Ft = Fh[qt * 64 + tid];
    float m = -INFINITY, l = 0.f, o[64];
#pragma unroll
    for (int d = 0; d < 64; ++d) o[d] = 0.f;
    for (int kt = 0; kt <= qt; ++kt) {
        __syncthreads();
        { const size_t krow = (size_t)b * SEQ + kt * 64 + tid; const bf16* kp = z + krow * ZP + ZC_FK + h * 64; const bf16* vp = z + krow * ZP + ZC_FV + h * 64;
          float kk[64]; float ss = 0.f;
#pragma unroll
          for (int d = 0; d < 64; ++d) { kk[d] = bf2f(kp[d]); ss += kk[d] * kk[d]; }
          const float r = 1.f / sqrtf(ss * (1.f / 64.f) + EPS);
#pragma unroll
          for (int d = 0; d < 64; ++d) { Ks[tid * KST + d] = kk[d] * r * kn[d]; Vs[tid * KST + d] = bf2f(vp[d]); }
          Fs[tid] = Fh[kt * 64 + tid]; }
        __syncthreads();
        float tmax = -INFINITY;
        for (int j = 0; j < 64; ++j) { float sc = 0.f;
#pragma unroll
            for (int d = 0; d < 64; ++d) sc += q[d] * Ks[j * KST + d];
            sc += Ft - Fs[j]; if (kt == qt && j > tid) sc = -INFINITY;
            Ss[j * 64 + tid] = sc; tmax = fmaxf(tmax, sc); }
        const float mn = fmaxf(m, tmax), alpha = __expf(m - mn); m = mn; l *= alpha;
#pragma unroll
        for (int d = 0; d < 64; ++d) o[d] *= alpha;
        for (int j = 0; j < 64; ++j) { const float p = __expf(Ss[j * 64 + tid] - mn); l += p;
#pragma unroll
            for (int d = 0; d < 64; ++d) o[d] += p * Vs[j * KST + d]; }
    }
    const bf16* gp = z + row * ZP + ZC_FG + h * 64; bf16* yp = y + row * D + 512 + h * 64; const float il = 1.f / l;
#pragma unroll
    for (int d = 0; d < 64; ++d) yp[d] = (bf16)f2bf(o[d] * il * sigmoidf_(bf2f(gp[d])));
}

__global__ void __launch_bounds__(64) naive_diff_k(const bf16* __restrict__ z, const float* __restrict__ qn, const float* __restrict__ kn, const float* __restrict__ lamv, const float* __restrict__ subg, int layer, bf16* __restrict__ y) {
    const int qt = (SEQ / 64 - 1) - blockIdx.x, h = blockIdx.y, b = blockIdx.z, tid = threadIdx.x;
    __shared__ float Ks[64 * KST], Vs[64 * KST], S1[64 * 64], S2[64 * 64];
    const float lam_init = 0.8f - 0.6f * expf(-0.3f * (float)layer);
    float d01 = 0.f, d23 = 0.f; for (int i = 0; i < 32; ++i) { d01 += lamv[i] * lamv[32 + i]; d23 += lamv[64 + i] * lamv[96 + i]; }
    const float lam = expf(d01) - expf(d23) + lam_init;
    const float slope = exp2f(-8.0f * (float)(h + 1) / 4.0f);
    const size_t row = (size_t)b * SEQ + qt * 64 + tid; const int tq = qt * 64 + tid;
    float q[64];
    { const bf16* qp = z + row * ZP + ZC_DQ + h * 64;
#pragma unroll
      for (int c = 0; c < 2; ++c) { float ss = 0.f;
#pragma unroll
          for (int d = 0; d < 32; ++d) { q[c * 32 + d] = bf2f(qp[c * 32 + d]); ss += q[c * 32 + d] * q[c * 32 + d]; }
          const float r = 1.f / sqrtf(ss * (1.f / 32.f) + EPS) * 0.17677669529663687f;
#pragma unroll
          for (int d = 0; d < 32; ++d) q[c * 32 + d] = q[c * 32 + d] * r * qn[d]; } }
    float m1 = -INFINITY, m2 = -INFINITY, l1 = 0.f, l2 = 0.f, o1[64], o2[64];
#pragma unroll
    for (int d = 0; d < 64; ++d) { o1[d] = 0.f; o2[d] = 0.f; }
    for (int kt = 0; kt <= qt; ++kt) {
        __syncthreads();
        { const size_t krow = (size_t)b * SEQ + kt * 64 + tid; const bf16* kp = z + krow * ZP + ZC_DK + h * 64; const bf16* vp = z + krow * ZP + ZC_DV + h * 64;
#pragma unroll
          for (int c = 0; c < 2; ++c) { float kk[32]; float ss = 0.f;
#pragma unroll
              for (int d = 0; d < 32; ++d) { kk[d] = bf2f(kp[c * 32 + d]); ss += kk[d] * kk[d]; }
              const float r = 1.f / sqrtf(ss * (1.f / 32.f) + EPS);
#pragma unroll
              for (int d = 0; d < 32; ++d) Ks[tid * KST + c * 32 + d] = kk[d] * r * kn[d]; }
#pragma unroll
          for (int d = 0; d < 64; ++d) Vs[tid * KST + d] = bf2f(vp[d]); }
        __syncthreads();
        float t1 = -INFINITY, t2 = -INFINITY;
        for (int j = 0; j < 64; ++j) { float s1 = 0.f, s2 = 0.f;
#pragma unroll
            for (int d = 0; d < 32; ++d) { s1 += q[d] * Ks[j * KST + d]; s2 += q[32 + d] * Ks[j * KST + 32 + d]; }
            const float bias = -slope * (float)(tq - (kt * 64 + j)); s1 += bias; s2 += bias;
            if (kt == qt && j > tid) { s1 = -INFINITY; s2 = -INFINITY; }
            S1[j * 64 + tid] = s1; S2[j * 64 + tid] = s2; t1 = fmaxf(t1, s1); t2 = fmaxf(t2, s2); }
        const float n1 = fmaxf(m1, t1), n2 = fmaxf(m2, t2), a1 = __expf(m1 - n1), a2 = __expf(m2 - n2); m1 = n1; m2 = n2; l1 *= a1; l2 *= a2;
#pragma unroll
        for (int d = 0; d < 64; ++d) { o1[d] *= a1; o2[d] *= a2; }
        for (int j = 0; j < 64; ++j) { const float p1 = __expf(S1[j * 64 + tid] - n1), p2 = __expf(S2[j * 64 + tid] - n2); l1 += p1; l2 += p2;
#pragma unroll
            for (int d = 0; d < 64; ++d) { const float v = Vs[j * KST + d]; o1[d] += p1 * v; o2[d] += p2 * v; } }
    }
    const float i1 = 1.f / l1, i2 = lam / l2; float ss = 0.f;
#pragma unroll
    for (int d = 0; d < 64; ++d) { o1[d] = o1[d] * i1 - o2[d] * i2; ss += o1[d] * o1[d]; }
    const float r = 1.f / sqrtf(ss * (1.f / 64.f) + EPS) * (1.f - lam_init);
    bf16* yp = y + row * D + 256 + h * 64;
#pragma unroll
    for (int d = 0; d < 64; ++d) yp[d] = (bf16)f2bf(o1[d] * r * subg[d]);
}

__global__ void __launch_bounds__(64) naive_hgrn2_k(const bf16* __restrict__ z, const float* __restrict__ lbl, const float* __restrict__ ng, int layer, bf16* __restrict__ y) {
    const int h = blockIdx.x & 3, b = blockIdx.x >> 2, j = threadIdx.x, c = h * 64 + j;
    __shared__ float qs[64], fs[64], ks[64];
    float lb = 0.f; if (layer == 1) { const float a0 = lbl[c], a1 = lbl[256 + c]; const float mx = fmaxf(a0, a1); const float e0 = expf(a0 - mx), e1 = expf(a1 - mx); lb = e1 / (e0 + e1); }
    float S[64];
#pragma unroll
    for (int d = 0; d < 64; ++d) S[d] = 0.f;
    const float gj = ng[j];
    const bf16* zp = z + (size_t)b * SEQ * ZP + c;
    float nq = bf2f(zp[ZC_HQ]), nf = bf2f(zp[ZC_HF]), ni = bf2f(zp[ZC_HI]), ngv = bf2f(zp[ZC_HG]);
    for (int t = 0; t < SEQ; ++t) {
        const float qv = nq, fp = nf, iv = ni, gv = ngv;
        if (t + 1 < SEQ) { const bf16* zn = zp + (size_t)(t + 1) * ZP; nq = bf2f(zn[ZC_HQ]); nf = bf2f(zn[ZC_HF]); ni = bf2f(zn[ZC_HI]); ngv = bf2f(zn[ZC_HG]); }
        const float f = lb + (1.f - lb) * sigmoidf_(fp);
        __syncthreads();
        qs[j] = qv; fs[j] = f; ks[j] = 1.f - f;
        __syncthreads();
        float acc = 0.f;
#pragma unroll
        for (int d = 0; d < 64; ++d) { S[d] = fs[d] * S[d] + ks[d] * iv; acc += S[d] * qs[d]; }
        const float ss = wave_sum(acc * acc);
        const float o = acc * (1.f / sqrtf(ss * (1.f / 64.f) + EPS)) * gj;
        y[((size_t)b * SEQ + t) * D + c] = (bf16)f2bf(o * gv * sigmoidf_(gv));
    }
}

__global__ void __launch_bounds__(64) naive_mlstm_k(const bf16* __restrict__ z, const float* __restrict__ gates, const float* __restrict__ convw, const float* __restrict__ ibias, const float* __restrict__ fbias, bf16* __restrict__ y) {
    const int h = blockIdx.x & 3, b = blockIdx.x >> 2, j = threadIdx.x, c = h * 64 + j;
    __shared__ float qs[64], ks[64];
    float C[64];
#pragma unroll
    for (int d = 0; d < 64; ++d) C[d] = 0.f;
    float nj = 0.f;
    const float wq0 = convw[0 * 512 + c], wq1 = convw[1 * 512 + c], wq2 = convw[2 * 512 + c], wq3 = convw[3 * 512 + c];
    const float wk0 = convw[0 * 512 + 256 + c], wk1 = convw[1 * 512 + 256 + c], wk2 = convw[2 * 512 + 256 + c], wk3 = convw[3 * 512 + 256 + c];
    const float ib = ibias[h], fb = fbias[h];
    float q1 = 0.f, q2 = 0.f, q3 = 0.f, k1 = 0.f, k2 = 0.f, k3 = 0.f;
    const bf16* zp = z + (size_t)b * SEQ * ZP + c; const float* gp = gates + (size_t)b * SEQ * 12;
    float nq = bf2f(zp[ZC_MQ]), nk = bf2f(zp[ZC_MK]), nv = bf2f(zp[ZC_MV]), no = bf2f(zp[ZC_MO]), ngi = gp[4 + h], ngf = gp[8 + h];
    for (int t = 0; t < SEQ; ++t) {
        const float q0 = nq, k0 = nk, v = nv, op = no, gi = ngi, gf = ngf;
        if (t + 1 < SEQ) { const bf16* zn = zp + (size_t)(t + 1) * ZP; nq = bf2f(zn[ZC_MQ]); nk = bf2f(zn[ZC_MK]); nv = bf2f(zn[ZC_MV]); no = bf2f(zn[ZC_MO]); ngi = gp[(size_t)(t + 1) * 12 + 4 + h]; ngf = gp[(size_t)(t + 1) * 12 + 8 + h]; }
        float qc = wq3 * q0 + wq2 * q1 + wq1 * q2 + wq0 * q3, kc = wk3 * k0 + wk2 * k1 + wk1 * k2 + wk0 * k3;
        q3 = q2; q2 = q1; q1 = q0; k3 = k2; k2 = k1; k1 = k0;
        qc = qc * sigmoidf_(qc) * 0.125f; kc = kc * sigmoidf_(kc);
        const float it = expf(gi + ib), ft = 1.f / (1.f + expf(-(gf + fb)));
        __syncthreads();
        qs[j] = qc; ks[j] = kc;
        __syncthreads();
        float num = 0.f; const float iv = it * v;
#pragma unroll
        for (int d = 0; d < 64; ++d) { C[d] = ft * C[d] + ks[d] * iv; num += C[d] * qs[d]; }
        nj = ft * nj + it * kc;
        const float den = wave_sum(nj * qc);
        const float hh = num / fmaxf(fabsf(den), 1.f);
        y[((size_t)b * SEQ + t) * D + 768 + c] = (bf16)f2bf(sigmoidf_(op) * hh);
    }
}

extern "C" void kernel_launch(void* const* d_in, const int* in_sizes, int n_in, void* d_out, int out_size, void* d_ws, size_t ws_size, hipStream_t stream) {
    static int grid = 0;
    if (grid == 0) {
        if (n_in != 22 || in_sizes[0] != T * D || out_size != T * D || ws_size < WS_END) { fprintf(stderr, "kernel_launch: unexpected shapes (n_in %d, in0 %d, out %d, ws %zu)\n", n_in, n_in > 0 ? in_sizes[0] : -1, out_size, ws_size); grid = -1; return; }
        int dev = 0, cus = 0;
        if (hipGetDevice(&dev) != hipSuccess || hipDeviceGetAttribute(&cus, hipDeviceAttributeMultiprocessorCount, dev) != hipSuccess) { grid = -1; return; }
        if (hipFuncSetAttribute((const void*)mk_fwd, hipFuncAttributeMaxDynamicSharedMemorySize, LDS_BYTES) != hipSuccess) { fprintf(stderr, "kernel_launch: hipFuncSetAttribute failed\n"); grid = -1; return; }
        (void)hipGetLastError();
        grid = cus;
    }
    if (grid < 0) return;
    (void)hipMemsetAsync((char*)d_ws + WS_CTL, 0, CTL_ZERO_BYTES, stream);
    Args a{};
    for (int i = 0; i < 22; ++i) a.in[i] = (const float*)d_in[i];
    a.out = (float*)d_out; a.ws = (unsigned char*)d_ws;
    unsigned char* ws = (unsigned char*)d_ws;
    const bf16* Z = (const bf16*)(ws + WS_Z); bf16* Y = (bf16*)(ws + WS_Y); const float* gates = (const float*)(ws + WS_GATES); float* Fcum = (float*)(ws + WS_FCUM);
    const int cuts[4] = {0, 1 + PL_MIX, 1 + PH_PER_LAYER + PL_MIX, NPH};
    for (int li = 0; li < 3; ++li) {
        a.ph_lo = cuts[li] + (li > 0 ? 1 : 0); a.ph_hi = cuts[li + 1]; a.li = li;
        hipLaunchKernelGGL(mk_fwd, dim3(grid), dim3(NWAVES * 64), LDS_BYTES, stream, a);
        if (li < 2) {
            const int l = li;
            hipLaunchKernelGGL(fox_cumsum_k, dim3(BATCH * NH), dim3(64), 0, stream, gates, a.in[16] + l * NH, Fcum);
            hipLaunchKernelGGL(naive_hgrn2_k, dim3(BATCH * NH), dim3(64), 0, stream, Z, a.in[8], a.in[9] + l * HD, l, Y);
            hipLaunchKernelGGL(naive_mlstm_k, dim3(BATCH * NH), dim3(64), 0, stream, Z, gates, a.in[17] + (size_t)l * 4 * 512, a.in[18] + l * NH, a.in[19] + l * NH, Y);
            hipLaunchKernelGGL(naive_fox_k, dim3(SEQ / 64, NH, BATCH), dim3(64), 0, stream, Z, (const float*)Fcum, a.in[14] + l * HD, a.in[15] + l * HD, Y);
            hipLaunchKernelGGL(naive_diff_k, dim3(SEQ / 64, NH, BATCH), dim3(64), 0, stream, Z, a.in[10] + l * 32, a.in[11] + l * 32, a.in[12] + l * 128, a.in[13] + l * HD, l, Y);
        }
    }
}
```

```cpp
#include <hip/hip_runtime.h>
#include <cstdio>
#include <cstdint>
#include <cmath>
#define ATTN_IN_MK 1
#define NEWPREP_H 1
#define NEWPREP_M 1
namespace pg8 {
#define PG8_LAS __attribute__((address_space(3)))
typedef unsigned short bf16_t;
typedef short bf16x8 __attribute__((ext_vector_type(8)));
typedef float f32x4 __attribute__((ext_vector_type(4)));
typedef unsigned u32x4 __attribute__((ext_vector_type(4)));
constexpr int BM = 256, BK = 64, HALF = 128, HTB = HALF * BK * 2  , STAGE_BYTES = 8 * HTB, NXCD = 8, WGM = 8;

__host__ __device__ __forceinline__ int lds_byte(int r, int c) { const int st = (r >> 4) * 2 + (c >> 5), rr = r & 15, cc = c & 31, ob = rr * 64 + cc * 2; return st * 1024 + (ob ^ (((ob >> 9) & 1) << 5)); }
__host__ __device__ __forceinline__ void stage_rc(int b, int& R, int& C) { const int st = b / 1024, sb = b % 1024, swz = sb ^ (((sb >> 9) & 1) << 5); R = (st >> 1) * 16 + swz / 64; C = (st & 1) * 32 + (swz % 64) / 2; }
__host__ __device__ __forceinline__ int perm32(int rho) { const int n = rho >> 4, i = rho & 15; return 8 * (i >> 2) + 4 * n + (i & 3); }

struct Unit { int pm, pn; };
struct Gemm { const bf16_t* A; const bf16_t* Bt; int M, N, K; };

struct StaticOrder {
    int nM, nN, nwg, G, c;
    __host__ __device__ void init(int M, int N, int G_, int c_) { nM = M / BM; nN = N / BM; nwg = nM * nN; G = G_; c = c_; }
    __host__ __device__ bool next(int i, Unit& u) const {
        const long L = (long)i * G + c; if (L >= nwg) return false;
        int wgid = (int)L; { const int q = nwg / NXCD, r = nwg % NXCD, xcd = wgid % NXCD, off = wgid / NXCD; wgid = (xcd < r ? xcd * (q + 1) : r * (q + 1) + (xcd - r) * q) + off; }
        const int nig = WGM * nN, gid = wgid / nig, fm = gid * WGM, gsz = (nM - fm) < WGM ? (nM - fm) : WGM;
        u.pm = fm + ((wgid % nig) % gsz); u.pn = (wgid % nig) / gsz; return true;
    }
    __device__ __forceinline__ void a_ready(const Unit&) const {}
    __device__ __forceinline__ void done(const Unit&) const {}
};

typedef __bf16 cv_bf16x2 __attribute__((ext_vector_type(2))); typedef float cv_f32x2 __attribute__((ext_vector_type(2)));
__device__ __forceinline__ unsigned cvt_pk_bf16(float lo, float hi) { unsigned r; asm volatile("v_cvt_pk_bf16_f32 %0, %1, %2" : "=v"(r) : "v"(lo), "v"(hi)); return r; }
template <int ACT> struct EpiBf16 {
    static constexpr bool PERM = true, SWZ = false, AFTER_DRAIN = false;
    bf16_t* O; int ldc;
    __device__ __forceinline__ void operator()(const f32x4 (&acc)[2][2][4][2], const Unit& u, int wr, int wc, int fr, int fq) const {
        const int row0 = u.pm * BM + wr * 64 + fr; const int col0 = u.pn * BM + wc * 32 + 8 * fq;
#pragma unroll
        for (int ai = 0; ai < 2; ++ai)
#pragma unroll
            for (int m = 0; m < 4; ++m) { bf16_t* rowp = O + (size_t)(row0 + ai * HALF + m * 16) * ldc + col0;
#pragma unroll
                for (int bj = 0; bj < 2; ++bj) { f32x4 v0 = acc[ai][bj][m][0], v1 = acc[ai][bj][m][1];
                    if (ACT == 2) {
#pragma unroll
                        for (int e = 0; e < 4; ++e) { const float a = fmaxf(v0[e], 0.f), b = fmaxf(v1[e], 0.f); v0[e] = a * a; v1[e] = b * b; } }
                    u32x4 w; w.x = cvt_pk_bf16(v0[0], v0[1]); w.y = cvt_pk_bf16(v0[2], v0[3]); w.z = cvt_pk_bf16(v1[0], v1[1]); w.w = cvt_pk_bf16(v1[2], v1[3]);
                    *(u32x4*)(rowp + bj * HALF) = w; } }
    }
};
template <bool BF> __device__ __forceinline__ void ld_res8(const void* p, size_t idx, f32x4& lo, f32x4& hi) {
    if (BF) { const u32x4 w = *(const u32x4*)((const bf16_t*)p + idx);
        lo = (f32x4){__builtin_bit_cast(float, w.x << 16), __builtin_bit_cast(float, w.x & 0xffff0000u), __builtin_bit_cast(float, w.y << 16), __builtin_bit_cast(float, w.y & 0xffff0000u)};
        hi = (f32x4){__builtin_bit_cast(float, w.z << 16), __builtin_bit_cast(float, w.z & 0xffff0000u), __builtin_bit_cast(float, w.w << 16), __builtin_bit_cast(float, w.w & 0xffff0000u)}; }
    else { lo = *(const f32x4*)((const float*)p + idx); hi = *(const f32x4*)((const float*)p + idx + 4); } }
template <bool BF> __device__ __forceinline__ void st_res8(void* p, size_t idx, f32x4 lo, f32x4 hi) {
    if (BF) { u32x4 w; w.x = cvt_pk_bf16(lo[0], lo[1]); w.y = cvt_pk_bf16(lo[2], lo[3]); w.z = cvt_pk_bf16(hi[0], hi[1]); w.w = cvt_pk_bf16(hi[2], hi[3]); *(u32x4*)((bf16_t*)p + idx) = w; }
    else { *(f32x4*)((float*)p + idx) = lo; *(f32x4*)((float*)p + idx + 4) = hi; } }
template <bool BASE_BF, bool OUT_BF> struct EpiResGate {
    static constexpr bool PERM = true, SWZ = false, AFTER_DRAIN = false; static constexpr int CW = SWZ ? 64 : 32, BJ = SWZ ? 32 : HALF;
    const void* base; void* out; const float* gate;
    __device__ __forceinline__ void operator()(const f32x4 (&acc)[2][2][4][2], const Unit& u, int wr, int wc, int fr, int fq) const {
        const int col0 = u.pn * BM + wc * CW + 8 * fq; const int b = (u.pm * BM) >> 12;
        const float* gp = gate + (size_t)b * 6144 + col0;
        f32x4 gv[2][2];
#pragma unroll
        for (int bj = 0; bj < 2; ++bj)
#pragma unroll
            for (int n = 0; n < 2; ++n) gv[bj][n] = *(const f32x4*)(gp + bj * BJ + 4 * n);
#pragma unroll
        for (int ai = 0; ai < 2; ++ai)
#pragma unroll
            for (int m = 0; m < 4; ++m) { const size_t off = (size_t)(u.pm * BM + ai * HALF + wr * 64 + m * 16 + fr) * 1024 + col0;
#pragma unroll
                for (int bj = 0; bj < 2; ++bj) { f32x4 b0, b1; ld_res8<BASE_BF>(base, off + bj * BJ, b0, b1);
                    st_res8<OUT_BF>(out, off + bj * BJ, b0 + gv[bj][0] * acc[ai][bj][m][0], b1 + gv[bj][1] * acc[ai][bj][m][1]); }
                if (m & 1) asm volatile("" ::: "memory"); }
    }
};
template <bool BASE_BF, bool OUT_BF> struct EpiResGateN {
    static_assert(OUT_BF, "the staged stores write bf16");
    static constexpr bool PERM = true, SWZ = true, AFTER_DRAIN = false; static constexpr int CW = 64, BJ = 32;
    const void* base; void* out; const float* gate; const float* gm; bf16_t* hn; float* ssq; PG8_LAS float* xch; PG8_LAS unsigned char* stg;
    __device__ __forceinline__ void operator()(const f32x4 (&acc)[2][2][4][2], const Unit& u, int wr, int wc, int fr, int fq) const {
        const int col0 = u.pn * BM + wc * CW + 8 * fq; const int b = (u.pm * BM) >> 12;
        const float* gp = gate + (size_t)b * 6144 + col0; const float* mp = gm + (size_t)b * 1024 + col0;
        f32x4 gv[2][2], mv[2][2];
#pragma unroll
        for (int bj = 0; bj < 2; ++bj)
#pragma unroll
            for (int n = 0; n < 2; ++n) { gv[bj][n] = *(const f32x4*)(gp + bj * BJ + 4 * n); mv[bj][n] = *(const f32x4*)(mp + bj * BJ + 4 * n); }
        PG8_LAS unsigned char* sw = stg + (wr * 4 + wc) * 2048;
        const int lane_ = fq * 16 + fr, rr_ = lane_ >> 3, cc_ = lane_ & 7;
        PG8_LAS unsigned char* wp_ = sw + fr * 128; const int wx_ = fr & 7;
        PG8_LAS unsigned char* rp_ = sw + rr_ * 128 + ((cc_ ^ (rr_ & 7)) << 4);
        const size_t goff_ = (size_t)(u.pm * BM + wr * 64 + rr_) * 1024 + u.pn * BM + wc * 64 + cc_ * 8;
#define RG_PUT(bj, w) (*(PG8_LAS u32x4*)(wp_ + (((4 * (bj) + fq) ^ wx_) << 4)) = (w))
#define RG_FLUSH(dst, ai, m) do { asm volatile("s_waitcnt lgkmcnt(0)" ::: "memory"); const u32x4 o0_ = *(const PG8_LAS u32x4*)rp_, o1_ = *(const PG8_LAS u32x4*)(rp_ + 1024); asm volatile("s_waitcnt lgkmcnt(0)" ::: "memory"); \
            bf16_t* g_ = (dst) + goff_ + (size_t)((ai) * HALF + (m) * 16) * 1024; *(u32x4*)g_ = o0_; *(u32x4*)(g_ + (size_t)8 * 1024) = o1_; } while (0)
#pragma unroll
        for (int ai = 0; ai < 2; ++ai)
#pragma unroll
            for (int m = 0; m < 4; ++m) { const int rl = ai * HALF + wr * 64 + m * 16 + fr; const size_t off = (size_t)(u.pm * BM + rl) * 1024 + col0; float s = 0.f;
                u32x4 wxb[2], whn[2];
#pragma unroll
                for (int bj = 0; bj < 2; ++bj) { f32x4 b0, b1; ld_res8<BASE_BF>(base, off + bj * BJ, b0, b1);
                    const f32x4 x0 = b0 + gv[bj][0] * acc[ai][bj][m][0], x1 = b1 + gv[bj][1] * acc[ai][bj][m][1];
                    s += ((x0[0] * x0[0] + x0[1] * x0[1]) + (x0[2] * x0[2] + x0[3] * x0[3])) + ((x1[0] * x1[0] + x1[1] * x1[1]) + (x1[2] * x1[2] + x1[3] * x1[3]));
                    wxb[bj].x = cvt_pk_bf16(x0[0], x0[1]); wxb[bj].y = cvt_pk_bf16(x0[2], x0[3]); wxb[bj].z = cvt_pk_bf16(x1[0], x1[1]); wxb[bj].w = cvt_pk_bf16(x1[2], x1[3]);
                    const f32x4 h0 = x0 * mv[bj][0], h1 = x1 * mv[bj][1];
                    whn[bj].x = cvt_pk_bf16(h0[0], h0[1]); whn[bj].y = cvt_pk_bf16(h0[2], h0[3]); whn[bj].z = cvt_pk_bf16(h1[0], h1[1]); whn[bj].w = cvt_pk_bf16(h1[2], h1[3]); }
                RG_PUT(0, wxb[0]); RG_PUT(1, wxb[1]); RG_FLUSH((bf16_t*)out, ai, m);
                RG_PUT(0, whn[0]); RG_PUT(1, whn[1]); RG_FLUSH(hn, ai, m);
                s += __shfl_xor(s, 16); s += __shfl_xor(s, 32);
                if (fq == 0) xch[rl * 4 + wc] = s; }
#undef RG_PUT
#undef RG_FLUSH
        asm volatile("s_waitcnt lgkmcnt(0)" ::: "memory"); __builtin_amdgcn_s_barrier(); asm volatile("" ::: "memory");
        const int tid = (wr * 4 + wc) * 64 + fq * 16 + fr;
        if (tid < 256) { const f32x4 p = *(const PG8_LAS f32x4*)(xch + tid * 4); ssq[(size_t)(u.pm * BM + tid) * 4 + u.pn] = (p[0] + p[1]) + (p[2] + p[3]); }
    }
};
struct EpiFF1 {
    static constexpr bool PERM = true, SWZ = true, AFTER_DRAIN = false;
    bf16_t* O; int ldc; const float* ssq; const float* bias; PG8_LAS unsigned char* stg;
    __device__ __forceinline__ void operator()(const f32x4 (&acc)[2][2][4][2], const Unit& u, int wr, int wc, int fr, int fq) const {
        const int rowb = u.pm * BM + wr * 64; const int colw = u.pn * BM + wc * 64; const int b = (u.pm * BM) >> 12;
        const float* bp = bias + (size_t)b * 4096 + colw + 8 * fq;
        f32x4 bv[2][2];
#pragma unroll
        for (int bj = 0; bj < 2; ++bj)
#pragma unroll
            for (int n = 0; n < 2; ++n) bv[bj][n] = *(const f32x4*)(bp + bj * 32 + 4 * n);
        PG8_LAS unsigned char* sw = stg + (wr * 4 + wc) * 2048;
        const int lane = fq * 16 + fr, rr = lane >> 3, cc = lane & 7;
        PG8_LAS unsigned char* wp = sw + fr * 128; const int wx = fr & 7;
        PG8_LAS unsigned char* rp = sw + rr * 128 + ((cc ^ (rr & 7)) << 4);
        bf16_t* gp = O + (size_t)(rowb + rr) * ldc + colw + cc * 8;
#pragma unroll
        for (int ai = 0; ai < 2; ++ai)
#pragma unroll
            for (int m = 0; m < 4; ++m) { const int row = rowb + ai * HALF + m * 16 + fr;
                const f32x4 p = *(const f32x4*)(ssq + (size_t)row * 4); const float r = __builtin_amdgcn_rsqf(((p[0] + p[1]) + (p[2] + p[3])) * (1.f / 1024.f) + 1e-6f);
#pragma unroll
                for (int bj = 0; bj < 2; ++bj) { f32x4 v0 = acc[ai][bj][m][0] * r + bv[bj][0], v1 = acc[ai][bj][m][1] * r + bv[bj][1];
#pragma unroll
                    for (int e = 0; e < 4; ++e) { const float a = fmaxf(v0[e], 0.f), c = fmaxf(v1[e], 0.f); v0[e] = a * a; v1[e] = c * c; }
                    u32x4 w; w.x = cvt_pk_bf16(v0[0], v0[1]); w.y = cvt_pk_bf16(v0[2], v0[3]); w.z = cvt_pk_bf16(v1[0], v1[1]); w.w = cvt_pk_bf16(v1[2], v1[3]);
                    *(PG8_LAS u32x4*)(wp + (((4 * bj + fq) ^ wx) << 4)) = w; }
                asm volatile("s_waitcnt lgkmcnt(0)" ::: "memory");
                const u32x4 o0 = *(const PG8_LAS u32x4*)rp, o1 = *(const PG8_LAS u32x4*)(rp + 1024);
                asm volatile("s_waitcnt lgkmcnt(0)" ::: "memory");
                bf16_t* g = gp + (size_t)(ai * HALF + m * 16) * ldc;
                *(u32x4*)g = o0; *(u32x4*)(g + (size_t)8 * ldc) = o1; }
    }
};
struct EpiInProj {
    static constexpr bool PERM = true, SWZ = true, AFTER_DRAIN = false;
    bf16_t* O; int ldc; const float* qkg  ; PG8_LAS unsigned char* stg  ;
    const float* ssq  ; const float* bias  ; float* gates  ; float* fgt  ;
    __device__ __forceinline__ void operator()(f32x4 (&acc)[2][2][4][2], const Unit& u, int wr, int wc, int fr, int fq) const {
        asm volatile("" : "+v"(fr), "+v"(fq));
        const int row0 = u.pm * BM + wr * 64 + fr; const int col0 = u.pn * BM + wc * 64 + 8 * fq;
        const int pn = u.pn; const bool nrm = (pn == 4) | (pn == 5) | (pn == 7) | (pn == 8);
        { const int b = (u.pm * BM) >> 12; const float* bp = bias + (size_t)b * 4096 + col0;
          f32x4 bv[2][2];
#pragma unroll
          for (int bj = 0; bj < 2; ++bj)
#pragma unroll
              for (int n = 0; n < 2; ++n) bv[bj][n] = *(const f32x4*)(bp + bj * 32 + 4 * n);
#pragma unroll
          for (int ai = 0; ai < 2; ++ai)
#pragma unroll
              for (int m = 0; m < 4; ++m) { const f32x4 p = *(const f32x4*)(ssq + (size_t)(row0 + ai * HALF + m * 16) * 4); const float r = __builtin_amdgcn_rsqf(((p[0] + p[1]) + (p[2] + p[3])) * (1.f / 1024.f) + 1e-6f);
#pragma unroll
                  for (int bj = 0; bj < 2; ++bj)
#pragma unroll
                      for (int n = 0; n < 2; ++n) acc[ai][bj][m][n] = acc[ai][bj][m][n] * r + bv[bj][n]; } }
        if (pn == 15) {
            int fq2 = fq; asm volatile("" : "+v"(fq2));
            if (wc == 0 && fq2 < 2) { const int b = (u.pm * BM) >> 12;
#pragma unroll
                for (int ai = 0; ai < 2; ++ai)
#pragma unroll
                    for (int m = 0; m < 4; ++m) { const int row = row0 + ai * HALF + m * 16; float* gp = gates + (size_t)row * 12 + 8 * fq2;
                        *(f32x4*)gp = acc[ai][0][m][0]; if (fq2 == 0) { *(f32x4*)(gp + 4) = acc[ai][0][m][1];
#pragma unroll
                            for (int e = 0; e < 4; ++e) fgt[(size_t)(b * 4 + e) * 4096 + (row & 4095)] = acc[ai][0][m][0][e]; } } }
            return;
        }
        PG8_LAS unsigned char* sw = stg + (wr * 4 + wc) * 2048;
        const int lane_ = fq * 16 + fr, rr_ = lane_ >> 3, cc_ = lane_ & 7;
        PG8_LAS unsigned char* wp_ = sw + fr * 128; const int wx_ = fr & 7;
        PG8_LAS unsigned char* rp_ = sw + rr_ * 128 + ((cc_ ^ (rr_ & 7)) << 4);
        bf16_t* gp_ = O + (size_t)(u.pm * BM + wr * 64 + rr_) * ldc + u.pn * BM + wc * 64 + cc_ * 8;
#define INPROJ_PUT(bj, w) (*(PG8_LAS u32x4*)(wp_ + (((4 * (bj) + fq) ^ wx_) << 4)) = (w))
#define INPROJ_FLUSH(ai, m) do { asm volatile("s_waitcnt lgkmcnt(0)" ::: "memory"); const u32x4 o0_ = *(const PG8_LAS u32x4*)rp_, o1_ = *(const PG8_LAS u32x4*)(rp_ + 1024); asm volatile("s_waitcnt lgkmcnt(0)" ::: "memory"); \
            bf16_t* g_ = gp_ + (size_t)((ai) * HALF + (m) * 16) * ldc; *(u32x4*)g_ = o0_; *(u32x4*)(g_ + (size_t)8 * ldc) = o1_; } while (0)
        if (!nrm) {
#pragma unroll
            for (int ai = 0; ai < 2; ++ai)
#pragma unroll
                for (int m = 0; m < 4; ++m) {
#pragma unroll
                    for (int bj = 0; bj < 2; ++bj) { const f32x4 v0 = acc[ai][bj][m][0], v1 = acc[ai][bj][m][1];
                        u32x4 w; w.x = cvt_pk_bf16(v0[0], v0[1]); w.y = cvt_pk_bf16(v0[2], v0[3]); w.z = cvt_pk_bf16(v1[0], v1[1]); w.w = cvt_pk_bf16(v1[2], v1[3]);
                        INPROJ_PUT(bj, w); }
                    INPROJ_FLUSH(ai, m); }
            return;
        }
        const bool wide = (pn >= 7);
        const float inv_n = wide ? (1.f / 64.f) : (1.f / 32.f);
        const float* gp = qkg + ((pn == 4) ? 0 : (pn == 5 ? 64 : (pn == 7 ? 128 : 192)));
        f32x4 gq[2][2];
#pragma unroll
        for (int bj = 0; bj < 2; ++bj) { const int gcol = (wide ? 32 * bj : 0) + 8 * fq; gq[bj][0] = *(const f32x4*)(gp + gcol); gq[bj][1] = *(const f32x4*)(gp + gcol + 4); }
#pragma unroll
        for (int ai = 0; ai < 2; ++ai)
#pragma unroll
            for (int m = 0; m < 4; ++m) { float sg[2];
#pragma unroll
                for (int bj = 0; bj < 2; ++bj) { const f32x4 a = acc[ai][bj][m][0], b = acc[ai][bj][m][1];
                    float s = (a[0] * a[0] + a[1] * a[1]) + (a[2] * a[2] + a[3] * a[3]) + (b[0] * b[0] + b[1] * b[1]) + (b[2] * b[2] + b[3] * b[3]);
                    s += __shfl_xor(s, 16); s += __shfl_xor(s, 32); sg[bj] = s; }
                const float tot = sg[0] + sg[1];
#pragma unroll
                for (int bj = 0; bj < 2; ++bj) { const float r = __builtin_amdgcn_rsqf((wide ? tot : sg[bj]) * inv_n + 1e-6f);
                    const f32x4 v0 = acc[ai][bj][m][0] * gq[bj][0] * r, v1 = acc[ai][bj][m][1] * gq[bj][1] * r;
                    u32x4 w; w.x = cvt_pk_bf16(v0[0], v0[1]); w.y = cvt_pk_bf16(v0[2], v0[3]); w.z = cvt_pk_bf16(v1[0], v1[1]); w.w = cvt_pk_bf16(v1[2], v1[3]);
                    INPROJ_PUT(bj, w); }
                INPROJ_FLUSH(ai, m); }
#undef INPROJ_PUT
#undef INPROJ_FLUSH
    }
};
template <class Epi, class Sched, bool ALIGN_EPI = false, bool SP2 = false>
__device__ __forceinline__ void gemm_phase(PG8_LAS unsigned char* lds, const Gemm g, const Sched& S, const Epi& E) {
    int tid_ = threadIdx.x; asm volatile("" : "+v"(tid_));
    const int tid = tid_, wid = __builtin_amdgcn_readfirstlane(tid >> 6), lane = tid & 63, wr = wid >> 2, wc = wid & 3, fr = lane & 15, fq = lane >> 4;
    const int K = g.K, nt = K / BK;
    unsigned voffA[2], voffB[2];
#pragma unroll
    for (int i = 0; i < 2; ++i) { int R, C; stage_rc(tid * 16 + i * 8192, R, C); const int Rb = Epi::SWZ ? ((R >> 5) * 64 + perm32(R & 31)) : Epi::PERM ? ((R & ~31) + perm32(R & 31)) : R;
        voffA[i] = (unsigned)(R * K + C) * 2u; voffB[i] = (unsigned)(Rb * K + C) * 2u; }
    const size_t kstep = (size_t)(BK * 2);
    const size_t hstep = (size_t)HALF * K * 2;
    const size_t hstepB = Epi::SWZ ? (size_t)32 * K * 2 : hstep;
    const size_t tstep = 2 * hstep;
    const unsigned ldsw = (unsigned)wid * 1024u;
    const int aoff = lds_byte(wr * 64 + fr, fq * 8), boff = lds_byte(wc * 32 + fr, fq * 8);
#define PG8_SA(b, h) (((b) * 2 + (h)) * HTB)
#define PG8_SB(b, h) ((4 + (b) * 2 + (h)) * HTB)
#define PG8_STAGE(bufoff, gbase, voff) do { _Pragma("unroll") for (int _i = 0; _i < 2; ++_i) \
        __builtin_amdgcn_global_load_lds((const unsigned*)((const char*)(gbase) + (voff)[_i]), (PG8_LAS unsigned*)(lds + (bufoff) + ldsw + _i * 8192), 16, 0, 0); } while (0)
#define PG8_LDA(dst, b, h) do { _Pragma("unroll") for (int m = 0; m < 4; ++m) _Pragma("unroll") for (int k = 0; k < 2; ++k) dst[m][k] = *(const PG8_LAS bf16x8*)(lds + PG8_SA(b, h) + aoff + m * 2048 + k * 1024); } while (0)
#define PG8_LDB(dst, b, h) do { _Pragma("unroll") for (int n = 0; n < 2; ++n) _Pragma("unroll") for (int k = 0; k < 2; ++k) dst[n][k] = *(const PG8_LAS bf16x8*)(lds + PG8_SB(b, h) + boff + n * 2048 + k * 1024); } while (0)
#define PG8_MMA(ai, bj, At, Bt) do { __builtin_amdgcn_s_setprio(1); _Pragma("unroll") for (int m = 0; m < 4; ++m) _Pragma("unroll") for (int n = 0; n < 2; ++n) _Pragma("unroll") for (int k = 0; k < 2; ++k) \
        acc[ai][bj][m][n] = __builtin_amdgcn_mfma_f32_16x16x32_bf16(Bt[n][k], At[m][k], acc[ai][bj][m][n], 0, 0, 0); __builtin_amdgcn_s_setprio(0); } while (0)
#define PG8_WAIT_V(n) asm volatile("s_waitcnt vmcnt(" #n ")" ::: "memory")
#define PG8_WAIT_L(n) asm volatile("s_waitcnt lgkmcnt(" #n ")" ::: "memory")
#define PG8_BAR __builtin_amdgcn_s_barrier()
#define PG8_SCHED __builtin_amdgcn_sched_barrier(0)
    Unit cur, nxt; int ui = 0;
    if (!S.next(0, cur)) return;
    f32x4 acc[2][2][4][2];
#pragma unroll
    for (int a = 0; a < 2; ++a)
#pragma unroll
        for (int b = 0; b < 2; ++b)
#pragma unroll
            for (int m = 0; m < 4; ++m)
#pragma unroll
                for (int n = 0; n < 2; ++n) acc[a][b][m][n] = (f32x4){0.f, 0.f, 0.f, 0.f};
    bf16x8 At[4][2], B0[2][2], B1[2][2];
    const char* cA = (const char*)g.A + (size_t)cur.pm * tstep; const char* cB = (const char*)g.Bt + (size_t)cur.pn * tstep;
    S.a_ready(cur);
    if constexpr (SP2) {
        PG8_STAGE(PG8_SB(0, 0), cB, voffB); PG8_STAGE(PG8_SB(0, 1), cB + hstepB, voffB); PG8_STAGE(PG8_SA(0, 0), cA, voffA); PG8_STAGE(PG8_SA(0, 1), cA + hstep, voffA);
        if (wr == 1) PG8_BAR;
        PG8_WAIT_V(2); PG8_BAR;
        PG8_STAGE(PG8_SB(1, 0), cB + kstep, voffB); PG8_STAGE(PG8_SA(1, 0), cA + kstep, voffA); PG8_STAGE(PG8_SB(1, 1), cB + hstepB + kstep, voffB);
        PG8_WAIT_V(6); PG8_BAR;
    } else {
        PG8_STAGE(PG8_SB(0, 0), cB, voffB); PG8_STAGE(PG8_SA(0, 0), cA, voffA); PG8_STAGE(PG8_SB(0, 1), cB + hstepB, voffB); PG8_STAGE(PG8_SA(0, 1), cA + hstep, voffA);
        if (wr == 1) PG8_BAR;
        PG8_WAIT_V(4); PG8_BAR;
        PG8_STAGE(PG8_SB(1, 0), cB + kstep, voffB); PG8_STAGE(PG8_SA(1, 0), cA + kstep, voffA); PG8_STAGE(PG8_SB(1, 1), cB + hstepB + kstep, voffB);
        PG8_WAIT_V(6); PG8_BAR;
    }
    for (;;) {
        const bool has_next = S.next(ui + 1, nxt);
        const char* nA = has_next ? (const char*)g.A + (size_t)nxt.pm * tstep : cA; const char* nB = has_next ? (const char*)g.Bt + (size_t)nxt.pn * tstep : cB;
        for (int t = 0; t < nt; t += 2) {
            const bool last = (t == nt - 2);
            const char* a1 = cA + (size_t)(t + 1) * kstep;
            const char* a2 = last ? nA : cA + (size_t)(t + 2) * kstep; const char* b2 = last ? nB : cB + (size_t)(t + 2) * kstep;
            const char* a3 = a2 + kstep; const char* b3 = b2 + kstep;
            if (last && has_next) S.a_ready(nxt);
            if constexpr (SP2) {
            PG8_LDB(B0, 0, 0); PG8_LDB(B1, 0, 1); PG8_SCHED; PG8_LDA(At, 0, 0); PG8_STAGE(PG8_SA(1, 1), a1 + hstep, voffA);
            PG8_WAIT_V(8); PG8_WAIT_L(0); PG8_BAR; PG8_MMA(0, 0, At, B0); PG8_MMA(0, 1, At, B1); PG8_BAR; PG8_SCHED;
            PG8_LDA(At, 0, 1); PG8_STAGE(PG8_SB(0, 0), b2, voffB); PG8_STAGE(PG8_SB(0, 1), b2 + hstepB, voffB); PG8_STAGE(PG8_SA(0, 0), a2, voffA);
            PG8_WAIT_V(8); PG8_WAIT_L(0); PG8_BAR; PG8_MMA(1, 0, At, B0); PG8_MMA(1, 1, At, B1); PG8_BAR; PG8_SCHED;
            PG8_LDB(B0, 1, 0); PG8_LDB(B1, 1, 1); PG8_SCHED; PG8_LDA(At, 1, 0); PG8_STAGE(PG8_SA(0, 1), a2 + hstep, voffA);
            PG8_WAIT_V(8); PG8_WAIT_L(0); PG8_BAR; PG8_MMA(0, 0, At, B0); PG8_MMA(0, 1, At, B1); PG8_BAR; PG8_SCHED;
            PG8_LDA(At, 1, 1); PG8_STAGE(PG8_SB(1, 0), b3, voffB); PG8_STAGE(PG8_SB(1, 1), b3 + hstepB, voffB); PG8_STAGE(PG8_SA(1, 0), a3, voffA);
            PG8_WAIT_V(8); PG8_WAIT_L(0); PG8_BAR; PG8_MMA(1, 0, At, B0); PG8_MMA(1, 1, At, B1); PG8_BAR; PG8_SCHED;
            } else {
            PG8_LDB(B0, 0, 0); PG8_SCHED; PG8_LDA(At, 0, 0); PG8_STAGE(PG8_SA(1, 1), a1 + hstep, voffA);
            PG8_WAIT_L(8); PG8_BAR; PG8_WAIT_L(0); PG8_MMA(0, 0, At, B0); PG8_BAR; PG8_SCHED;
            PG8_LDB(B1, 0, 1); PG8_STAGE(PG8_SB(0, 0), b2, voffB);
            PG8_BAR; PG8_WAIT_L(0); PG8_MMA(0, 1, At, B1); PG8_BAR;
            PG8_LDA(At, 0, 1); PG8_STAGE(PG8_SA(0, 0), a2, voffA);
            PG8_BAR; PG8_WAIT_L(0); PG8_MMA(1, 0, At, B0); PG8_BAR; PG8_SCHED;
            PG8_STAGE(PG8_SB(0, 1), b2 + hstepB, voffB);
            PG8_WAIT_V(6); PG8_BAR; PG8_MMA(1, 1, At, B1); PG8_BAR;
            PG8_LDB(B0, 1, 0); PG8_SCHED; PG8_LDA(At, 1, 0); PG8_STAGE(PG8_SA(0, 1), a2 + hstep, voffA);
            PG8_WAIT_L(8); PG8_BAR; PG8_WAIT_L(0); PG8_MMA(0, 0, At, B0); PG8_BAR; PG8_SCHED;
            PG8_LDB(B1, 1, 1); PG8_STAGE(PG8_SB(1, 0), b3, voffB);
            PG8_BAR; PG8_WAIT_L(0); PG8_MMA(0, 1, At, B1); PG8_BAR;
            PG8_LDA(At, 1, 1); PG8_STAGE(PG8_SA(1, 0), a3, voffA);
            PG8_BAR; PG8_WAIT_L(0); PG8_MMA(1, 0, At, B0); PG8_BAR; PG8_SCHED;
            PG8_STAGE(PG8_SB(1, 1), b3 + hstepB, voffB);
            PG8_WAIT_V(6); PG8_BAR; PG8_MMA(1, 1, At, B1); PG8_BAR;
            }
        }
        if constexpr (ALIGN_EPI) { if (wr == 0) PG8_BAR; }
        if constexpr (!Epi::AFTER_DRAIN) { E(acc, cur, wr, wc, fr, fq); S.done(cur); }
        if (!has_next) break;
#pragma unroll
        for (int a = 0; a < 2; ++a)
#pragma unroll
            for (int b = 0; b < 2; ++b)
#pragma unroll
                for (int m = 0; m < 4; ++m)
#pragma unroll
                    for (int n = 0; n < 2; ++n) acc[a][b][m][n] = (f32x4){0.f, 0.f, 0.f, 0.f};
        cur = nxt; cA = nA; cB = nB; ++ui;
        if constexpr (ALIGN_EPI) { if (wr == 1) PG8_BAR; }
    }
    PG8_WAIT_V(0);
    if constexpr (!ALIGN_EPI) { if (wr == 0) PG8_BAR; }
    PG8_BAR;
    if constexpr (Epi::AFTER_DRAIN) { E.fused(acc, cur, wr, wc, fr, fq, lds, wid, lane); S.done(cur); }
#undef PG8_SA
#undef PG8_SB
#undef PG8_STAGE
#undef PG8_LDA
#undef PG8_LDB
#undef PG8_MMA
#undef PG8_WAIT_V
#undef PG8_WAIT_L
#undef PG8_BAR
#undef PG8_SCHED
}
}
#define GAS __attribute__((address_space(1)))
#define LAS __attribute__((address_space(3)))
typedef unsigned short bf16;
typedef unsigned v4u __attribute__((ext_vector_type(4)));
typedef float f32x4 __attribute__((ext_vector_type(4)));
typedef short bf16x8 __attribute__((ext_vector_type(8)));
typedef GAS unsigned gu32;
typedef GAS unsigned long long gu64;
#define RLX_AGENT __ATOMIC_RELAXED, __HIP_MEMORY_SCOPE_AGENT
#define LDS_WAIT() asm volatile("s_waitcnt lgkmcnt(0)" ::: "memory")
#define VM_WAIT() asm volatile("s_waitcnt vmcnt(0)" ::: "memory")
__device__ __forceinline__ unsigned long long rt() { return __builtin_amdgcn_s_memrealtime(); }
__device__ __forceinline__ unsigned f2bf(float f) { unsigned u = __builtin_bit_cast(unsigned, f); return (u + 0x7fffu + ((u >> 16) & 1u)) >> 16; }
__device__ __forceinline__ unsigned pk2(float lo, float hi) { return f2bf(lo) | (f2bf(hi) << 16); }

#define XB_TMO      128
#define XB_XCNT(j)  (256  + 64 * (j))
#define XB_XSUB(j)  (1280 + 64 * (j))
#define XB_XGEN(j)  (2304 + 64 * (j))
#define XB_TOP      3328
#define XB_TOPGEN   3392
#define XCD_BAR_WORDS 3456
#define XB_SPIN_CAP (1u << 18)

__device__ __forceinline__ unsigned xb_ld(unsigned* p)              { return __hip_atomic_load(p, __ATOMIC_RELAXED, __HIP_MEMORY_SCOPE_AGENT); }
__device__ __forceinline__ unsigned xb_add(unsigned* p, unsigned v) { return __hip_atomic_fetch_add(p, v, __ATOMIC_RELAXED, __HIP_MEMORY_SCOPE_AGENT); }
__device__ __forceinline__ unsigned xb_xcc_id() { return (unsigned)__builtin_amdgcn_s_getreg((3 << 11) | 20) & 0xFu; }
#define XB_SPIN(cond, bar) do { unsigned _sp = 0; while (cond) { __builtin_amdgcn_s_sleep(1); \
    if ((++_sp & 255u) == 0u) { if (xb_ld(&(bar)[XB_TMO])) break; if (_sp > XB_SPIN_CAP) { atomicAdd(&(bar)[XB_TMO], 1u); break; } } } } while (0)

struct XcdBarrier {
    unsigned* bar; unsigned x;
    volatile LAS unsigned* st;
};

__device__ __forceinline__ XcdBarrier xcd_barrier_post(unsigned* bar, volatile LAS unsigned* st) {
    XcdBarrier b; b.bar = bar; b.x = xb_xcc_id(); b.st = st;
    if (threadIdx.x == 0) (void)xb_add(&bar[XB_XCNT(b.x)], 1u);
    return b;
}
__device__ __forceinline__ void xcd_barrier_complete(unsigned* bar, unsigned x, unsigned& nloc, unsigned& nx) {
    const unsigned G = gridDim.x * gridDim.y * gridDim.z;
    unsigned sum, cnt, mine, sp = 0u;
    for (;;) {
        sum = 0u; cnt = 0u; mine = 0u;
#pragma unroll
        for (unsigned j = 0; j < 16; ++j) { const unsigned c = xb_ld(&bar[XB_XCNT(j)]); sum += c; cnt += (c > 0u) ? 1u : 0u; mine = (j == x) ? c : mine; }
        if (sum == G) break;
        __builtin_amdgcn_s_sleep(1);
        if ((++sp & 255u) == 0u) { if (xb_ld(&bar[XB_TMO])) break; if (sp > XB_SPIN_CAP) { atomicAdd(&bar[XB_TMO], 1u); break; } }
    }
    nloc = mine > 0u ? mine : 1u; nx = cnt > 0u ? cnt : 1u;
}

__device__ __forceinline__ void xcd_barrier(const XcdBarrier& b) {
    asm volatile("s_waitcnt vmcnt(0)" ::: "memory");
    __syncthreads();
    if (threadIdx.x == 0) {
        unsigned* bar = b.bar;
        __builtin_amdgcn_s_waitcnt(0);
        unsigned nloc = b.st[0], nx = b.st[1];
        if (nloc == 0u) { xcd_barrier_complete(bar, b.x, nloc, nx); b.st[0] = nloc; b.st[1] = nx; }
        const unsigned old = xb_add(&bar[XB_XSUB(b.x)], 1u);
        const unsigned gen = old / nloc;
        if (old + 1u == (gen + 1u) * nloc) {
            __builtin_amdgcn_fence(__ATOMIC_RELEASE, "agent");
            asm volatile("s_waitcnt vmcnt(0)" ::: "memory");
            const unsigned og = xb_add(&bar[XB_TOP], 1u);
            const unsigned tg = og / nx;
            if (og + 1u == (tg + 1u) * nx) xb_add(&bar[XB_TOPGEN], 1u);
            else XB_SPIN(xb_ld(&bar[XB_TOPGEN]) == tg, bar);
            __builtin_amdgcn_fence(__ATOMIC_ACQUIRE, "agent");
            xb_add(&bar[XB_XGEN(b.x)], 1u);
            asm volatile("s_waitcnt vmcnt(0)" ::: "memory");
        } else {
            XB_SPIN(xb_ld(&bar[XB_XGEN(b.x)]) == gen, bar);
            __builtin_amdgcn_fence(__ATOMIC_ACQUIRE, "agent");
            asm volatile("s_waitcnt vmcnt(0)" ::: "memory");
        }
    }
    __syncthreads();
}
constexpr int NWAVES = 8;
constexpr int BATCH = 8, SEQ = 4096, D = 1024, FF = 4096, DEPTH = 2, T = BATCH * SEQ, NH = 4, HD = 64;
constexpr int INC = 3852, ZP = 3840, NMOD = 6 * D;
constexpr float EPS = 1e-6f;
constexpr int ZC_HQ = 0, ZC_HF = 256, ZC_HI = 512, ZC_HG = 768, ZC_DQ = 1024, ZC_DK = 1280, ZC_DV = 1536, ZC_FQ = 1792, ZC_FK = 2048, ZC_FV = 2304, ZC_FG = 2560, ZC_MQ = 2816, ZC_MK = 3072, ZC_MV = 3328, ZC_MO = 3584;
constexpr size_t MiB = 1u << 20;
constexpr size_t WS_CTL = 0, CTL_ZERO_BYTES = 1 * MiB;
constexpr size_t WS_MOD = 1 * MiB;
constexpr size_t WS_WG = 1 * MiB + 512 * 1024;
constexpr size_t WS_QKG = 1 * MiB + 768 * 1024;
constexpr size_t WS_SMAX = 1 * MiB + 896 * 1024;
constexpr size_t WS_SCHED = 1 * MiB + 904 * 1024;
constexpr size_t WS_KST = 1 * MiB + 900 * 1024;
constexpr size_t WS_FGT = 3 * MiB + 512 * 1024;
constexpr size_t WS_GATES = 2 * MiB;
constexpr size_t WS_FCUM = 4 * MiB;
constexpr size_t WS_GM1 = 4 * MiB + 768 * 1024;
constexpr size_t WS_BIAS1 = 7 * MiB;
constexpr size_t WS_SS1 = 6 * MiB + 512 * 1024;
constexpr size_t WS_GM2 = 4 * MiB + 512 * 1024;
constexpr size_t WS_BIAS2 = 5 * MiB;
constexpr size_t WS_SSQ = 6 * MiB;
constexpr size_t WS_WIN = 8 * MiB, WS_WOUT = 24 * MiB, WS_W1 = 28 * MiB, WS_W2 = 44 * MiB;
constexpr size_t WS_HN = 64 * MiB;
constexpr size_t WS_Z = 128 * MiB;
constexpr size_t WS_H = 128 * MiB;
constexpr size_t WS_XB = 384 * MiB;
constexpr size_t WS_Y = 448 * MiB;
constexpr size_t WS_DECH = 7 * MiB + 512 * 1024, WS_DECM = 7 * MiB + 800 * 1024;
constexpr size_t WS_END = 512 * MiB;
constexpr size_t WS_IMGH = WS_HN, WS_IMGM = WS_HN + 16 * MiB;
static_assert(16 * MiB + (size_t)32 * 32 * 4160 * 4 <= 64 * MiB, "state images fit HN");
static_assert(WS_Z + (size_t)T * ZP * 2 <= WS_XB && WS_H + (size_t)T * FF * 2 <= WS_XB && WS_XB + (size_t)T * D * 2 <= WS_Y && WS_Y + (size_t)T * D * 2 <= WS_END, "ws map");
constexpr int CW_TMO = 0, CW_BAR = 4096;
constexpr int RING_OFF = 0, RING_BYTES = 131072, LDS_BYTES = 152576, LDSCTL_OFF = LDS_BYTES - 1024, MISC_OFF = LDSCTL_OFF + 320, XCH_OFF = RING_BYTES;
constexpr float LOG2E = 1.4426950408889634f;
static_assert(XCH_OFF + 256 * 8 * 4 <= LDSCTL_OFF && XCH_OFF + 4096 + 8 * 2048 <= LDSCTL_OFF, "exchange / store-staging area");
constexpr int PH_PRO = 0, PH_PER_LAYER = 8, NPH = 1 + 2 * PH_PER_LAYER;
constexpr int PL_NORM1 = 0, PL_INPROJ = 1, PL_MIXA = 2, PL_MIXB = 3, PL_MIXC = 4, PL_OUTPROJ = 5, PL_FF1 = 6, PL_FF2 = 7;

struct Frame {
    LAS unsigned char* lds; volatile LAS unsigned* MISC; gu32* ctl;
    int tid, lane, wave, vcu, G;
};
__device__ __forceinline__ float wave_sum(float v) {
#pragma unroll
    for (int o = 1; o < 64; o <<= 1) v += __shfl_xor(v, o);
    return v;
}
__device__ __forceinline__ float bf2f(bf16 v) { return __builtin_bit_cast(float, (unsigned)v << 16); }
__device__ __forceinline__ float sigmoidf_(float x) { return 1.f / (1.f + __expf(-x)); }
__device__ __forceinline__ float logsigmoidf_(float x) { return fminf(x, 0.f) - log1pf(expf(-fabsf(x))); }

__device__ __forceinline__ void p0_transpose_item(const float* W, int K, int pitch, int nblk, bf16* WT, LAS float* scr, int item, int lane) {
    const int kb = item / nblk, nb = item % nblk, k0 = 64 * kb, n0 = 32 * nb;
    float v_[32];
#pragma unroll
    for (int i = 0; i < 32; ++i) v_[i] = W[(size_t)(k0 + 2 * i + (lane >> 5)) * pitch + n0 + (lane & 31)];
#pragma unroll
    for (int i = 0; i < 32; ++i) scr[(2 * i + (lane >> 5)) * 33 + (lane & 31)] = v_[i];
    LDS_WAIT(); asm volatile("" ::: "memory");
    const int c = lane & 7;
#pragma unroll
    for (int j = 0; j < 4; ++j) { const int n = (lane >> 3) + 8 * j; const LAS float* s = scr + (8 * c) * 33 + n;
        v4u o; o.x = pk2(s[0 * 33], s[1 * 33]); o.y = pk2(s[2 * 33], s[3 * 33]); o.z = pk2(s[4 * 33], s[5 * 33]); o.w = pk2(s[6 * 33], s[7 * 33]);
        *(GAS v4u*)(WT + (size_t)(n0 + n) * K + k0 + 8 * c) = o; }
    LDS_WAIT(); asm volatile("" ::: "memory");
}

struct Args { const float* in[22]; float* out; unsigned char* ws; int ph_lo, ph_hi, li, pad; };

__device__ __forceinline__ void p0_transposes(Frame& F0, const Args& A, int it0, int it1, int gw, int NGW) {
    Frame F = F0; { int t_ = threadIdx.x; asm volatile("" : "+v"(t_)); F.tid = t_; F.lane = t_ & 63; }
    unsigned char* ws = A.ws; const float* w_in = A.in[6];
    LAS float* scr = (LAS float*)(F.lds + RING_OFF + F.wave * 16384);
    constexpr int I_A = 16 * 88, I_B = 16 * 32, I_O = 16 * 32, I_1 = 16 * 128, I_2 = 64 * 32, I_L = I_A + I_B + I_O + I_1 + I_2;
    bf16* Win_t = (bf16*)(ws + WS_WIN); bf16* Wout_t = (bf16*)(ws + WS_WOUT); bf16* W1_t = (bf16*)(ws + WS_W1); bf16* W2_t = (bf16*)(ws + WS_W2);
    for (int it = it0 + gw; it < it1; it += NGW) {
        const int l = it / I_L; int r = it % I_L;
        if (r < I_A) { p0_transpose_item(w_in + (size_t)l * 1024 * INC, 1024, INC, 88, Win_t + (size_t)l * 4096 * 1024, scr, r, F.lane); continue; } r -= I_A;
        if (r < I_B) { p0_transpose_item(w_in + (size_t)l * 1024 * INC + 2820, 1024, INC, 32, Win_t + (size_t)l * 4096 * 1024 + (size_t)2816 * 1024, scr, r, F.lane); continue; } r -= I_B;
        if (r < I_O) { p0_transpose_item(A.in[7] + (size_t)l * 1024 * 1024, 1024, 1024, 32, Wout_t + (size_t)l * 1024 * 1024, scr, r, F.lane); continue; } r -= I_O;
        if (r < I_1) { p0_transpose_item(A.in[20] + (size_t)l * 1024 * 4096, 1024, 4096, 128, W1_t + (size_t)l * 4096 * 1024, scr, r, F.lane); continue; } r -= I_1;
        p0_transpose_item(A.in[21] + (size_t)l * 4096 * 1024, 4096, 1024, 32, W2_t + (size_t)l * 1024 * 4096, scr, r, F.lane);
    }
}
constexpr int TR_ITEMS_L = 16 * 88 + 16 * 32 + 16 * 32 + 16 * 128 + 64 * 32;


__device__ __forceinline__ void p0_prologue(Frame& F0, const Args& A) {
    Frame F = F0; { int t_ = threadIdx.x; asm volatile("" : "+v"(t_)); F.tid = t_; F.lane = t_ & 63; }
    unsigned char* ws = A.ws;
    const float* c_in = A.in[1]; const float* w_ada = A.in[2]; const float* b_ada = A.in[3]; const float* w_in = A.in[6];
    float* mod = (float*)(ws + WS_MOD); float* wg = (float*)(ws + WS_WG);
    {
        LAS float* cact = (LAS float*)(F.lds); LAS float* red = (LAS float*)(F.lds + 32768);
        bool staged = false;
        for (int unit = blockIdx.x; unit < 192; unit += F.G) {
            if (!staged) { for (int i = F.tid; i < 8192; i += NWAVES * 64) { const int b = i >> 10, k = i & 1023; const float v = c_in[b * 1024 + k]; cact[k * 8 + b] = v / (1.f + expf(-v)); } staged = true; }
            __syncthreads();
            const int l = unit / 96, n0 = (unit % 96) * 64;
            const float* W = w_ada + (size_t)l * 1024 * NMOD + n0 + F.lane;
            float acc[8];
#pragma unroll
            for (int b = 0; b < 8; ++b) acc[b] = 0.f;
            const int k0 = F.wave * 128;
#pragma unroll 32
            for (int kk = 0; kk < 128; ++kk) { const int k = k0 + kk; const float w = W[(size_t)k * NMOD];
                const f32x4 c0 = *(const LAS f32x4*)(cact + k * 8), c1 = *(const LAS f32x4*)(cact + k * 8 + 4);
                acc[0] += w * c0[0]; acc[1] += w * c0[1]; acc[2] += w * c0[2]; acc[3] += w * c0[3]; acc[4] += w * c1[0]; acc[5] += w * c1[1]; acc[6] += w * c1[2]; acc[7] += w * c1[3]; }
#pragma unroll
            for (int b = 0; b < 8; ++b) red[(F.wave * 8 + b) * 64 + F.lane] = acc[b];
            __syncthreads();
            { const int b = F.tid >> 6, col = F.tid & 63; float s = b_ada[l * NMOD + n0 + col];
#pragma unroll
              for (int w = 0; w < 8; ++w) s += red[(w * 8 + b) * 64 + col];
              mod[(size_t)(l * 8 + b) * NMOD + n0 + col] = s;
              if (n0 >= 1 * D && n0 < 2 * D) ((float*)(ws + WS_GM1))[(size_t)(l * 8 + b) * D + (n0 - 1 * D) + col] = A.in[4][l * D + (n0 - 1 * D) + col] * (1.f + s);
              if (n0 >= 4 * D && n0 < 5 * D) ((float*)(ws + WS_GM2))[(size_t)(l * 8 + b) * D + (n0 - 4 * D) + col] = A.in[5][l * D + (n0 - 4 * D) + col] * (1.f + s); }
            __syncthreads();
        }
    }
    __syncthreads();
    for (int idx = blockIdx.x * (NWAVES * 64) + F.tid; idx < 2 * 12 * 1024; idx += F.G * NWAVES * 64) {
        const int l = idx / 12288, r = idx % 12288, j = r >> 10, k = r & 1023;
        const int col = (j < 4) ? 2816 + j : (j < 8 ? 3844 + (j - 4) : 3848 + (j - 8));
        const float wv = w_in[(size_t)l * 1024 * INC + (size_t)k * INC + col]; wg[idx] = wv;
        ((bf16*)(ws + WS_WIN))[(size_t)l * 4096 * 1024 + (size_t)(3840 + j) * 1024 + k] = (bf16)f2bf(wv);
    }
    for (int idx = blockIdx.x * (NWAVES * 64) + F.tid; idx < 2 * 244 * 1024 / 8; idx += F.G * NWAVES * 64) {
        const int l = idx / (244 * 128), r = idx % (244 * 128);
        ((GAS v4u*)((bf16*)(ws + WS_WIN) + (size_t)l * 4096 * 1024 + (size_t)3852 * 1024))[r] = (v4u){0u, 0u, 0u, 0u};
    }
    if (blockIdx.x == F.G - 1 && F.tid < 2 * 4 * 64) {
        const int l = F.tid >> 8, k = (F.tid >> 6) & 3, d = F.tid & 63; float v;
        if (k == 0) v = A.in[10][l * 32 + (d & 31)] * (0.17677669529663687f * LOG2E);
        else if (k == 1) v = A.in[11][l * 32 + (d & 31)];
        else if (k == 2) v = A.in[14][l * 64 + d] * (0.125f * LOG2E);
        else v = A.in[15][l * 64 + d];
        ((float*)(ws + WS_QKG))[F.tid] = v;
    }
    if (blockIdx.x == F.G - 2 && F.tid < 4) {
        const int l = F.tid >> 1, k = F.tid & 1; float mq = 0.f, mk = 0.f;
        if (k == 0) { for (int d = 0; d < 64; ++d) { mq = fmaxf(mq, fabsf(A.in[14][l * 64 + d])); mk = fmaxf(mk, fabsf(A.in[15][l * 64 + d])); } }
        else { for (int d = 0; d < 32; ++d) { mq = fmaxf(mq, fabsf(A.in[10][l * 32 + d])); mk = fmaxf(mk, fabsf(A.in[11][l * 32 + d])); } }
        ((float*)(ws + WS_SMAX))[F.tid] = (k == 0 ? 8.0f : 5.656854249f) * LOG2E * mq * mk * 1.02f + 0.5f;
    }
    if (F.G == 256) { constexpr int N1 = 192 * NWAVES * 6;
        if (blockIdx.x < 192) p0_transposes(F, A, 0, N1, (int)blockIdx.x * NWAVES + F.wave, 192 * NWAVES);
        else p0_transposes(F, A, N1, 2 * TR_ITEMS_L, ((int)blockIdx.x - 192) * NWAVES + F.wave, 64 * NWAVES); }
    else p0_transposes(F, A, 0, 2 * TR_ITEMS_L, F.vcu * NWAVES + F.wave, F.G * NWAVES);
}

__device__ __forceinline__ void norm_phase(Frame& F0, const float* xsrc, const float* gain, const float* modl, int shift_slot, bf16* hn, const float* wg, float* gates, float* fgt) {
    Frame F = F0; { int t_ = threadIdx.x; asm volatile("" : "+v"(t_)); F.tid = t_; F.lane = t_ & 63; }
    LAS float* wgl = (LAS float*)(F.lds);
    if (wg) { for (int i = F.tid; i < 12 * 1024 / 4; i += NWAVES * 64) ((LAS f32x4*)wgl)[i] = ((const GAS f32x4*)wg)[i]; }
    __syncthreads();
    const int gw = F.vcu * NWAVES + F.wave, NGW = F.G * NWAVES;
    for (int m0 = gw * 16; m0 < T; m0 += NGW * 16) {
        const int b = m0 >> 12;
        f32x4 gm[4], sh[4];
        { const GAS f32x4* g4 = (const GAS f32x4*)gain + F.lane;
          const GAS f32x4* sh4 = (const GAS f32x4*)(modl + (size_t)b * NMOD + shift_slot * D) + F.lane;
          const GAS f32x4* sc4 = (const GAS f32x4*)(modl + (size_t)b * NMOD + (shift_slot + 1) * D) + F.lane;
#pragma unroll
          for (int j = 0; j < 4; ++j) { gm[j] = g4[64 * j] * (sc4[64 * j] + 1.0f); sh[j] = sh4[64 * j]; } }
#pragma unroll 1
        for (int rb = 0; rb < 16; rb += 4) {
            f32x4 v[4][4]; float s[4];
#pragma unroll
            for (int r = 0; r < 4; ++r) { const GAS f32x4* xr = (const GAS f32x4*)(xsrc + (size_t)(m0 + rb + r) * D) + F.lane;
#pragma unroll
                for (int j = 0; j < 4; ++j) v[r][j] = xr[64 * j]; }
#pragma unroll
            for (int r = 0; r < 4; ++r) { float a = 0.f;
#pragma unroll
                for (int j = 0; j < 4; ++j) a += (v[r][j].x * v[r][j].x + v[r][j].y * v[r][j].y) + (v[r][j].z * v[r][j].z + v[r][j].w * v[r][j].w);
                s[r] = a; }
#pragma unroll
            for (int o = 1; o < 64; o <<= 1) {
#pragma unroll
                for (int r = 0; r < 4; ++r) s[r] += __shfl_xor(s[r], o); }
#pragma unroll
            for (int r = 0; r < 4; ++r) { const float rstd = __builtin_amdgcn_rsqf(s[r] * (1.f / D) + EPS);
                GAS unsigned long long* o8 = (GAS unsigned long long*)(hn + (size_t)(m0 + rb + r) * D) + F.lane;
#pragma unroll
                for (int j = 0; j < 4; ++j) { v[r][j] = (v[r][j] * rstd) * gm[j] + sh[j];
                    o8[64 * j] = (unsigned long long)pk2(v[r][j].x, v[r][j].y) | ((unsigned long long)pk2(v[r][j].z, v[r][j].w) << 32); } }
            if (wg) {
                float mine[4] = {0.f, 0.f, 0.f, 0.f};
#pragma unroll 1
                for (int g = 0; g < 12; ++g) { float d[4] = {0.f, 0.f, 0.f, 0.f};
#pragma unroll
                    for (int j = 0; j < 4; ++j) { const f32x4 w = ((const LAS f32x4*)(wgl + g * 1024))[F.lane + 64 * j];
#pragma unroll
                        for (int r = 0; r < 4; ++r) d[r] += (v[r][j].x * w.x + v[r][j].y * w.y) + (v[r][j].z * w.z + v[r][j].w * w.w); }
#pragma unroll
                    for (int o = 1; o < 64; o <<= 1) {
#pragma unroll
                        for (int r = 0; r < 4; ++r) d[r] += __shfl_xor(d[r], o); }
#pragma unroll
                    for (int r = 0; r < 4; ++r) mine[r] = (F.lane == g) ? d[r] : mine[r]; }
                if (F.lane < 12) {
#pragma unroll
                    for (int r = 0; r < 4; ++r) gates[(size_t)(m0 + rb + r) * 12 + F.lane] = mine[r]; }
                if (F.lane < 4) {
#pragma unroll
                    for (int r = 0; r < 4; ++r) fgt[(size_t)(b * NH + F.lane) * SEQ + ((m0 + rb + r) & (SEQ - 1))] = mine[r]; }
            }
        }
    }
}
__device__ __forceinline__ void fox_scan_wave(const float* fgt, const float* fbias, float* Fcum, int* kst, float smax, int bh, int lane_) {
    int lane = lane_; asm volatile("" : "+v"(lane));
    const int h = bh & 3; const float fb = fbias[h]; const GAS f32x4* g4 = (const GAS f32x4*)(fgt + (size_t)bh * SEQ + lane * 64);
    f32x4 lf[16]; float s = 0.f;
#pragma unroll
    for (int i = 0; i < 16; ++i) lf[i] = g4[i];
#pragma unroll
    for (int i = 0; i < 16; ++i) {
#pragma unroll
        for (int e = 0; e < 4; ++e) { lf[i][e] = logsigmoidf_(lf[i][e] + fb); s += lf[i][e]; } }
    float incl = s;
#pragma unroll
    for (int o = 1; o < 64; o <<= 1) { const float v = __shfl_up(incl, o); if (lane >= o) incl += v; }
    float run = incl - s; GAS f32x4* Fo = (GAS f32x4*)(Fcum + (size_t)bh * SEQ + lane * 64); float ffirst = 0.f;
#pragma unroll
    for (int i = 0; i < 16; ++i) { f32x4 o4;
#pragma unroll
        for (int e = 0; e < 4; ++e) { run += lf[i][e]; o4[e] = run; if (i == 0 && e == 0) ffirst = run; }
        Fo[i] = o4; }
    const float blast = -run * LOG2E;
    for (int qb = 0; qb < 16; ++qb) { const float bq0 = -__shfl(ffirst, 4 * qb) * LOG2E;
        const unsigned long long m = __ballot(blast < bq0 - 152.0f - 2.0f * smax);
        int ks = (int)__builtin_ctzll(~m); const int nt = 4 * qb + 4; ks = ks < nt - 4 ? ks : nt - 4; ks &= ~1;
        if (lane == 0) kst[bh * 16 + qb] = ks; }
}

__device__ __forceinline__ void fox_scan_block(const float* fgt, const float* fbias, float* Fcum, int* kst, float smax, int bh, LAS unsigned char* lds) {
    int tid_ = threadIdx.x; asm volatile("" : "+v"(tid_)); const int tid = tid_, lane = tid & 63, wave = tid >> 6;
    LAS float* Fl = (LAS float*)lds; LAS float* part = Fl + SEQ;
    const int h = bh & 3; const float fb = fbias[h];
    const GAS f32x4* g4 = (const GAS f32x4*)(fgt + (size_t)bh * SEQ + tid * 8);
    const f32x4 a = g4[0], b = g4[1];
    float v[8] = {a[0], a[1], a[2], a[3], b[0], b[1], b[2], b[3]}; float s = 0.f;
#pragma unroll
    for (int e = 0; e < 8; ++e) { s += logsigmoidf_(v[e] + fb); v[e] = s; }
    float incl = s;
#pragma unroll
    for (int o = 1; o < 64; o <<= 1) { const float t = __shfl_up(incl, o); if (lane >= o) incl += t; }
    if (lane == 63) part[wave] = incl;
    __syncthreads();
    float base = incl - s;
    for (int w = 0; w < wave; ++w) base += part[w];
    f32x4 o0, o1;
#pragma unroll
    for (int e = 0; e < 4; ++e) { o0[e] = base + v[e]; o1[e] = base + v[4 + e]; }
    GAS f32x4* Fo = (GAS f32x4*)(Fcum + (size_t)bh * SEQ + tid * 8); Fo[0] = o0; Fo[1] = o1;
    *(LAS f32x4*)(Fl + tid * 8) = o0; *(LAS f32x4*)(Fl + tid * 8 + 4) = o1;
    __syncthreads();
    if (wave == 0) {
        const float blast = -Fl[64 * lane + 63] * LOG2E;
        for (int qb = 0; qb < 16; ++qb) { const float bq0 = -Fl[256 * qb] * LOG2E;
            const unsigned long long m = __ballot(blast < bq0 - 152.0f - 2.0f * smax);
            int ks = (int)__builtin_ctzll(~m); const int nt = 4 * qb + 4; ks = ks < nt - 4 ? ks : nt - 4; ks &= ~1;
            if (lane == 0) kst[bh * 16 + qb] = ks; }
    }
    __syncthreads();
}

__device__ __forceinline__ void bias_gemv(Frame& F0, const bf16* Wt, int N, const float* shift, int sstride, float* out) {
    Frame F = F0; { int t_ = threadIdx.x; asm volatile("" : "+v"(t_)); F.tid = t_; F.lane = t_ & 63; }
    LAS float* sl = (LAS float*)(F.lds);
    __syncthreads();
    for (int i = F.tid; i < 8 * 1024; i += NWAVES * 64) sl[i] = shift[(size_t)(i >> 10) * sstride + (i & 1023)];
    __syncthreads();
    const int gw = F.vcu * NWAVES + F.wave, NGW = F.G * NWAVES;
    for (int n = gw; n < N; n += NGW) {
        float w[16];
#pragma unroll
        for (int j = 0; j < 4; ++j) { const unsigned long long q = *(const GAS unsigned long long*)(Wt + (size_t)n * 1024 + 256 * j + F.lane * 4);
#pragma unroll
            for (int e = 0; e < 4; ++e) w[j * 4 + e] = __builtin_bit_cast(float, (unsigned)((q >> (16 * e)) & 0xffffu) << 16); }
        float mine = 0.f;
#pragma unroll 1
        for (int b = 0; b < 8; ++b) { float d = 0.f;
#pragma unroll
            for (int j = 0; j < 4; ++j) { const f32x4 s4 = *(const LAS f32x4*)(sl + b * 1024 + 256 * j + F.lane * 4); d += (w[j * 4] * s4[0] + w[j * 4 + 1] * s4[1]) + (w[j * 4 + 2] * s4[2] + w[j * 4 + 3] * s4[3]); }
            d = wave_sum(d); mine = (F.lane == b) ? d : mine; }
        if (F.lane < 8) out[(size_t)F.lane * N + n] = mine;
    }
    __syncthreads();
}

__device__ __forceinline__ void prenorm0_phase(Frame& F0, const float* xsrc, const float* gm, bf16* hn, float* ss) {
    Frame F = F0; { int t_ = threadIdx.x; asm volatile("" : "+v"(t_)); F.tid = t_; F.lane = t_ & 63; }
    const int gw = F.vcu * NWAVES + F.wave, NGW = F.G * NWAVES;
    for (int m0 = gw * 16; m0 < T; m0 += NGW * 16) {
        const int b = m0 >> 12; f32x4 g[4];
        { const GAS f32x4* g4 = (const GAS f32x4*)(gm + (size_t)b * D) + F.lane;
#pragma unroll
          for (int j = 0; j < 4; ++j) g[j] = g4[64 * j]; }
#pragma unroll 1
        for (int rb = 0; rb < 16; rb += 4) {
            f32x4 v[4][4]; float s[4];
#pragma unroll
            for (int r = 0; r < 4; ++r) { const GAS f32x4* xr = (const GAS f32x4*)(xsrc + (size_t)(m0 + rb + r) * D) + F.lane;
#pragma unroll
                for (int j = 0; j < 4; ++j) v[r][j] = xr[64 * j]; }
#pragma unroll
            for (int r = 0; r < 4; ++r) { float a = 0.f;
#pragma unroll
                for (int j = 0; j < 4; ++j) a += (v[r][j].x * v[r][j].x + v[r][j].y * v[r][j].y) + (v[r][j].z * v[r][j].z + v[r][j].w * v[r][j].w);
                s[r] = a;
                GAS unsigned long long* o8 = (GAS unsigned long long*)(hn + (size_t)(m0 + rb + r) * D) + F.lane;
#pragma unroll
                for (int j = 0; j < 4; ++j) { const f32x4 a4 = v[r][j] * g[j]; o8[64 * j] = (unsigned long long)pk2(a4.x, a4.y) | ((unsigned long long)pk2(a4.z, a4.w) << 32); } }
#pragma unroll
            for (int o = 1; o < 64; o <<= 1) {
#pragma unroll
                for (int r = 0; r < 4; ++r) s[r] += __shfl_xor(s[r], o); }
            if (F.lane < 4) { const float mine = (F.lane == 0) ? s[0] : (F.lane == 1 ? s[1] : (F.lane == 2 ? s[2] : s[3]));
                *(GAS f32x4*)(ss + (size_t)(m0 + rb + F.lane) * 4) = (f32x4){mine, 0.f, 0.f, 0.f}; }
        }
    }
}

__device__ __forceinline__ void bias_all(Frame& F0, const bf16* Win_t, const bf16* W1_t, const float* mod, float* bias1, float* bias2) {
    Frame F = F0; { int t_ = threadIdx.x; asm volatile("" : "+v"(t_)); F.tid = t_; F.lane = t_ & 63; }
    LAS float* sl = (LAS float*)(F.lds);
    __syncthreads();
    for (int i = F.tid; i < 4 * 8192; i += NWAVES * 64) { const int set = i >> 13, l = set & 1, slot = (set >> 1) ? 3 : 0, b = (i >> 10) & 7, k = i & 1023;
        sl[i] = mod[(size_t)(l * 8 + b) * NMOD + slot * 1024 + k]; }
    __syncthreads();
    const int gw = F.vcu * NWAVES + F.wave, NGW = F.G * NWAVES;
    for (int r = gw; r < 4 * 4096; r += NGW) {
        const int set = r >> 12, n = r & 4095, l = set & 1;
        const bf16* wrow = ((set >> 1) ? W1_t : Win_t) + (size_t)(l * 4096 + n) * 1024; float* out = ((set >> 1) ? bias2 : bias1) + (size_t)l * 8 * 4096;
        float w[16];
#pragma unroll
        for (int j = 0; j < 4; ++j) { const unsigned long long q = *(const GAS unsigned long long*)(wrow + 256 * j + F.lane * 4);
#pragma unroll
            for (int e = 0; e < 4; ++e) w[j * 4 + e] = __builtin_bit_cast(float, (unsigned)((q >> (16 * e)) & 0xffffu) << 16); }
        float d[8];
#pragma unroll
        for (int b = 0; b < 8; ++b) { float a = 0.f;
#pragma unroll
            for (int j = 0; j < 4; ++j) { const f32x4 s4 = *(const LAS f32x4*)(sl + set * 8192 + b * 1024 + 256 * j + F.lane * 4); a += (w[j * 4] * s4[0] + w[j * 4 + 1] * s4[1]) + (w[j * 4 + 2] * s4[2] + w[j * 4 + 3] * s4[3]); }
            d[b] = a; }
#pragma unroll
        for (int o = 1; o < 64; o <<= 1) {
#pragma unroll
            for (int b = 0; b < 8; ++b) d[b] += __shfl_xor(d[b], o); }
        float mine = d[0];
#pragma unroll
        for (int b = 1; b < 8; ++b) mine = (F.lane == b) ? d[b] : mine;
        if (F.lane < 8) out[(size_t)F.lane * 4096 + n] = mine;
    }
    __syncthreads();
}
namespace att {
using bf16x8 = __attribute__((ext_vector_type(8))) short;
using s16x4 = __attribute__((ext_vector_type(4))) short;
using f32x16 = __attribute__((ext_vector_type(16))) float;
using f32x4v = __attribute__((ext_vector_type(4))) float;
using u32x4 = __attribute__((ext_vector_type(4))) unsigned;
constexpr int NW = 8, QBLK = 32, QB = QBLK * NW, KVBLK = 64, NQB = SEQ / QB, PITCH = ZP;
constexpr int SLOTB = 8192, LDS_K = 0, LDS_V = 3 * SLOTB, LDS_WS = 6 * SLOTB, LDS_OST = LDS_WS + NW * 256, LDS_TBL = LDS_OST + NW * 8192, LDS_END = LDS_TBL + SEQ * 4 + 256;
static_assert(LDS_END <= LDSCTL_OFF, "attention LDS map");
constexpr int THR = 48;
#define SBAR() __builtin_amdgcn_sched_barrier(0)
#define PIN(x) asm volatile("" : "+v"(x))
#define MFMA(a, b, c) __builtin_amdgcn_mfma_f32_32x32x16_bf16(a, b, c, 0, 0, 0)
#define WAIT_BAR(N) asm volatile("s_waitcnt vmcnt(" #N ") lgkmcnt(0)\n\ts_barrier" ::: "memory")
__device__ __forceinline__ int crow(int r, int hi) { return (r & 3) + 8 * (r >> 2) + 4 * hi; }
__device__ __forceinline__ unsigned cvtpk(float lo, float hi) { unsigned r; asm("v_cvt_pk_bf16_f32 %0, %1, %2\n\ts_nop 1" : "=v"(r) : "v"(lo), "v"(hi)); return r; }
__device__ __forceinline__ unsigned cvtpk_b(float lo, float hi) { const pg8::cv_f32x2 v = {lo, hi}; return __builtin_bit_cast(unsigned, __builtin_convertvector(v, pg8::cv_bf16x2)); }
__device__ __forceinline__ void glds16(const void* g, unsigned lds_base) {
    unsigned sv; asm volatile("s_mov_b32 %0, m0\n\ts_mov_b32 m0, %2\n\ts_nop 0\n\tglobal_load_lds_dwordx4 %1, off\n\ts_mov_b32 m0, %0" : "=&s"(sv) : "v"(g), "s"(lds_base) : "memory"); }
typedef __attribute__((address_space(3))) const char* lds_cptr;
typedef short v4i16_t __attribute__((ext_vector_type(4)));
__device__ __forceinline__ void kload2(bf16x8* kf, lds_cptr kp, int d0) { kf[2 * d0] = *(const __attribute__((address_space(3))) bf16x8*)(kp + d0 * 2048); kf[2 * d0 + 1] = *(const __attribute__((address_space(3))) bf16x8*)(kp + d0 * 2048 + 512); }
__device__ __forceinline__ s16x4 vtr(lds_cptr p) { return __builtin_bit_cast(s16x4, __builtin_amdgcn_ds_read_tr16_b64_v4i16((__attribute__((address_space(3))) v4i16_t*)p)); }
__device__ __forceinline__ f32x16 ldbias(lds_cptr p) {
    const f32x4v a = *(const __attribute__((address_space(3))) f32x4v*)(p), b = *(const __attribute__((address_space(3))) f32x4v*)(p + 32), c = *(const __attribute__((address_space(3))) f32x4v*)(p + 64), d = *(const __attribute__((address_space(3))) f32x4v*)(p + 96);
    return (f32x16){a[0], a[1], a[2], a[3], b[0], b[1], b[2], b[3], c[0], c[1], c[2], c[3], d[0], d[1], d[2], d[3]}; }
#define MX3(a, b, c) __builtin_fmaxf(__builtin_fmaxf((a), (b)), (c))
__device__ __forceinline__ float rowmax(const f32x16& p0, const f32x16& p1) {
    float a = MX3(p0[0], p0[1], p1[0]), b = MX3(p0[2], p0[3], p1[1]); a = MX3(a, p1[2], p1[3]);
#pragma unroll
    for (int r = 4; r < 16; r += 4) { a = MX3(a, p0[r], p0[r + 1]); b = MX3(b, p0[r + 2], p0[r + 3]); a = MX3(a, p1[r], p1[r + 1]); b = MX3(b, p1[r + 2], p1[r + 3]); }
    float m = __builtin_fmaxf(a, b); auto rr = __builtin_amdgcn_permlane32_swap(__float_as_uint(m), __float_as_uint(m), false, false);
    return __builtin_fmaxf(__uint_as_float(rr[0]), __uint_as_float(rr[1])); }
__device__ __forceinline__ void cmask(f32x16& p0, f32x16& p1, int jb, int qrel, int hi) {
    const int kb = 64 * jb + 4 * hi;
#pragma unroll
    for (int r = 0; r < 16; ++r) { const int kv = kb + (r & 3) + 8 * (r >> 2); if (kv > qrel) p0[r] = -INFINITY; if (kv + 32 > qrel) p1[r] = -INFINITY; } }

template <int ND0>
__device__ __forceinline__ void attn_pass(int b, int qb, int kst, const bf16* Z, int qcol, int kcol, int vcol, int kcoff, char* lds, f32x16 (&o)[2], float& l_out) {
    int tid_ = threadIdx.x; asm volatile("" : "+v"(tid_));
    const int tid = tid_, lane = tid & 63, r32 = lane & 31, hi = lane >> 5; const int wid = __builtin_amdgcn_readfirstlane(tid >> 6);
    const long rowbase = (long)b * SEQ; const int q0 = qb * QB, NT = (q0 + QB) / KVBLK - kst;
    const bf16* Qw = Z + (rowbase + q0 + wid * QBLK) * PITCH + qcol;
    const unsigned lds0 = (unsigned)(uintptr_t)lds; float* wsf = (float*)(lds + LDS_WS) + wid * 64;
    const bf16* ksrc = Z + (rowbase + (long)kst * KVBLK) * PITCH + kcol + (long)lane * PITCH + wid * 8;
    const bf16* vsrc = Z + (rowbase + (long)kst * KVBLK) * PITCH + vcol + (long)(16 * (wid & 3) + (lane >> 2)) * PITCH + (wid >> 2) * 32 + (lane & 3) * 8;
    const unsigned kdst = lds0 + LDS_K + wid * 1024, vdst = lds0 + LDS_V + wid * 1024;
#define DMA_K(t, slot) glds16(ksrc + (long)(t) * KVBLK * PITCH, (unsigned)__builtin_amdgcn_readfirstlane(kdst + (slot)))
#define DMA_V(t, slot) glds16(vsrc + (long)(t) * KVBLK * PITCH, (unsigned)__builtin_amdgcn_readfirstlane(vdst + (slot)))
    const lds_cptr vp0 = (lds_cptr)lds + LDS_V + ((lane >> 4) & 1) * 32 + (lane & 3) * 8 + (4 * hi + ((lane & 15) >> 2)) * 64;
    const lds_cptr kp0 = (lds_cptr)lds + LDS_K + kcoff + hi * 1024 + r32 * 16;
    const lds_cptr tb0 = (lds_cptr)lds + LDS_TBL + hi * 16 + kst * 256;
    DMA_K(0, 0); DMA_V(0, 0); DMA_K(1, SLOTB);
    bf16x8 qr[ND0];
#pragma unroll
    for (int d0 = 0; d0 < ND0; ++d0) qr[d0] = *reinterpret_cast<const bf16x8*>(&Qw[(long)r32 * PITCH + d0 * 16 + hi * 8]);
    float mhat = 0.f, l_reg = 0.f; o[0] = f32x16{}; o[1] = f32x16{};
    const int qrel = wid * QBLK + r32; bool resc = false;
    f32x16 pA0, pA1, pB0, pB1; bf16x8 kf[2 * ND0]; s16x4 vlo[8], vhi[8]; u32x4 pw0, pw1, pw2, pw3;
    int sl_prev = 0, sl_cur = 0, sl_next = SLOTB;
#define ROT() do { sl_prev = sl_cur; sl_cur = sl_next; sl_next = (sl_next == 2 * SLOTB) ? 0 : sl_next + SLOTB; } while (0)
#define EX(v) __builtin_amdgcn_exp2f((v) + nmh)
#define RESC() do { if (resc) { _Pragma("unroll") for (int d_ = 0; d_ < 2; ++d_) _Pragma("unroll") for (int r = 0; r < 16; ++r) o[d_][r] *= wsf[crow(r, hi)]; } } while (0)
    DMA_K(2, 2 * SLOTB);
    WAIT_BAR(3);
    _Pragma("unroll") for (int d0 = 0; d0 < ND0; ++d0) kload2(kf, kp0, d0);
    pA0 = ldbias(tb0); pA1 = ldbias(tb0 + 128);
    _Pragma("unroll") for (int d0 = 0; d0 < ND0; ++d0) { pA0 = MFMA(kf[2 * d0], qr[d0], pA0); pA1 = MFMA(kf[2 * d0 + 1], qr[d0], pA1); }
    if (NT == 4) cmask(pA0, pA1, 0, qrel, hi);
    { const float rm = rowmax(pA0, pA1); mhat = rm; const float nmh = -mhat;
#pragma unroll
      for (int r = 0; r < 16; ++r) { pA0[r] = EX(pA0[r]); pA1[r] = EX(pA1[r]); } }
    pB0 = ldbias(tb0 + 256); pB1 = ldbias(tb0 + 256 + 128);
    WAIT_BAR(0);
    DMA_K(3, 0); DMA_V(1, SLOTB); ROT();
    _Pragma("unroll") for (int d0 = 0; d0 < ND0; ++d0) kload2(kf, kp0 + sl_cur, d0);
    WAIT_BAR(2);
#define PKW(P, i) cvtpk_b(P[i], P[i + 1])
#define PAF(k) __builtin_bit_cast(bf16x8, pw##k)
#define VFR(i) (bf16x8){vlo[i][0], vlo[i][1], vlo[i][2], vlo[i][3], vhi[i][0], vhi[i][1], vhi[i][2], vhi[i][3]}
#define VRD(i) do { vlo[i] = vtr(vp_ + (((i) >> 2) * 4096 + ((i) & 3) * 1024)); vhi[i] = vtr(vp_ + (((i) >> 2) * 4096 + ((i) & 3) * 1024 + 512)); } while (0)
#define KRD(G, d0) do { if ((G) && (d0) < ND0) { kload2(kf, kp0 + sl_next, d0); SBAR(); } } while (0)
#define QK(C, i) do { if constexpr ((i) < 2 * ND0) { C = MFMA(kf[(i) < 2 * ND0 ? (i) : 0], qr[(i) < 2 * ND0 ? (i) / 2 : 0], C); } } while (0)
#define GAPA(MF, a0, a1, a2, a3, W0, W1, PW) do { MF; sacc += a0; sacc += a1; sacc += a2; sacc += a3; W0; W1; PIN(PW); PIN(sacc); SBAR(); } while (0)
#define GAPB(MF, X, i) do { MF; X[i] = EX(X[i]); X[i + 1] = EX(X[i + 1]); X[i + 2] = EX(X[i + 2]); X[i + 3] = EX(X[i + 3]); PIN(X); SBAR(); } while (0)
#define STEP(C0, C1, P0, P1, t, MASK, GK, GV, GL) do { SBAR(); \
    const lds_cptr vp_ = vp0 + sl_prev; \
    VRD(0); SBAR(); float sacc = P0[0] + P0[1]; \
                    GAPA(QK(C0, 0), P0[2], P0[3], P0[4], P0[5],     pw0[0] = PKW(P0, 0),  pw0[1] = PKW(P0, 2),  pw0); \
    VRD(4); SBAR(); GAPA(QK(C1, 1), P0[6], P0[7], P0[8], P0[9],     pw0[2] = PKW(P0, 4),  pw0[3] = PKW(P0, 6),  pw0); \
    VRD(1); SBAR(); GAPA(QK(C0, 2), P0[10], P0[11], P0[12], P0[13], pw1[0] = PKW(P0, 8),  pw1[1] = PKW(P0, 10), pw1); \
    VRD(5); SBAR(); GAPA(QK(C1, 3), P0[14], P0[15], P1[0], P1[1],   pw1[2] = PKW(P0, 12), pw1[3] = PKW(P0, 14), pw1); \
    VRD(2); SBAR(); GAPA(QK(C0, 4), P1[2], P1[3], P1[4], P1[5],     pw2[0] = PKW(P1, 0),  pw2[1] = PKW(P1, 2),  pw2); \
    VRD(6); SBAR(); GAPA(QK(C1, 5), P1[6], P1[7], P1[8], P1[9],     pw2[2] = PKW(P1, 4),  pw2[3] = PKW(P1, 6),  pw2); \
    VRD(3); SBAR(); GAPA(QK(C0, 6), P1[10], P1[11], P1[12], P1[13], pw3[0] = PKW(P1, 8),  pw3[1] = PKW(P1, 10), pw3); \
    VRD(7); SBAR(); GAPA(QK(C1, 7), P1[14], P1[15], 0.f, 0.f,       pw3[2] = PKW(P1, 12), pw3[3] = PKW(P1, 14), pw3); \
    l_reg += sacc; \
    if (GK) DMA_K((t) + 3, sl_cur); if (GV) DMA_V((t) + 1, sl_next); \
    if (MASK) cmask(C0, C1, (t) - (NT - 4), qrel, hi); \
    { const float rm = rowmax(C0, C1) - mhat; resc = false; \
      if (__builtin_expect(__any(rm > (float)THR), 0)) { const float dl = __builtin_fmaxf(rm, 0.f); mhat += dl; \
          const float f = __builtin_amdgcn_exp2f(-dl); l_reg *= f; if (hi == 0) wsf[r32] = f; resc = true; } } \
    const float nmh = -mhat; SBAR(); \
    if (GL) { P0 = ldbias(tb0 + ((t) + 1) * 256); P1 = ldbias(tb0 + ((t) + 1) * 256 + 128); } SBAR(); \
    GAPB(o[0] = MFMA(PAF(0), VFR(0), o[0]), C0, 0);              GAPB(o[1] = MFMA(PAF(0), VFR(4), o[1]), C0, 4); \
    KRD(GL, 0); GAPB(o[0] = MFMA(PAF(1), VFR(1), o[0]), C0, 8);  KRD(GL, 1); GAPB(o[1] = MFMA(PAF(1), VFR(5), o[1]), C0, 12); \
    KRD(GL, 2); GAPB(o[0] = MFMA(PAF(2), VFR(2), o[0]), C1, 0);  KRD(GL, 3); GAPB(o[1] = MFMA(PAF(2), VFR(6), o[1]), C1, 4); \
    GAPB(o[0] = MFMA(PAF(3), VFR(3), o[0]), C1, 8);              GAPB(o[1] = MFMA(PAF(3), VFR(7), o[1]), C1, 12); \
    if (GL) { PIN(P0); PIN(P1); } \
    } while (0)
    int t = 1;
    for (; t + 5 < NT; t += 2) {
        STEP(pB0, pB1, pA0, pA1, t, false, true, true, true);     WAIT_BAR(2); RESC(); ROT();
        STEP(pA0, pA1, pB0, pB1, t + 1, false, true, true, true); WAIT_BAR(2); RESC(); ROT();
    }
#define ENDW(tt) do { if ((tt) + 3 < NT) { WAIT_BAR(2); } else if ((tt) + 2 < NT) { WAIT_BAR(1); } else { WAIT_BAR(0); } } while (0)
    for (; t + 1 < NT; t += 2) {
        STEP(pB0, pB1, pA0, pA1, t, true, (t + 3 < NT), (t + 1 < NT), (t + 1 < NT));         ENDW(t);     RESC(); ROT();
        STEP(pA0, pA1, pB0, pB1, t + 1, true, (t + 4 < NT), (t + 2 < NT), (t + 2 < NT));     ENDW(t + 1); RESC(); ROT();
    }
    STEP(pB0, pB1, pA0, pA1, NT - 1, true, false, false, false); RESC();
    { float sacc = pB0[0] + pB0[1];
#pragma unroll
      for (int r = 2; r < 16; ++r) sacc += pB0[r];
#pragma unroll
      for (int r = 0; r < 16; ++r) sacc += pB1[r];
      l_reg += sacc;
      pw0 = (u32x4){PKW(pB0, 0), PKW(pB0, 2), PKW(pB0, 4), PKW(pB0, 6)}; pw1 = (u32x4){PKW(pB0, 8), PKW(pB0, 10), PKW(pB0, 12), PKW(pB0, 14)};
      pw2 = (u32x4){PKW(pB1, 0), PKW(pB1, 2), PKW(pB1, 4), PKW(pB1, 6)}; pw3 = (u32x4){PKW(pB1, 8), PKW(pB1, 10), PKW(pB1, 12), PKW(pB1, 14)};
      const lds_cptr vp_ = vp0 + sl_cur; _Pragma("unroll") for (int i = 0; i < 8; ++i) VRD(i);
      o[0] = MFMA(PAF(0), VFR(0), o[0]); o[1] = MFMA(PAF(0), VFR(4), o[1]); o[0] = MFMA(PAF(1), VFR(1), o[0]); o[1] = MFMA(PAF(1), VFR(5), o[1]);
      o[0] = MFMA(PAF(2), VFR(2), o[0]); o[1] = MFMA(PAF(2), VFR(6), o[1]); o[0] = MFMA(PAF(3), VFR(3), o[0]); o[1] = MFMA(PAF(3), VFR(7), o[1]); }
    { auto rr = __builtin_amdgcn_permlane32_swap(__float_as_uint(l_reg), __float_as_uint(l_reg), false, false); l_reg = __uint_as_float(rr[0]) + __uint_as_float(rr[1]); }
    l_out = l_reg;
#undef DMA_K
#undef DMA_V
#undef ROT
#undef EX
#undef RESC
#undef PKW
#undef PAF
#undef VFR
#undef VRD
#undef KRD
#undef QK
#undef ENDW
#undef GAPA
#undef GAPB
#undef STEP
}

__device__ __forceinline__ void row_scales(float l_reg, float extra, float* wsf, int r32, int hi, float (&rli)[16]) {
    if (hi == 0) wsf[32 + r32] = l_reg; asm volatile("s_waitcnt lgkmcnt(0)" ::: "memory");
#pragma unroll
    for (int r = 0; r < 16; ++r) rli[r] = extra * __builtin_amdgcn_rcpf(wsf[32 + crow(r, hi)]);
    asm volatile("s_waitcnt lgkmcnt(0)" ::: "memory");
}

__device__ __forceinline__ void fox_unit(int b, int h, int qb, int kst, const bf16* Z, bf16* Y, char* lds) {
    int tid_ = threadIdx.x; asm volatile("" : "+v"(tid_));
    const int tid = tid_, lane = tid & 63, r32 = lane & 31, hi = lane >> 5; const int wid = __builtin_amdgcn_readfirstlane(tid >> 6);
    f32x16 o[2]; float l_reg;
    attn_pass<4>(b, qb, kst, Z, ZC_FQ + h * 64, ZC_FK + h * 64, ZC_FV + h * 64, 0, lds, o, l_reg);
    float* wsf = (float*)(lds + LDS_WS) + wid * 64; float rli[16]; row_scales(l_reg, 1.f, wsf, r32, hi, rli);
    const long row0 = (long)b * SEQ + qb * QB + wid * QBLK;
    unsigned short* stg = (unsigned short*)(lds + LDS_OST) + wid * 4096;
#pragma unroll
    for (int r = 0; r < 16; ++r) { const int orow = crow(r, hi);
#pragma unroll
        for (int d0 = 0; d0 < 2; ++d0) stg[orow * 64 + d0 * 32 + r32] = (unsigned short)f2bf(o[d0][r] * rli[r]); }
    asm volatile("s_waitcnt lgkmcnt(0)" ::: "memory");
#pragma unroll
    for (int i = 0; i < 4; ++i) { const int row = i * 8 + (lane >> 3), ch = lane & 7;
        const u32x4 ov = *(const u32x4*)(stg + row * 64 + ch * 8); const u32x4 gv = *(const u32x4*)(Z + (row0 + row) * PITCH + ZC_FG + h * 64 + ch * 8);
        u32x4 w;
#pragma unroll
        for (int e = 0; e < 4; ++e) { const float o0 = __uint_as_float(ov[e] << 16), o1 = __uint_as_float(ov[e] & 0xffff0000u), g0 = __uint_as_float(gv[e] << 16), g1 = __uint_as_float(gv[e] & 0xffff0000u);
            w[e] = pk2(o0 / (1.f + __expf(-g0)), o1 / (1.f + __expf(-g1))); }
        *(u32x4*)(Y + (row0 + row) * D + 512 + h * 64 + ch * 8) = w; }
    asm volatile("s_waitcnt lgkmcnt(0)\n\ts_barrier" ::: "memory");
}

__device__ __forceinline__ void diff_unit(int b, int h, int qb, int kst, const bf16* Z, bf16* Y, float lam, float oscale, const float* subg, char* lds) {
    int tid_ = threadIdx.x; asm volatile("" : "+v"(tid_));
    const int tid = tid_, lane = tid & 63, r32 = lane & 31, hi = lane >> 5; const int wid = __builtin_amdgcn_readfirstlane(tid >> 6);
    float* wsf = (float*)(lds + LDS_WS) + wid * 64; float* stg = (float*)(lds + LDS_OST) + wid * 2048;
    const long row0 = (long)b * SEQ + qb * QB + wid * QBLK;
    for (int c = 0; c < 2; ++c) {
        f32x16 o[2]; float l_reg;
        attn_pass<2>(b, qb, kst, Z, ZC_DQ + h * 64 + c * 32, ZC_DK + h * 64, ZC_DV + h * 64, c * 4096, lds, o, l_reg);
        float rli[16]; row_scales(l_reg, c == 0 ? 1.f : -lam, wsf, r32, hi, rli);
#pragma unroll
        for (int r = 0; r < 16; ++r) { const int orow = crow(r, hi);
#pragma unroll
            for (int d0 = 0; d0 < 2; ++d0) { float* p = stg + orow * 64 + d0 * 32 + r32; const float v = o[d0][r] * rli[r]; *p = (c == 0) ? v : (*p + v); } }
        asm volatile("s_waitcnt lgkmcnt(0)\n\ts_barrier" ::: "memory");
    }
#pragma unroll
    for (int i = 0; i < 4; ++i) { const int row = i * 8 + (lane >> 3), ch = lane & 7;
        const f32x4v a = *(const f32x4v*)(stg + row * 64 + ch * 8), c4 = *(const f32x4v*)(stg + row * 64 + ch * 8 + 4);
        float ss = (a[0] * a[0] + a[1] * a[1]) + (a[2] * a[2] + a[3] * a[3]) + (c4[0] * c4[0] + c4[1] * c4[1]) + (c4[2] * c4[2] + c4[3] * c4[3]);
        ss += __shfl_xor(ss, 1); ss += __shfl_xor(ss, 2); ss += __shfl_xor(ss, 4);
        const float rs = oscale / sqrtf(ss * (1.f / 64.f) + EPS);
        const f32x4v g0 = *(const f32x4v*)(subg + ch * 8), g1 = *(const f32x4v*)(subg + ch * 8 + 4);
        u32x4 w; w[0] = pk2(a[0] * rs * g0[0], a[1] * rs * g0[1]); w[1] = pk2(a[2] * rs * g0[2], a[3] * rs * g0[3]); w[2] = pk2(c4[0] * rs * g1[0], c4[1] * rs * g1[1]); w[3] = pk2(c4[2] * rs * g1[2], c4[3] * rs * g1[3]);
        *(u32x4*)(Y + (row0 + row) * D + 256 + h * 64 + ch * 8) = w; }
    asm volatile("s_waitcnt lgkmcnt(0)\n\ts_barrier" ::: "memory");
}
#undef SBAR
#undef PIN
#undef MFMA
#undef WAIT_BAR
#undef MX3
}
namespace rec {
using att::bf16x8; using att::s16x4; using att::f32x16; using att::f32x4v; using att::u32x4;
typedef __attribute__((address_space(3))) char* lptr;
typedef short v4i16_t __attribute__((ext_vector_type(4)));
constexpr int SEGL = 128, NSEG = SEQ / SEGL, NBLK = SEGL / 32, TSTR = 136;
constexpr int W_Q = 0, W_K = 32 * TSTR, W_V = 2 * 32 * TSTR, W_TAB = 3 * 32 * TSTR, W_BYTES = W_TAB + 512;
static_assert(W_BYTES * NWAVES <= RING_BYTES && W_TAB % 16 == 0, "rec LDS map");
constexpr int IMG_H = 4 * 16 * 64, IMG_M = 6 * 16 * 64;
#define RMFMA(a, b, c) __builtin_amdgcn_mfma_f32_32x32x16_bf16(a, b, c, 0, 0, 0)
#define LFENCE() asm volatile("s_waitcnt lgkmcnt(0)" ::: "memory")
__device__ __forceinline__ float fsig(float x) { return __builtin_amdgcn_rcpf(1.f + __builtin_amdgcn_exp2f(x * -1.44269504f)); }
constexpr float EMIN = 1.8048514e-35f;
__device__ __forceinline__ bf16x8 join(s16x4 a, s16x4 b) { return (bf16x8){a[0], a[1], a[2], a[3], b[0], b[1], b[2], b[3]}; }
__device__ __forceinline__ s16x4 vtr(lptr p) { return __builtin_bit_cast(s16x4, __builtin_amdgcn_ds_read_tr16_b64_v4i16((__attribute__((address_space(3))) v4i16_t*)p)); }
__device__ __forceinline__ bf16x8 rowfrag(lptr tile, int r32, int hi, int ks) {
    const lptr p = tile + r32 * TSTR + (16 * ks + 4 * hi) * 2;
    return join(*(const __attribute__((address_space(3))) s16x4*)p, *(const __attribute__((address_space(3))) s16x4*)(p + 16)); }
__device__ __forceinline__ bf16x8 trfrag(lptr tile, int lane, int ct, int ks) {
    const int hi = lane >> 5, i = lane & 15, gb = (lane >> 4) & 1;
    const lptr p = tile + (16 * ks + 4 * hi + (i >> 2)) * TSTR + (32 * ct + 16 * gb + 4 * (i & 3)) * 2;
    return join(vtr(p), vtr(p + 8 * TSTR)); }
__device__ __forceinline__ bf16x8 accfrag(const f32x16& x, int ks) {
    u32x4 w; w[0] = att::cvtpk_b(x[8 * ks], x[8 * ks + 1]); w[1] = att::cvtpk_b(x[8 * ks + 2], x[8 * ks + 3]); w[2] = att::cvtpk_b(x[8 * ks + 4], x[8 * ks + 5]); w[3] = att::cvtpk_b(x[8 * ks + 6], x[8 * ks + 7]);
    return __builtin_bit_cast(bf16x8, w); }

struct RecPtrs { const bf16* Z; const float* gates; bf16* Y; float* imgH; float* imgM; float* decH; float* decM;
                 const float* lbl; const float* ng; const float* convw; const float* ibias; const float* fbias; int layer; };

template <bool ML, bool FULL>
__device__ __forceinline__ void rec_unit(const RecPtrs& P, int bh, int seg, char* wlds) {
    constexpr int NVT = ML ? 3 : 2, NT = 2 * NVT;
    int lane_ = threadIdx.x & 63; asm volatile("" : "+v"(lane_));
    const int lane = lane_, r32 = lane & 31, hi = lane >> 5, h = bh & 3, b = bh >> 2;
    const lptr wl = (lptr)wlds; const lptr tq = wl + W_Q, tk = wl + W_K, tv = wl + W_V;
    __attribute__((address_space(3))) float* tab = (__attribute__((address_space(3))) float*)(wl + W_TAB);
    f32x16 S[NT];
    float* img = ML ? P.imgM + (size_t)(bh * NSEG + seg) * IMG_M : P.imgH + (size_t)(bh * NSEG + seg) * IMG_H;
    if (FULL) {
#pragma unroll
        for (int t = 0; t < NT; ++t)
#pragma unroll
            for (int g = 0; g < 16; ++g) S[t][g] = img[(t * 16 + g) * 64 + lane];
    } else {
#pragma unroll
        for (int t = 0; t < NT; ++t) S[t] = f32x16{};
    }
    float lb = 0.f, oml = 1.f, wq0 = 0.f, wq1 = 0.f, wq2 = 0.f, wq3 = 0.f, wk0 = 0.f, wk1 = 0.f, wk2 = 0.f, wk3 = 0.f, ib = 0.f, fb = 0.f;
    float q1 = 0.f, q2 = 0.f, q3 = 0.f, k1 = 0.f, k2 = 0.f, k3 = 0.f, dtot = 1.f;
    const int c = h * 64 + lane;
    const long rowS = (long)b * SEQ + seg * SEGL;
    if (!ML) {
        if (P.layer == 1) { const float a0 = P.lbl[c], a1 = P.lbl[256 + c]; const float mx = fmaxf(a0, a1); const float e0 = expf(a0 - mx), e1 = expf(a1 - mx); lb = e1 / (e0 + e1); }
        oml = 1.f - lb;
        if (FULL) tab[64 + lane] = P.ng[lane];
    } else {
        wk0 = P.convw[0 * 512 + 256 + c]; wk1 = P.convw[1 * 512 + 256 + c]; wk2 = P.convw[2 * 512 + 256 + c]; wk3 = P.convw[3 * 512 + 256 + c];
        if (FULL) { wq0 = P.convw[0 * 512 + c]; wq1 = P.convw[1 * 512 + c]; wq2 = P.convw[2 * 512 + c]; wq3 = P.convw[3 * 512 + c]; }
        ib = P.ibias[h]; fb = P.fbias[h];
        if (seg > 0) { const bf16* zp = P.Z + (rowS - 3) * ZP + c;
            k3 = bf2f(zp[ZC_MK]); k2 = bf2f(zp[ZP + ZC_MK]); k1 = bf2f(zp[2 * ZP + ZC_MK]);
            if (FULL) { q3 = bf2f(zp[ZC_MQ]); q2 = bf2f(zp[ZP + ZC_MQ]); q1 = bf2f(zp[2 * ZP + ZC_MQ]); } }
    }
    const bf16x8 ones = (r32 == 0) ? (bf16x8){0x3F80, 0x3F80, 0x3F80, 0x3F80, 0x3F80, 0x3F80, 0x3F80, 0x3F80} : (bf16x8){0, 0, 0, 0, 0, 0, 0, 0};
#define LOADV(VW, R0) do { _Pragma("unroll") for (int i_ = 0; i_ < 4; ++i_) VW[i_] = *(const u32x4*)(P.Z + ((R0) + (lane >> 3) + 8 * i_) * ZP + h * 64 + (lane & 7) * 8 + (ML ? ZC_MV : ZC_HI)); } while (0)
#define LOADG(GF, GI, R0) do { if (ML) { const float* gp_ = P.gates + (size_t)((R0) + (lane & 31)) * 12 + h; GF = gp_[8]; GI = gp_[4]; } } while (0)
#define RAWDMA(REGION, COL, R0) do { _Pragma("unroll") for (int j_ = 0; j_ < 4; ++j_) \
        att::glds16(P.Z + ((R0) + 8 * j_ + (lane >> 3)) * ZP + (COL) + h * 64 + (((lane & 7) ^ (lane >> 3)) * 8), (unsigned)__builtin_amdgcn_readfirstlane((int)(unsigned)(uintptr_t)((REGION) + j_ * 1024))); } while (0)
#define WSTORE(TILE, W) do { _Pragma("unroll") for (int i_ = 0; i_ < 4; ++i_) { \
            __attribute__((address_space(3))) unsigned long long* dp_ = (__attribute__((address_space(3))) unsigned long long*)((TILE) + ((lane >> 3) + 8 * i_) * TSTR + (lane & 7) * 16); \
            dp_[0] = (unsigned long long)W[i_][0] | ((unsigned long long)W[i_][1] << 32); dp_[1] = (unsigned long long)W[i_][2] | ((unsigned long long)W[i_][3] << 32); } } while (0)
    const lptr rawK = tq, rawQ = tk;
    constexpr int COLK = ML ? ZC_MK : ZC_HF, COLQ = ML ? ZC_MQ : ZC_HQ;
    RAWDMA(rawK, COLK, rowS); if (FULL) RAWDMA(rawQ, COLQ, rowS);
    u32x4 vwN[4]; float glfN = 0.f, gliN = 0.f;
    if (!FULL) LOADV(vwN, rowS);
    LOADG(glfN, gliN, rowS);
    const int i16 = lane & 15, rr = i16 >> 2, pc = 2 * (lane >> 4) + ((i16 & 3) >> 1);
    const int troffE = rr * 128 + ((pc ^ rr) << 4) + (i16 & 1) * 8, troffO = rr * 128 + ((pc ^ (4 + rr)) << 4) + (i16 & 1) * 8;
    for (int blk = 0; blk < NBLK; ++blk) {
        const long row0 = rowS + blk * 32;
        u32x4 vw[4]; const float glf = glfN, gli = gliN;
        asm volatile("s_waitcnt vmcnt(0)" ::: "memory");
        if (!FULL) {
#pragma unroll
            for (int i = 0; i < 4; ++i) vw[i] = vwN[i];
        }
        s16x4 ra4[8], rb4[8];
#pragma unroll
        for (int pb = 0; pb < 8; ++pb) { ra4[pb] = vtr(rawK + pb * 512 + ((pb & 1) ? troffO : troffE)); if (FULL) rb4[pb] = vtr(rawQ + pb * 512 + ((pb & 1) ? troffO : troffE)); }
        LFENCE();
        if (FULL) LOADV(vw, row0);
        if (!FULL) { if (blk + 1 < NBLK) { RAWDMA(rawK, COLK, row0 + 32); LOADV(vwN, row0 + 32); LOADG(glfN, gliN, row0 + 32); }
            WSTORE(tv, vw); }
        float dec;
        if (!ML) {
            float E = 1.f;
#pragma unroll
            for (int t2 = 0; t2 < 16; ++t2) {
                float kq[2], qq[2];
#pragma unroll
                for (int u = 0; u < 2; ++u) { const int t = 2 * t2 + u;
                    const float f = lb + oml * fsig(bf2f((bf16)ra4[t >> 2][t & 3]));
                    E *= f; const float e = fmaxf(E, EMIN);
                    kq[u] = (1.f - f) * __builtin_amdgcn_rcpf(e);
                    if (FULL) qq[u] = bf2f((bf16)rb4[t >> 2][t & 3]) * e; }
                const unsigned wkk = att::cvtpk(kq[0], kq[1]);
                *(__attribute__((address_space(3))) bf16*)(tk + (2 * t2) * TSTR + lane * 2) = (bf16)(wkk & 0xffffu); *(__attribute__((address_space(3))) bf16*)(tk + (2 * t2 + 1) * TSTR + lane * 2) = (bf16)(wkk >> 16);
                if (FULL) { const unsigned wqq = att::cvtpk(qq[0], qq[1]);
                    *(__attribute__((address_space(3))) bf16*)(tq + (2 * t2) * TSTR + lane * 2) = (bf16)(wqq & 0xffffu); *(__attribute__((address_space(3))) bf16*)(tq + (2 * t2 + 1) * TSTR + lane * 2) = (bf16)(wqq >> 16); }
            }
            dec = fmaxf(E, EMIN);
            tab[lane] = dec;
        } else {
            float F = fsig(glf + fb);
            { float t_;
              t_ = __builtin_bit_cast(float, __builtin_amdgcn_update_dpp(0x3f800000, __builtin_bit_cast(int, F), 0x111, 0xf, 0xf, false)); F *= t_;
              t_ = __builtin_bit_cast(float, __builtin_amdgcn_update_dpp(0x3f800000, __builtin_bit_cast(int, F), 0x112, 0xf, 0xf, false)); F *= t_;
              t_ = __builtin_bit_cast(float, __builtin_amdgcn_update_dpp(0x3f800000, __builtin_bit_cast(int, F), 0x114, 0xf, 0xf, false)); F *= t_;
              t_ = __builtin_bit_cast(float, __builtin_amdgcn_update_dpp(0x3f800000, __builtin_bit_cast(int, F), 0x118, 0xf, 0xf, false)); F *= t_;
              const float r0 = __builtin_bit_cast(float, __builtin_amdgcn_readlane(__builtin_bit_cast(int, F), 15)); if (lane & 16) F *= r0; }
            const int ekb = __builtin_bit_cast(int, __builtin_amdgcn_exp2f((gli + ib) * LOG2E) * __builtin_amdgcn_rcpf(F)), eqb = __builtin_bit_cast(int, F * 0.125f);
            dec = fmaxf(__builtin_bit_cast(float, __builtin_amdgcn_readlane(__builtin_bit_cast(int, F), 31)), EMIN);
#pragma unroll
            for (int t2 = 0; t2 < 16; ++t2) {
                float kq[2], qq[2];
#pragma unroll
                for (int u = 0; u < 2; ++u) { const int t = 2 * t2 + u;
                    const float k0 = bf2f((bf16)ra4[t >> 2][t & 3]); float kc = wk3 * k0 + wk2 * k1 + wk1 * k2 + wk0 * k3; k3 = k2; k2 = k1; k1 = k0;
                    kq[u] = kc * fsig(kc) * __builtin_bit_cast(float, __builtin_amdgcn_readlane(ekb, t));
                    if (FULL) { const float q0 = bf2f((bf16)rb4[t >> 2][t & 3]); float qc = wq3 * q0 + wq2 * q1 + wq1 * q2 + wq0 * q3; q3 = q2; q2 = q1; q1 = q0;
                        qq[u] = qc * fsig(qc) * __builtin_bit_cast(float, __builtin_amdgcn_readlane(eqb, t)); } }
                const unsigned wkk = att::cvtpk(kq[0], kq[1]);
                *(__attribute__((address_space(3))) bf16*)(tk + (2 * t2) * TSTR + lane * 2) = (bf16)(wkk & 0xffffu); *(__attribute__((address_space(3))) bf16*)(tk + (2 * t2 + 1) * TSTR + lane * 2) = (bf16)(wkk >> 16);
                if (FULL) { const unsigned wqq = att::cvtpk(qq[0], qq[1]);
                    *(__attribute__((address_space(3))) bf16*)(tq + (2 * t2) * TSTR + lane * 2) = (bf16)(wqq & 0xffffu); *(__attribute__((address_space(3))) bf16*)(tq + (2 * t2 + 1) * TSTR + lane * 2) = (bf16)(wqq >> 16); }
            }
        }
        dtot *= dec;
        unsigned long long gwp[8];
        if (FULL) {
#pragma unroll
            for (int vt = 0; vt < 2; ++vt)
#pragma unroll
                for (int g4 = 0; g4 < 4; ++g4) gwp[vt * 4 + g4] = *(const unsigned long long*)(P.Z + (row0 + r32) * ZP + (ML ? ZC_MO : ZC_HG) + h * 64 + 32 * vt + 8 * g4 + 4 * hi); }
        if (FULL) WSTORE(tv, vw);
        LFENCE();
        bf16x8 vf[NVT][2];
#pragma unroll
        for (int vt = 0; vt < 2; ++vt)
#pragma unroll
            for (int ks = 0; ks < 2; ++ks) vf[vt][ks] = trfrag(tv, lane, vt, ks);
        if (ML) { vf[NVT - 1][0] = ones; vf[NVT - 1][1] = ones; }
        if (FULL) {
            bf16x8 qf[4], kf[4];
#pragma unroll
            for (int ks = 0; ks < 4; ++ks) { qf[ks] = rowfrag(tq, r32, hi, ks); kf[ks] = rowfrag(tk, r32, hi, ks); }
            LFENCE();
            if (blk + 1 < NBLK) { RAWDMA(rawK, COLK, row0 + 32); LOADG(glfN, gliN, row0 + 32); }
            f32x16 x1 = f32x16{};
#pragma unroll
            for (int ks = 0; ks < 4; ++ks) x1 = RMFMA(kf[ks], qf[ks], x1);
#pragma unroll
            for (int g = 0; g < 16; ++g) if (att::crow(g, hi) > r32) x1[g] = 0.f;
            const bf16x8 xb0 = accfrag(x1, 0), xb1 = accfrag(x1, 1);
            f32x16 ot[NVT];
#pragma unroll
            for (int vt = 0; vt < NVT; ++vt) {
                ot[vt] = RMFMA(vf[vt][0], xb0, f32x16{}); ot[vt] = RMFMA(vf[vt][1], xb1, ot[vt]);
#pragma unroll
                for (int dt = 0; dt < 2; ++dt)
#pragma unroll
                    for (int ks = 0; ks < 2; ++ks) ot[vt] = RMFMA(accfrag(S[dt * NVT + vt], ks), qf[2 * dt + ks], ot[vt]);
            }
            const long orow = row0 + r32;
            if (!ML) {
                float ss = 0.f;
#pragma unroll
                for (int vt = 0; vt < 2; ++vt)
#pragma unroll
                    for (int g = 0; g < 16; ++g) ss += ot[vt][g] * ot[vt][g];
                { auto rr = __builtin_amdgcn_permlane32_swap(__float_as_uint(ss), __float_as_uint(ss), false, false); ss = __uint_as_float(rr[0]) + __uint_as_float(rr[1]); }
                const float rstd = __builtin_amdgcn_rsqf(ss * (1.f / 64.f) + EPS);
#pragma unroll
                for (int vt = 0; vt < 2; ++vt)
#pragma unroll
                    for (int g4 = 0; g4 < 4; ++g4) { const int v0 = 32 * vt + 8 * g4 + 4 * hi;
                        const f32x4v gn = *(const __attribute__((address_space(3))) f32x4v*)(tab + 64 + v0);
                        const unsigned long long gw = gwp[vt * 4 + g4];
                        float o4[4];
#pragma unroll
                        for (int e = 0; e < 4; ++e) { const float gv = __uint_as_float((unsigned)((gw >> (16 * e)) & 0xffffu) << 16); o4[e] = ot[vt][4 * g4 + e] * rstd * gn[e] * gv * fsig(gv); }
                        *(unsigned long long*)(P.Y + orow * D + h * 64 + v0) = (unsigned long long)att::cvtpk(o4[0], o4[1]) | ((unsigned long long)att::cvtpk(o4[2], o4[3]) << 32); }
            } else {
                const float den = __shfl(ot[NVT - 1][0], r32); const float rd = 1.f / fmaxf(fabsf(den), 1.f);
#pragma unroll
                for (int vt = 0; vt < 2; ++vt)
#pragma unroll
                    for (int g4 = 0; g4 < 4; ++g4) { const int v0 = 32 * vt + 8 * g4 + 4 * hi;
                        const unsigned long long gw = gwp[vt * 4 + g4];
                        float o4[4];
#pragma unroll
                        for (int e = 0; e < 4; ++e) { const float gv = __uint_as_float((unsigned)((gw >> (16 * e)) & 0xffffu) << 16); o4[e] = ot[vt][4 * g4 + e] * rd * fsig(gv); }
                        *(unsigned long long*)(P.Y + orow * D + 768 + h * 64 + v0) = (unsigned long long)att::cvtpk(o4[0], o4[1]) | ((unsigned long long)att::cvtpk(o4[2], o4[3]) << 32); }
            }
        }
        {
            bf16x8 ktf[2][2];
#pragma unroll
            for (int dt = 0; dt < 2; ++dt)
#pragma unroll
                for (int ks = 0; ks < 2; ++ks) ktf[dt][ks] = trfrag(tk, lane, dt, ks);
            if (FULL) { LFENCE(); if (blk + 1 < NBLK) RAWDMA(rawQ, COLQ, row0 + 32); }
#pragma unroll
            for (int dt = 0; dt < 2; ++dt) {
                f32x4v dv[4];
                if (!ML) {
#pragma unroll
                    for (int g4 = 0; g4 < 4; ++g4) dv[g4] = *(const __attribute__((address_space(3))) f32x4v*)(tab + 32 * dt + 8 * g4 + 4 * hi);
                }
#pragma unroll
                for (int vt = 0; vt < NVT; ++vt) { f32x16 s = S[dt * NVT + vt];
                    s = RMFMA(ktf[dt][0], vf[vt][0], s); s = RMFMA(ktf[dt][1], vf[vt][1], s);
#pragma unroll
                    for (int g = 0; g < 16; ++g) s[g] *= ML ? dec : dv[g >> 2][g & 3];
                    S[dt * NVT + vt] = s; }
            }
        }
        LFENCE();
    }
    if (!FULL) {
#pragma unroll
        for (int t = 0; t < NT; ++t)
#pragma unroll
            for (int g = 0; g < 16; ++g) img[(t * 16 + g) * 64 + lane] = S[t][g];
        if (!ML) P.decH[(size_t)(bh * NSEG + seg) * 64 + lane] = dtot;
        else if (lane == 0) P.decM[bh * NSEG + seg] = dtot;
    }
}

__device__ __forceinline__ void scan_items(const RecPtrs& P, int item0, int nitem_stride) {
    int tid_ = threadIdx.x; asm volatile("" : "+v"(tid_)); const int tid = tid_;
    constexpr int ITEMS_H = BATCH * NH * (IMG_H / 512), ITEMS_M = BATCH * NH * (IMG_M / 512), NIT = ITEMS_H + ITEMS_M;
    for (int it0 = item0; it0 < NIT; it0 += 2 * nitem_stride) {
        const bool two = it0 + nitem_stride < NIT;
        float* basev[2]; const float* dpv[2]; int iszv[2], dstrv[2];
#pragma unroll
        for (int q = 0; q < 2; ++q) { const int it = (q == 1 && two) ? it0 + nitem_stride : it0;
            const bool ml = it >= ITEMS_H; const int r = ml ? it - ITEMS_H : it; const int per = ml ? IMG_M / 512 : IMG_H / 512;
            const int bh = r / per, e = (r % per) * 512 + tid; const int isz = ml ? IMG_M : IMG_H;
            basev[q] = (ml ? P.imgM : P.imgH) + (size_t)bh * NSEG * isz + e; iszv[q] = isz;
            const int tile = e >> 10, g = (e >> 6) & 15, ln = e & 63; const int dt = ml ? tile / 3 : tile >> 1; const int d = 32 * dt + att::crow(g, ln >> 5);
            dpv[q] = ml ? P.decM + bh * NSEG : P.decH + (size_t)bh * NSEG * 64 + d; dstrv[q] = ml ? 1 : 64; }
        float u0[NSEG], p0[NSEG], u1[NSEG], p1[NSEG];
#pragma unroll
        for (int j = 0; j < NSEG; ++j) { u0[j] = basev[0][(size_t)j * iszv[0]]; p0[j] = dpv[0][j * dstrv[0]]; }
        if (two) {
#pragma unroll
            for (int j = 0; j < NSEG; ++j) { u1[j] = basev[1][(size_t)j * iszv[1]]; p1[j] = dpv[1][j * dstrv[1]]; } }
        { float s = 0.f;
#pragma unroll
          for (int j = 0; j < NSEG; ++j) { basev[0][(size_t)j * iszv[0]] = s; s = p0[j] * s + u0[j]; } }
        if (two) { float s = 0.f;
#pragma unroll
          for (int j = 0; j < NSEG; ++j) { basev[1][(size_t)j * iszv[1]] = s; s = p1[j] * s + u1[j]; } }
    }
}
#undef LOADV
#undef LOADG
#undef RAWDMA
#undef WSTORE
#undef RMFMA
#undef LFENCE
}
__global__ void __launch_bounds__(NWAVES * 64, 2) mk_fwd(Args args) {
    extern __shared__ __attribute__((aligned(16))) unsigned char lds[];
    Frame F;
    F.lds = (LAS unsigned char*)lds; F.MISC = (volatile LAS unsigned*)(F.lds + MISC_OFF);
    F.tid = threadIdx.x; F.lane = F.tid & 63; F.wave = __builtin_amdgcn_readfirstlane(F.tid >> 6);
    F.G = gridDim.x; { const int bx = blockIdx.x; F.vcu = (F.G % 8 == 0) ? (bx % 8) * (F.G / 8) + bx / 8 : bx; }
    unsigned char* ws = args.ws;
    F.ctl = (gu32*)(ws + WS_CTL);
    for (int u = F.tid; u < (LDS_BYTES - LDSCTL_OFF) / 4; u += NWAVES * 64) ((LAS unsigned*)(F.lds + LDSCTL_OFF))[u] = 0u;
    __syncthreads();
    XcdBarrier bar = xcd_barrier_post((unsigned*)(F.ctl + CW_BAR) + args.li * XCD_BAR_WORDS, F.MISC + 8);
    const int lo = args.ph_lo, hi = args.ph_hi;
#ifdef PROBE_GROUP
    unsigned long long t_prev = __builtin_amdgcn_s_memrealtime(); unsigned long long t_acc = 0ull;
#define STAMP(grp) do { const unsigned long long t_now = __builtin_amdgcn_s_memrealtime(); if ((grp) == PROBE_GROUP) t_acc += t_now - t_prev; t_prev = t_now; } while (0)
#else
#define STAMP(grp) do {} while (0)
#endif
#define IN(k) (lo <= (k) && (k) < hi)
#define SEAM(k) do { if (IN(k) && IN((k) + 1)) xcd_barrier(bar); } while (0)
    float* mod = (float*)(ws + WS_MOD); float* wgw = (float*)(ws + WS_WG); float* gates = (float*)(ws + WS_GATES);
    bf16* HN = (bf16*)(ws + WS_HN); bf16* Z = (bf16*)(ws + WS_Z); bf16* Y = (bf16*)(ws + WS_Y); bf16* HB = (bf16*)(ws + WS_H); bf16* XB = (bf16*)(ws + WS_XB);
    if (IN(PH_PRO)) { p0_prologue(F, args); }
    SEAM(PH_PRO); STAMP(5);
    for (int l = 0; l < DEPTH; ++l) {
        const int pb = 1 + PH_PER_LAYER * l;
        const float* modl = mod + (size_t)l * 8 * NMOD;
        const float* xin = (l == 0) ? args.in[0] : args.out;
        if (IN(pb + PL_NORM1) && l == 0) {
            bias_all(F, (const bf16*)(ws + WS_WIN), (const bf16*)(ws + WS_W1), mod, (float*)(ws + WS_BIAS1), (float*)(ws + WS_BIAS2)); STAMP(8);
            prenorm0_phase(F, xin, (const float*)(ws + WS_GM1), HN, (float*)(ws + WS_SS1));
        }
        if (l == 0) { SEAM(pb + PL_NORM1); } STAMP(4);
        if (IN(pb + PL_INPROJ)) {
            pg8::Gemm g{HN, (const bf16*)(ws + WS_WIN) + (size_t)l * 4096 * 1024, T, 4096, D}; pg8::StaticOrder S; S.init(T, 4096, F.G, (int)blockIdx.x);
            pg8::EpiInProj E{Z, ZP, (const float*)(ws + WS_QKG) + l * 256, (LAS unsigned char*)(F.lds + XCH_OFF), (const float*)(ws + WS_SS1), (const float*)(ws + WS_BIAS1) + (size_t)l * 8 * 4096, gates, (float*)(ws + WS_FGT)};
            pg8::gemm_phase<pg8::EpiInProj, pg8::StaticOrder, true, true>(F.lds + RING_OFF, g, S, E);
        }
        SEAM(pb + PL_INPROJ); STAMP(11);
        rec::RecPtrs RP{Z, gates, Y, (float*)(ws + WS_IMGH), (float*)(ws + WS_IMGM), (float*)(ws + WS_DECH), (float*)(ws + WS_DECM),
                        args.in[8], args.in[9] + l * HD, args.in[17] + (size_t)l * 4 * 512, args.in[18] + l * NH, args.in[19] + l * NH, l};
        char* al = (char*)lds + RING_OFF; float* tbl = (float*)(al + att::LDS_TBL);
        if (IN(pb + PL_MIXA)) {
            for (int bh = blockIdx.x; bh < BATCH * NH; bh += F.G) fox_scan_block((const float*)(ws + WS_FGT), args.in[16] + l * NH, (float*)(ws + WS_FCUM), (int*)(ws + WS_KST), ((const float*)(ws + WS_SMAX))[l * 2], bh, F.lds);
            for (int w = F.vcu * NWAVES + F.wave; w < 2048; w += F.G * NWAVES) { const int rem = w >> 1;
                if ((((w & 1) ^ (F.wave >> 2)) & 1) == 0) rec::rec_unit<false, false>(RP, rem >> 5, rem & 31, al + F.wave * rec::W_BYTES);
                else rec::rec_unit<true, false>(RP, rem >> 5, rem & 31, al + F.wave * rec::W_BYTES); }
        }
        SEAM(pb + PL_MIXA); STAMP(3);
        if (IN(pb + PL_MIXB)) {
            const bool sched_blk = (F.G == 256) && ((F.vcu & 31) == 0);
            if (!sched_blk) { if (F.G == 256) rec::scan_items(RP, F.vcu - (F.vcu >> 5) - 1, 248); else rec::scan_items(RP, (int)blockIdx.x, F.G); }
            for (int vc = F.vcu; vc < 256; vc += F.G) if ((vc & 31) == 0) {
                int mt_ = threadIdx.x; asm volatile("" : "+v"(mt_));
                const int x = vc >> 5; const int* kstF = (const int*)(ws + WS_KST); const float smax_d = ((const float*)(ws + WS_SMAX))[l * 2 + 1];
                LAS int* cst = (LAS int*)(F.lds);
                __syncthreads();
                if (mt_ < 128) { const int v = mt_, ty = v >> 6, hh = (v >> 4) & 3, qb = v & 15, nt = 4 * qb + 4; int ks, c;
                    if (ty == 0) { ks = kstF[(4 * x + hh) * 16 + qb]; c = (nt - ks + 4) * 100; }
                    else { const float slope2 = exp2f(-2.0f * (float)(hh + 1)) * LOG2E; const float jf = ((float)(256 * qb) - (152.0f + 2.0f * smax_d) / slope2 - 63.0f) * (1.0f / 64.0f);
                        ks = jf > 0.f ? (int)jf : 0; ks = ks < nt - 4 ? ks : nt - 4; ks &= ~1; c = (nt - ks + 4) * 215; }
                    cst[v] = c; cst[128 + v] = ks; }
                cst[512 + mt_] = -1; cst[512 + 512 + mt_] = -1;
                __syncthreads();
                if (mt_ < 128) { const int c = cst[mt_]; int rank = 0;
                    for (int v4 = 0; v4 < 32; ++v4) { const v4u cc = *(const LAS v4u*)(cst + 4 * v4);
                        rank += ((int)cc.x > c || ((int)cc.x == c && 4 * v4 + 0 < mt_)) + ((int)cc.y > c || ((int)cc.y == c && 4 * v4 + 1 < mt_)) + ((int)cc.z > c || ((int)cc.z == c && 4 * v4 + 2 < mt_)) + ((int)cc.w > c || ((int)cc.w == c && 4 * v4 + 3 < mt_)); }
                    cst[256 + rank] = mt_; }
                __syncthreads();
                if (F.wave == 0) {
                    const int ln = mt_ & 63; int load = 0, own_lo = 0, own_hi = 0;
                    const int c_lo = cst[cst[256 + ln]], c_hi = cst[cst[256 + 64 + ln]];
                    for (int r = 0; r < 128; ++r) {
                        const int c = (r < 64) ? __builtin_amdgcn_readlane(c_lo, r & 63) : __builtin_amdgcn_readlane(c_hi, r & 63);
                        int m = (ln < 32) ? ((load << 5) | ln) : 0x7fffffff;
                        { int t2;
                          t2 = __builtin_amdgcn_update_dpp(0x7fffffff, m, 0x111, 0xf, 0xf, false); m = t2 < m ? t2 : m;
                          t2 = __builtin_amdgcn_update_dpp(0x7fffffff, m, 0x112, 0xf, 0xf, false); m = t2 < m ? t2 : m;
                          t2 = __builtin_amdgcn_update_dpp(0x7fffffff, m, 0x114, 0xf, 0xf, false); m = t2 < m ? t2 : m;
                          t2 = __builtin_amdgcn_update_dpp(0x7fffffff, m, 0x118, 0xf, 0xf, false); m = t2 < m ? t2 : m; }
                        const int m0 = __builtin_amdgcn_readlane(m, 15), m1 = __builtin_amdgcn_readlane(m, 31); const int o = (m0 < m1 ? m0 : m1) & 31;
                        load += (ln == o) ? c : 0;
                        if (r < 64) own_lo = (ln == r) ? o : own_lo; else own_hi = (ln == (r - 64)) ? o : own_hi; }
                    cst[384 + ln] = own_lo; cst[384 + 64 + ln] = own_hi;
                }
                __syncthreads();
                if (mt_ < 128) { const int o = cst[384 + mt_]; int pos = 0;
                    for (int r4 = 0; r4 < 32; ++r4) { const v4u oo = *(const LAS v4u*)(cst + 384 + 4 * r4);
                        pos += ((int)oo.x == o && 4 * r4 + 0 < mt_) + ((int)oo.y == o && 4 * r4 + 1 < mt_) + ((int)oo.z == o && 4 * r4 + 2 < mt_) + ((int)oo.w == o && 4 * r4 + 3 < mt_); }
                    const int v = cst[256 + mt_]; if (pos < 32) cst[512 + o * 32 + pos] = v | (cst[128 + v] << 8); }
                __syncthreads();
                int* gl = (int*)(ws + WS_SCHED) + x * 1024;
                for (int i = mt_; i < 1024; i += NWAVES * 64) gl[i] = cst[512 + i];
                __syncthreads();
            }
        }
        SEAM(pb + PL_MIXB); STAMP(6);
        if (IN(pb + PL_MIXC)) {
            for (int w = F.vcu * NWAVES + F.wave; w < 2048; w += F.G * NWAVES) { const int rem = w >> 1;
                if ((((w & 1) ^ (F.wave >> 2)) & 1) == 0) rec::rec_unit<false, true>(RP, rem >> 5, rem & 31, al + F.wave * rec::W_BYTES);
                else rec::rec_unit<true, true>(RP, rem >> 5, rem & 31, al + F.wave * rec::W_BYTES); }
            __syncthreads(); STAMP(7);
            int mt_ = threadIdx.x; asm volatile("" : "+v"(mt_));
            const float* Fc = (const float*)(ws + WS_FCUM); const int* kstF = (const int*)(ws + WS_KST);
            const float smax_d = ((const float*)(ws + WS_SMAX))[l * 2 + 1];
            const float lam_init = 0.8f - 0.6f * expf(-0.3f * (float)l);
            float lam; { const float* lv = args.in[12] + l * 128; float d01 = 0.f, d23 = 0.f; for (int i = 0; i < 32; ++i) { d01 += lv[i] * lv[32 + i]; d23 += lv[64 + i] * lv[96 + i]; } lam = expf(d01) - expf(d23) + lam_init; }
            LAS int* cst = (LAS int*)(F.lds + 134144);
            static_assert(att::LDS_END <= 134144 && 134144 + (384 + 1024) * 4 <= LDSCTL_OFF, "unit table placement");
            for (int vc = F.vcu; vc < 256; vc += F.G) {
                const int x = vc >> 5, j = vc & 31; const int* myl = (const int*)(ws + WS_SCHED) + (x * 32 + j) * 32;
                for (int k2 = 0; k2 < 64; ++k2) {
                    const int e = myl[k2 & 31]; if (e < 0) continue;
                    const int v = e & 255, ks = e >> 8; if ((v >> 6) != (k2 >> 5)) continue;
                    const int ty = v >> 6, h = (v >> 4) & 3, qb = v & 15, b = x, bh = 4 * x + h;
                    if (ty == 0) {
                        for (int i = ks * 64 + mt_; i < 256 * qb + 256; i += NWAVES * 64) tbl[i] = -Fc[(size_t)bh * SEQ + i] * LOG2E;
                        att::fox_unit(b, h, qb, ks, Z, Y, al);
                    } else {
                        const float slope2 = exp2f(-2.0f * (float)(h + 1)) * LOG2E;
                        for (int i = ks * 64 + mt_; i < 256 * qb + 256; i += NWAVES * 64) tbl[i] = slope2 * (float)i;
                        att::diff_unit(b, h, qb, ks, Z, Y, lam, 1.f - lam_init, args.in[13] + l * HD, al);
                    }
                }
            }
        }
        SEAM(pb + PL_MIXC); STAMP(2);
        if (IN(pb + PL_OUTPROJ)) {
            pg8::Gemm g{Y, (const bf16*)(ws + WS_WOUT) + (size_t)l * 1024 * 1024, T, D, D}; pg8::StaticOrder S; S.init(T, D, F.G, (int)blockIdx.x);
            if (l == 0) { pg8::EpiResGateN<false, true> E{args.in[0], XB, modl + 2 * D, (const float*)(ws + WS_GM2) + (size_t)l * 8 * D, HN, (float*)(ws + WS_SSQ), (LAS float*)(F.lds + XCH_OFF), (LAS unsigned char*)(F.lds + XCH_OFF + 4096)};
                pg8::gemm_phase<pg8::EpiResGateN<false, true>, pg8::StaticOrder, true, true>(F.lds + RING_OFF, g, S, E); }
            else { pg8::EpiResGateN<true, true> E{XB, XB, modl + 2 * D, (const float*)(ws + WS_GM2) + (size_t)l * 8 * D, HN, (float*)(ws + WS_SSQ), (LAS float*)(F.lds + XCH_OFF), (LAS unsigned char*)(F.lds + XCH_OFF + 4096)};
                pg8::gemm_phase<pg8::EpiResGateN<true, true>, pg8::StaticOrder, true, true>(F.lds + RING_OFF, g, S, E); }
        }
        SEAM(pb + PL_OUTPROJ); STAMP(12);
        if (IN(pb + PL_FF1)) {
            pg8::Gemm g{HN, (const bf16*)(ws + WS_W1) + (size_t)l * 4096 * 1024, T, FF, D}; pg8::StaticOrder S; S.init(T, FF, F.G, (int)blockIdx.x);
            pg8::EpiFF1 E{HB, FF, (const float*)(ws + WS_SSQ), (const float*)(ws + WS_BIAS2) + (size_t)l * 8 * FF, (LAS unsigned char*)(F.lds + XCH_OFF)};
            pg8::gemm_phase<pg8::EpiFF1, pg8::StaticOrder, true, true>(F.lds + RING_OFF, g, S, E);
        }
        SEAM(pb + PL_FF1); STAMP(13);
        if (IN(pb + PL_FF2)) {
            pg8::Gemm g{HB, (const bf16*)(ws + WS_W2) + (size_t)l * 1024 * 4096, T, D, FF}; pg8::StaticOrder S; S.init(T, D, F.G, (int)blockIdx.x);
            if (l + 1 < DEPTH) { pg8::EpiResGateN<true, true> E{XB, XB, modl + 5 * D, (const float*)(ws + WS_GM1) + (size_t)(l + 1) * 8 * D, HN, (float*)(ws + WS_SS1), (LAS float*)(F.lds + XCH_OFF), (LAS unsigned char*)(F.lds + XCH_OFF + 4096)};
                pg8::gemm_phase<pg8::EpiResGateN<true, true>, pg8::StaticOrder, true, true>(F.lds + RING_OFF, g, S, E); }
            else { pg8::EpiResGate<true, false> E{XB, args.out, modl + 5 * D};
                pg8::gemm_phase<pg8::EpiResGate<true, false>, pg8::StaticOrder, true, true>(F.lds + RING_OFF, g, S, E); }
        }
        SEAM(pb + PL_FF2); STAMP(14);
    }
#ifdef PROBE_GROUP
    if (blockIdx.x == 0) { const unsigned long long t_end = __builtin_amdgcn_s_memrealtime() + 4ull * t_acc; while (__builtin_amdgcn_s_memrealtime() < t_end) __builtin_amdgcn_s_sleep(8); }
#endif
#undef IN
#undef SEAM
}

extern "C" void kernel_launch(void* const* d_in, const int* in_sizes, int n_in, void* d_out, int out_size, void* d_ws, size_t ws_size, hipStream_t stream) {
    static int grid = 0;
    if (grid == 0) {
        if (n_in != 22 || in_sizes[0] != T * D || out_size != T * D || ws_size < WS_END) { fprintf(stderr, "kernel_launch: unexpected shapes (n_in %d, in0 %d, out %d, ws %zu)\n", n_in, n_in > 0 ? in_sizes[0] : -1, out_size, ws_size); grid = -1; return; }
        int dev = 0, cus = 0;
        if (hipGetDevice(&dev) != hipSuccess || hipDeviceGetAttribute(&cus, hipDeviceAttributeMultiprocessorCount, dev) != hipSuccess) { grid = -1; return; }
        if (hipFuncSetAttribute((const void*)mk_fwd, hipFuncAttributeMaxDynamicSharedMemorySize, LDS_BYTES) != hipSuccess) { fprintf(stderr, "kernel_launch: hipFuncSetAttribute failed\n"); grid = -1; return; }
        (void)hipGetLastError();
        grid = cus;
    }
    if (grid < 0) return;
    (void)hipMemsetAsync((char*)d_ws + WS_CTL, 0, CTL_ZERO_BYTES, stream);
    Args a{};
    for (int i = 0; i < 22; ++i) a.in[i] = (const float*)d_in[i];
    a.out = (float*)d_out; a.ws = (unsigned char*)d_ws;
    a.ph_lo = 0; a.ph_hi = NPH; a.li = 0;
    hipLaunchKernelGGL(mk_fwd, dim3(grid), dim3(NWAVES * 64), LDS_BYTES, stream, a);
}
```

```cpp
#include <hip/hip_runtime.h>
#include <cstdio>
#include <cstdint>
#include <cmath>
#define ATTN_IN_MK 1
#define NEWPREP_H 1
#define NEWPREP_M 1
namespace pg8 {
#define PG8_LAS __attribute__((address_space(3)))
typedef unsigned short bf16_t;
typedef short bf16x8 __attribute__((ext_vector_type(8)));
typedef float f32x4 __attribute__((ext_vector_type(4)));
typedef unsigned u32x4 __attribute__((ext_vector_type(4)));
constexpr int BM = 256, BK = 64, HALF = 128, HTB = HALF * BK * 2  , STAGE_BYTES = 8 * HTB, NXCD = 8, WGM = 8;

__host__ __device__ __forceinline__ int lds_byte(int r, int c) { const int st = (r >> 4) * 2 + (c >> 5), rr = r & 15, cc = c & 31, ob = rr * 64 + cc * 2; return st * 1024 + (ob ^ (((ob >> 9) & 1) << 5)); }
__host__ __device__ __forceinline__ void stage_rc(int b, int& R, int& C) { const int st = b / 1024, sb = b % 1024, swz = sb ^ (((sb >> 9) & 1) << 5); R = (st >> 1) * 16 + swz / 64; C = (st & 1) * 32 + (swz % 64) / 2; }
__host__ __device__ __forceinline__ int perm32(int rho) { const int n = rho >> 4, i = rho & 15; return 8 * (i >> 2) + 4 * n + (i & 3); }

struct Unit { int pm, pn; };
struct Gemm { const bf16_t* A; const bf16_t* Bt; int M, N, K; };

struct StaticOrder {
    int nM, nN, nwg, G, c;
    __host__ __device__ void init(int M, int N, int G_, int c_) { nM = M / BM; nN = N / BM; nwg = nM * nN; G = G_; c = c_; }
    __host__ __device__ bool next(int i, Unit& u) const {
        const long L = (long)i * G + c; if (L >= nwg) return false;
        int wgid = (int)L; { const int q = nwg / NXCD, r = nwg % NXCD, xcd = wgid % NXCD, off = wgid / NXCD; wgid = (xcd < r ? xcd * (q + 1) : r * (q + 1) + (xcd - r) * q) + off; }
        const int nig = WGM * nN, gid = wgid / nig, fm = gid * WGM, gsz = (nM - fm) < WGM ? (nM - fm) : WGM;
        u.pm = fm + ((wgid % nig) % gsz); u.pn = (wgid % nig) / gsz; return true;
    }
    __device__ __forceinline__ void a_ready(const Unit&) const {}
    __device__ __forceinline__ void done(const Unit&) const {}
};

typedef __bf16 cv_bf16x2 __attribute__((ext_vector_type(2))); typedef float cv_f32x2 __attribute__((ext_vector_type(2)));
__device__ __forceinline__ unsigned cvt_pk_bf16(float lo, float hi) { unsigned r; asm volatile("v_cvt_pk_bf16_f32 %0, %1, %2" : "=v"(r) : "v"(lo), "v"(hi)); return r; }
template <int ACT> struct EpiBf16 {
    static constexpr bool PERM = true, SWZ = false, AFTER_DRAIN = false;
    bf16_t* O; int ldc;
    __device__ __forceinline__ void operator()(const f32x4 (&acc)[2][2][4][2], const Unit& u, int wr, int wc, int fr, int fq) const {
        const int row0 = u.pm * BM + wr * 64 + fr; const int col0 = u.pn * BM + wc * 32 + 8 * fq;
#pragma unroll
        for (int ai = 0; ai < 2; ++ai)
#pragma unroll
            for (int m = 0; m < 4; ++m) { bf16_t* rowp = O + (size_t)(row0 + ai * HALF + m * 16) * ldc + col0;
#pragma unroll
                for (int bj = 0; bj < 2; ++bj) { f32x4 v0 = acc[ai][bj][m][0], v1 = acc[ai][bj][m][1];
                    if (ACT == 2) {
#pragma unroll
                        for (int e = 0; e < 4; ++e) { const float a = fmaxf(v0[e], 0.f), b = fmaxf(v1[e], 0.f); v0[e] = a * a; v1[e] = b * b; } }
                    u32x4 w; w.x = cvt_pk_bf16(v0[0], v0[1]); w.y = cvt_pk_bf16(v0[2], v0[3]); w.z = cvt_pk_bf16(v1[0], v1[1]); w.w = cvt_pk_bf16(v1[2], v1[3]);
                    *(u32x4*)(rowp + bj * HALF) = w; } }
    }
};
template <bool BF> __device__ __forceinline__ void ld_res8(const void* p, size_t idx, f32x4& lo, f32x4& hi) {
    if (BF) { const u32x4 w = *(const u32x4*)((const bf16_t*)p + idx);
        lo = (f32x4){__builtin_bit_cast(float, w.x << 16), __builtin_bit_cast(float, w.x & 0xffff0000u), __builtin_bit_cast(float, w.y << 16), __builtin_bit_cast(float, w.y & 0xffff0000u)};
        hi = (f32x4){__builtin_bit_cast(float, w.z << 16), __builtin_bit_cast(float, w.z & 0xffff0000u), __builtin_bit_cast(float, w.w << 16), __builtin_bit_cast(float, w.w & 0xffff0000u)}; }
    else { lo = *(const f32x4*)((const float*)p + idx); hi = *(const f32x4*)((const float*)p + idx + 4); } }
template <bool BF> __device__ __forceinline__ void st_res8(void* p, size_t idx, f32x4 lo, f32x4 hi) {
    if (BF) { u32x4 w; w.x = cvt_pk_bf16(lo[0], lo[1]); w.y = cvt_pk_bf16(lo[2], lo[3]); w.z = cvt_pk_bf16(hi[0], hi[1]); w.w = cvt_pk_bf16(hi[2], hi[3]); *(u32x4*)((bf16_t*)p + idx) = w; }
    else { *(f32x4*)((float*)p + idx) = lo; *(f32x4*)((float*)p + idx + 4) = hi; } }
template <bool BASE_BF, bool OUT_BF> struct EpiResGate {
    static constexpr bool PERM = true, SWZ = false, AFTER_DRAIN = false; static constexpr int CW = SWZ ? 64 : 32, BJ = SWZ ? 32 : HALF;
    const void* base; void* out; const float* gate;
    __device__ __forceinline__ void operator()(const f32x4 (&acc)[2][2][4][2], const Unit& u, int wr, int wc, int fr, int fq) const {
        const int col0 = u.pn * BM + wc * CW + 8 * fq; const int b = (u.pm * BM) >> 12;
        const float* gp = gate + (size_t)b * 6144 + col0;
        f32x4 gv[2][2];
#pragma unroll
        for (int bj = 0; bj < 2; ++bj)
#pragma unroll
            for (int n = 0; n < 2; ++n) gv[bj][n] = *(const f32x4*)(gp + bj * BJ + 4 * n);
#pragma unroll
        for (int ai = 0; ai < 2; ++ai)
#pragma unroll
            for (int m = 0; m < 4; ++m) { const size_t off = (size_t)(u.pm * BM + ai * HALF + wr * 64 + m * 16 + fr) * 1024 + col0;
#pragma unroll
                for (int bj = 0; bj < 2; ++bj) { f32x4 b0, b1; ld_res8<BASE_BF>(base, off + bj * BJ, b0, b1);
                    st_res8<OUT_BF>(out, off + bj * BJ, b0 + gv[bj][0] * acc[ai][bj][m][0], b1 + gv[bj][1] * acc[ai][bj][m][1]); }
                if (m & 1) asm volatile("" ::: "memory"); }
    }
};
template <bool BASE_BF, bool OUT_BF> struct EpiResGateN {
    static_assert(OUT_BF, "the staged stores write bf16");
    static constexpr bool PERM = true, SWZ = true, AFTER_DRAIN = false; static constexpr int CW = 64, BJ = 32;
    const void* base; void* out; const float* gate; const float* gm; bf16_t* hn; float* ssq; PG8_LAS float* xch; PG8_LAS unsigned char* stg;
    __device__ __forceinline__ void operator()(const f32x4 (&acc)[2][2][4][2], const Unit& u, int wr, int wc, int fr, int fq) const {
        const int col0 = u.pn * BM + wc * CW + 8 * fq; const int b = (u.pm * BM) >> 12;
        const float* gp = gate + (size_t)b * 6144 + col0; const float* mp = gm + (size_t)b * 1024 + col0;
        f32x4 gv[2][2], mv[2][2];
#pragma unroll
        for (int bj = 0; bj < 2; ++bj)
#pragma unroll
            for (int n = 0; n < 2; ++n) { gv[bj][n] = *(const f32x4*)(gp + bj * BJ + 4 * n); mv[bj][n] = *(const f32x4*)(mp + bj * BJ + 4 * n); }
        PG8_LAS unsigned char* sw = stg + (wr * 4 + wc) * 2048;
        const int lane_ = fq * 16 + fr, rr_ = lane_ >> 3, cc_ = lane_ & 7;
        PG8_LAS unsigned char* wp_ = sw + fr * 128; const int wx_ = fr & 7;
        PG8_LAS unsigned char* rp_ = sw + rr_ * 128 + ((cc_ ^ (rr_ & 7)) << 4);
        const size_t goff_ = (size_t)(u.pm * BM + wr * 64 + rr_) * 1024 + u.pn * BM + wc * 64 + cc_ * 8;
#define RG_PUT(bj, w) (*(PG8_LAS u32x4*)(wp_ + (((4 * (bj) + fq) ^ wx_) << 4)) = (w))
#define RG_FLUSH(dst, ai, m) do { asm volatile("s_waitcnt lgkmcnt(0)" ::: "memory"); const u32x4 o0_ = *(const PG8_LAS u32x4*)rp_, o1_ = *(const PG8_LAS u32x4*)(rp_ + 1024); asm volatile("s_waitcnt lgkmcnt(0)" ::: "memory"); \
            bf16_t* g_ = (dst) + goff_ + (size_t)((ai) * HALF + (m) * 16) * 1024; *(u32x4*)g_ = o0_; *(u32x4*)(g_ + (size_t)8 * 1024) = o1_; } while (0)
#pragma unroll
        for (int ai = 0; ai < 2; ++ai)
#pragma unroll
            for (int m = 0; m < 4; ++m) { const int rl = ai * HALF + wr * 64 + m * 16 + fr; const size_t off = (size_t)(u.pm * BM + rl) * 1024 + col0; float s = 0.f;
                u32x4 wxb[2], whn[2];
#pragma unroll
                for (int bj = 0; bj < 2; ++bj) { f32x4 b0, b1; ld_res8<BASE_BF>(base, off + bj * BJ, b0, b1);
                    const f32x4 x0 = b0 + gv[bj][0] * acc[ai][bj][m][0], x1 = b1 + gv[bj][1] * acc[ai][bj][m][1];
                    s += ((x0[0] * x0[0] + x0[1] * x0[1]) + (x0[2] * x0[2] + x0[3] * x0[3])) + ((x1[0] * x1[0] + x1[1] * x1[1]) + (x1[2] * x1[2] + x1[3] * x1[3]));
                    wxb[bj].x = cvt_pk_bf16(x0[0], x0[1]); wxb[bj].y = cvt_pk_bf16(x0[2], x0[3]); wxb[bj].z = cvt_pk_bf16(x1[0], x1[1]); wxb[bj].w = cvt_pk_bf16(x1[2], x1[3]);
                    const f32x4 h0 = x0 * mv[bj][0], h1 = x1 * mv[bj][1];
                    whn[bj].x = cvt_pk_bf16(h0[0], h0[1]); whn[bj].y = cvt_pk_bf16(h0[2], h0[3]); whn[bj].z = cvt_pk_bf16(h1[0], h1[1]); whn[bj].w = cvt_pk_bf16(h1[2], h1[3]); }
                RG_PUT(0, wxb[0]); RG_PUT(1, wxb[1]); RG_FLUSH((bf16_t*)out, ai, m);
                RG_PUT(0, whn[0]); RG_PUT(1, whn[1]); RG_FLUSH(hn, ai, m);
                s += __shfl_xor(s, 16); s += __shfl_xor(s, 32);
                if (fq == 0) xch[rl * 4 + wc] = s; }
#undef RG_PUT
#undef RG_FLUSH
        asm volatile("s_waitcnt lgkmcnt(0)" ::: "memory"); __builtin_amdgcn_s_barrier(); asm volatile("" ::: "memory");
        const int tid = (wr * 4 + wc) * 64 + fq * 16 + fr;
        if (tid < 256) { const f32x4 p = *(const PG8_LAS f32x4*)(xch + tid * 4); ssq[(size_t)(u.pm * BM + tid) * 4 + u.pn] = (p[0] + p[1]) + (p[2] + p[3]); }
    }
};
struct EpiFF1 {
    static constexpr bool PERM = true, SWZ = true, AFTER_DRAIN = false;
    bf16_t* O; int ldc; const float* ssq; const float* bias; PG8_LAS unsigned char* stg;
    __device__ __forceinline__ void operator()(const f32x4 (&acc)[2][2][4][2], const Unit& u, int wr, int wc, int fr, int fq) const {
        const int rowb = u.pm * BM + wr * 64; const int colw = u.pn * BM + wc * 64; const int b = (u.pm * BM) >> 12;
        const float* bp = bias + (size_t)b * 4096 + colw + 8 * fq;
        f32x4 bv[2][2];
#pragma unroll
        for (int bj = 0; bj < 2; ++bj)
#pragma unroll
            for (int n = 0; n < 2; ++n) bv[bj][n] = *(const f32x4*)(bp + bj * 32 + 4 * n);
        PG8_LAS unsigned char* sw = stg + (wr * 4 + wc) * 2048;
        const int lane = fq * 16 + fr, rr = lane >> 3, cc = lane & 7;
        PG8_LAS unsigned char* wp = sw + fr * 128; const int wx = fr & 7;
        PG8_LAS unsigned char* rp = sw + rr * 128 + ((cc ^ (rr & 7)) << 4);
        bf16_t* gp = O + (size_t)(rowb + rr) * ldc + colw + cc * 8;
#pragma unroll
        for (int ai = 0; ai < 2; ++ai)
#pragma unroll
            for (int m = 0; m < 4; ++m) { const int row = rowb + ai * HALF + m * 16 + fr;
                const f32x4 p = *(const f32x4*)(ssq + (size_t)row * 4); const float r = __builtin_amdgcn_rsqf(((p[0] + p[1]) + (p[2] + p[3])) * (1.f / 1024.f) + 1e-6f);
#pragma unroll
                for (int bj = 0; bj < 2; ++bj) { f32x4 v0 = acc[ai][bj][m][0] * r + bv[bj][0], v1 = acc[ai][bj][m][1] * r + bv[bj][1];
#pragma unroll
                    for (int e = 0; e < 4; ++e) { const float a = fmaxf(v0[e], 0.f), c = fmaxf(v1[e], 0.f); v0[e] = a * a; v1[e] = c * c; }
                    u32x4 w; w.x = cvt_pk_bf16(v0[0], v0[1]); w.y = cvt_pk_bf16(v0[2], v0[3]); w.z = cvt_pk_bf16(v1[0], v1[1]); w.w = cvt_pk_bf16(v1[2], v1[3]);
                    *(PG8_LAS u32x4*)(wp + (((4 * bj + fq) ^ wx) << 4)) = w; }
                asm volatile("s_waitcnt lgkmcnt(0)" ::: "memory");
                const u32x4 o0 = *(const PG8_LAS u32x4*)rp, o1 = *(const PG8_LAS u32x4*)(rp + 1024);
                asm volatile("s_waitcnt lgkmcnt(0)" ::: "memory");
                bf16_t* g = gp + (size_t)(ai * HALF + m * 16) * ldc;
                *(u32x4*)g = o0; *(u32x4*)(g + (size_t)8 * ldc) = o1; }
    }
};
struct EpiInProj {
    static constexpr bool PERM = true, SWZ = true, AFTER_DRAIN = false;
    bf16_t* O; int ldc; const float* qkg  ; PG8_LAS unsigned char* stg  ;
    const float* ssq  ; const float* bias  ; float* gates  ; float* fgt  ;
    __device__ __forceinline__ void operator()(f32x4 (&acc)[2][2][4][2], const Unit& u, int wr, int wc, int fr, int fq) const {
        asm volatile("" : "+v"(fr), "+v"(fq));
        const int row0 = u.pm * BM + wr * 64 + fr; const int col0 = u.pn * BM + wc * 64 + 8 * fq;
        const int pn = u.pn; const bool nrm = (pn == 4) | (pn == 5) | (pn == 7) | (pn == 8);
        { const int b = (u.pm * BM) >> 12; const float* bp = bias + (size_t)b * 4096 + col0;
          f32x4 bv[2][2];
#pragma unroll
          for (int bj = 0; bj < 2; ++bj)
#pragma unroll
              for (int n = 0; n < 2; ++n) bv[bj][n] = *(const f32x4*)(bp + bj * 32 + 4 * n);
#pragma unroll
          for (int ai = 0; ai < 2; ++ai)
#pragma unroll
              for (int m = 0; m < 4; ++m) { const f32x4 p = *(const f32x4*)(ssq + (size_t)(row0 + ai * HALF + m * 16) * 4); const float r = __builtin_amdgcn_rsqf(((p[0] + p[1]) + (p[2] + p[3])) * (1.f / 1024.f) + 1e-6f);
#pragma unroll
                  for (int bj = 0; bj < 2; ++bj)
#pragma unroll
                      for (int n = 0; n < 2; ++n) acc[ai][bj][m][n] = acc[ai][bj][m][n] * r + bv[bj][n]; } }
        if (pn == 15) {
            int fq2 = fq; asm volatile("" : "+v"(fq2));
            if (wc == 0 && fq2 < 2) { const int b = (u.pm * BM) >> 12;
#pragma unroll
                for (int ai = 0; ai < 2; ++ai)
#pragma unroll
                    for (int m = 0; m < 4; ++m) { const int row = row0 + ai * HALF + m * 16; float* gp = gates + (size_t)row * 12 + 8 * fq2;
                        *(f32x4*)gp = acc[ai][0][m][0]; if (fq2 == 0) { *(f32x4*)(gp + 4) = acc[ai][0][m][1];
#pragma unroll
                            for (int e = 0; e < 4; ++e) fgt[(size_t)(b * 4 + e) * 4096 + (row & 4095)] = acc[ai][0][m][0][e]; } } }
            return;
        }
        PG8_LAS unsigned char* sw = stg + (wr * 4 + wc) * 2048;
        const int lane_ = fq * 16 + fr, rr_ = lane_ >> 3, cc_ = lane_ & 7;
        PG8_LAS unsigned char* wp_ = sw + fr * 128; const int wx_ = fr & 7;
        PG8_LAS unsigned char* rp_ = sw + rr_ * 128 + ((cc_ ^ (rr_ & 7)) << 4);
        bf16_t* gp_ = O + (size_t)(u.pm * BM + wr * 64 + rr_) * ldc + u.pn * BM + wc * 64 + cc_ * 8;
#define INPROJ_PUT(bj, w) (*(PG8_LAS u32x4*)(wp_ + (((4 * (bj) + fq) ^ wx_) << 4)) = (w))
#define INPROJ_FLUSH(ai, m) do { asm volatile("s_waitcnt lgkmcnt(0)" ::: "memory"); const u32x4 o0_ = *(const PG8_LAS u32x4*)rp_, o1_ = *(const PG8_LAS u32x4*)(rp_ + 1024); asm volatile("s_waitcnt lgkmcnt(0)" ::: "memory"); \
            bf16_t* g_ = gp_ + (size_t)((ai) * HALF + (m) * 16) * ldc; *(u32x4*)g_ = o0_; *(u32x4*)(g_ + (size_t)8 * ldc) = o1_; } while (0)
        if (!nrm) {
#pragma unroll
            for (int ai = 0; ai < 2; ++ai)
#pragma unroll
                for (int m = 0; m < 4; ++m) {
#pragma unroll
                    for (int bj = 0; bj < 2; ++bj) { const f32x4 v0 = acc[ai][bj][m][0], v1 = acc[ai][bj][m][1];
                        u32x4 w; w.x = cvt_pk_bf16(v0[0], v0[1]); w.y = cvt_pk_bf16(v0[2], v0[3]); w.z = cvt_pk_bf16(v1[0], v1[1]); w.w = cvt_pk_bf16(v1[2], v1[3]);
                        INPROJ_PUT(bj, w); }
                    INPROJ_FLUSH(ai, m); }
            return;
        }
        const bool wide = (pn >= 7);
        const float inv_n = wide ? (1.f / 64.f) : (1.f / 32.f);
        const float* gp = qkg + ((pn == 4) ? 0 : (pn == 5 ? 64 : (pn == 7 ? 128 : 192)));
        f32x4 gq[2][2];
#pragma unroll
        for (int bj = 0; bj < 2; ++bj) { const int gcol = (wide ? 32 * bj : 0) + 8 * fq; gq[bj][0] = *(const f32x4*)(gp + gcol); gq[bj][1] = *(const f32x4*)(gp + gcol + 4); }
#pragma unroll
        for (int ai = 0; ai < 2; ++ai)
#pragma unroll
            for (int m = 0; m < 4; ++m) { float sg[2];
#pragma unroll
                for (int bj = 0; bj < 2; ++bj) { const f32x4 a = acc[ai][bj][m][0], b = acc[ai][bj][m][1];
                    float s = (a[0] * a[0] + a[1] * a[1]) + (a[2] * a[2] + a[3] * a[3]) + (b[0] * b[0] + b[1] * b[1]) + (b[2] * b[2] + b[3] * b[3]);
                    s += __shfl_xor(s, 16); s += __shfl_xor(s, 32); sg[bj] = s; }
                const float tot = sg[0] + sg[1];
#pragma unroll
                for (int bj = 0; bj < 2; ++bj) { const float r = __builtin_amdgcn_rsqf((wide ? tot : sg[bj]) * inv_n + 1e-6f);
                    const f32x4 v0 = acc[ai][bj][m][0] * gq[bj][0] * r, v1 = acc[ai][bj][m][1] * gq[bj][1] * r;
                    u32x4 w; w.x = cvt_pk_bf16(v0[0], v0[1]); w.y = cvt_pk_bf16(v0[2], v0[3]); w.z = cvt_pk_bf16(v1[0], v1[1]); w.w = cvt_pk_bf16(v1[2], v1[3]);
                    INPROJ_PUT(bj, w); }
                INPROJ_FLUSH(ai, m); }
#undef INPROJ_PUT
#undef INPROJ_FLUSH
    }
};
template <class Epi, class Sched, bool ALIGN_EPI = false, bool SP2 = false>
__device__ __forceinline__ void gemm_phase(PG8_LAS unsigned char* lds, const Gemm g, const Sched& S, const Epi& E) {
    int tid_ = threadIdx.x; asm volatile("" : "+v"(tid_));
    const int tid = tid_, wid = __builtin_amdgcn_readfirstlane(tid >> 6), lane = tid & 63, wr = wid >> 2, wc = wid & 3, fr = lane & 15, fq = lane >> 4;
    const int K = g.K, nt = K / BK;
    unsigned voffA[2], voffB[2];
#pragma unroll
    for (int i = 0; i < 2; ++i) { int R, C; stage_rc(tid * 16 + i * 8192, R, C); const int Rb = Epi::SWZ ? ((R >> 5) * 64 + perm32(R & 31)) : Epi::PERM ? ((R & ~31) + perm32(R & 31)) : R;
        voffA[i] = (unsigned)(R * K + C) * 2u; voffB[i] = (unsigned)(Rb * K + C) * 2u; }
    const size_t kstep = (size_t)(BK * 2);
    const size_t hstep = (size_t)HALF * K * 2;
    const size_t hstepB = Epi::SWZ ? (size_t)32 * K * 2 : hstep;
    const size_t tstep = 2 * hstep;
    const unsigned ldsw = (unsigned)wid * 1024u;
    const int aoff = lds_byte(wr * 64 + fr, fq * 8), boff = lds_byte(wc * 32 + fr, fq * 8);
#define PG8_SA(b, h) (((b) * 2 + (h)) * HTB)
#define PG8_SB(b, h) ((4 + (b) * 2 + (h)) * HTB)
#define PG8_STAGE(bufoff, gbase, voff) do { _Pragma("unroll") for (int _i = 0; _i < 2; ++_i) \
        __builtin_amdgcn_global_load_lds((const unsigned*)((const char*)(gbase) + (voff)[_i]), (PG8_LAS unsigned*)(lds + (bufoff) + ldsw + _i * 8192), 16, 0, 0); } while (0)
#define PG8_LDA(dst, b, h) do { _Pragma("unroll") for (int m = 0; m < 4; ++m) _Pragma("unroll") for (int k = 0; k < 2; ++k) dst[m][k] = *(const PG8_LAS bf16x8*)(lds + PG8_SA(b, h) + aoff + m * 2048 + k * 1024); } while (0)
#define PG8_LDB(dst, b, h) do { _Pragma("unroll") for (int n = 0; n < 2; ++n) _Pragma("unroll") for (int k = 0; k < 2; ++k) dst[n][k] = *(const PG8_LAS bf16x8*)(lds + PG8_SB(b, h) + boff + n * 2048 + k * 1024); } while (0)
#define PG8_MMA(ai, bj, At, Bt) do { __builtin_amdgcn_s_setprio(1); _Pragma("unroll") for (int m = 0; m < 4; ++m) _Pragma("unroll") for (int n = 0; n < 2; ++n) _Pragma("unroll") for (int k = 0; k < 2; ++k) \
        acc[ai][bj][m][n] = __builtin_amdgcn_mfma_f32_16x16x32_bf16(Bt[n][k], At[m][k], acc[ai][bj][m][n], 0, 0, 0); __builtin_amdgcn_s_setprio(0); } while (0)
#define PG8_WAIT_V(n) asm volatile("s_waitcnt vmcnt(" #n ")" ::: "memory")
#define PG8_WAIT_L(n) asm volatile("s_waitcnt lgkmcnt(" #n ")" ::: "memory")
#define PG8_BAR __builtin_amdgcn_s_barrier()
#define PG8_SCHED __builtin_amdgcn_sched_barrier(0)
    Unit cur, nxt; int ui = 0;
    if (!S.next(0, cur)) return;
    f32x4 acc[2][2][4][2];
#pragma unroll
    for (int a = 0; a < 2; ++a)
#pragma unroll
        for (int b = 0; b < 2; ++b)
#pragma unroll
            for (int m = 0; m < 4; ++m)
#pragma unroll
                for (int n = 0; n < 2; ++n) acc[a][b][m][n] = (f32x4){0.f, 0.f, 0.f, 0.f};
    bf16x8 At[4][2], B0[2][2], B1[2][2];
    const char* cA = (const char*)g.A + (size_t)cur.pm * tstep; const char* cB = (const char*)g.Bt + (size_t)cur.pn * tstep;
    S.a_ready(cur);
    if constexpr (SP2) {
        PG8_STAGE(PG8_SB(0, 0), cB, voffB); PG8_STAGE(PG8_SB(0, 1), cB + hstepB, voffB); PG8_STAGE(PG8_SA(0, 0), cA, voffA); PG8_STAGE(PG8_SA(0, 1), cA + hstep, voffA);
        if (wr == 1) PG8_BAR;
        PG8_WAIT_V(2); PG8_BAR;
        PG8_STAGE(PG8_SB(1, 0), cB + kstep, voffB); PG8_STAGE(PG8_SA(1, 0), cA + kstep, voffA); PG8_STAGE(PG8_SB(1, 1), cB + hstepB + kstep, voffB);
        PG8_WAIT_V(6); PG8_BAR;
    } else {
        PG8_STAGE(PG8_SB(0, 0), cB, voffB); PG8_STAGE(PG8_SA(0, 0), cA, voffA); PG8_STAGE(PG8_SB(0, 1), cB + hstepB, voffB); PG8_STAGE(PG8_SA(0, 1), cA + hstep, voffA);
        if (wr == 1) PG8_BAR;
        PG8_WAIT_V(4); PG8_BAR;
        PG8_STAGE(PG8_SB(1, 0), cB + kstep, voffB); PG8_STAGE(PG8_SA(1, 0), cA + kstep, voffA); PG8_STAGE(PG8_SB(1, 1), cB + hstepB + kstep, voffB);
        PG8_WAIT_V(6); PG8_BAR;
    }
    for (;;) {
        const bool has_next = S.next(ui + 1, nxt);
        const char* nA = has_next ? (const char*)g.A + (size_t)nxt.pm * tstep : cA; const char* nB = has_next ? (const char*)g.Bt + (size_t)nxt.pn * tstep : cB;
        for (int t = 0; t < nt; t += 2) {
            const bool last = (t == nt - 2);
            const char* a1 = cA + (size_t)(t + 1) * kstep;
            const char* a2 = last ? nA : cA + (size_t)(t + 2) * kstep; const char* b2 = last ? nB : cB + (size_t)(t + 2) * kstep;
            const char* a3 = a2 + kstep; const char* b3 = b2 + kstep;
            if (last && has_next) S.a_ready(nxt);
            if constexpr (SP2) {
            PG8_LDB(B0, 0, 0); PG8_LDB(B1, 0, 1); PG8_SCHED; PG8_LDA(At, 0, 0); PG8_STAGE(PG8_SA(1, 1), a1 + hstep, voffA);
            PG8_WAIT_V(8); PG8_WAIT_L(0); PG8_BAR; PG8_MMA(0, 0, At, B0); PG8_MMA(0, 1, At, B1); PG8_BAR; PG8_SCHED;
            PG8_LDA(At, 0, 1); PG8_STAGE(PG8_SB(0, 0), b2, voffB); PG8_STAGE(PG8_SB(0, 1), b2 + hstepB, voffB); PG8_STAGE(PG8_SA(0, 0), a2, voffA);
            PG8_WAIT_V(8); PG8_WAIT_L(0); PG8_BAR; PG8_MMA(1, 0, At, B0); PG8_MMA(1, 1, At, B1); PG8_BAR; PG8_SCHED;
            PG8_LDB(B0, 1, 0); PG8_LDB(B1, 1, 1); PG8_SCHED; PG8_LDA(At, 1, 0); PG8_STAGE(PG8_SA(0, 1), a2 + hstep, voffA);
            PG8_WAIT_V(8); PG8_WAIT_L(0); PG8_BAR; PG8_MMA(0, 0, At, B0); PG8_MMA(0, 1, At, B1); PG8_BAR; PG8_SCHED;
            PG8_LDA(At, 1, 1); PG8_STAGE(PG8_SB(1, 0), b3, voffB); PG8_STAGE(PG8_SB(1, 1), b3 + hstepB, voffB); PG8_STAGE(PG8_SA(1, 0), a3, voffA);
            PG8_WAIT_V(8); PG8_WAIT_L(0); PG8_BAR; PG8_MMA(1, 0, At, B0); PG8_MMA(1, 1, At, B1); PG8_BAR; PG8_SCHED;
            } else {
            PG8_LDB(B0, 0, 0); PG8_SCHED; PG8_LDA(At, 0, 0); PG8_STAGE(PG8_SA(1, 1), a1 + hstep, voffA);
            PG8_WAIT_L(8); PG8_BAR; PG8_WAIT_L(0); PG8_MMA(0, 0, At, B0); PG8_BAR; PG8_SCHED;
            PG8_LDB(B1, 0, 1); PG8_STAGE(PG8_SB(0, 0), b2, voffB);
            PG8_BAR; PG8_WAIT_L(0); PG8_MMA(0, 1, At, B1); PG8_BAR;
            PG8_LDA(At, 0, 1); PG8_STAGE(PG8_SA(0, 0), a2, voffA);
            PG8_BAR; PG8_WAIT_L(0); PG8_MMA(1, 0, At, B0); PG8_BAR; PG8_SCHED;
            PG8_STAGE(PG8_SB(0, 1), b2 + hstepB, voffB);
            PG8_WAIT_V(6); PG8_BAR; PG8_MMA(1, 1, At, B1); PG8_BAR;
            PG8_LDB(B0, 1, 0); PG8_SCHED; PG8_LDA(At, 1, 0); PG8_STAGE(PG8_SA(0, 1), a2 + hstep, voffA);
            PG8_WAIT_L(8); PG8_BAR; PG8_WAIT_L(0); PG8_MMA(0, 0, At, B0); PG8_BAR; PG8_SCHED;
            PG8_LDB(B1, 1, 1); PG8_STAGE(PG8_SB(1, 0), b3, voffB);
            PG8_BAR; PG8_WAIT_L(0); PG8_MMA(0, 1, At, B1); PG8_BAR;
            PG8_LDA(At, 1, 1); PG8_STAGE(PG8_SA(1, 0), a3, voffA);
            PG8_BAR; PG8_WAIT_L(0); PG8_MMA(1, 0, At, B0); PG8_BAR; PG8_SCHED;
            PG8_STAGE(PG8_SB(1, 1), b3 + hstepB, voffB);
            PG8_WAIT_V(6); PG8_BAR; PG8_MMA(1, 1, At, B1); PG8_BAR;
            }
        }
        if constexpr (ALIGN_EPI) { if (wr == 0) PG8_BAR; }
        if constexpr (!Epi::AFTER_DRAIN) { E(acc, cur, wr, wc, fr, fq); S.done(cur); }
        if (!has_next) break;
#pragma unroll
        for (int a = 0; a < 2; ++a)
#pragma unroll
            for (int b = 0; b < 2; ++b)
#pragma unroll
                for (int m = 0; m < 4; ++m)
#pragma unroll
                    for (int n = 0; n < 2; ++n) acc[a][b][m][n] = (f32x4){0.f, 0.f, 0.f, 0.f};
        cur = nxt; cA = nA; cB = nB; ++ui;
        if constexpr (ALIGN_EPI) { if (wr == 1) PG8_BAR; }
    }
    PG8_WAIT_V(0);
    if constexpr (!ALIGN_EPI) { if (wr == 0) PG8_BAR; }
    PG8_BAR;
    if constexpr (Epi::AFTER_DRAIN) { E.fused(acc, cur, wr, wc, fr, fq, lds, wid, lane); S.done(cur); }
#undef PG8_SA
#undef PG8_SB
#undef PG8_STAGE
#undef PG8_LDA
#undef PG8_LDB
#undef PG8_MMA
#undef PG8_WAIT_V
#undef PG8_WAIT_L
#undef PG8_BAR
#undef PG8_SCHED
}
}
#define GAS __attribute__((address_space(1)))
#define LAS __attribute__((address_space(3)))
typedef unsigned short bf16;
typedef unsigned v4u __attribute__((ext_vector_type(4)));
typedef float f32x4 __attribute__((ext_vector_type(4)));
typedef short bf16x8 __attribute__((ext_vector_type(8)));
typedef GAS unsigned gu32;
typedef GAS unsigned long long gu64;
#define RLX_AGENT __ATOMIC_RELAXED, __HIP_MEMORY_SCOPE_AGENT
#define LDS_WAIT() asm volatile("s_waitcnt lgkmcnt(0)" ::: "memory")
#define VM_WAIT() asm volatile("s_waitcnt vmcnt(0)" ::: "memory")
__device__ __forceinline__ unsigned long long rt() { return __builtin_amdgcn_s_memrealtime(); }
__device__ __forceinline__ unsigned f2bf(float f) { unsigned u = __builtin_bit_cast(unsigned, f); return (u + 0x7fffu + ((u >> 16) & 1u)) >> 16; }
__device__ __forceinline__ unsigned pk2(float lo, float hi) { return f2bf(lo) | (f2bf(hi) << 16); }

#define XB_TMO      128
#define XB_XCNT(j)  (256  + 64 * (j))
#define XB_XSUB(j)  (1280 + 64 * (j))
#define XB_XGEN(j)  (2304 + 64 * (j))
#define XB_TOP      3328
#define XB_TOPGEN   3392
#define XCD_BAR_WORDS 3456
#define XB_SPIN_CAP (1u << 18)

__device__ __forceinline__ unsigned xb_ld(unsigned* p)              { return __hip_atomic_load(p, __ATOMIC_RELAXED, __HIP_MEMORY_SCOPE_AGENT); }
__device__ __forceinline__ unsigned xb_add(unsigned* p, unsigned v) { return __hip_atomic_fetch_add(p, v, __ATOMIC_RELAXED, __HIP_MEMORY_SCOPE_AGENT); }
__device__ __forceinline__ unsigned xb_xcc_id() { return (unsigned)__builtin_amdgcn_s_getreg((3 << 11) | 20) & 0xFu; }
#define XB_SPIN(cond, bar) do { unsigned _sp = 0; while (cond) { __builtin_amdgcn_s_sleep(1); \
    if ((++_sp & 255u) == 0u) { if (xb_ld(&(bar)[XB_TMO])) break; if (_sp > XB_SPIN_CAP) { atomicAdd(&(bar)[XB_TMO], 1u); break; } } } } while (0)

struct XcdBarrier {
    unsigned* bar; unsigned x;
    volatile LAS unsigned* st;
};

__device__ __forceinline__ XcdBarrier xcd_barrier_post(unsigned* bar, volatile LAS unsigned* st) {
    XcdBarrier b; b.bar = bar; b.x = xb_xcc_id(); b.st = st;
    if (threadIdx.x == 0) (void)xb_add(&bar[XB_XCNT(b.x)], 1u);
    return b;
}
__device__ __forceinline__ void xcd_barrier_complete(unsigned* bar, unsigned x, unsigned& nloc, unsigned& nx) {
    const unsigned G = gridDim.x * gridDim.y * gridDim.z;
    unsigned sum, cnt, mine, sp = 0u;
    for (;;) {
        sum = 0u; cnt = 0u; mine = 0u;
#pragma unroll
        for (unsigned j = 0; j < 16; ++j) { const unsigned c = xb_ld(&bar[XB_XCNT(j)]); sum += c; cnt += (c > 0u) ? 1u : 0u; mine = (j == x) ? c : mine; }
        if (sum == G) break;
        __builtin_amdgcn_s_sleep(1);
        if ((++sp & 255u) == 0u) { if (xb_ld(&bar[XB_TMO])) break; if (sp > XB_SPIN_CAP) { atomicAdd(&bar[XB_TMO], 1u); break; } }
    }
    nloc = mine > 0u ? mine : 1u; nx = cnt > 0u ? cnt : 1u;
}

__device__ __forceinline__ void xcd_barrier(const XcdBarrier& b) {
    asm volatile("s_waitcnt vmcnt(0)" ::: "memory");
    __syncthreads();
    if (threadIdx.x == 0) {
        unsigned* bar = b.bar;
        __builtin_amdgcn_s_waitcnt(0);
        unsigned nloc = b.st[0], nx = b.st[1];
        if (nloc == 0u) { xcd_barrier_complete(bar, b.x, nloc, nx); b.st[0] = nloc; b.st[1] = nx; }
        const unsigned old = xb_add(&bar[XB_XSUB(b.x)], 1u);
        const unsigned gen = old / nloc;
        if (old + 1u == (gen + 1u) * nloc) {
            __builtin_amdgcn_fence(__ATOMIC_RELEASE, "agent");
            asm volatile("s_waitcnt vmcnt(0)" ::: "memory");
            const unsigned og = xb_add(&bar[XB_TOP], 1u);
            const unsigned tg = og / nx;
            if (og + 1u == (tg + 1u) * nx) xb_add(&bar[XB_TOPGEN], 1u);
            else XB_SPIN(xb_ld(&bar[XB_TOPGEN]) == tg, bar);
            __builtin_amdgcn_fence(__ATOMIC_ACQUIRE, "agent");
            xb_add(&bar[XB_XGEN(b.x)], 1u);
            asm volatile("s_waitcnt vmcnt(0)" ::: "memory");
        } else {
            XB_SPIN(xb_ld(&bar[XB_XGEN(b.x)]) == gen, bar);
            __builtin_amdgcn_fence(__ATOMIC_ACQUIRE, "agent");
            asm volatile("s_waitcnt vmcnt(0)" ::: "memory");
        }
    }
    __syncthreads();
}
constexpr int NWAVES = 8;
constexpr int BATCH = 8, SEQ = 4096, D = 1024, FF = 4096, DEPTH = 2, T = BATCH * SEQ, NH = 4, HD = 64;
constexpr int INC = 3852, ZP = 3840, NMOD = 6 * D;
constexpr float EPS = 1e-6f;
constexpr int ZC_HQ = 0, ZC_HF = 256, ZC_HI = 512, ZC_HG = 768, ZC_DQ = 1024, ZC_DK = 1280, ZC_DV = 1536, ZC_FQ = 1792, ZC_FK = 2048, ZC_FV = 2304, ZC_FG = 2560, ZC_MQ = 2816, ZC_MK = 3072, ZC_MV = 3328, ZC_MO = 3584;
constexpr size_t MiB = 1u << 20;
constexpr size_t WS_CTL = 0, CTL_ZERO_BYTES = 1 * MiB;
constexpr size_t WS_MOD = 1 * MiB;
constexpr size_t WS_WG = 1 * MiB + 512 * 1024;
constexpr size_t WS_QKG = 1 * MiB + 768 * 1024;
constexpr size_t WS_SMAX = 1 * MiB + 896 * 1024;
constexpr size_t WS_SCHED = 1 * MiB + 904 * 1024;
constexpr size_t WS_KST = 1 * MiB + 900 * 1024;
constexpr size_t WS_FGT = 3 * MiB + 512 * 1024;
constexpr size_t WS_GATES = 2 * MiB;
constexpr size_t WS_FCUM = 4 * MiB;
constexpr size_t WS_GM1 = 4 * MiB + 768 * 1024;
constexpr size_t WS_BIAS1 = 7 * MiB;
constexpr size_t WS_SS1 = 6 * MiB + 512 * 1024;
constexpr size_t WS_GM2 = 4 * MiB + 512 * 1024;
constexpr size_t WS_BIAS2 = 5 * MiB;
constexpr size_t WS_SSQ = 6 * MiB;
constexpr size_t WS_WIN = 8 * MiB, WS_WOUT = 24 * MiB, WS_W1 = 28 * MiB, WS_W2 = 44 * MiB;
constexpr size_t WS_HN = 64 * MiB;
constexpr size_t WS_Z = 128 * MiB;
constexpr size_t WS_H = 128 * MiB;
constexpr size_t WS_XB = 384 * MiB;
constexpr size_t WS_Y = 448 * MiB;
constexpr size_t WS_DECH = 7 * MiB + 512 * 1024, WS_DECM = 7 * MiB + 800 * 1024;
constexpr size_t WS_END = 512 * MiB;
constexpr size_t WS_IMGH = WS_HN, WS_IMGM = WS_HN + 16 * MiB;
static_assert(16 * MiB + (size_t)32 * 32 * 4160 * 4 <= 64 * MiB, "state images fit HN");
static_assert(WS_Z + (size_t)T * ZP * 2 <= WS_XB && WS_H + (size_t)T * FF * 2 <= WS_XB && WS_XB + (size_t)T * D * 2 <= WS_Y && WS_Y + (size_t)T * D * 2 <= WS_END, "ws map");
constexpr int CW_TMO = 0, CW_BAR = 4096;
constexpr int RING_OFF = 0, RING_BYTES = 131072, LDS_BYTES = 152576, LDSCTL_OFF = LDS_BYTES - 1024, MISC_OFF = LDSCTL_OFF + 320, XCH_OFF = RING_BYTES;
constexpr float LOG2E = 1.4426950408889634f;
static_assert(XCH_OFF + 256 * 8 * 4 <= LDSCTL_OFF && XCH_OFF + 4096 + 8 * 2048 <= LDSCTL_OFF, "exchange / store-staging area");
constexpr int PH_PRO = 0, PH_PER_LAYER = 8, NPH = 1 + 2 * PH_PER_LAYER;
constexpr int PL_NORM1 = 0, PL_INPROJ = 1, PL_MIXA = 2, PL_MIXB = 3, PL_MIXC = 4, PL_OUTPROJ = 5, PL_FF1 = 6, PL_FF2 = 7;

struct Frame {
    LAS unsigned char* lds; volatile LAS unsigned* MISC; gu32* ctl;
    int tid, lane, wave, vcu, G;
};
__device__ __forceinline__ float wave_sum(float v) {
#pragma unroll
    for (int o = 1; o < 64; o <<= 1) v += __shfl_xor(v, o);
    return v;
}
__device__ __forceinline__ float bf2f(bf16 v) { return __builtin_bit_cast(float, (unsigned)v << 16); }
__device__ __forceinline__ float sigmoidf_(float x) { return 1.f / (1.f + __expf(-x)); }
__device__ __forceinline__ float logsigmoidf_(float x) { return fminf(x, 0.f) - log1pf(expf(-fabsf(x))); }

__device__ __forceinline__ void p0_transpose_item(const float* W, int K, int pitch, int nblk, bf16* WT, LAS float* scr, int item, int lane) {
    const int kb = item / nblk, nb = item % nblk, k0 = 64 * kb, n0 = 32 * nb;
    float v_[32];
#pragma unroll
    for (int i = 0; i < 32; ++i) v_[i] = W[(size_t)(k0 + 2 * i + (lane >> 5)) * pitch + n0 + (lane & 31)];
#pragma unroll
    for (int i = 0; i < 32; ++i) scr[(2 * i + (lane >> 5)) * 33 + (lane & 31)] = v_[i];
    LDS_WAIT(); asm volatile("" ::: "memory");
    const int c = lane & 7;
#pragma unroll
    for (int j = 0; j < 4; ++j) { const int n = (lane >> 3) + 8 * j; const LAS float* s = scr + (8 * c) * 33 + n;
        v4u o; o.x = pk2(s[0 * 33], s[1 * 33]); o.y = pk2(s[2 * 33], s[3 * 33]); o.z = pk2(s[4 * 33], s[5 * 33]); o.w = pk2(s[6 * 33], s[7 * 33]);
        *(GAS v4u*)(WT + (size_t)(n0 + n) * K + k0 + 8 * c) = o; }
    LDS_WAIT(); asm volatile("" ::: "memory");
}

struct Args { const float* in[22]; float* out; unsigned char* ws; int ph_lo, ph_hi, li, pad; };

__device__ __forceinline__ void p0_transposes(Frame& F0, const Args& A, int it0, int it1, int gw, int NGW) {
    Frame F = F0; { int t_ = threadIdx.x; asm volatile("" : "+v"(t_)); F.tid = t_; F.lane = t_ & 63; }
    unsigned char* ws = A.ws; const float* w_in = A.in[6];
    LAS float* scr = (LAS float*)(F.lds + RING_OFF + F.wave * 16384);
    constexpr int I_A = 16 * 88, I_B = 16 * 32, I_O = 16 * 32, I_1 = 16 * 128, I_2 = 64 * 32, I_L = I_A + I_B + I_O + I_1 + I_2;
    bf16* Win_t = (bf16*)(ws + WS_WIN); bf16* Wout_t = (bf16*)(ws + WS_WOUT); bf16* W1_t = (bf16*)(ws + WS_W1); bf16* W2_t = (bf16*)(ws + WS_W2);
    for (int it = it0 + gw; it < it1; it += NGW) {
        const int l = it / I_L; int r = it % I_L;
        if (r < I_A) { p0_transpose_item(w_in + (size_t)l * 1024 * INC, 1024, INC, 88, Win_t + (size_t)l * 4096 * 1024, scr, r, F.lane); continue; } r -= I_A;
        if (r < I_B) { p0_transpose_item(w_in + (size_t)l * 1024 * INC + 2820, 1024, INC, 32, Win_t + (size_t)l * 4096 * 1024 + (size_t)2816 * 1024, scr, r, F.lane); continue; } r -= I_B;
        if (r < I_O) { p0_transpose_item(A.in[7] + (size_t)l * 1024 * 1024, 1024, 1024, 32, Wout_t + (size_t)l * 1024 * 1024, scr, r, F.lane); continue; } r -= I_O;
        if (r < I_1) { p0_transpose_item(A.in[20] + (size_t)l * 1024 * 4096, 1024, 4096, 128, W1_t + (size_t)l * 4096 * 1024, scr, r, F.lane); continue; } r -= I_1;
        p0_transpose_item(A.in[21] + (size_t)l * 4096 * 1024, 4096, 1024, 32, W2_t + (size_t)l * 1024 * 4096, scr, r, F.lane);
    }
}
constexpr int TR_ITEMS_L = 16 * 88 + 16 * 32 + 16 * 32 + 16 * 128 + 64 * 32;


__device__ __forceinline__ void p0_prologue(Frame& F0, const Args& A) {
    Frame F = F0; { int t_ = threadIdx.x; asm volatile("" : "+v"(t_)); F.tid = t_; F.lane = t_ & 63; }
    unsigned char* ws = A.ws;
    const float* c_in = A.in[1]; const float* w_ada = A.in[2]; const float* b_ada = A.in[3]; const float* w_in = A.in[6];
    float* mod = (float*)(ws + WS_MOD); float* wg = (float*)(ws + WS_WG);
    {
        LAS float* cact = (LAS float*)(F.lds); LAS float* red = (LAS float*)(F.lds + 32768);
        bool staged = false;
        for (int unit = blockIdx.x; unit < 192; unit += F.G) {
            if (!staged) { for (int i = F.tid; i < 8192; i += NWAVES * 64) { const int b = i >> 10, k = i & 1023; const float v = c_in[b * 1024 + k]; cact[k * 8 + b] = v / (1.f + expf(-v)); } staged = true; }
            __syncthreads();
            const int l = unit / 96, n0 = (unit % 96) * 64;
            const float* W = w_ada + (size_t)l * 1024 * NMOD + n0 + F.lane;
            float acc[8];
#pragma unroll
            for (int b = 0; b < 8; ++b) acc[b] = 0.f;
            const int k0 = F.wave * 128;
#pragma unroll 32
            for (int kk = 0; kk < 128; ++kk) { const int k = k0 + kk; const float w = W[(size_t)k * NMOD];
                const f32x4 c0 = *(const LAS f32x4*)(cact + k * 8), c1 = *(const LAS f32x4*)(cact + k * 8 + 4);
                acc[0] += w * c0[0]; acc[1] += w * c0[1]; acc[2] += w * c0[2]; acc[3] += w * c0[3]; acc[4] += w * c1[0]; acc[5] += w * c1[1]; acc[6] += w * c1[2]; acc[7] += w * c1[3]; }
#pragma unroll
            for (int b = 0; b < 8; ++b) red[(F.wave * 8 + b) * 64 + F.lane] = acc[b];
            __syncthreads();
            { const int b = F.tid >> 6, col = F.tid & 63; float s = b_ada[l * NMOD + n0 + col];
#pragma unroll
              for (int w = 0; w < 8; ++w) s += red[(w * 8 + b) * 64 + col];
              mod[(size_t)(l * 8 + b) * NMOD + n0 + col] = s;
              if (n0 >= 1 * D && n0 < 2 * D) ((float*)(ws + WS_GM1))[(size_t)(l * 8 + b) * D + (n0 - 1 * D) + col] = A.in[4][l * D + (n0 - 1 * D) + col] * (1.f + s);
              if (n0 >= 4 * D && n0 < 5 * D) ((float*)(ws + WS_GM2))[(size_t)(l * 8 + b) * D + (n0 - 4 * D) + col] = A.in[5][l * D + (n0 - 4 * D) + col] * (1.f + s); }
            __syncthreads();
        }
    }
    __syncthreads();
    for (int idx = blockIdx.x * (NWAVES * 64) + F.tid; idx < 2 * 12 * 1024; idx += F.G * NWAVES * 64) {
        const int l = idx / 12288, r = idx % 12288, j = r >> 10, k = r & 1023;
        const int col = (j < 4) ? 2816 + j : (j < 8 ? 3844 + (j - 4) : 3848 + (j - 8));
        const float wv = w_in[(size_t)l * 1024 * INC + (size_t)k * INC + col]; wg[idx] = wv;
        ((bf16*)(ws + WS_WIN))[(size_t)l * 4096 * 1024 + (size_t)(3840 + j) * 1024 + k] = (bf16)f2bf(wv);
    }
    for (int idx = blockIdx.x * (NWAVES * 64) + F.tid; idx < 2 * 244 * 1024 / 8; idx += F.G * NWAVES * 64) {
        const int l = idx / (244 * 128), r = idx % (244 * 128);
        ((GAS v4u*)((bf16*)(ws + WS_WIN) + (size_t)l * 4096 * 1024 + (size_t)3852 * 1024))[r] = (v4u){0u, 0u, 0u, 0u};
    }
    if (blockIdx.x == F.G - 1 && F.tid < 2 * 4 * 64) {
        const int l = F.tid >> 8, k = (F.tid >> 6) & 3, d = F.tid & 63; float v;
        if (k == 0) v = A.in[10][l * 32 + (d & 31)] * (0.17677669529663687f * LOG2E);
        else if (k == 1) v = A.in[11][l * 32 + (d & 31)];
        else if (k == 2) v = A.in[14][l * 64 + d] * (0.125f * LOG2E);
        else v = A.in[15][l * 64 + d];
        ((float*)(ws + WS_QKG))[F.tid] = v;
    }
    if (blockIdx.x == F.G - 2 && F.tid < 4) {
        const int l = F.tid >> 1, k = F.tid & 1; float mq = 0.f, mk = 0.f;
        if (k == 0) { for (int d = 0; d < 64; ++d) { mq = fmaxf(mq, fabsf(A.in[14][l * 64 + d])); mk = fmaxf(mk, fabsf(A.in[15][l * 64 + d])); } }
        else { for (int d = 0; d < 32; ++d) { mq = fmaxf(mq, fabsf(A.in[10][l * 32 + d])); mk = fmaxf(mk, fabsf(A.in[11][l * 32 + d])); } }
        ((float*)(ws + WS_SMAX))[F.tid] = (k == 0 ? 8.0f : 5.656854249f) * LOG2E * mq * mk * 1.02f + 0.5f;
    }
    if (F.G == 256) { constexpr int N1 = 192 * NWAVES * 6;
        if (blockIdx.x < 192) p0_transposes(F, A, 0, N1, (int)blockIdx.x * NWAVES + F.wave, 192 * NWAVES);
        else p0_transposes(F, A, N1, 2 * TR_ITEMS_L, ((int)blockIdx.x - 192) * NWAVES + F.wave, 64 * NWAVES); }
    else p0_transposes(F, A, 0, 2 * TR_ITEMS_L, F.vcu * NWAVES + F.wave, F.G * NWAVES);
}

__device__ __forceinline__ void norm_phase(Frame& F0, const float* xsrc, const float* gain, const float* modl, int shift_slot, bf16* hn, const float* wg, float* gates, float* fgt) {
    Frame F = F0; { int t_ = threadIdx.x; asm volatile("" : "+v"(t_)); F.tid = t_; F.lane = t_ & 63; }
    LAS float* wgl = (LAS float*)(F.lds);
    if (wg) { for (int i = F.tid; i < 12 * 1024 / 4; i += NWAVES * 64) ((LAS f32x4*)wgl)[i] = ((const GAS f32x4*)wg)[i]; }
    __syncthreads();
    const int gw = F.vcu * NWAVES + F.wave, NGW = F.G * NWAVES;
    for (int m0 = gw * 16; m0 < T; m0 += NGW * 16) {
        const int b = m0 >> 12;
        f32x4 gm[4], sh[4];
        { const GAS f32x4* g4 = (const GAS f32x4*)gain + F.lane;
          const GAS f32x4* sh4 = (const GAS f32x4*)(modl + (size_t)b * NMOD + shift_slot * D) + F.lane;
          const GAS f32x4* sc4 = (const GAS f32x4*)(modl + (size_t)b * NMOD + (shift_slot + 1) * D) + F.lane;
#pragma unroll
          for (int j = 0; j < 4; ++j) { gm[j] = g4[64 * j] * (sc4[64 * j] + 1.0f); sh[j] = sh4[64 * j]; } }
#pragma unroll 1
        for (int rb = 0; rb < 16; rb += 4) {
            f32x4 v[4][4]; float s[4];
#pragma unroll
            for (int r = 0; r < 4; ++r) { const GAS f32x4* xr = (const GAS f32x4*)(xsrc + (size_t)(m0 + rb + r) * D) + F.lane;
#pragma unroll
                for (int j = 0; j < 4; ++j) v[r][j] = xr[64 * j]; }
#pragma unroll
            for (int r = 0; r < 4; ++r) { float a = 0.f;
#pragma unroll
                for (int j = 0; j < 4; ++j) a += (v[r][j].x * v[r][j].x + v[r][j].y * v[r][j].y) + (v[r][j].z * v[r][j].z + v[r][j].w * v[r][j].w);
                s[r] = a; }
#pragma unroll
            for (int o = 1; o < 64; o <<= 1) {
#pragma unroll
                for (int r = 0; r < 4; ++r) s[r] += __shfl_xor(s[r], o); }
#pragma unroll
            for (int r = 0; r < 4; ++r) { const float rstd = __builtin_amdgcn_rsqf(s[r] * (1.f / D) + EPS);
                GAS unsigned long long* o8 = (GAS unsigned long long*)(hn + (size_t)(m0 + rb + r) * D) + F.lane;
#pragma unroll
                for (int j = 0; j < 4; ++j) { v[r][j] = (v[r][j] * rstd) * gm[j] + sh[j];
                    o8[64 * j] = (unsigned long long)pk2(v[r][j].x, v[r][j].y) | ((unsigned long long)pk2(v[r][j].z, v[r][j].w) << 32); } }
            if (wg) {
                float mine[4] = {0.f, 0.f, 0.f, 0.f};
#pragma unroll 1
                for (int g = 0; g < 12; ++g) { float d[4] = {0.f, 0.f, 0.f, 0.f};
#pragma unroll
                    for (int j = 0; j < 4; ++j) { const f32x4 w = ((const LAS f32x4*)(wgl + g * 1024))[F.lane + 64 * j];
#pragma unroll
                        for (int r = 0; r < 4; ++r) d[r] += (v[r][j].x * w.x + v[r][j].y * w.y) + (v[r][j].z * w.z + v[r][j].w * w.w); }
#pragma unroll
                    for (int o = 1; o < 64; o <<= 1) {
#pragma unroll
                        for (int r = 0; r < 4; ++r) d[r] += __shfl_xor(d[r], o); }
#pragma unroll
                    for (int r = 0; r < 4; ++r) mine[r] = (F.lane == g) ? d[r] : mine[r]; }
                if (F.lane < 12) {
#pragma unroll
                    for (int r = 0; r < 4; ++r) gates[(size_t)(m0 + rb + r) * 12 + F.lane] = mine[r]; }
                if (F.lane < 4) {
#pragma unroll
                    for (int r = 0; r < 4; ++r) fgt[(size_t)(b * NH + F.lane) * SEQ + ((m0 + rb + r) & (SEQ - 1))] = mine[r]; }
            }
        }
    }
}
__device__ __forceinline__ void fox_scan_wave(const float* fgt, const float* fbias, float* Fcum, int* kst, float smax, int bh, int lane_) {
    int lane = lane_; asm volatile("" : "+v"(lane));
    const int h = bh & 3; const float fb = fbias[h]; const GAS f32x4* g4 = (const GAS f32x4*)(fgt + (size_t)bh * SEQ + lane * 64);
    f32x4 lf[16]; float s = 0.f;
#pragma unroll
    for (int i = 0; i < 16; ++i) lf[i] = g4[i];
#pragma unroll
    for (int i = 0; i < 16; ++i) {
#pragma unroll
        for (int e = 0; e < 4; ++e) { lf[i][e] = logsigmoidf_(lf[i][e] + fb); s += lf[i][e]; } }
    float incl = s;
#pragma unroll
    for (int o = 1; o < 64; o <<= 1) { const float v = __shfl_up(incl, o); if (lane >= o) incl += v; }
    float run = incl - s; GAS f32x4* Fo = (GAS f32x4*)(Fcum + (size_t)bh * SEQ + lane * 64); float ffirst = 0.f;
#pragma unroll
    for (int i = 0; i < 16; ++i) { f32x4 o4;
#pragma unroll
        for (int e = 0; e < 4; ++e) { run += lf[i][e]; o4[e] = run; if (i == 0 && e == 0) ffirst = run; }
        Fo[i] = o4; }
    const float blast = -run * LOG2E;
    for (int qb = 0; qb < 16; ++qb) { const float bq0 = -__shfl(ffirst, 4 * qb) * LOG2E;
        const unsigned long long m = __ballot(blast < bq0 - 152.0f - 2.0f * smax);
        int ks = (int)__builtin_ctzll(~m); const int nt = 4 * qb + 4; ks = ks < nt - 4 ? ks : nt - 4; ks &= ~1;
        if (lane == 0) kst[bh * 16 + qb] = ks; }
}

__device__ __forceinline__ void fox_scan_block(const float* fgt, const float* fbias, float* Fcum, int* kst, float smax, int bh, LAS unsigned char* lds) {
    int tid_ = threadIdx.x; asm volatile("" : "+v"(tid_)); const int tid = tid_, lane = tid & 63, wave = tid >> 6;
    LAS float* Fl = (LAS float*)lds; LAS float* part = Fl + SEQ;
    const int h = bh & 3; const float fb = fbias[h];
    const GAS f32x4* g4 = (const GAS f32x4*)(fgt + (size_t)bh * SEQ + tid * 8);
    const f32x4 a = g4[0], b = g4[1];
    float v[8] = {a[0], a[1], a[2], a[3], b[0], b[1], b[2], b[3]}; float s = 0.f;
#pragma unroll
    for (int e = 0; e < 8; ++e) { s += logsigmoidf_(v[e] + fb); v[e] = s; }
    float incl = s;
#pragma unroll
    for (int o = 1; o < 64; o <<= 1) { const float t = __shfl_up(incl, o); if (lane >= o) incl += t; }
    if (lane == 63) part[wave] = incl;
    __syncthreads();
    float base = incl - s;
    for (int w = 0; w < wave; ++w) base += part[w];
    f32x4 o0, o1;
#pragma unroll
    for (int e = 0; e < 4; ++e) { o0[e] = base + v[e]; o1[e] = base + v[4 + e]; }
    GAS f32x4* Fo = (GAS f32x4*)(Fcum + (size_t)bh * SEQ + tid * 8); Fo[0] = o0; Fo[1] = o1;
    *(LAS f32x4*)(Fl + tid * 8) = o0; *(LAS f32x4*)(Fl + tid * 8 + 4) = o1;
    __syncthreads();
    if (wave == 0) {
        const float blast = -Fl[64 * lane + 63] * LOG2E;
        for (int qb = 0; qb < 16; ++qb) { const float bq0 = -Fl[256 * qb] * LOG2E;
            const unsigned long long m = __ballot(blast < bq0 - 152.0f - 2.0f * smax);
            int ks = (int)__builtin_ctzll(~m); const int nt = 4 * qb + 4; ks = ks < nt - 4 ? ks : nt - 4; ks &= ~1;
            if (lane == 0) kst[bh * 16 + qb] = ks; }
    }
    __syncthreads();
}

__device__ __forceinline__ void bias_gemv(Frame& F0, const bf16* Wt, int N, const float* shift, int sstride, float* out) {
    Frame F = F0; { int t_ = threadIdx.x; asm volatile("" : "+v"(t_)); F.tid = t_; F.lane = t_ & 63; }
    LAS float* sl = (LAS float*)(F.lds);
    __syncthreads();
    for (int i = F.tid; i < 8 * 1024; i += NWAVES * 64) sl[i] = shift[(size_t)(i >> 10) * sstride + (i & 1023)];
    __syncthreads();
    const int gw = F.vcu * NWAVES + F.wave, NGW = F.G * NWAVES;
    for (int n = gw; n < N; n += NGW) {
        float w[16];
#pragma unroll
        for (int j = 0; j < 4; ++j) { const unsigned long long q = *(const GAS unsigned long long*)(Wt + (size_t)n * 1024 + 256 * j + F.lane * 4);
#pragma unroll
            for (int e = 0; e < 4; ++e) w[j * 4 + e] = __builtin_bit_cast(float, (unsigned)((q >> (16 * e)) & 0xffffu) << 16); }
        float mine = 0.f;
#pragma unroll 1
        for (int b = 0; b < 8; ++b) { float d = 0.f;
#pragma unroll
            for (int j = 0; j < 4; ++j) { const f32x4 s4 = *(const LAS f32x4*)(sl + b * 1024 + 256 * j + F.lane * 4); d += (w[j * 4] * s4[0] + w[j * 4 + 1] * s4[1]) + (w[j * 4 + 2] * s4[2] + w[j * 4 + 3] * s4[3]); }
            d = wave_sum(d); mine = (F.lane == b) ? d : mine; }
        if (F.lane < 8) out[(size_t)F.lane * N + n] = mine;
    }
    __syncthreads();
}

__device__ __forceinline__ void prenorm0_phase(Frame& F0, const float* xsrc, const float* gm, bf16* hn, float* ss) {
    Frame F = F0; { int t_ = threadIdx.x; asm volatile("" : "+v"(t_)); F.tid = t_; F.lane = t_ & 63; }
    const int gw = F.vcu * NWAVES + F.wave, NGW = F.G * NWAVES;
    for (int m0 = gw * 16; m0 < T; m0 += NGW * 16) {
        const int b = m0 >> 12; f32x4 g[4];
        { const GAS f32x4* g4 = (const GAS f32x4*)(gm + (size_t)b * D) + F.lane;
#pragma unroll
          for (int j = 0; j < 4; ++j) g[j] = g4[64 * j]; }
#pragma unroll 1
        for (int rb = 0; rb < 16; rb += 4) {
            f32x4 v[4][4]; float s[4];
#pragma unroll
            for (int r = 0; r < 4; ++r) { const GAS f32x4* xr = (const GAS f32x4*)(xsrc + (size_t)(m0 + rb + r) * D) + F.lane;
#pragma unroll
                for (int j = 0; j < 4; ++j) v[r][j] = xr[64 * j]; }
#pragma unroll
            for (int r = 0; r < 4; ++r) { float a = 0.f;
#pragma unroll
                for (int j = 0; j < 4; ++j) a += (v[r][j].x * v[r][j].x + v[r][j].y * v[r][j].y) + (v[r][j].z * v[r][j].z + v[r][j].w * v[r][j].w);
                s[r] = a;
                GAS unsigned long long* o8 = (GAS unsigned long long*)(hn + (size_t)(m0 + rb + r) * D) + F.lane;
#pragma unroll
                for (int j = 0; j < 4; ++j) { const f32x4 a4 = v[r][j] * g[j]; o8[64 * j] = (unsigned long long)pk2(a4.x, a4.y) | ((unsigned long long)pk2(a4.z, a4.w) << 32); } }
#pragma unroll
            for (int o = 1; o < 64; o <<= 1) {
#pragma unroll
                for (int r = 0; r < 4; ++r) s[r] += __shfl_xor(s[r], o); }
            if (F.lane < 4) { const float mine = (F.lane == 0) ? s[0] : (F.lane == 1 ? s[1] : (F.lane == 2 ? s[2] : s[3]));
                *(GAS f32x4*)(ss + (size_t)(m0 + rb + F.lane) * 4) = (f32x4){mine, 0.f, 0.f, 0.f}; }
        }
    }
}

__device__ __forceinline__ void bias_all(Frame& F0, const bf16* Win_t, const bf16* W1_t, const float* mod, float* bias1, float* bias2) {
    Frame F = F0; { int t_ = threadIdx.x; asm volatile("" : "+v"(t_)); F.tid = t_; F.lane = t_ & 63; }
    LAS float* sl = (LAS float*)(F.lds);
    __syncthreads();
    for (int i = F.tid; i < 4 * 8192; i += NWAVES * 64) { const int set = i >> 13, l = set & 1, slot = (set >> 1) ? 3 : 0, b = (i >> 10) & 7, k = i & 1023;
        sl[i] = mod[(size_t)(l * 8 + b) * NMOD + slot * 1024 + k]; }
    __syncthreads();
    const int gw = F.vcu * NWAVES + F.wave, NGW = F.G * NWAVES;
    for (int r = gw; r < 4 * 4096; r += NGW) {
        const int set = r >> 12, n = r & 4095, l = set & 1;
        const bf16* wrow = ((set >> 1) ? W1_t : Win_t) + (size_t)(l * 4096 + n) * 1024; float* out = ((set >> 1) ? bias2 : bias1) + (size_t)l * 8 * 4096;
        float w[16];
#pragma unroll
        for (int j = 0; j < 4; ++j) { const unsigned long long q = *(const GAS unsigned long long*)(wrow + 256 * j + F.lane * 4);
#pragma unroll
            for (int e = 0; e < 4; ++e) w[j * 4 + e] = __builtin_bit_cast(float, (unsigned)((q >> (16 * e)) & 0xffffu) << 16); }
        float d[8];
#pragma unroll
        for (int b = 0; b < 8; ++b) { float a = 0.f;
#pragma unroll
            for (int j = 0; j < 4; ++j) { const f32x4 s4 = *(const LAS f32x4*)(sl + set * 8192 + b * 1024 + 256 * j + F.lane * 4); a += (w[j * 4] * s4[0] + w[j * 4 + 1] * s4[1]) + (w[j * 4 + 2] * s4[2] + w[j * 4 + 3] * s4[3]); }
            d[b] = a; }
#pragma unroll
        for (int o = 1; o < 64; o <<= 1) {
#pragma unroll
            for (int b = 0; b < 8; ++b) d[b] += __shfl_xor(d[b], o); }
        float mine = d[0];
#pragma unroll
        for (int b = 1; b < 8; ++b) mine = (F.lane == b) ? d[b] : mine;
        if (F.lane < 8) out[(size_t)F.lane * 4096 + n] = mine;
    }
    __syncthreads();
}
namespace att {
using bf16x8 = __attribute__((ext_vector_type(8))) short;
using s16x4 = __attribute__((ext_vector_type(4))) short;
using f32x16 = __attribute__((ext_vector_type(16))) float;
using f32x4v = __attribute__((ext_vector_type(4))) float;
using u32x4 = __attribute__((ext_vector_type(4))) unsigned;
constexpr int NW = 8, QBLK = 32, QB = QBLK * NW, KVBLK = 64, NQB = SEQ / QB, PITCH = ZP;
constexpr int SLOTB = 8192, LDS_K = 0, LDS_V = 3 * SLOTB, LDS_WS = 6 * SLOTB, LDS_OST = LDS_WS + NW * 256, LDS_TBL = LDS_OST + NW * 8192, LDS_END = LDS_TBL + SEQ * 4 + 256;
static_assert(LDS_END <= LDSCTL_OFF, "attention LDS map");
constexpr int THR = 48;
#define SBAR() __builtin_amdgcn_sched_barrier(0)
#define PIN(x) asm volatile("" : "+v"(x))
#define MFMA(a, b, c) __builtin_amdgcn_mfma_f32_32x32x16_bf16(a, b, c, 0, 0, 0)
#define WAIT_BAR(N) asm volatile("s_waitcnt vmcnt(" #N ") lgkmcnt(0)\n\ts_barrier" ::: "memory")
__device__ __forceinline__ int crow(int r, int hi) { return (r & 3) + 8 * (r >> 2) + 4 * hi; }
__device__ __forceinline__ unsigned cvtpk(float lo, float hi) { unsigned r; asm("v_cvt_pk_bf16_f32 %0, %1, %2\n\ts_nop 1" : "=v"(r) : "v"(lo), "v"(hi)); return r; }
__device__ __forceinline__ unsigned cvtpk_b(float lo, float hi) { const pg8::cv_f32x2 v = {lo, hi}; return __builtin_bit_cast(unsigned, __builtin_convertvector(v, pg8::cv_bf16x2)); }
__device__ __forceinline__ void glds16(const void* g, unsigned lds_base) {
    unsigned sv; asm volatile("s_mov_b32 %0, m0\n\ts_mov_b32 m0, %2\n\ts_nop 0\n\tglobal_load_lds_dwordx4 %1, off\n\ts_mov_b32 m0, %0" : "=&s"(sv) : "v"(g), "s"(lds_base) : "memory"); }
typedef __attribute__((address_space(3))) const char* lds_cptr;
typedef short v4i16_t __attribute__((ext_vector_type(4)));
__device__ __forceinline__ void kload2(bf16x8* kf, lds_cptr kp, int d0) { kf[2 * d0] = *(const __attribute__((address_space(3))) bf16x8*)(kp + d0 * 2048); kf[2 * d0 + 1] = *(const __attribute__((address_space(3))) bf16x8*)(kp + d0 * 2048 + 512); }
__device__ __forceinline__ s16x4 vtr(lds_cptr p) { return __builtin_bit_cast(s16x4, __builtin_amdgcn_ds_read_tr16_b64_v4i16((__attribute__((address_space(3))) v4i16_t*)p)); }
__device__ __forceinline__ f32x16 ldbias(lds_cptr p) {
    const f32x4v a = *(const __attribute__((address_space(3))) f32x4v*)(p), b = *(const __attribute__((address_space(3))) f32x4v*)(p + 32), c = *(const __attribute__((address_space(3))) f32x4v*)(p + 64), d = *(const __attribute__((address_space(3))) f32x4v*)(p + 96);
    return (f32x16){a[0], a[1], a[2], a[3], b[0], b[1], b[2], b[3], c[0], c[1], c[2], c[3], d[0], d[1], d[2], d[3]}; }
#define MX3(a, b, c) __builtin_fmaxf(__builtin_fmaxf((a), (b)), (c))
__device__ __forceinline__ float rowmax(const f32x16& p0, const f32x16& p1) {
    float a = MX3(p0[0], p0[1], p1[0]), b = MX3(p0[2], p0[3], p1[1]); a = MX3(a, p1[2], p1[3]);
#pragma unroll
    for (int r = 4; r < 16; r += 4) { a = MX3(a, p0[r], p0[r + 1]); b = MX3(b, p0[r + 2], p0[r + 3]); a = MX3(a, p1[r], p1[r + 1]); b = MX3(b, p1[r + 2], p1[r + 3]); }
    float m = __builtin_fmaxf(a, b); auto rr = __builtin_amdgcn_permlane32_swap(__float_as_uint(m), __float_as_uint(m), false, false);
    return __builtin_fmaxf(__uint_as_float(rr[0]), __uint_as_float(rr[1])); }
__device__ __forceinline__ void cmask(f32x16& p0, f32x16& p1, int jb, int qrel, int hi) {
    const int kb = 64 * jb + 4 * hi;
#pragma unroll
    for (int r = 0; r < 16; ++r) { const int kv = kb + (r & 3) + 8 * (r >> 2); if (kv > qrel) p0[r] = -INFINITY; if (kv + 32 > qrel) p1[r] = -INFINITY; } }

template <int ND0>
__device__ __forceinline__ void attn_pass(int b, int qb, int kst, const bf16* Z, int qcol, int kcol, int vcol, int kcoff, char* lds, f32x16 (&o)[2], float& l_out) {
    int tid_ = threadIdx.x; asm volatile("" : "+v"(tid_));
    const int tid = tid_, lane = tid & 63, r32 = lane & 31, hi = lane >> 5; const int wid = __builtin_amdgcn_readfirstlane(tid >> 6);
    const long rowbase = (long)b * SEQ; const int q0 = qb * QB, NT = (q0 + QB) / KVBLK - kst;
    const bf16* Qw = Z + (rowbase + q0 + wid * QBLK) * PITCH + qcol;
    const unsigned lds0 = (unsigned)(uintptr_t)lds; float* wsf = (float*)(lds + LDS_WS) + wid * 64;
    const bf16* ksrc = Z + (rowbase + (long)kst * KVBLK) * PITCH + kcol + (long)lane * PITCH + wid * 8;
    const bf16* vsrc = Z + (rowbase + (long)kst * KVBLK) * PITCH + vcol + (long)(16 * (wid & 3) + (lane >> 2)) * PITCH + (wid >> 2) * 32 + (lane & 3) * 8;
    const unsigned kdst = lds0 + LDS_K + wid * 1024, vdst = lds0 + LDS_V + wid * 1024;
#define DMA_K(t, slot) glds16(ksrc + (long)(t) * KVBLK * PITCH, (unsigned)__builtin_amdgcn_readfirstlane(kdst + (slot)))
#define DMA_V(t, slot) glds16(vsrc + (long)(t) * KVBLK * PITCH, (unsigned)__builtin_amdgcn_readfirstlane(vdst + (slot)))
    const lds_cptr vp0 = (lds_cptr)lds + LDS_V + ((lane >> 4) & 1) * 32 + (lane & 3) * 8 + (4 * hi + ((lane & 15) >> 2)) * 64;
    const lds_cptr kp0 = (lds_cptr)lds + LDS_K + kcoff + hi * 1024 + r32 * 16;
    const lds_cptr tb0 = (lds_cptr)lds + LDS_TBL + hi * 16 + kst * 256;
    DMA_K(0, 0); DMA_V(0, 0); DMA_K(1, SLOTB);
    bf16x8 qr[ND0];
#pragma unroll
    for (int d0 = 0; d0 < ND0; ++d0) qr[d0] = *reinterpret_cast<const bf16x8*>(&Qw[(long)r32 * PITCH + d0 * 16 + hi * 8]);
    float mhat = 0.f, l_reg = 0.f; o[0] = f32x16{}; o[1] = f32x16{};
    const int qrel = wid * QBLK + r32; bool resc = false;
    f32x16 pA0, pA1, pB0, pB1; bf16x8 kf[2 * ND0]; s16x4 vlo[8], vhi[8]; u32x4 pw0, pw1, pw2, pw3;
    int sl_prev = 0, sl_cur = 0, sl_next = SLOTB;
#define ROT() do { sl_prev = sl_cur; sl_cur = sl_next; sl_next = (sl_next == 2 * SLOTB) ? 0 : sl_next + SLOTB; } while (0)
#define EX(v) __builtin_amdgcn_exp2f((v) + nmh)
#define RESC() do { if (resc) { _Pragma("unroll") for (int d_ = 0; d_ < 2; ++d_) _Pragma("unroll") for (int r = 0; r < 16; ++r) o[d_][r] *= wsf[crow(r, hi)]; } } while (0)
    DMA_K(2, 2 * SLOTB);
    WAIT_BAR(3);
    _Pragma("unroll") for (int d0 = 0; d0 < ND0; ++d0) kload2(kf, kp0, d0);
    pA0 = ldbias(tb0); pA1 = ldbias(tb0 + 128);
    _Pragma("unroll") for (int d0 = 0; d0 < ND0; ++d0) { pA0 = MFMA(kf[2 * d0], qr[d0], pA0); pA1 = MFMA(kf[2 * d0 + 1], qr[d0], pA1); }
    if (NT == 4) cmask(pA0, pA1, 0, qrel, hi);
    { const float rm = rowmax(pA0, pA1); mhat = rm; const float nmh = -mhat;
#pragma unroll
      for (int r = 0; r < 16; ++r) { pA0[r] = EX(pA0[r]); pA1[r] = EX(pA1[r]); } }
    pB0 = ldbias(tb0 + 256); pB1 = ldbias(tb0 + 256 + 128);
    WAIT_BAR(0);
    DMA_K(3, 0); DMA_V(1, SLOTB); ROT();
    _Pragma("unroll") for (int d0 = 0; d0 < ND0; ++d0) kload2(kf, kp0 + sl_cur, d0);
    WAIT_BAR(2);
#define PKW(P, i) cvtpk_b(P[i], P[i + 1])
#define PAF(k) __builtin_bit_cast(bf16x8, pw##k)
#define VFR(i) (bf16x8){vlo[i][0], vlo[i][1], vlo[i][2], vlo[i][3], vhi[i][0], vhi[i][1], vhi[i][2], vhi[i][3]}
#define VRD(i) do { vlo[i] = vtr(vp_ + (((i) >> 2) * 4096 + ((i) & 3) * 1024)); vhi[i] = vtr(vp_ + (((i) >> 2) * 4096 + ((i) & 3) * 1024 + 512)); } while (0)
#define KRD(G, d0) do { if ((G) && (d0) < ND0) { kload2(kf, kp0 + sl_next, d0); SBAR(); } } while (0)
#define QK(C, i) do { if constexpr ((i) < 2 * ND0) { C = MFMA(kf[(i) < 2 * ND0 ? (i) : 0], qr[(i) < 2 * ND0 ? (i) / 2 : 0], C); } } while (0)
#define GAPA(MF, a0, a1, a2, a3, W0, W1, PW) do { MF; sacc += a0; sacc += a1; sacc += a2; sacc += a3; W0; W1; PIN(PW); PIN(sacc); SBAR(); } while (0)
#define GAPB(MF, X, i) do { MF; X[i] = EX(X[i]); X[i + 1] = EX(X[i + 1]); X[i + 2] = EX(X[i + 2]); X[i + 3] = EX(X[i + 3]); PIN(X); SBAR(); } while (0)
#define STEP(C0, C1, P0, P1, t, MASK, GK, GV, GL) do { SBAR(); \
    const lds_cptr vp_ = vp0 + sl_prev; \
    VRD(0); SBAR(); float sacc = P0[0] + P0[1]; \
                    GAPA(QK(C0, 0), P0[2], P0[3], P0[4], P0[5],     pw0[0] = PKW(P0, 0),  pw0[1] = PKW(P0, 2),  pw0); \
    VRD(4); SBAR(); GAPA(QK(C1, 1), P0[6], P0[7], P0[8], P0[9],     pw0[2] = PKW(P0, 4),  pw0[3] = PKW(P0, 6),  pw0); \
    VRD(1); SBAR(); GAPA(QK(C0, 2), P0[10], P0[11], P0[12], P0[13], pw1[0] = PKW(P0, 8),  pw1[1] = PKW(P0, 10), pw1); \
    VRD(5); SBAR(); GAPA(QK(C1, 3), P0[14], P0[15], P1[0], P1[1],   pw1[2] = PKW(P0, 12), pw1[3] = PKW(P0, 14), pw1); \
    VRD(2); SBAR(); GAPA(QK(C0, 4), P1[2], P1[3], P1[4], P1[5],     pw2[0] = PKW(P1, 0),  pw2[1] = PKW(P1, 2),  pw2); \
    VRD(6); SBAR(); GAPA(QK(C1, 5), P1[6], P1[7], P1[8], P1[9],     pw2[2] = PKW(P1, 4),  pw2[3] = PKW(P1, 6),  pw2); \
    VRD(3); SBAR(); GAPA(QK(C0, 6), P1[10], P1[11], P1[12], P1[13], pw3[0] = PKW(P1, 8),  pw3[1] = PKW(P1, 10), pw3); \
    VRD(7); SBAR(); GAPA(QK(C1, 7), P1[14], P1[15], 0.f, 0.f,       pw3[2] = PKW(P1, 12), pw3[3] = PKW(P1, 14), pw3); \
    l_reg += sacc; \
    if (GK) DMA_K((t) + 3, sl_cur); if (GV) DMA_V((t) + 1, sl_next); \
    if (MASK) cmask(C0, C1, (t) - (NT - 4), qrel, hi); \
    { const float rm = rowmax(C0, C1) - mhat; resc = false; \
      if (__builtin_expect(__any(rm > (float)THR), 0)) { const float dl = __builtin_fmaxf(rm, 0.f); mhat += dl; \
          const float f = __builtin_amdgcn_exp2f(-dl); l_reg *= f; if (hi == 0) wsf[r32] = f; resc = true; } } \
    const float nmh = -mhat; SBAR(); \
    if (GL) { P0 = ldbias(tb0 + ((t) + 1) * 256); P1 = ldbias(tb0 + ((t) + 1) * 256 + 128); } SBAR(); \
    GAPB(o[0] = MFMA(PAF(0), VFR(0), o[0]), C0, 0);              GAPB(o[1] = MFMA(PAF(0), VFR(4), o[1]), C0, 4); \
    KRD(GL, 0); GAPB(o[0] = MFMA(PAF(1), VFR(1), o[0]), C0, 8);  KRD(GL, 1); GAPB(o[1] = MFMA(PAF(1), VFR(5), o[1]), C0, 12); \
    KRD(GL, 2); GAPB(o[0] = MFMA(PAF(2), VFR(2), o[0]), C1, 0);  KRD(GL, 3); GAPB(o[1] = MFMA(PAF(2), VFR(6), o[1]), C1, 4); \
    GAPB(o[0] = MFMA(PAF(3), VFR(3), o[0]), C1, 8);              GAPB(o[1] = MFMA(PAF(3), VFR(7), o[1]), C1, 12); \
    if (GL) { PIN(P0); PIN(P1); } \
    } while (0)
    int t = 1;
    for (; t + 5 < NT; t += 2) {
        STEP(pB0, pB1, pA0, pA1, t, false, true, true, true);     WAIT_BAR(2); RESC(); ROT();
        STEP(pA0, pA1, pB0, pB1, t + 1, false, true, true, true); WAIT_BAR(2); RESC(); ROT();
    }
#define ENDW(tt) do { if ((tt) + 3 < NT) { WAIT_BAR(2); } else if ((tt) + 2 < NT) { WAIT_BAR(1); } else { WAIT_BAR(0); } } while (0)
    for (; t + 1 < NT; t += 2) {
        STEP(pB0, pB1, pA0, pA1, t, true, (t + 3 < NT), (t + 1 < NT), (t + 1 < NT));         ENDW(t);     RESC(); ROT();
        STEP(pA0, pA1, pB0, pB1, t + 1, true, (t + 4 < NT), (t + 2 < NT), (t + 2 < NT));     ENDW(t + 1); RESC(); ROT();
    }
    STEP(pB0, pB1, pA0, pA1, NT - 1, true, false, false, false); RESC();
    { float sacc = pB0[0] + pB0[1];
#pragma unroll
      for (int r = 2; r < 16; ++r) sacc += pB0[r];
#pragma unroll
      for (int r = 0; r < 16; ++r) sacc += pB1[r];
      l_reg += sacc;
      pw0 = (u32x4){PKW(pB0, 0), PKW(pB0, 2), PKW(pB0, 4), PKW(pB0, 6)}; pw1 = (u32x4){PKW(pB0, 8), PKW(pB0, 10), PKW(pB0, 12), PKW(pB0, 14)};
      pw2 = (u32x4){PKW(pB1, 0), PKW(pB1, 2), PKW(pB1, 4), PKW(pB1, 6)}; pw3 = (u32x4){PKW(pB1, 8), PKW(pB1, 10), PKW(pB1, 12), PKW(pB1, 14)};
      const lds_cptr vp_ = vp0 + sl_cur; _Pragma("unroll") for (int i = 0; i < 8; ++i) VRD(i);
      o[0] = MFMA(PAF(0), VFR(0), o[0]); o[1] = MFMA(PAF(0), VFR(4), o[1]); o[0] = MFMA(PAF(1), VFR(1), o[0]); o[1] = MFMA(PAF(1), VFR(5), o[1]);
      o[0] = MFMA(PAF(2), VFR(2), o[0]); o[1] = MFMA(PAF(2), VFR(6), o[1]); o[0] = MFMA(PAF(3), VFR(3), o[0]); o[1] = MFMA(PAF(3), VFR(7), o[1]); }
    { auto rr = __builtin_amdgcn_permlane32_swap(__float_as_uint(l_reg), __float_as_uint(l_reg), false, false); l_reg = __uint_as_float(rr[0]) + __uint_as_float(rr[1]); }
    l_out = l_reg;
#undef DMA_K
#undef DMA_V
#undef ROT
#undef EX
#undef RESC
#undef PKW
#undef PAF
#undef VFR
#undef VRD
#undef KRD
#undef QK
#undef ENDW
#undef GAPA
#undef GAPB
#undef STEP
}

__device__ __forceinline__ void row_scales(float l_reg, float extra, float* wsf, int r32, int hi, float (&rli)[16]) {
    if (hi == 0) wsf[32 + r32] = l_reg; asm volatile("s_waitcnt lgkmcnt(0)" ::: "memory");
#pragma unroll
    for (int r = 0; r < 16; ++r) rli[r] = extra * __builtin_amdgcn_rcpf(wsf[32 + crow(r, hi)]);
    asm volatile("s_waitcnt lgkmcnt(0)" ::: "memory");
}

__device__ __forceinline__ void fox_unit(int b, int h, int qb, int kst, const bf16* Z, bf16* Y, char* lds) {
    int tid_ = threadIdx.x; asm volatile("" : "+v"(tid_));
    const int tid = tid_, lane = tid & 63, r32 = lane & 31, hi = lane >> 5; const int wid = __builtin_amdgcn_readfirstlane(tid >> 6);
    f32x16 o[2]; float l_reg;
    attn_pass<4>(b, qb, kst, Z, ZC_FQ + h * 64, ZC_FK + h * 64, ZC_FV + h * 64, 0, lds, o, l_reg);
    float* wsf = (float*)(lds + LDS_WS) + wid * 64; float rli[16]; row_scales(l_reg, 1.f, wsf, r32, hi, rli);
    const long row0 = (long)b * SEQ + qb * QB + wid * QBLK;
    unsigned short* stg = (unsigned short*)(lds + LDS_OST) + wid * 4096;
#pragma unroll
    for (int r = 0; r < 16; ++r) { const int orow = crow(r, hi);
#pragma unroll
        for (int d0 = 0; d0 < 2; ++d0) stg[orow * 64 + d0 * 32 + r32] = (unsigned short)f2bf(o[d0][r] * rli[r]); }
    asm volatile("s_waitcnt lgkmcnt(0)" ::: "memory");
#pragma unroll
    for (int i = 0; i < 4; ++i) { const int row = i * 8 + (lane >> 3), ch = lane & 7;
        const u32x4 ov = *(const u32x4*)(stg + row * 64 + ch * 8); const u32x4 gv = *(const u32x4*)(Z + (row0 + row) * PITCH + ZC_FG + h * 64 + ch * 8);
        u32x4 w;
#pragma unroll
        for (int e = 0; e < 4; ++e) { const float o0 = __uint_as_float(ov[e] << 16), o1 = __uint_as_float(ov[e] & 0xffff0000u), g0 = __uint_as_float(gv[e] << 16), g1 = __uint_as_float(gv[e] & 0xffff0000u);
            w[e] = pk2(o0 / (1.f + __expf(-g0)), o1 / (1.f + __expf(-g1))); }
        *(u32x4*)(Y + (row0 + row) * D + 512 + h * 64 + ch * 8) = w; }
    asm volatile("s_waitcnt lgkmcnt(0)\n\ts_barrier" ::: "memory");
}

__device__ __forceinline__ void diff_unit(int b, int h, int qb, int kst, const bf16* Z, bf16* Y, float lam, float oscale, const float* subg, char* lds) {
    int tid_ = threadIdx.x; asm volatile("" : "+v"(tid_));
    const int tid = tid_, lane = tid & 63, r32 = lane & 31, hi = lane >> 5; const int wid = __builtin_amdgcn_readfirstlane(tid >> 6);
    float* wsf = (float*)(lds + LDS_WS) + wid * 64; float* stg = (float*)(lds + LDS_OST) + wid * 2048;
    const long row0 = (long)b * SEQ + qb * QB + wid * QBLK;
    for (int c = 0; c < 2; ++c) {
        f32x16 o[2]; float l_reg;
        attn_pass<2>(b, qb, kst, Z, ZC_DQ + h * 64 + c * 32, ZC_DK + h * 64, ZC_DV + h * 64, c * 4096, lds, o, l_reg);
        float rli[16]; row_scales(l_reg, c == 0 ? 1.f : -lam, wsf, r32, hi, rli);
#pragma unroll
        for (int r = 0; r < 16; ++r) { const int orow = crow(r, hi);
#pragma unroll
            for (int d0 = 0; d0 < 2; ++d0) { float* p = stg + orow * 64 + d0 * 32 + r32; const float v = o[d0][r] * rli[r]; *p = (c == 0) ? v : (*p + v); } }
        asm volatile("s_waitcnt lgkmcnt(0)\n\ts_barrier" ::: "memory");
    }
#pragma unroll
    for (int i = 0; i < 4; ++i) { const int row = i * 8 + (lane >> 3), ch = lane & 7;
        const f32x4v a = *(const f32x4v*)(stg + row * 64 + ch * 8), c4 = *(const f32x4v*)(stg + row * 64 + ch * 8 + 4);
        float ss = (a[0] * a[0] + a[1] * a[1]) + (a[2] * a[2] + a[3] * a[3]) + (c4[0] * c4[0] + c4[1] * c4[1]) + (c4[2] * c4[2] + c4[3] * c4[3]);
        ss += __shfl_xor(ss, 1); ss += __shfl_xor(ss, 2); ss += __shfl_xor(ss, 4);
        const float rs = oscale / sqrtf(ss * (1.f / 64.f) + EPS);
        const f32x4v g0 = *(const f32x4v*)(subg + ch * 8), g1 = *(const f32x4v*)(subg + ch * 8 + 4);
        u32x4 w; w[0] = pk2(a[0] * rs * g0[0], a[1] * rs * g0[1]); w[1] = pk2(a[2] * rs * g0[2], a[3] * rs * g0[3]); w[2] = pk2(c4[0] * rs * g1[0], c4[1] * rs * g1[1]); w[3] = pk2(c4[2] * rs * g1[2], c4[3] * rs * g1[3]);
        *(u32x4*)(Y + (row0 + row) * D + 256 + h * 64 + ch * 8) = w; }
    asm volatile("s_waitcnt lgkmcnt(0)\n\ts_barrier" ::: "memory");
}
#undef SBAR
#undef PIN
#undef MFMA
#undef WAIT_BAR
#undef MX3
}
namespace rec {
using att::bf16x8; using att::s16x4; using att::f32x16; using att::f32x4v; using att::u32x4;
typedef __attribute__((address_space(3))) char* lptr;
typedef short v4i16_t __attribute__((ext_vector_type(4)));
constexpr int SEGL = 128, NSEG = SEQ / SEGL, NBLK = SEGL / 32, TSTR = 136;
constexpr int W_Q = 0, W_K = 32 * TSTR, W_V = 2 * 32 * TSTR, W_TAB = 3 * 32 * TSTR, W_BYTES = W_TAB + 512;
static_assert(W_BYTES * NWAVES <= RING_BYTES && W_TAB % 16 == 0, "rec LDS map");
constexpr int IMG_H = 4 * 16 * 64, IMG_M = 6 * 16 * 64;
#define RMFMA(a, b, c) __builtin_amdgcn_mfma_f32_32x32x16_bf16(a, b, c, 0, 0, 0)
#define LFENCE() asm volatile("s_waitcnt lgkmcnt(0)" ::: "memory")
__device__ __forceinline__ float fsig(float x) { return __builtin_amdgcn_rcpf(1.f + __builtin_amdgcn_exp2f(x * -1.44269504f)); }
constexpr float EMIN = 1.8048514e-35f;
__device__ __forceinline__ bf16x8 join(s16x4 a, s16x4 b) { return (bf16x8){a[0], a[1], a[2], a[3], b[0], b[1], b[2], b[3]}; }
__device__ __forceinline__ s16x4 vtr(lptr p) { return __builtin_bit_cast(s16x4, __builtin_amdgcn_ds_read_tr16_b64_v4i16((__attribute__((address_space(3))) v4i16_t*)p)); }
__device__ __forceinline__ bf16x8 rowfrag(lptr tile, int r32, int hi, int ks) {
    const lptr p = tile + r32 * TSTR + (16 * ks + 4 * hi) * 2;
    return join(*(const __attribute__((address_space(3))) s16x4*)p, *(const __attribute__((address_space(3))) s16x4*)(p + 16)); }
__device__ __forceinline__ bf16x8 trfrag(lptr tile, int lane, int ct, int ks) {
    const int hi = lane >> 5, i = lane & 15, gb = (lane >> 4) & 1;
    const lptr p = tile + (16 * ks + 4 * hi + (i >> 2)) * TSTR + (32 * ct + 16 * gb + 4 * (i & 3)) * 2;
    return join(vtr(p), vtr(p + 8 * TSTR)); }
__device__ __forceinline__ bf16x8 accfrag(const f32x16& x, int ks) {
    u32x4 w; w[0] = att::cvtpk_b(x[8 * ks], x[8 * ks + 1]); w[1] = att::cvtpk_b(x[8 * ks + 2], x[8 * ks + 3]); w[2] = att::cvtpk_b(x[8 * ks + 4], x[8 * ks + 5]); w[3] = att::cvtpk_b(x[8 * ks + 6], x[8 * ks + 7]);
    return __builtin_bit_cast(bf16x8, w); }

struct RecPtrs { const bf16* Z; const float* gates; bf16* Y; float* imgH; float* imgM; float* decH; float* decM;
                 const float* lbl; const float* ng; const float* convw; const float* ibias; const float* fbias; int layer; };

template <bool ML, bool FULL>
__device__ __forceinline__ void rec_unit(const RecPtrs& P, int bh, int seg, char* wlds) {
    constexpr int NVT = ML ? 3 : 2, NT = 2 * NVT;
    int lane_ = threadIdx.x & 63; asm volatile("" : "+v"(lane_));
    const int lane = lane_, r32 = lane & 31, hi = lane >> 5, h = bh & 3, b = bh >> 2;
    const lptr wl = (lptr)wlds; const lptr tq = wl + W_Q, tk = wl + W_K, tv = wl + W_V;
    __attribute__((address_space(3))) float* tab = (__attribute__((address_space(3))) float*)(wl + W_TAB);
    f32x16 S[NT];
    float* img = ML ? P.imgM + (size_t)(bh * NSEG + seg) * IMG_M : P.imgH + (size_t)(bh * NSEG + seg) * IMG_H;
    if (FULL) {
#pragma unroll
        for (int t = 0; t < NT; ++t)
#pragma unroll
            for (int g = 0; g < 16; ++g) S[t][g] = img[(t * 16 + g) * 64 + lane];
    } else {
#pragma unroll
        for (int t = 0; t < NT; ++t) S[t] = f32x16{};
    }
    float lb = 0.f, oml = 1.f, wq0 = 0.f, wq1 = 0.f, wq2 = 0.f, wq3 = 0.f, wk0 = 0.f, wk1 = 0.f, wk2 = 0.f, wk3 = 0.f, ib = 0.f, fb = 0.f;
    float q1 = 0.f, q2 = 0.f, q3 = 0.f, k1 = 0.f, k2 = 0.f, k3 = 0.f, dtot = 1.f;
    const int c = h * 64 + lane;
    const long rowS = (long)b * SEQ + seg * SEGL;
    if (!ML) {
        if (P.layer == 1) { const float a0 = P.lbl[c], a1 = P.lbl[256 + c]; const float mx = fmaxf(a0, a1); const float e0 = expf(a0 - mx), e1 = expf(a1 - mx); lb = e1 / (e0 + e1); }
        oml = 1.f - lb;
        if (FULL) tab[64 + lane] = P.ng[lane];
    } else {
        wk0 = P.convw[0 * 512 + 256 + c]; wk1 = P.convw[1 * 512 + 256 + c]; wk2 = P.convw[2 * 512 + 256 + c]; wk3 = P.convw[3 * 512 + 256 + c];
        if (FULL) { wq0 = P.convw[0 * 512 + c]; wq1 = P.convw[1 * 512 + c]; wq2 = P.convw[2 * 512 + c]; wq3 = P.convw[3 * 512 + c]; }
        ib = P.ibias[h]; fb = P.fbias[h];
        if (seg > 0) { const bf16* zp = P.Z + (rowS - 3) * ZP + c;
            k3 = bf2f(zp[ZC_MK]); k2 = bf2f(zp[ZP + ZC_MK]); k1 = bf2f(zp[2 * ZP + ZC_MK]);
            if (FULL) { q3 = bf2f(zp[ZC_MQ]); q2 = bf2f(zp[ZP + ZC_MQ]); q1 = bf2f(zp[2 * ZP + ZC_MQ]); } }
    }
    const bf16x8 ones = (r32 == 0) ? (bf16x8){0x3F80, 0x3F80, 0x3F80, 0x3F80, 0x3F80, 0x3F80, 0x3F80, 0x3F80} : (bf16x8){0, 0, 0, 0, 0, 0, 0, 0};
#define LOADV(VW, R0) do { _Pragma("unroll") for (int i_ = 0; i_ < 4; ++i_) VW[i_] = *(const u32x4*)(P.Z + ((R0) + (lane >> 3) + 8 * i_) * ZP + h * 64 + (lane & 7) * 8 + (ML ? ZC_MV : ZC_HI)); } while (0)
#define LOADG(GF, GI, R0) do { if (ML) { const float* gp_ = P.gates + (size_t)((R0) + (lane & 31)) * 12 + h; GF = gp_[8]; GI = gp_[4]; } } while (0)
#define RAWDMA(REGION, COL, R0) do { _Pragma("unroll") for (int j_ = 0; j_ < 4; ++j_) \
        __builtin_amdgcn_global_load_lds((const unsigned*)(P.Z + ((R0) + 8 * j_ + (lane >> 3)) * ZP + (COL) + h * 64 + (((lane & 7) ^ (lane >> 3)) * 8)), (__attribute__((address_space(3))) unsigned*)((REGION) + j_ * 1024), 16, 0, 0); } while (0)
#define WSTORE(TILE, W) do { _Pragma("unroll") for (int i_ = 0; i_ < 4; ++i_) { \
            __attribute__((address_space(3))) unsigned long long* dp_ = (__attribute__((address_space(3))) unsigned long long*)((TILE) + ((lane >> 3) + 8 * i_) * TSTR + (lane & 7) * 16); \
            dp_[0] = (unsigned long long)W[i_][0] | ((unsigned long long)W[i_][1] << 32); dp_[1] = (unsigned long long)W[i_][2] | ((unsigned long long)W[i_][3] << 32); } } while (0)
    const lptr rawK = tq, rawQ = tk;
    constexpr int COLK = ML ? ZC_MK : ZC_HF, COLQ = ML ? ZC_MQ : ZC_HQ;
    RAWDMA(rawK, COLK, rowS); if (FULL) RAWDMA(rawQ, COLQ, rowS);
    u32x4 vwN[4]; float glfN = 0.f, gliN = 0.f;
    if (!FULL) LOADV(vwN, rowS);
    LOADG(glfN, gliN, rowS);
    const int i16 = lane & 15, rr = i16 >> 2, pc = 2 * (lane >> 4) + ((i16 & 3) >> 1);
    const int troffE = rr * 128 + ((pc ^ rr) << 4) + (i16 & 1) * 8, troffO = rr * 128 + ((pc ^ (4 + rr)) << 4) + (i16 & 1) * 8;
    for (int blk = 0; blk < NBLK; ++blk) {
        const long row0 = rowS + blk * 32;
        u32x4 vw[4]; const float glf = glfN, gli = gliN;
        asm volatile("s_waitcnt vmcnt(0)" ::: "memory");
        if (FULL) LOADV(vw, row0);
        else {
#pragma unroll
            for (int i = 0; i < 4; ++i) vw[i] = vwN[i];
        }
        s16x4 ra4[8], rb4[8];
#pragma unroll
        for (int pb = 0; pb < 8; ++pb) { ra4[pb] = vtr(rawK + pb * 512 + ((pb & 1) ? troffO : troffE)); if (FULL) rb4[pb] = vtr(rawQ + pb * 512 + ((pb & 1) ? troffO : troffE)); }
        LFENCE();
        if (!FULL) { if (blk + 1 < NBLK) { RAWDMA(rawK, COLK, row0 + 32); LOADV(vwN, row0 + 32); LOADG(glfN, gliN, row0 + 32); }
            WSTORE(tv, vw); }
        float dec;
        if (!ML) {
            float E = 1.f;
#pragma unroll
            for (int t2 = 0; t2 < 16; ++t2) {
                float kq[2], qq[2];
#pragma unroll
                for (int u = 0; u < 2; ++u) { const int t = 2 * t2 + u;
                    const float f = lb + oml * fsig(bf2f((bf16)ra4[t >> 2][t & 3]));
                    E *= f; const float e = fmaxf(E, EMIN);
                    kq[u] = (1.f - f) * __builtin_amdgcn_rcpf(e);
                    if (FULL) qq[u] = bf2f((bf16)rb4[t >> 2][t & 3]) * e; }
                const unsigned wkk = att::cvtpk(kq[0], kq[1]);
                *(__attribute__((address_space(3))) bf16*)(tk + (2 * t2) * TSTR + lane * 2) = (bf16)(wkk & 0xffffu); *(__attribute__((address_space(3))) bf16*)(tk + (2 * t2 + 1) * TSTR + lane * 2) = (bf16)(wkk >> 16);
                if (FULL) { const unsigned wqq = att::cvtpk(qq[0], qq[1]);
                    *(__attribute__((address_space(3))) bf16*)(tq + (2 * t2) * TSTR + lane * 2) = (bf16)(wqq & 0xffffu); *(__attribute__((address_space(3))) bf16*)(tq + (2 * t2 + 1) * TSTR + lane * 2) = (bf16)(wqq >> 16); }
            }
            dec = fmaxf(E, EMIN);
            tab[lane] = dec;
        } else {
            float F = fsig(glf + fb);
            { float t_;
              t_ = __builtin_bit_cast(float, __builtin_amdgcn_update_dpp(0x3f800000, __builtin_bit_cast(int, F), 0x111, 0xf, 0xf, false)); F *= t_;
              t_ = __builtin_bit_cast(float, __builtin_amdgcn_update_dpp(0x3f800000, __builtin_bit_cast(int, F), 0x112, 0xf, 0xf, false)); F *= t_;
              t_ = __builtin_bit_cast(float, __builtin_amdgcn_update_dpp(0x3f800000, __builtin_bit_cast(int, F), 0x114, 0xf, 0xf, false)); F *= t_;
              t_ = __builtin_bit_cast(float, __builtin_amdgcn_update_dpp(0x3f800000, __builtin_bit_cast(int, F), 0x118, 0xf, 0xf, false)); F *= t_;
              const float r0 = __builtin_bit_cast(float, __builtin_amdgcn_readlane(__builtin_bit_cast(int, F), 15)); if (lane & 16) F *= r0; }
            const int ekb = __builtin_bit_cast(int, __builtin_amdgcn_exp2f((gli + ib) * LOG2E) * __builtin_amdgcn_rcpf(F)), eqb = __builtin_bit_cast(int, F * 0.125f);
            dec = fmaxf(__builtin_bit_cast(float, __builtin_amdgcn_readlane(__builtin_bit_cast(int, F), 31)), EMIN);
#pragma unroll
            for (int t2 = 0; t2 < 16; ++t2) {
                float kq[2], qq[2];
#pragma unroll
                for (int u = 0; u < 2; ++u) { const int t = 2 * t2 + u;
                    const float k0 = bf2f((bf16)ra4[t >> 2][t & 3]); float kc = wk3 * k0 + wk2 * k1 + wk1 * k2 + wk0 * k3; k3 = k2; k2 = k1; k1 = k0;
                    kq[u] = kc * fsig(kc) * __builtin_bit_cast(float, __builtin_amdgcn_readlane(ekb, t));
                    if (FULL) { const float q0 = bf2f((bf16)rb4[t >> 2][t & 3]); float qc = wq3 * q0 + wq2 * q1 + wq1 * q2 + wq0 * q3; q3 = q2; q2 = q1; q1 = q0;
                        qq[u] = qc * fsig(qc) * __builtin_bit_cast(float, __builtin_amdgcn_readlane(eqb, t)); } }
                const unsigned wkk = att::cvtpk(kq[0], kq[1]);
                *(__attribute__((address_space(3))) bf16*)(tk + (2 * t2) * TSTR + lane * 2) = (bf16)(wkk & 0xffffu); *(__attribute__((address_space(3))) bf16*)(tk + (2 * t2 + 1) * TSTR + lane * 2) = (bf16)(wkk >> 16);
                if (FULL) { const unsigned wqq = att::cvtpk(qq[0], qq[1]);
                    *(__attribute__((address_space(3))) bf16*)(tq + (2 * t2) * TSTR + lane * 2) = (bf16)(wqq & 0xffffu); *(__attribute__((address_space(3))) bf16*)(tq + (2 * t2 + 1) * TSTR + lane * 2) = (bf16)(wqq >> 16); }
            }
        }
        dtot *= dec;
        if (FULL) WSTORE(tv, vw);
        LFENCE();
        bf16x8 vf[NVT][2];
#pragma unroll
        for (int vt = 0; vt < 2; ++vt)
#pragma unroll
            for (int ks = 0; ks < 2; ++ks) vf[vt][ks] = trfrag(tv, lane, vt, ks);
        if (ML) { vf[NVT - 1][0] = ones; vf[NVT - 1][1] = ones; }
        if (FULL) {
            bf16x8 qf[4], kf[4];
#pragma unroll
            for (int ks = 0; ks < 4; ++ks) { qf[ks] = rowfrag(tq, r32, hi, ks); kf[ks] = rowfrag(tk, r32, hi, ks); }
            LFENCE();
            RAWDMA(tv, (ML ? ZC_MO : ZC_HG), row0);
            if (blk + 1 < NBLK) { RAWDMA(rawK, COLK, row0 + 32); LOADG(glfN, gliN, row0 + 32); }
            f32x16 x1 = f32x16{};
#pragma unroll
            for (int ks = 0; ks < 4; ++ks) x1 = RMFMA(kf[ks], qf[ks], x1);
#pragma unroll
            for (int g = 0; g < 16; ++g) if (att::crow(g, hi) > r32) x1[g] = 0.f;
            const bf16x8 xb0 = accfrag(x1, 0), xb1 = accfrag(x1, 1);
            f32x16 ot[NVT];
#pragma unroll
            for (int vt = 0; vt < NVT; ++vt) {
                ot[vt] = RMFMA(vf[vt][0], xb0, f32x16{}); ot[vt] = RMFMA(vf[vt][1], xb1, ot[vt]);
#pragma unroll
                for (int dt = 0; dt < 2; ++dt)
#pragma unroll
                    for (int ks = 0; ks < 2; ++ks) ot[vt] = RMFMA(accfrag(S[dt * NVT + vt], ks), qf[2 * dt + ks], ot[vt]);
            }
            asm volatile("s_waitcnt vmcnt(0)" ::: "memory");
            const lptr gy = tv + r32 * 128 + 8 * hi; const int gx = r32 & 7;
            float osc;
            if (!ML) {
                float ss = 0.f;
#pragma unroll
                for (int vt = 0; vt < 2; ++vt)
#pragma unroll
                    for (int g = 0; g < 16; ++g) ss += ot[vt][g] * ot[vt][g];
                { auto rr = __builtin_amdgcn_permlane32_swap(__float_as_uint(ss), __float_as_uint(ss), false, false); ss = __uint_as_float(rr[0]) + __uint_as_float(rr[1]); }
                osc = __builtin_amdgcn_rsqf(ss * (1.f / 64.f) + EPS);
            } else { const float den = __shfl(ot[NVT - 1][0], r32); osc = 1.f / fmaxf(fabsf(den), 1.f); }
#pragma unroll
            for (int vt = 0; vt < 2; ++vt)
#pragma unroll
                for (int g4 = 0; g4 < 4; ++g4) { const int v0 = 32 * vt + 8 * g4 + 4 * hi;
                    __attribute__((address_space(3))) unsigned long long* gp_ = (__attribute__((address_space(3))) unsigned long long*)(gy + (((4 * vt + g4) ^ gx) << 4));
                    const unsigned long long gw = *gp_;
                    float o4[4];
                    if (!ML) { const f32x4v gn = *(const __attribute__((address_space(3))) f32x4v*)(tab + 64 + v0);
#pragma unroll
                        for (int e = 0; e < 4; ++e) { const float gv = __uint_as_float((unsigned)((gw >> (16 * e)) & 0xffffu) << 16); o4[e] = ot[vt][4 * g4 + e] * osc * gn[e] * gv * fsig(gv); }
                    } else {
#pragma unroll
                        for (int e = 0; e < 4; ++e) { const float gv = __uint_as_float((unsigned)((gw >> (16 * e)) & 0xffffu) << 16); o4[e] = ot[vt][4 * g4 + e] * osc * fsig(gv); } }
                    *gp_ = (unsigned long long)att::cvtpk(o4[0], o4[1]) | ((unsigned long long)att::cvtpk(o4[2], o4[3]) << 32); }
            LFENCE();
#pragma unroll
            for (int j = 0; j < 4; ++j) { const int row = 8 * j + (lane >> 3), ch = lane & 7;
                const u32x4 yv = *(const __attribute__((address_space(3))) u32x4*)(tv + row * 128 + ((ch ^ (row & 7)) << 4));
                *(u32x4*)(P.Y + (row0 + row) * D + (ML ? 768 : 0) + h * 64 + ch * 8) = yv; }
        }
        {
            bf16x8 ktf[2][2];
#pragma unroll
            for (int dt = 0; dt < 2; ++dt)
#pragma unroll
                for (int ks = 0; ks < 2; ++ks) ktf[dt][ks] = trfrag(tk, lane, dt, ks);
            if (FULL) { LFENCE(); if (blk + 1 < NBLK) RAWDMA(rawQ, COLQ, row0 + 32); }
#pragma unroll
            for (int dt = 0; dt < 2; ++dt) {
                f32x4v dv[4];
                if (!ML) {
#pragma unroll
                    for (int g4 = 0; g4 < 4; ++g4) dv[g4] = *(const __attribute__((address_space(3))) f32x4v*)(tab + 32 * dt + 8 * g4 + 4 * hi);
                }
#pragma unroll
                for (int vt = 0; vt < NVT; ++vt) { f32x16 s = S[dt * NVT + vt];
                    s = RMFMA(ktf[dt][0], vf[vt][0], s); s = RMFMA(ktf[dt][1], vf[vt][1], s);
#pragma unroll
                    for (int g = 0; g < 16; ++g) s[g] *= ML ? dec : dv[g >> 2][g & 3];
                    S[dt * NVT + vt] = s; }
            }
        }
        LFENCE();
    }
    if (!FULL) {
#pragma unroll
        for (int t = 0; t < NT; ++t)
#pragma unroll
            for (int g = 0; g < 16; ++g) img[(t * 16 + g) * 64 + lane] = S[t][g];
        if (!ML) P.decH[(size_t)(bh * NSEG + seg) * 64 + lane] = dtot;
        else if (lane == 0) P.decM[bh * NSEG + seg] = dtot;
    }
}

__device__ __forceinline__ void scan_items(const RecPtrs& P, int item0, int nitem_stride) {
    int tid_ = threadIdx.x; asm volatile("" : "+v"(tid_)); const int tid = tid_;
    constexpr int ITEMS_H = BATCH * NH * (IMG_H / 512), ITEMS_M = BATCH * NH * (IMG_M / 512), NIT = ITEMS_H + ITEMS_M;
    for (int it0 = item0; it0 < NIT; it0 += 2 * nitem_stride) {
        const bool two = it0 + nitem_stride < NIT;
        float* basev[2]; const float* dpv[2]; int iszv[2], dstrv[2];
#pragma unroll
        for (int q = 0; q < 2; ++q) { const int it = (q == 1 && two) ? it0 + nitem_stride : it0;
            const bool ml = it >= ITEMS_H; const int r = ml ? it - ITEMS_H : it; const int per = ml ? IMG_M / 512 : IMG_H / 512;
            const int bh = r / per, e = (r % per) * 512 + tid; const int isz = ml ? IMG_M : IMG_H;
            basev[q] = (ml ? P.imgM : P.imgH) + (size_t)bh * NSEG * isz + e; iszv[q] = isz;
            const int tile = e >> 10, g = (e >> 6) & 15, ln = e & 63; const int dt = ml ? tile / 3 : tile >> 1; const int d = 32 * dt + att::crow(g, ln >> 5);
            dpv[q] = ml ? P.decM + bh * NSEG : P.decH + (size_t)bh * NSEG * 64 + d; dstrv[q] = ml ? 1 : 64; }
        float u0[NSEG], p0[NSEG], u1[NSEG], p1[NSEG];
#pragma unroll
        for (int j = 0; j < NSEG; ++j) { u0[j] = basev[0][(size_t)j * iszv[0]]; p0[j] = dpv[0][j * dstrv[0]]; }
        if (two) {
#pragma unroll
            for (int j = 0; j < NSEG; ++j) { u1[j] = basev[1][(size_t)j * iszv[1]]; p1[j] = dpv[1][j * dstrv[1]]; } }
        { float s = 0.f;
#pragma unroll
          for (int j = 0; j < NSEG; ++j) { basev[0][(size_t)j * iszv[0]] = s; s = p0[j] * s + u0[j]; } }
        if (two) { float s = 0.f;
#pragma unroll
          for (int j = 0; j < NSEG; ++j) { basev[1][(size_t)j * iszv[1]] = s; s = p1[j] * s + u1[j]; } }
    }
}
#undef LOADV
#undef LOADG
#undef RAWDMA
#undef WSTORE
#undef RMFMA
#undef LFENCE
}
__global__ void __launch_bounds__(NWAVES * 64, 2) mk_fwd(Args args) {
    extern __shared__ __attribute__((aligned(16))) unsigned char lds[];
    Frame F;
    F.lds = (LAS unsigned char*)lds; F.MISC = (volatile LAS unsigned*)(F.lds + MISC_OFF);
    F.tid = threadIdx.x; F.lane = F.tid & 63; F.wave = __builtin_amdgcn_readfirstlane(F.tid >> 6);
    F.G = gridDim.x; { const int bx = blockIdx.x; F.vcu = (F.G % 8 == 0) ? (bx % 8) * (F.G / 8) + bx / 8 : bx; }
    unsigned char* ws = args.ws;
    F.ctl = (gu32*)(ws + WS_CTL);
    for (int u = F.tid; u < (LDS_BYTES - LDSCTL_OFF) / 4; u += NWAVES * 64) ((LAS unsigned*)(F.lds + LDSCTL_OFF))[u] = 0u;
    __syncthreads();
    XcdBarrier bar = xcd_barrier_post((unsigned*)(F.ctl + CW_BAR) + args.li * XCD_BAR_WORDS, F.MISC + 8);
    const int lo = args.ph_lo, hi = args.ph_hi;
#ifdef PROBE_GROUP
    unsigned long long t_prev = __builtin_amdgcn_s_memrealtime(); unsigned long long t_acc = 0ull;
#define STAMP(grp) do { const unsigned long long t_now = __builtin_amdgcn_s_memrealtime(); if ((grp) == PROBE_GROUP) t_acc += t_now - t_prev; t_prev = t_now; } while (0)
#else
#define STAMP(grp) do {} while (0)
#endif
#define IN(k) (lo <= (k) && (k) < hi)
#define SEAM(k) do { if (IN(k) && IN((k) + 1)) xcd_barrier(bar); } while (0)
    float* mod = (float*)(ws + WS_MOD); float* wgw = (float*)(ws + WS_WG); float* gates = (float*)(ws + WS_GATES);
    bf16* HN = (bf16*)(ws + WS_HN); bf16* Z = (bf16*)(ws + WS_Z); bf16* Y = (bf16*)(ws + WS_Y); bf16* HB = (bf16*)(ws + WS_H); bf16* XB = (bf16*)(ws + WS_XB);
    if (IN(PH_PRO)) { p0_prologue(F, args); }
    SEAM(PH_PRO); STAMP(5);
    for (int l = 0; l < DEPTH; ++l) {
        const int pb = 1 + PH_PER_LAYER * l;
        const float* modl = mod + (size_t)l * 8 * NMOD;
        const float* xin = (l == 0) ? args.in[0] : args.out;
        if (IN(pb + PL_NORM1) && l == 0) {
            bias_all(F, (const bf16*)(ws + WS_WIN), (const bf16*)(ws + WS_W1), mod, (float*)(ws + WS_BIAS1), (float*)(ws + WS_BIAS2)); STAMP(8);
            prenorm0_phase(F, xin, (const float*)(ws + WS_GM1), HN, (float*)(ws + WS_SS1));
        }
        if (l == 0) { SEAM(pb + PL_NORM1); } STAMP(4);
        if (IN(pb + PL_INPROJ)) {
            pg8::Gemm g{HN, (const bf16*)(ws + WS_WIN) + (size_t)l * 4096 * 1024, T, 4096, D}; pg8::StaticOrder S; S.init(T, 4096, F.G, (int)blockIdx.x);
            pg8::EpiInProj E{Z, ZP, (const float*)(ws + WS_QKG) + l * 256, (LAS unsigned char*)(F.lds + XCH_OFF), (const float*)(ws + WS_SS1), (const float*)(ws + WS_BIAS1) + (size_t)l * 8 * 4096, gates, (float*)(ws + WS_FGT)};
            pg8::gemm_phase<pg8::EpiInProj, pg8::StaticOrder, true, true>(F.lds + RING_OFF, g, S, E);
        }
        SEAM(pb + PL_INPROJ); STAMP(11);
        rec::RecPtrs RP{Z, gates, Y, (float*)(ws + WS_IMGH), (float*)(ws + WS_IMGM), (float*)(ws + WS_DECH), (float*)(ws + WS_DECM),
                        args.in[8], args.in[9] + l * HD, args.in[17] + (size_t)l * 4 * 512, args.in[18] + l * NH, args.in[19] + l * NH, l};
        char* al = (char*)lds + RING_OFF; float* tbl = (float*)(al + att::LDS_TBL);
        if (IN(pb + PL_MIXA)) {
            for (int bh = blockIdx.x; bh < BATCH * NH; bh += F.G) fox_scan_block((const float*)(ws + WS_FGT), args.in[16] + l * NH, (float*)(ws + WS_FCUM), (int*)(ws + WS_KST), ((const float*)(ws + WS_SMAX))[l * 2], bh, F.lds);
            for (int w = F.vcu * NWAVES + F.wave; w < 2048; w += F.G * NWAVES) { const int rem = w >> 1;
                if ((((w & 1) ^ (F.wave >> 2)) & 1) == 0) rec::rec_unit<false, false>(RP, rem >> 5, rem & 31, al + F.wave * rec::W_BYTES);
                else rec::rec_unit<true, false>(RP, rem >> 5, rem & 31, al + F.wave * rec::W_BYTES); }
        }
        SEAM(pb + PL_MIXA); STAMP(3);
        if (IN(pb + PL_MIXB)) {
            const bool sched_blk = (F.G == 256) && ((F.vcu & 31) == 0);
            if (!sched_blk) { if (F.G == 256) rec::scan_items(RP, F.vcu - (F.vcu >> 5) - 1, 248); else rec::scan_items(RP, (int)blockIdx.x, F.G); }
            for (int vc = F.vcu; vc < 256; vc += F.G) if ((vc & 31) == 0) {
                int mt_ = threadIdx.x; asm volatile("" : "+v"(mt_));
                const int x = vc >> 5; const int* kstF = (const int*)(ws + WS_KST); const float smax_d = ((const float*)(ws + WS_SMAX))[l * 2 + 1];
                LAS int* cst = (LAS int*)(F.lds);
                __syncthreads();
                if (mt_ < 128) { const int v = mt_, ty = v >> 6, hh = (v >> 4) & 3, qb = v & 15, nt = 4 * qb + 4; int ks, c;
                    if (ty == 0) { ks = kstF[(4 * x + hh) * 16 + qb]; c = (nt - ks + 4) * 100; }
                    else { const float slope2 = exp2f(-2.0f * (float)(hh + 1)) * LOG2E; const float jf = ((float)(256 * qb) - (152.0f + 2.0f * smax_d) / slope2 - 63.0f) * (1.0f / 64.0f);
                        ks = jf > 0.f ? (int)jf : 0; ks = ks < nt - 4 ? ks : nt - 4; ks &= ~1; c = (nt - ks + 4) * 215; }
                    cst[v] = c; cst[128 + v] = ks; }
                cst[512 + mt_] = -1; cst[512 + 512 + mt_] = -1;
                __syncthreads();
                if (mt_ < 128) { const int c = cst[mt_]; int rank = 0;
                    for (int v4 = 0; v4 < 32; ++v4) { const v4u cc = *(const LAS v4u*)(cst + 4 * v4);
                        rank += ((int)cc.x > c || ((int)cc.x == c && 4 * v4 + 0 < mt_)) + ((int)cc.y > c || ((int)cc.y == c && 4 * v4 + 1 < mt_)) + ((int)cc.z > c || ((int)cc.z == c && 4 * v4 + 2 < mt_)) + ((int)cc.w > c || ((int)cc.w == c && 4 * v4 + 3 < mt_)); }
                    cst[256 + rank] = mt_; }
                __syncthreads();
                if (F.wave == 0) {
                    const int ln = mt_ & 63; int load = 0, own_lo = 0, own_hi = 0;
                    const int c_lo = cst[cst[256 + ln]], c_hi = cst[cst[256 + 64 + ln]];
                    for (int r = 0; r < 128; ++r) {
                        const int c = (r < 64) ? __builtin_amdgcn_readlane(c_lo, r & 63) : __builtin_amdgcn_readlane(c_hi, r & 63);
                        int m = (ln < 32) ? ((load << 5) | ln) : 0x7fffffff;
                        { int t2;
                          t2 = __builtin_amdgcn_update_dpp(0x7fffffff, m, 0x111, 0xf, 0xf, false); m = t2 < m ? t2 : m;
                          t2 = __builtin_amdgcn_update_dpp(0x7fffffff, m, 0x112, 0xf, 0xf, false); m = t2 < m ? t2 : m;
                          t2 = __builtin_amdgcn_update_dpp(0x7fffffff, m, 0x114, 0xf, 0xf, false); m = t2 < m ? t2 : m;
                          t2 = __builtin_amdgcn_update_dpp(0x7fffffff, m, 0x118, 0xf, 0xf, false); m = t2 < m ? t2 : m; }
                        const int m0 = __builtin_amdgcn_readlane(m, 15), m1 = __builtin_amdgcn_readlane(m, 31); const int o = (m0 < m1 ? m0 : m1) & 31;
                        load += (ln == o) ? c : 0;
                        if (r < 64) own_lo = (ln == r) ? o : own_lo; else own_hi = (ln == (r - 64)) ? o : own_hi; }
                    cst[384 + ln] = own_lo; cst[384 + 64 + ln] = own_hi;
                }
                __syncthreads();
                if (mt_ < 128) { const int o = cst[384 + mt_]; int pos = 0;
                    for (int r4 = 0; r4 < 32; ++r4) { const v4u oo = *(const LAS v4u*)(cst + 384 + 4 * r4);
                        pos += ((int)oo.x == o && 4 * r4 + 0 < mt_) + ((int)oo.y == o && 4 * r4 + 1 < mt_) + ((int)oo.z == o && 4 * r4 + 2 < mt_) + ((int)oo.w == o && 4 * r4 + 3 < mt_); }
                    const int v = cst[256 + mt_]; if (pos < 32) cst[512 + o * 32 + pos] = v | (cst[128 + v] << 8); }
                __syncthreads();
                int* gl = (int*)(ws + WS_SCHED) + x * 1024;
                for (int i = mt_; i < 1024; i += NWAVES * 64) gl[i] = cst[512 + i];
                __syncthreads();
            }
        }
        SEAM(pb + PL_MIXB); STAMP(6);
        if (IN(pb + PL_MIXC)) {
            for (int w = F.vcu * NWAVES + F.wave; w < 2048; w += F.G * NWAVES) { const int rem = w >> 1;
                if ((((w & 1) ^ (F.wave >> 2)) & 1) == 0) rec::rec_unit<false, true>(RP, rem >> 5, rem & 31, al + F.wave * rec::W_BYTES);
                else rec::rec_unit<true, true>(RP, rem >> 5, rem & 31, al + F.wave * rec::W_BYTES); }
            __syncthreads(); STAMP(7);
            int mt_ = threadIdx.x; asm volatile("" : "+v"(mt_));
            const float* Fc = (const float*)(ws + WS_FCUM); const int* kstF = (const int*)(ws + WS_KST);
            const float smax_d = ((const float*)(ws + WS_SMAX))[l * 2 + 1];
            const float lam_init = 0.8f - 0.6f * expf(-0.3f * (float)l);
            float lam; { const float* lv = args.in[12] + l * 128; float d01 = 0.f, d23 = 0.f; for (int i = 0; i < 32; ++i) { d01 += lv[i] * lv[32 + i]; d23 += lv[64 + i] * lv[96 + i]; } lam = expf(d01) - expf(d23) + lam_init; }
            LAS int* cst = (LAS int*)(F.lds + 134144);
            static_assert(att::LDS_END <= 134144 && 134144 + (384 + 1024) * 4 <= LDSCTL_OFF, "unit table placement");
            for (int vc = F.vcu; vc < 256; vc += F.G) {
                const int x = vc >> 5, j = vc & 31; const int* myl = (const int*)(ws + WS_SCHED) + (x * 32 + j) * 32;
                for (int k2 = 0; k2 < 64; ++k2) {
                    const int e = myl[k2 & 31]; if (e < 0) continue;
                    const int v = e & 255, ks = e >> 8; if ((v >> 6) != (k2 >> 5)) continue;
                    const int ty = v >> 6, h = (v >> 4) & 3, qb = v & 15, b = x, bh = 4 * x + h;
                    if (ty == 0) {
                        for (int i = ks * 64 + mt_; i < 256 * qb + 256; i += NWAVES * 64) tbl[i] = -Fc[(size_t)bh * SEQ + i] * LOG2E;
                        att::fox_unit(b, h, qb, ks, Z, Y, al);
                    } else {
                        const float slope2 = exp2f(-2.0f * (float)(h + 1)) * LOG2E;
                        for (int i = ks * 64 + mt_; i < 256 * qb + 256; i += NWAVES * 64) tbl[i] = slope2 * (float)i;
                        att::diff_unit(b, h, qb, ks, Z, Y, lam, 1.f - lam_init, args.in[13] + l * HD, al);
                    }
                }
            }
        }
        SEAM(pb + PL_MIXC); STAMP(2);
        if (IN(pb + PL_OUTPROJ)) {
            pg8::Gemm g{Y, (const bf16*)(ws + WS_WOUT) + (size_t)l * 1024 * 1024, T, D, D}; pg8::StaticOrder S; S.init(T, D, F.G, (int)blockIdx.x);
            if (l == 0) { pg8::EpiResGateN<false, true> E{args.in[0], XB, modl + 2 * D, (const float*)(ws + WS_GM2) + (size_t)l * 8 * D, HN, (float*)(ws + WS_SSQ), (LAS float*)(F.lds + XCH_OFF), (LAS unsigned char*)(F.lds + XCH_OFF + 4096)};
                pg8::gemm_phase<pg8::EpiResGateN<false, true>, pg8::StaticOrder, true, true>(F.lds + RING_OFF, g, S, E); }
            else { pg8::EpiResGateN<true, true> E{XB, XB, modl + 2 * D, (const float*)(ws + WS_GM2) + (size_t)l * 8 * D, HN, (float*)(ws + WS_SSQ), (LAS float*)(F.lds + XCH_OFF), (LAS unsigned char*)(F.lds + XCH_OFF + 4096)};
                pg8::gemm_phase<pg8::EpiResGateN<true, true>, pg8::StaticOrder, true, true>(F.lds + RING_OFF, g, S, E); }
        }
        SEAM(pb + PL_OUTPROJ); STAMP(12);
        if (IN(pb + PL_FF1)) {
            pg8::Gemm g{HN, (const bf16*)(ws + WS_W1) + (size_t)l * 4096 * 1024, T, FF, D}; pg8::StaticOrder S; S.init(T, FF, F.G, (int)blockIdx.x);
            pg8::EpiFF1 E{HB, FF, (const float*)(ws + WS_SSQ), (const float*)(ws + WS_BIAS2) + (size_t)l * 8 * FF, (LAS unsigned char*)(F.lds + XCH_OFF)};
            pg8::gemm_phase<pg8::EpiFF1, pg8::StaticOrder, true, true>(F.lds + RING_OFF, g, S, E);
        }
        SEAM(pb + PL_FF1); STAMP(13);
        if (IN(pb + PL_FF2)) {
            pg8::Gemm g{HB, (const bf16*)(ws + WS_W2) + (size_t)l * 1024 * 4096, T, D, FF}; pg8::StaticOrder S; S.init(T, D, F.G, (int)blockIdx.x);
            if (l + 1 < DEPTH) { pg8::EpiResGateN<true, true> E{XB, XB, modl + 5 * D, (const float*)(ws + WS_GM1) + (size_t)(l + 1) * 8 * D, HN, (float*)(ws + WS_SS1), (LAS float*)(F.lds + XCH_OFF), (LAS unsigned char*)(F.lds + XCH_OFF + 4096)};
                pg8::gemm_phase<pg8::EpiResGateN<true, true>, pg8::StaticOrder, true, true>(F.lds + RING_OFF, g, S, E); }
            else { pg8::EpiResGate<true, false> E{XB, args.out, modl + 5 * D};
                pg8::gemm_phase<pg8::EpiResGate<true, false>, pg8::StaticOrder, true, true>(F.lds + RING_OFF, g, S, E); }
        }
        SEAM(pb + PL_FF2); STAMP(14);
    }
#ifdef PROBE_GROUP
    if (blockIdx.x == 0) { const unsigned long long t_end = __builtin_amdgcn_s_memrealtime() + 4ull * t_acc; while (__builtin_amdgcn_s_memrealtime() < t_end) __builtin_amdgcn_s_sleep(8); }
#endif
#undef IN
#undef SEAM
}

extern "C" void kernel_launch(void* const* d_in, const int* in_sizes, int n_in, void* d_out, int out_size, void* d_ws, size_t ws_size, hipStream_t stream) {
    static int grid = 0;
    if (grid == 0) {
        if (n_in != 22 || in_sizes[0] != T * D || out_size != T * D || ws_size < WS_END) { fprintf(stderr, "kernel_launch: unexpected shapes (n_in %d, in0 %d, out %d, ws %zu)\n", n_in, n_in > 0 ? in_sizes[0] : -1, out_size, ws_size); grid = -1; return; }
        int dev = 0, cus = 0;
        if (hipGetDevice(&dev) != hipSuccess || hipDeviceGetAttribute(&cus, hipDeviceAttributeMultiprocessorCount, dev) != hipSuccess) { grid = -1; return; }
        if (hipFuncSetAttribute((const void*)mk_fwd, hipFuncAttributeMaxDynamicSharedMemorySize, LDS_BYTES) != hipSuccess) { fprintf(stderr, "kernel_launch: hipFuncSetAttribute failed\n"); grid = -1; return; }
        (void)hipGetLastError();
        grid = cus;
    }
    if (grid < 0) return;
    (void)hipMemsetAsync((char*)d_ws + WS_CTL, 0, CTL_ZERO_BYTES, stream);
    Args a{};
    for (int i = 0; i < 22; ++i) a.in[i] = (const float*)d_in[i];
    a.out = (float*)d_out; a.ws = (unsigned char*)d_ws;
    a.ph_lo = 0; a.ph_hi = NPH; a.li = 0;
    hipLaunchKernelGGL(mk_fwd, dim3(grid), dim3(NWAVES * 64), LDS_BYTES, stream, a);
}
```

```cpp
#include <hip/hip_runtime.h>
#include <cstdio>
#include <cstdint>
#include <cmath>
#define ATTN_IN_MK 1
#define NEWPREP_H 1
#define NEWPREP_M 1
namespace pg8 {
#define PG8_LAS __attribute__((address_space(3)))
typedef unsigned short bf16_t;
typedef short bf16x8 __attribute__((ext_vector_type(8)));
typedef float f32x4 __attribute__((ext_vector_type(4)));
typedef unsigned u32x4 __attribute__((ext_vector_type(4)));
constexpr int BM = 256, BK = 64, HALF = 128, HTB = HALF * BK * 2  , STAGE_BYTES = 8 * HTB, NXCD = 8, WGM = 8;

__host__ __device__ __forceinline__ int lds_byte(int r, int c) { const int st = (r >> 4) * 2 + (c >> 5), rr = r & 15, cc = c & 31, ob = rr * 64 + cc * 2; return st * 1024 + (ob ^ (((ob >> 9) & 1) << 5)); }
__host__ __device__ __forceinline__ void stage_rc(int b, int& R, int& C) { const int st = b / 1024, sb = b % 1024, swz = sb ^ (((sb >> 9) & 1) << 5); R = (st >> 1) * 16 + swz / 64; C = (st & 1) * 32 + (swz % 64) / 2; }
__host__ __device__ __forceinline__ int perm32(int rho) { const int n = rho >> 4, i = rho & 15; return 8 * (i >> 2) + 4 * n + (i & 3); }

struct Unit { int pm, pn; };
struct Gemm { const bf16_t* A; const bf16_t* Bt; int M, N, K; };

struct StaticOrder {
    int nM, nN, nwg, G, c;
    __host__ __device__ void init(int M, int N, int G_, int c_) { nM = M / BM; nN = N / BM; nwg = nM * nN; G = G_; c = c_; }
    __host__ __device__ bool next(int i, Unit& u) const {
        const long L = (long)i * G + c; if (L >= nwg) return false;
        int wgid = (int)L; { const int q = nwg / NXCD, r = nwg % NXCD, xcd = wgid % NXCD, off = wgid / NXCD; wgid = (xcd < r ? xcd * (q + 1) : r * (q + 1) + (xcd - r) * q) + off; }
        const int nig = WGM * nN, gid = wgid / nig, fm = gid * WGM, gsz = (nM - fm) < WGM ? (nM - fm) : WGM;
        u.pm = fm + ((wgid % nig) % gsz); u.pn = (wgid % nig) / gsz; return true;
    }
    __device__ __forceinline__ void a_ready(const Unit&) const {}
    __device__ __forceinline__ void done(const Unit&) const {}
};

typedef __bf16 cv_bf16x2 __attribute__((ext_vector_type(2))); typedef float cv_f32x2 __attribute__((ext_vector_type(2)));
__device__ __forceinline__ unsigned cvt_pk_bf16(float lo, float hi) { unsigned r; asm volatile("v_cvt_pk_bf16_f32 %0, %1, %2" : "=v"(r) : "v"(lo), "v"(hi)); return r; }
template <int ACT> struct EpiBf16 {
    static constexpr bool PERM = true, SWZ = false, AFTER_DRAIN = false;
    bf16_t* O; int ldc;
    __device__ __forceinline__ void operator()(const f32x4 (&acc)[2][2][4][2], const Unit& u, int wr, int wc, int fr, int fq) const {
        const int row0 = u.pm * BM + wr * 64 + fr; const int col0 = u.pn * BM + wc * 32 + 8 * fq;
#pragma unroll
        for (int ai = 0; ai < 2; ++ai)
#pragma unroll
            for (int m = 0; m < 4; ++m) { bf16_t* rowp = O + (size_t)(row0 + ai * HALF + m * 16) * ldc + col0;
#pragma unroll
                for (int bj = 0; bj < 2; ++bj) { f32x4 v0 = acc[ai][bj][m][0], v1 = acc[ai][bj][m][1];
                    if (ACT == 2) {
#pragma unroll
                        for (int e = 0; e < 4; ++e) { const float a = fmaxf(v0[e], 0.f), b = fmaxf(v1[e], 0.f); v0[e] = a * a; v1[e] = b * b; } }
                    u32x4 w; w.x = cvt_pk_bf16(v0[0], v0[1]); w.y = cvt_pk_bf16(v0[2], v0[3]); w.z = cvt_pk_bf16(v1[0], v1[1]); w.w = cvt_pk_bf16(v1[2], v1[3]);
                    *(u32x4*)(rowp + bj * HALF) = w; } }
    }
};
template <bool BF> __device__ __forceinline__ void ld_res8(const void* p, size_t idx, f32x4& lo, f32x4& hi) {
    if (BF) { const u32x4 w = *(const u32x4*)((const bf16_t*)p + idx);
        lo = (f32x4){__builtin_bit_cast(float, w.x << 16), __builtin_bit_cast(float, w.x & 0xffff0000u), __builtin_bit_cast(float, w.y << 16), __builtin_bit_cast(float, w.y & 0xffff0000u)};
        hi = (f32x4){__builtin_bit_cast(float, w.z << 16), __builtin_bit_cast(float, w.z & 0xffff0000u), __builtin_bit_cast(float, w.w << 16), __builtin_bit_cast(float, w.w & 0xffff0000u)}; }
    else { lo = *(const f32x4*)((const float*)p + idx); hi = *(const f32x4*)((const float*)p + idx + 4); } }
template <bool BF> __device__ __forceinline__ void st_res8(void* p, size_t idx, f32x4 lo, f32x4 hi) {
    if (BF) { u32x4 w; w.x = cvt_pk_bf16(lo[0], lo[1]); w.y = cvt_pk_bf16(lo[2], lo[3]); w.z = cvt_pk_bf16(hi[0], hi[1]); w.w = cvt_pk_bf16(hi[2], hi[3]); *(u32x4*)((bf16_t*)p + idx) = w; }
    else { *(f32x4*)((float*)p + idx) = lo; *(f32x4*)((float*)p + idx + 4) = hi; } }
template <bool BASE_BF, bool OUT_BF> struct EpiResGate {
    static constexpr bool PERM = true, SWZ = false, AFTER_DRAIN = false; static constexpr int CW = SWZ ? 64 : 32, BJ = SWZ ? 32 : HALF;
    const void* base; void* out; const float* gate;
    __device__ __forceinline__ void operator()(const f32x4 (&acc)[2][2][4][2], const Unit& u, int wr, int wc, int fr, int fq) const {
        const int col0 = u.pn * BM + wc * CW + 8 * fq; const int b = (u.pm * BM) >> 12;
        const float* gp = gate + (size_t)b * 6144 + col0;
        f32x4 gv[2][2];
#pragma unroll
        for (int bj = 0; bj < 2; ++bj)
#pragma unroll
            for (int n = 0; n < 2; ++n) gv[bj][n] = *(const f32x4*)(gp + bj * BJ + 4 * n);
#pragma unroll
        for (int ai = 0; ai < 2; ++ai)
#pragma unroll
            for (int m = 0; m < 4; ++m) { const size_t off = (size_t)(u.pm * BM + ai * HALF + wr * 64 + m * 16 + fr) * 1024 + col0;
#pragma unroll
                for (int bj = 0; bj < 2; ++bj) { f32x4 b0, b1; ld_res8<BASE_BF>(base, off + bj * BJ, b0, b1);
                    st_res8<OUT_BF>(out, off + bj * BJ, b0 + gv[bj][0] * acc[ai][bj][m][0], b1 + gv[bj][1] * acc[ai][bj][m][1]); }
                if (m & 1) asm volatile("" ::: "memory"); }
    }
};
template <bool BASE_BF, bool OUT_BF> struct EpiResGateN {
    static_assert(OUT_BF, "the staged stores write bf16");
    static constexpr bool PERM = true, SWZ = true, AFTER_DRAIN = false; static constexpr int CW = 64, BJ = 32;
    const void* base; void* out; const float* gate; const float* gm; bf16_t* hn; float* ssq; PG8_LAS float* xch; PG8_LAS unsigned char* stg;
    __device__ __forceinline__ void operator()(const f32x4 (&acc)[2][2][4][2], const Unit& u, int wr, int wc, int fr, int fq) const {
        const int col0 = u.pn * BM + wc * CW + 8 * fq; const int b = (u.pm * BM) >> 12;
        const float* gp = gate + (size_t)b * 6144 + col0; const float* mp = gm + (size_t)b * 1024 + col0;
        f32x4 gv[2][2], mv[2][2];
#pragma unroll
        for (int bj = 0; bj < 2; ++bj)
#pragma unroll
            for (int n = 0; n < 2; ++n) { gv[bj][n] = *(const f32x4*)(gp + bj * BJ + 4 * n); mv[bj][n] = *(const f32x4*)(mp + bj * BJ + 4 * n); }
        PG8_LAS unsigned char* sw = stg + (wr * 4 + wc) * 2048;
        const int lane_ = fq * 16 + fr, rr_ = lane_ >> 3, cc_ = lane_ & 7;
        PG8_LAS unsigned char* wp_ = sw + fr * 128; const int wx_ = fr & 7;
        PG8_LAS unsigned char* rp_ = sw + rr_ * 128 + ((cc_ ^ (rr_ & 7)) << 4);
        const size_t goff_ = (size_t)(u.pm * BM + wr * 64 + rr_) * 1024 + u.pn * BM + wc * 64 + cc_ * 8;
#define RG_PUT(bj, w) (*(PG8_LAS u32x4*)(wp_ + (((4 * (bj) + fq) ^ wx_) << 4)) = (w))
#define RG_FLUSH(dst, ai, m) do { asm volatile("s_waitcnt lgkmcnt(0)" ::: "memory"); const u32x4 o0_ = *(const PG8_LAS u32x4*)rp_, o1_ = *(const PG8_LAS u32x4*)(rp_ + 1024); asm volatile("s_waitcnt lgkmcnt(0)" ::: "memory"); \
            bf16_t* g_ = (dst) + goff_ + (size_t)((ai) * HALF + (m) * 16) * 1024; *(u32x4*)g_ = o0_; *(u32x4*)(g_ + (size_t)8 * 1024) = o1_; } while (0)
#pragma unroll
        for (int ai = 0; ai < 2; ++ai)
#pragma unroll
            for (int m = 0; m < 4; ++m) { const int rl = ai * HALF + wr * 64 + m * 16 + fr; const size_t off = (size_t)(u.pm * BM + rl) * 1024 + col0; float s = 0.f;
                u32x4 wxb[2], whn[2];
#pragma unroll
                for (int bj = 0; bj < 2; ++bj) { f32x4 b0, b1; ld_res8<BASE_BF>(base, off + bj * BJ, b0, b1);
                    const f32x4 x0 = b0 + gv[bj][0] * acc[ai][bj][m][0], x1 = b1 + gv[bj][1] * acc[ai][bj][m][1];
                    s += ((x0[0] * x0[0] + x0[1] * x0[1]) + (x0[2] * x0[2] + x0[3] * x0[3])) + ((x1[0] * x1[0] + x1[1] * x1[1]) + (x1[2] * x1[2] + x1[3] * x1[3]));
                    wxb[bj].x = cvt_pk_bf16(x0[0], x0[1]); wxb[bj].y = cvt_pk_bf16(x0[2], x0[3]); wxb[bj].z = cvt_pk_bf16(x1[0], x1[1]); wxb[bj].w = cvt_pk_bf16(x1[2], x1[3]);
                    const f32x4 h0 = x0 * mv[bj][0], h1 = x1 * mv[bj][1];
                    whn[bj].x = cvt_pk_bf16(h0[0], h0[1]); whn[bj].y = cvt_pk_bf16(h0[2], h0[3]); whn[bj].z = cvt_pk_bf16(h1[0], h1[1]); whn[bj].w = cvt_pk_bf16(h1[2], h1[3]); }
                RG_PUT(0, wxb[0]); RG_PUT(1, wxb[1]); RG_FLUSH((bf16_t*)out, ai, m);
                RG_PUT(0, whn[0]); RG_PUT(1, whn[1]); RG_FLUSH(hn, ai, m);
                s += __shfl_xor(s, 16); s += __shfl_xor(s, 32);
                if (fq == 0) xch[rl * 4 + wc] = s; }
#undef RG_PUT
#undef RG_FLUSH
        asm volatile("s_waitcnt lgkmcnt(0)" ::: "memory"); __builtin_amdgcn_s_barrier(); asm volatile("" ::: "memory");
        const int tid = (wr * 4 + wc) * 64 + fq * 16 + fr;
        if (tid < 256) { const f32x4 p = *(const PG8_LAS f32x4*)(xch + tid * 4); ssq[(size_t)(u.pm * BM + tid) * 4 + u.pn] = (p[0] + p[1]) + (p[2] + p[3]); }
    }
};
struct EpiFF1 {
    static constexpr bool PERM = true, SWZ = true, AFTER_DRAIN = false;
    bf16_t* O; int ldc; const float* ssq; const float* bias; PG8_LAS unsigned char* stg;
    __device__ __forceinline__ void operator()(const f32x4 (&acc)[2][2][4][2], const Unit& u, int wr, int wc, int fr, int fq) const {
        const int rowb = u.pm * BM + wr * 64; const int colw = u.pn * BM + wc * 64; const int b = (u.pm * BM) >> 12;
        const float* bp = bias + (size_t)b * 4096 + colw + 8 * fq;
        f32x4 bv[2][2];
#pragma unroll
        for (int bj = 0; bj < 2; ++bj)
#pragma unroll
            for (int n = 0; n < 2; ++n) bv[bj][n] = *(const f32x4*)(bp + bj * 32 + 4 * n);
        PG8_LAS unsigned char* sw = stg + (wr * 4 + wc) * 2048;
        const int lane = fq * 16 + fr, rr = lane >> 3, cc = lane & 7;
        PG8_LAS unsigned char* wp = sw + fr * 128; const int wx = fr & 7;
        PG8_LAS unsigned char* rp = sw + rr * 128 + ((cc ^ (rr & 7)) << 4);
        bf16_t* gp = O + (size_t)(rowb + rr) * ldc + colw + cc * 8;
#pragma unroll
        for (int ai = 0; ai < 2; ++ai)
#pragma unroll
            for (int m = 0; m < 4; ++m) { const int row = rowb + ai * HALF + m * 16 + fr;
                const f32x4 p = *(const f32x4*)(ssq + (size_t)row * 4); const float r = __builtin_amdgcn_rsqf(((p[0] + p[1]) + (p[2] + p[3])) * (1.f / 1024.f) + 1e-6f);
#pragma unroll
                for (int bj = 0; bj < 2; ++bj) { f32x4 v0 = acc[ai][bj][m][0] * r + bv[bj][0], v1 = acc[ai][bj][m][1] * r + bv[bj][1];
#pragma unroll
                    for (int e = 0; e < 4; ++e) { const float a = fmaxf(v0[e], 0.f), c = fmaxf(v1[e], 0.f); v0[e] = a * a; v1[e] = c * c; }
                    u32x4 w; w.x = cvt_pk_bf16(v0[0], v0[1]); w.y = cvt_pk_bf16(v0[2], v0[3]); w.z = cvt_pk_bf16(v1[0], v1[1]); w.w = cvt_pk_bf16(v1[2], v1[3]);
                    *(PG8_LAS u32x4*)(wp + (((4 * bj + fq) ^ wx) << 4)) = w; }
                asm volatile("s_waitcnt lgkmcnt(0)" ::: "memory");
                const u32x4 o0 = *(const PG8_LAS u32x4*)rp, o1 = *(const PG8_LAS u32x4*)(rp + 1024);
                asm volatile("s_waitcnt lgkmcnt(0)" ::: "memory");
                bf16_t* g = gp + (size_t)(ai * HALF + m * 16) * ldc;
                *(u32x4*)g = o0; *(u32x4*)(g + (size_t)8 * ldc) = o1; }
    }
};
struct EpiInProj {
    static constexpr bool PERM = true, SWZ = true, AFTER_DRAIN = false;
    bf16_t* O; int ldc; const float* qkg  ; PG8_LAS unsigned char* stg  ;
    const float* ssq  ; const float* bias  ; float* gates  ; float* fgt  ;
    __device__ __forceinline__ void operator()(f32x4 (&acc)[2][2][4][2], const Unit& u, int wr, int wc, int fr, int fq) const {
        asm volatile("" : "+v"(fr), "+v"(fq));
        const int row0 = u.pm * BM + wr * 64 + fr; const int col0 = u.pn * BM + wc * 64 + 8 * fq;
        const int pn = u.pn; const bool nrm = (pn == 4) | (pn == 5) | (pn == 7) | (pn == 8);
        { const int b = (u.pm * BM) >> 12; const float* bp = bias + (size_t)b * 4096 + col0;
          f32x4 bv[2][2];
#pragma unroll
          for (int bj = 0; bj < 2; ++bj)
#pragma unroll
              for (int n = 0; n < 2; ++n) bv[bj][n] = *(const f32x4*)(bp + bj * 32 + 4 * n);
#pragma unroll
          for (int ai = 0; ai < 2; ++ai)
#pragma unroll
              for (int m = 0; m < 4; ++m) { const f32x4 p = *(const f32x4*)(ssq + (size_t)(row0 + ai * HALF + m * 16) * 4); const float r = __builtin_amdgcn_rsqf(((p[0] + p[1]) + (p[2] + p[3])) * (1.f / 1024.f) + 1e-6f);
#pragma unroll
                  for (int bj = 0; bj < 2; ++bj)
#pragma unroll
                      for (int n = 0; n < 2; ++n) acc[ai][bj][m][n] = acc[ai][bj][m][n] * r + bv[bj][n]; } }
        if (pn == 15) {
            int fq2 = fq; asm volatile("" : "+v"(fq2));
            if (wc == 0 && fq2 < 2) { const int b = (u.pm * BM) >> 12;
#pragma unroll
                for (int ai = 0; ai < 2; ++ai)
#pragma unroll
                    for (int m = 0; m < 4; ++m) { const int row = row0 + ai * HALF + m * 16; float* gp = gates + (size_t)row * 12 + 8 * fq2;
                        *(f32x4*)gp = acc[ai][0][m][0]; if (fq2 == 0) { *(f32x4*)(gp + 4) = acc[ai][0][m][1];
#pragma unroll
                            for (int e = 0; e < 4; ++e) fgt[(size_t)(b * 4 + e) * 4096 + (row & 4095)] = acc[ai][0][m][0][e]; } } }
            return;
        }
        PG8_LAS unsigned char* sw = stg + (wr * 4 + wc) * 2048;
        const int lane_ = fq * 16 + fr, rr_ = lane_ >> 3, cc_ = lane_ & 7;
        PG8_LAS unsigned char* wp_ = sw + fr * 128; const int wx_ = fr & 7;
        PG8_LAS unsigned char* rp_ = sw + rr_ * 128 + ((cc_ ^ (rr_ & 7)) << 4);
        bf16_t* gp_ = O + (size_t)(u.pm * BM + wr * 64 + rr_) * ldc + u.pn * BM + wc * 64 + cc_ * 8;
#define INPROJ_PUT(bj, w) (*(PG8_LAS u32x4*)(wp_ + (((4 * (bj) + fq) ^ wx_) << 4)) = (w))
#define INPROJ_FLUSH(ai, m) do { asm volatile("s_waitcnt lgkmcnt(0)" ::: "memory"); const u32x4 o0_ = *(const PG8_LAS u32x4*)rp_, o1_ = *(const PG8_LAS u32x4*)(rp_ + 1024); asm volatile("s_waitcnt lgkmcnt(0)" ::: "memory"); \
            bf16_t* g_ = gp_ + (size_t)((ai) * HALF + (m) * 16) * ldc; *(u32x4*)g_ = o0_; *(u32x4*)(g_ + (size_t)8 * ldc) = o1_; } while (0)
        if (!nrm) {
#pragma unroll
            for (int ai = 0; ai < 2; ++ai)
#pragma unroll
                for (int m = 0; m < 4; ++m) {
#pragma unroll
                    for (int bj = 0; bj < 2; ++bj) { const f32x4 v0 = acc[ai][bj][m][0], v1 = acc[ai][bj][m][1];
                        u32x4 w; w.x = cvt_pk_bf16(v0[0], v0[1]); w.y = cvt_pk_bf16(v0[2], v0[3]); w.z = cvt_pk_bf16(v1[0], v1[1]); w.w = cvt_pk_bf16(v1[2], v1[3]);
                        INPROJ_PUT(bj, w); }
                    INPROJ_FLUSH(ai, m); }
            return;
        }
        const bool wide = (pn >= 7);
        const float inv_n = wide ? (1.f / 64.f) : (1.f / 32.f);
        const float* gp = qkg + ((pn == 4) ? 0 : (pn == 5 ? 64 : (pn == 7 ? 128 : 192)));
        f32x4 gq[2][2];
#pragma unroll
        for (int bj = 0; bj < 2; ++bj) { const int gcol = (wide ? 32 * bj : 0) + 8 * fq; gq[bj][0] = *(const f32x4*)(gp + gcol); gq[bj][1] = *(const f32x4*)(gp + gcol + 4); }
#pragma unroll
        for (int ai = 0; ai < 2; ++ai)
#pragma unroll
            for (int m = 0; m < 4; ++m) { float sg[2];
#pragma unroll
                for (int bj = 0; bj < 2; ++bj) { const f32x4 a = acc[ai][bj][m][0], b = acc[ai][bj][m][1];
                    float s = (a[0] * a[0] + a[1] * a[1]) + (a[2] * a[2] + a[3] * a[3]) + (b[0] * b[0] + b[1] * b[1]) + (b[2] * b[2] + b[3] * b[3]);
                    s += __shfl_xor(s, 16); s += __shfl_xor(s, 32); sg[bj] = s; }
                const float tot = sg[0] + sg[1];
#pragma unroll
                for (int bj = 0; bj < 2; ++bj) { const float r = __builtin_amdgcn_rsqf((wide ? tot : sg[bj]) * inv_n + 1e-6f);
                    const f32x4 v0 = acc[ai][bj][m][0] * gq[bj][0] * r, v1 = acc[ai][bj][m][1] * gq[bj][1] * r;
                    u32x4 w; w.x = cvt_pk_bf16(v0[0], v0[1]); w.y = cvt_pk_bf16(v0[2], v0[3]); w.z = cvt_pk_bf16(v1[0], v1[1]); w.w = cvt_pk_bf16(v1[2], v1[3]);
                    INPROJ_PUT(bj, w); }
                INPROJ_FLUSH(ai, m); }
#undef INPROJ_PUT
#undef INPROJ_FLUSH
    }
};
template <class Epi, class Sched, bool ALIGN_EPI = false, bool SP2 = false>
__device__ __forceinline__ void gemm_phase(PG8_LAS unsigned char* lds, const Gemm g, const Sched& S, const Epi& E) {
    int tid_ = threadIdx.x; asm volatile("" : "+v"(tid_));
    const int tid = tid_, wid = __builtin_amdgcn_readfirstlane(tid >> 6), lane = tid & 63, wr = wid >> 2, wc = wid & 3, fr = lane & 15, fq = lane >> 4;
    const int K = g.K, nt = K / BK;
    unsigned voffA[2], voffB[2];
#pragma unroll
    for (int i = 0; i < 2; ++i) { int R, C; stage_rc(tid * 16 + i * 8192, R, C); const int Rb = Epi::SWZ ? ((R >> 5) * 64 + perm32(R & 31)) : Epi::PERM ? ((R & ~31) + perm32(R & 31)) : R;
        voffA[i] = (unsigned)(R * K + C) * 2u; voffB[i] = (unsigned)(Rb * K + C) * 2u; }
    const size_t kstep = (size_t)(BK * 2);
    const size_t hstep = (size_t)HALF * K * 2;
    const size_t hstepB = Epi::SWZ ? (size_t)32 * K * 2 : hstep;
    const size_t tstep = 2 * hstep;
    const unsigned ldsw = (unsigned)wid * 1024u;
    const int aoff = lds_byte(wr * 64 + fr, fq * 8), boff = lds_byte(wc * 32 + fr, fq * 8);
#define PG8_SA(b, h) (((b) * 2 + (h)) * HTB)
#define PG8_SB(b, h) ((4 + (b) * 2 + (h)) * HTB)
#define PG8_STAGE(bufoff, gbase, voff) do { _Pragma("unroll") for (int _i = 0; _i < 2; ++_i) \
        __builtin_amdgcn_global_load_lds((const unsigned*)((const char*)(gbase) + (voff)[_i]), (PG8_LAS unsigned*)(lds + (bufoff) + ldsw + _i * 8192), 16, 0, 0); } while (0)
#define PG8_LDA(dst, b, h) do { _Pragma("unroll") for (int m = 0; m < 4; ++m) _Pragma("unroll") for (int k = 0; k < 2; ++k) dst[m][k] = *(const PG8_LAS bf16x8*)(lds + PG8_SA(b, h) + aoff + m * 2048 + k * 1024); } while (0)
#define PG8_LDB(dst, b, h) do { _Pragma("unroll") for (int n = 0; n < 2; ++n) _Pragma("unroll") for (int k = 0; k < 2; ++k) dst[n][k] = *(const PG8_LAS bf16x8*)(lds + PG8_SB(b, h) + boff + n * 2048 + k * 1024); } while (0)
#define PG8_MMA(ai, bj, At, Bt) do { __builtin_amdgcn_s_setprio(1); _Pragma("unroll") for (int m = 0; m < 4; ++m) _Pragma("unroll") for (int n = 0; n < 2; ++n) _Pragma("unroll") for (int k = 0; k < 2; ++k) \
        acc[ai][bj][m][n] = __builtin_amdgcn_mfma_f32_16x16x32_bf16(Bt[n][k], At[m][k], acc[ai][bj][m][n], 0, 0, 0); __builtin_amdgcn_s_setprio(0); } while (0)
#define PG8_WAIT_V(n) asm volatile("s_waitcnt vmcnt(" #n ")" ::: "memory")
#define PG8_WAIT_L(n) asm volatile("s_waitcnt lgkmcnt(" #n ")" ::: "memory")
#define PG8_BAR __builtin_amdgcn_s_barrier()
#define PG8_SCHED __builtin_amdgcn_sched_barrier(0)
    Unit cur, nxt; int ui = 0;
    if (!S.next(0, cur)) return;
    f32x4 acc[2][2][4][2];
#pragma unroll
    for (int a = 0; a < 2; ++a)
#pragma unroll
        for (int b = 0; b < 2; ++b)
#pragma unroll
            for (int m = 0; m < 4; ++m)
#pragma unroll
                for (int n = 0; n < 2; ++n) acc[a][b][m][n] = (f32x4){0.f, 0.f, 0.f, 0.f};
    bf16x8 At[4][2], B0[2][2], B1[2][2];
    const char* cA = (const char*)g.A + (size_t)cur.pm * tstep; const char* cB = (const char*)g.Bt + (size_t)cur.pn * tstep;
    S.a_ready(cur);
    if constexpr (SP2) {
        PG8_STAGE(PG8_SB(0, 0), cB, voffB); PG8_STAGE(PG8_SB(0, 1), cB + hstepB, voffB); PG8_STAGE(PG8_SA(0, 0), cA, voffA); PG8_STAGE(PG8_SA(0, 1), cA + hstep, voffA);
        if (wr == 1) PG8_BAR;
        PG8_WAIT_V(2); PG8_BAR;
        PG8_STAGE(PG8_SB(1, 0), cB + kstep, voffB); PG8_STAGE(PG8_SA(1, 0), cA + kstep, voffA); PG8_STAGE(PG8_SB(1, 1), cB + hstepB + kstep, voffB);
        PG8_WAIT_V(6); PG8_BAR;
    } else {
        PG8_STAGE(PG8_SB(0, 0), cB, voffB); PG8_STAGE(PG8_SA(0, 0), cA, voffA); PG8_STAGE(PG8_SB(0, 1), cB + hstepB, voffB); PG8_STAGE(PG8_SA(0, 1), cA + hstep, voffA);
        if (wr == 1) PG8_BAR;
        PG8_WAIT_V(4); PG8_BAR;
        PG8_STAGE(PG8_SB(1, 0), cB + kstep, voffB); PG8_STAGE(PG8_SA(1, 0), cA + kstep, voffA); PG8_STAGE(PG8_SB(1, 1), cB + hstepB + kstep, voffB);
        PG8_WAIT_V(6); PG8_BAR;
    }
    for (;;) {
        const bool has_next = S.next(ui + 1, nxt);
        const char* nA = has_next ? (const char*)g.A + (size_t)nxt.pm * tstep : cA; const char* nB = has_next ? (const char*)g.Bt + (size_t)nxt.pn * tstep : cB;
        for (int t = 0; t < nt; t += 2) {
            const bool last = (t == nt - 2);
            const char* a1 = cA + (size_t)(t + 1) * kstep;
            const char* a2 = last ? nA : cA + (size_t)(t + 2) * kstep; const char* b2 = last ? nB : cB + (size_t)(t + 2) * kstep;
            const char* a3 = a2 + kstep; const char* b3 = b2 + kstep;
            if (last && has_next) S.a_ready(nxt);
            if constexpr (SP2) {
            PG8_LDB(B0, 0, 0); PG8_LDB(B1, 0, 1); PG8_SCHED; PG8_LDA(At, 0, 0); PG8_STAGE(PG8_SA(1, 1), a1 + hstep, voffA);
            PG8_WAIT_V(8); PG8_WAIT_L(0); PG8_BAR; PG8_MMA(0, 0, At, B0); PG8_MMA(0, 1, At, B1); PG8_BAR; PG8_SCHED;
            PG8_LDA(At, 0, 1); PG8_STAGE(PG8_SB(0, 0), b2, voffB); PG8_STAGE(PG8_SB(0, 1), b2 + hstepB, voffB); PG8_STAGE(PG8_SA(0, 0), a2, voffA);
            PG8_WAIT_V(8); PG8_WAIT_L(0); PG8_BAR; PG8_MMA(1, 0, At, B0); PG8_MMA(1, 1, At, B1); PG8_BAR; PG8_SCHED;
            PG8_LDB(B0, 1, 0); PG8_LDB(B1, 1, 1); PG8_SCHED; PG8_LDA(At, 1, 0); PG8_STAGE(PG8_SA(0, 1), a2 + hstep, voffA);
            PG8_WAIT_V(8); PG8_WAIT_L(0); PG8_BAR; PG8_MMA(0, 0, At, B0); PG8_MMA(0, 1, At, B1); PG8_BAR; PG8_SCHED;
            PG8_LDA(At, 1, 1); PG8_STAGE(PG8_SB(1, 0), b3, voffB); PG8_STAGE(PG8_SB(1, 1), b3 + hstepB, voffB); PG8_STAGE(PG8_SA(1, 0), a3, voffA);
            PG8_WAIT_V(8); PG8_WAIT_L(0); PG8_BAR; PG8_MMA(1, 0, At, B0); PG8_MMA(1, 1, At, B1); PG8_BAR; PG8_SCHED;
            } else {
            PG8_LDB(B0, 0, 0); PG8_SCHED; PG8_LDA(At, 0, 0); PG8_STAGE(PG8_SA(1, 1), a1 + hstep, voffA);
            PG8_WAIT_L(8); PG8_BAR; PG8_WAIT_L(0); PG8_MMA(0, 0, At, B0); PG8_BAR; PG8_SCHED;
            PG8_LDB(B1, 0, 1); PG8_STAGE(PG8_SB(0, 0), b2, voffB);
            PG8_BAR; PG8_WAIT_L(0); PG8_MMA(0, 1, At, B1); PG8_BAR;
            PG8_LDA(At, 0, 1); PG8_STAGE(PG8_SA(0, 0), a2, voffA);
            PG8_BAR; PG8_WAIT_L(0); PG8_MMA(1, 0, At, B0); PG8_BAR; PG8_SCHED;
            PG8_STAGE(PG8_SB(0, 1), b2 + hstepB, voffB);
            PG8_WAIT_V(6); PG8_BAR; PG8_MMA(1, 1, At, B1); PG8_BAR;
            PG8_LDB(B0, 1, 0); PG8_SCHED; PG8_LDA(At, 1, 0); PG8_STAGE(PG8_SA(0, 1), a2 + hstep, voffA);
            PG8_WAIT_L(8); PG8_BAR; PG8_WAIT_L(0); PG8_MMA(0, 0, At, B0); PG8_BAR; PG8_SCHED;
            PG8_LDB(B1, 1, 1); PG8_STAGE(PG8_SB(1, 0), b3, voffB);
            PG8_BAR; PG8_WAIT_L(0); PG8_MMA(0, 1, At, B1); PG8_BAR;
            PG8_LDA(At, 1, 1); PG8_STAGE(PG8_SA(1, 0), a3, voffA);
            PG8_BAR; PG8_WAIT_L(0); PG8_MMA(1, 0, At, B0); PG8_BAR; PG8_SCHED;
            PG8_STAGE(PG8_SB(1, 1), b3 + hstepB, voffB);
            PG8_WAIT_V(6); PG8_BAR; PG8_MMA(1, 1, At, B1); PG8_BAR;
            }
        }
        if constexpr (ALIGN_EPI) { if (wr == 0) PG8_BAR; }
        if constexpr (!Epi::AFTER_DRAIN) { E(acc, cur, wr, wc, fr, fq); S.done(cur); }
        if (!has_next) break;
#pragma unroll
        for (int a = 0; a < 2; ++a)
#pragma unroll
            for (int b = 0; b < 2; ++b)
#pragma unroll
                for (int m = 0; m < 4; ++m)
#pragma unroll
                    for (int n = 0; n < 2; ++n) acc[a][b][m][n] = (f32x4){0.f, 0.f, 0.f, 0.f};
        cur = nxt; cA = nA; cB = nB; ++ui;
        if constexpr (ALIGN_EPI) { if (wr == 1) PG8_BAR; }
    }
    PG8_WAIT_V(0);
    if constexpr (!ALIGN_EPI) { if (wr == 0) PG8_BAR; }
    PG8_BAR;
    if constexpr (Epi::AFTER_DRAIN) { E.fused(acc, cur, wr, wc, fr, fq, lds, wid, lane); S.done(cur); }
#undef PG8_SA
#undef PG8_SB
#undef PG8_STAGE
#undef PG8_LDA
#undef PG8_LDB
#undef PG8_MMA
#undef PG8_WAIT_V
#undef PG8_WAIT_L
#undef PG8_BAR
#undef PG8_SCHED
}
}
#define GAS __attribute__((address_space(1)))
#define LAS __attribute__((address_space(3)))
typedef unsigned short bf16;
typedef unsigned v4u __attribute__((ext_vector_type(4)));
typedef float f32x4 __attribute__((ext_vector_type(4)));
typedef short bf16x8 __attribute__((ext_vector_type(8)));
typedef GAS unsigned gu32;
typedef GAS unsigned long long gu64;
#define RLX_AGENT __ATOMIC_RELAXED, __HIP_MEMORY_SCOPE_AGENT
#define LDS_WAIT() asm volatile("s_waitcnt lgkmcnt(0)" ::: "memory")
#define VM_WAIT() asm volatile("s_waitcnt vmcnt(0)" ::: "memory")
__device__ __forceinline__ unsigned long long rt() { return __builtin_amdgcn_s_memrealtime(); }
__device__ __forceinline__ unsigned f2bf(float f) { unsigned u = __builtin_bit_cast(unsigned, f); return (u + 0x7fffu + ((u >> 16) & 1u)) >> 16; }
__device__ __forceinline__ unsigned pk2(float lo, float hi) { return f2bf(lo) | (f2bf(hi) << 16); }

#define XB_TMO      128
#define XB_XCNT(j)  (256  + 64 * (j))
#define XB_XSUB(j)  (1280 + 64 * (j))
#define XB_XGEN(j)  (2304 + 64 * (j))
#define XB_TOP      3328
#define XB_TOPGEN   3392
#define XCD_BAR_WORDS 3456
#define XB_SPIN_CAP (1u << 18)

__device__ __forceinline__ unsigned xb_ld(unsigned* p)              { return __hip_atomic_load(p, __ATOMIC_RELAXED, __HIP_MEMORY_SCOPE_AGENT); }
__device__ __forceinline__ unsigned xb_add(unsigned* p, unsigned v) { return __hip_atomic_fetch_add(p, v, __ATOMIC_RELAXED, __HIP_MEMORY_SCOPE_AGENT); }
__device__ __forceinline__ unsigned xb_xcc_id() { return (unsigned)__builtin_amdgcn_s_getreg((3 << 11) | 20) & 0xFu; }
#define XB_SPIN(cond, bar) do { unsigned _sp = 0; while (cond) { __builtin_amdgcn_s_sleep(1); \
    if ((++_sp & 255u) == 0u) { if (xb_ld(&(bar)[XB_TMO])) break; if (_sp > XB_SPIN_CAP) { atomicAdd(&(bar)[XB_TMO], 1u); break; } } } } while (0)

struct XcdBarrier {
    unsigned* bar; unsigned x;
    volatile LAS unsigned* st;
};

__device__ __forceinline__ XcdBarrier xcd_barrier_post(unsigned* bar, volatile LAS unsigned* st) {
    XcdBarrier b; b.bar = bar; b.x = xb_xcc_id(); b.st = st;
    if (threadIdx.x == 0) (void)xb_add(&bar[XB_XCNT(b.x)], 1u);
    return b;
}
__device__ __forceinline__ void xcd_barrier_complete(unsigned* bar, unsigned x, unsigned& nloc, unsigned& nx) {
    const unsigned G = gridDim.x * gridDim.y * gridDim.z;
    unsigned sum, cnt, mine, sp = 0u;
    for (;;) {
        sum = 0u; cnt = 0u; mine = 0u;
#pragma unroll
        for (unsigned j = 0; j < 16; ++j) { const unsigned c = xb_ld(&bar[XB_XCNT(j)]); sum += c; cnt += (c > 0u) ? 1u : 0u; mine = (j == x) ? c : mine; }
        if (sum == G) break;
        __builtin_amdgcn_s_sleep(1);
        if ((++sp & 255u) == 0u) { if (xb_ld(&bar[XB_TMO])) break; if (sp > XB_SPIN_CAP) { atomicAdd(&bar[XB_TMO], 1u); break; } }
    }
    nloc = mine > 0u ? mine : 1u; nx = cnt > 0u ? cnt : 1u;
}

__device__ __forceinline__ void xcd_barrier(const XcdBarrier& b) {
    asm volatile("s_waitcnt vmcnt(0)" ::: "memory");
    __syncthreads();
    if (threadIdx.x == 0) {
        unsigned* bar = b.bar;
        __builtin_amdgcn_s_waitcnt(0);
        unsigned nloc = b.st[0], nx = b.st[1];
        if (nloc == 0u) { xcd_barrier_complete(bar, b.x, nloc, nx); b.st[0] = nloc; b.st[1] = nx; }
        const unsigned old = xb_add(&bar[XB_XSUB(b.x)], 1u);
        const unsigned gen = old / nloc;
        if (old + 1u == (gen + 1u) * nloc) {
            __builtin_amdgcn_fence(__ATOMIC_RELEASE, "agent");
            asm volatile("s_waitcnt vmcnt(0)" ::: "memory");
            const unsigned og = xb_add(&bar[XB_TOP], 1u);
            const unsigned tg = og / nx;
            if (og + 1u == (tg + 1u) * nx) xb_add(&bar[XB_TOPGEN], 1u);
            else XB_SPIN(xb_ld(&bar[XB_TOPGEN]) == tg, bar);
            __builtin_amdgcn_fence(__ATOMIC_ACQUIRE, "agent");
            xb_add(&bar[XB_XGEN(b.x)], 1u);
            asm volatile("s_waitcnt vmcnt(0)" ::: "memory");
        } else {
            XB_SPIN(xb_ld(&bar[XB_XGEN(b.x)]) == gen, bar);
            __builtin_amdgcn_fence(__ATOMIC_ACQUIRE, "agent");
            asm volatile("s_waitcnt vmcnt(0)" ::: "memory");
        }
    }
    __syncthreads();
}
constexpr int NWAVES = 8;
constexpr int BATCH = 8, SEQ = 4096, D = 1024, FF = 4096, DEPTH = 2, T = BATCH * SEQ, NH = 4, HD = 64;
constexpr int INC = 3852, ZP = 3840, NMOD = 6 * D;
constexpr float EPS = 1e-6f;
constexpr int ZC_HQ = 0, ZC_HF = 256, ZC_HI = 512, ZC_HG = 768, ZC_DQ = 1024, ZC_DK = 1280, ZC_DV = 1536, ZC_FQ = 1792, ZC_FK = 2048, ZC_FV = 2304, ZC_FG = 2560, ZC_MQ = 2816, ZC_MK = 3072, ZC_MV = 3328, ZC_MO = 3584;
constexpr size_t MiB = 1u << 20;
constexpr size_t WS_CTL = 0, CTL_ZERO_BYTES = 1 * MiB;
constexpr size_t WS_MOD = 1 * MiB;
constexpr size_t WS_WG = 1 * MiB + 512 * 1024;
constexpr size_t WS_QKG = 1 * MiB + 768 * 1024;
constexpr size_t WS_SMAX = 1 * MiB + 896 * 1024;
constexpr size_t WS_SCHED = 1 * MiB + 904 * 1024;
constexpr size_t WS_KST = 1 * MiB + 900 * 1024;
constexpr size_t WS_FGT = 3 * MiB + 512 * 1024;
constexpr size_t WS_GATES = 2 * MiB;
constexpr size_t WS_FCUM = 4 * MiB;
constexpr size_t WS_GM1 = 4 * MiB + 768 * 1024;
constexpr size_t WS_BIAS1 = 7 * MiB;
constexpr size_t WS_SS1 = 6 * MiB + 512 * 1024;
constexpr size_t WS_GM2 = 4 * MiB + 512 * 1024;
constexpr size_t WS_BIAS2 = 5 * MiB;
constexpr size_t WS_SSQ = 6 * MiB;
constexpr size_t WS_WIN = 8 * MiB, WS_WOUT = 24 * MiB, WS_W1 = 28 * MiB, WS_W2 = 44 * MiB;
constexpr size_t WS_HN = 64 * MiB;
constexpr size_t WS_Z = 128 * MiB;
constexpr size_t WS_H = 128 * MiB;
constexpr size_t WS_XB = 384 * MiB;
constexpr size_t WS_Y = 448 * MiB;
constexpr size_t WS_DECH = 7 * MiB + 512 * 1024, WS_DECM = 7 * MiB + 800 * 1024;
constexpr size_t WS_END = 512 * MiB;
constexpr size_t WS_IMGH = WS_HN, WS_IMGM = WS_HN + 16 * MiB;
static_assert(16 * MiB + (size_t)32 * 32 * 4160 * 4 <= 64 * MiB, "state images fit HN");
static_assert(WS_Z + (size_t)T * ZP * 2 <= WS_XB && WS_H + (size_t)T * FF * 2 <= WS_XB && WS_XB + (size_t)T * D * 2 <= WS_Y && WS_Y + (size_t)T * D * 2 <= WS_END, "ws map");
constexpr int CW_TMO = 0, CW_BAR = 4096;
constexpr int RING_OFF = 0, RING_BYTES = 131072, LDS_BYTES = 152576, LDSCTL_OFF = LDS_BYTES - 1024, MISC_OFF = LDSCTL_OFF + 320, XCH_OFF = RING_BYTES;
constexpr float LOG2E = 1.4426950408889634f;
static_assert(XCH_OFF + 256 * 8 * 4 <= LDSCTL_OFF && XCH_OFF + 4096 + 8 * 2048 <= LDSCTL_OFF, "exchange / store-staging area");
constexpr int PH_PRO = 0, PH_PER_LAYER = 8, NPH = 1 + 2 * PH_PER_LAYER;
constexpr int PL_NORM1 = 0, PL_INPROJ = 1, PL_MIXA = 2, PL_MIXB = 3, PL_MIXC = 4, PL_OUTPROJ = 5, PL_FF1 = 6, PL_FF2 = 7;

struct Frame {
    LAS unsigned char* lds; volatile LAS unsigned* MISC; gu32* ctl;
    int tid, lane, wave, vcu, G;
};
__device__ __forceinline__ float wave_sum(float v) {
#pragma unroll
    for (int o = 1; o < 64; o <<= 1) v += __shfl_xor(v, o);
    return v;
}
__device__ __forceinline__ float bf2f(bf16 v) { return __builtin_bit_cast(float, (unsigned)v << 16); }
__device__ __forceinline__ float sigmoidf_(float x) { return 1.f / (1.f + __expf(-x)); }
__device__ __forceinline__ float logsigmoidf_(float x) { return fminf(x, 0.f) - log1pf(expf(-fabsf(x))); }

__device__ __forceinline__ void p0_transpose_item(const float* W, int K, int pitch, int nblk, bf16* WT, LAS float* scr, int item, int lane) {
    const int kb = item / nblk, nb = item % nblk, k0 = 64 * kb, n0 = 32 * nb;
    float v_[32];
#pragma unroll
    for (int i = 0; i < 32; ++i) v_[i] = W[(size_t)(k0 + 2 * i + (lane >> 5)) * pitch + n0 + (lane & 31)];
#pragma unroll
    for (int i = 0; i < 32; ++i) scr[(2 * i + (lane >> 5)) * 33 + (lane & 31)] = v_[i];
    LDS_WAIT(); asm volatile("" ::: "memory");
    const int c = lane & 7;
#pragma unroll
    for (int j = 0; j < 4; ++j) { const int n = (lane >> 3) + 8 * j; const LAS float* s = scr + (8 * c) * 33 + n;
        v4u o; o.x = pk2(s[0 * 33], s[1 * 33]); o.y = pk2(s[2 * 33], s[3 * 33]); o.z = pk2(s[4 * 33], s[5 * 33]); o.w = pk2(s[6 * 33], s[7 * 33]);
        *(GAS v4u*)(WT + (size_t)(n0 + n) * K + k0 + 8 * c) = o; }
    LDS_WAIT(); asm volatile("" ::: "memory");
}

struct Args { const float* in[22]; float* out; unsigned char* ws; int ph_lo, ph_hi, li, pad; };

__device__ __forceinline__ void p0_transposes(Frame& F0, const Args& A, int it0, int it1, int gw, int NGW) {
    Frame F = F0; { int t_ = threadIdx.x; asm volatile("" : "+v"(t_)); F.tid = t_; F.lane = t_ & 63; }
    unsigned char* ws = A.ws; const float* w_in = A.in[6];
    LAS float* scr = (LAS float*)(F.lds + RING_OFF + F.wave * 16384);
    constexpr int I_A = 16 * 88, I_B = 16 * 32, I_O = 16 * 32, I_1 = 16 * 128, I_2 = 64 * 32, I_L = I_A + I_B + I_O + I_1 + I_2;
    bf16* Win_t = (bf16*)(ws + WS_WIN); bf16* Wout_t = (bf16*)(ws + WS_WOUT); bf16* W1_t = (bf16*)(ws + WS_W1); bf16* W2_t = (bf16*)(ws + WS_W2);
    for (int it = it0 + gw; it < it1; it += NGW) {
        const int l = it / I_L; int r = it % I_L;
        if (r < I_A) { p0_transpose_item(w_in + (size_t)l * 1024 * INC, 1024, INC, 88, Win_t + (size_t)l * 4096 * 1024, scr, r, F.lane); continue; } r -= I_A;
        if (r < I_B) { p0_transpose_item(w_in + (size_t)l * 1024 * INC + 2820, 1024, INC, 32, Win_t + (size_t)l * 4096 * 1024 + (size_t)2816 * 1024, scr, r, F.lane); continue; } r -= I_B;
        if (r < I_O) { p0_transpose_item(A.in[7] + (size_t)l * 1024 * 1024, 1024, 1024, 32, Wout_t + (size_t)l * 1024 * 1024, scr, r, F.lane); continue; } r -= I_O;
        if (r < I_1) { p0_transpose_item(A.in[20] + (size_t)l * 1024 * 4096, 1024, 4096, 128, W1_t + (size_t)l * 4096 * 1024, scr, r, F.lane); continue; } r -= I_1;
        p0_transpose_item(A.in[21] + (size_t)l * 4096 * 1024, 4096, 1024, 32, W2_t + (size_t)l * 1024 * 4096, scr, r, F.lane);
    }
}
constexpr int TR_ITEMS_L = 16 * 88 + 16 * 32 + 16 * 32 + 16 * 128 + 64 * 32;


__device__ __forceinline__ void p0_prologue(Frame& F0, const Args& A) {
    Frame F = F0; { int t_ = threadIdx.x; asm volatile("" : "+v"(t_)); F.tid = t_; F.lane = t_ & 63; }
    unsigned char* ws = A.ws;
    const float* c_in = A.in[1]; const float* w_ada = A.in[2]; const float* b_ada = A.in[3]; const float* w_in = A.in[6];
    float* mod = (float*)(ws + WS_MOD); float* wg = (float*)(ws + WS_WG);
    {
        LAS float* cact = (LAS float*)(F.lds); LAS float* red = (LAS float*)(F.lds + 32768);
        bool staged = false;
        for (int unit = blockIdx.x; unit < 192; unit += F.G) {
            if (!staged) { for (int i = F.tid; i < 8192; i += NWAVES * 64) { const int b = i >> 10, k = i & 1023; const float v = c_in[b * 1024 + k]; cact[k * 8 + b] = v / (1.f + expf(-v)); } staged = true; }
            __syncthreads();
            const int l = unit / 96, n0 = (unit % 96) * 64;
            const float* W = w_ada + (size_t)l * 1024 * NMOD + n0 + F.lane;
            float acc[8];
#pragma unroll
            for (int b = 0; b < 8; ++b) acc[b] = 0.f;
            const int k0 = F.wave * 128;
#pragma unroll 32
            for (int kk = 0; kk < 128; ++kk) { const int k = k0 + kk; const float w = W[(size_t)k * NMOD];
                const f32x4 c0 = *(const LAS f32x4*)(cact + k * 8), c1 = *(const LAS f32x4*)(cact + k * 8 + 4);
                acc[0] += w * c0[0]; acc[1] += w * c0[1]; acc[2] += w * c0[2]; acc[3] += w * c0[3]; acc[4] += w * c1[0]; acc[5] += w * c1[1]; acc[6] += w * c1[2]; acc[7] += w * c1[3]; }
#pragma unroll
            for (int b = 0; b < 8; ++b) red[(F.wave * 8 + b) * 64 + F.lane] = acc[b];
            __syncthreads();
            { const int b = F.tid >> 6, col = F.tid & 63; float s = b_ada[l * NMOD + n0 + col];
#pragma unroll
              for (int w = 0; w < 8; ++w) s += red[(w * 8 + b) * 64 + col];
              mod[(size_t)(l * 8 + b) * NMOD + n0 + col] = s;
              if (n0 >= 1 * D && n0 < 2 * D) ((float*)(ws + WS_GM1))[(size_t)(l * 8 + b) * D + (n0 - 1 * D) + col] = A.in[4][l * D + (n0 - 1 * D) + col] * (1.f + s);
              if (n0 >= 4 * D && n0 < 5 * D) ((float*)(ws + WS_GM2))[(size_t)(l * 8 + b) * D + (n0 - 4 * D) + col] = A.in[5][l * D + (n0 - 4 * D) + col] * (1.f + s); }
            __syncthreads();
        }
    }
    __syncthreads();
    for (int idx = blockIdx.x * (NWAVES * 64) + F.tid; idx < 2 * 12 * 1024; idx += F.G * NWAVES * 64) {
        const int l = idx / 12288, r = idx % 12288, j = r >> 10, k = r & 1023;
        const int col = (j < 4) ? 2816 + j : (j < 8 ? 3844 + (j - 4) : 3848 + (j - 8));
        const float wv = w_in[(size_t)l * 1024 * INC + (size_t)k * INC + col]; wg[idx] = wv;
        ((bf16*)(ws + WS_WIN))[(size_t)l * 4096 * 1024 + (size_t)(3840 + j) * 1024 + k] = (bf16)f2bf(wv);
    }
    for (int idx = blockIdx.x * (NWAVES * 64) + F.tid; idx < 2 * 244 * 1024 / 8; idx += F.G * NWAVES * 64) {
        const int l = idx / (244 * 128), r = idx % (244 * 128);
        ((GAS v4u*)((bf16*)(ws + WS_WIN) + (size_t)l * 4096 * 1024 + (size_t)3852 * 1024))[r] = (v4u){0u, 0u, 0u, 0u};
    }
    if (blockIdx.x == F.G - 1 && F.tid < 2 * 4 * 64) {
        const int l = F.tid >> 8, k = (F.tid >> 6) & 3, d = F.tid & 63; float v;
        if (k == 0) v = A.in[10][l * 32 + (d & 31)] * (0.17677669529663687f * LOG2E);
        else if (k == 1) v = A.in[11][l * 32 + (d & 31)];
        else if (k == 2) v = A.in[14][l * 64 + d] * (0.125f * LOG2E);
        else v = A.in[15][l * 64 + d];
        ((float*)(ws + WS_QKG))[F.tid] = v;
    }
    if (blockIdx.x == F.G - 2 && F.tid < 4) {
        const int l = F.tid >> 1, k = F.tid & 1; float mq = 0.f, mk = 0.f;
        if (k == 0) { for (int d = 0; d < 64; ++d) { mq = fmaxf(mq, fabsf(A.in[14][l * 64 + d])); mk = fmaxf(mk, fabsf(A.in[15][l * 64 + d])); } }
        else { for (int d = 0; d < 32; ++d) { mq = fmaxf(mq, fabsf(A.in[10][l * 32 + d])); mk = fmaxf(mk, fabsf(A.in[11][l * 32 + d])); } }
        ((float*)(ws + WS_SMAX))[F.tid] = (k == 0 ? 8.0f : 5.656854249f) * LOG2E * mq * mk * 1.02f + 0.5f;
    }
    if (F.G == 256) { constexpr int N1 = 192 * NWAVES * 6;
        if (blockIdx.x < 192) p0_transposes(F, A, 0, N1, (int)blockIdx.x * NWAVES + F.wave, 192 * NWAVES);
        else p0_transposes(F, A, N1, 2 * TR_ITEMS_L, ((int)blockIdx.x - 192) * NWAVES + F.wave, 64 * NWAVES); }
    else p0_transposes(F, A, 0, 2 * TR_ITEMS_L, F.vcu * NWAVES + F.wave, F.G * NWAVES);
}

__device__ __forceinline__ void norm_phase(Frame& F0, const float* xsrc, const float* gain, const float* modl, int shift_slot, bf16* hn, const float* wg, float* gates, float* fgt) {
    Frame F = F0; { int t_ = threadIdx.x; asm volatile("" : "+v"(t_)); F.tid = t_; F.lane = t_ & 63; }
    LAS float* wgl = (LAS float*)(F.lds);
    if (wg) { for (int i = F.tid; i < 12 * 1024 / 4; i += NWAVES * 64) ((LAS f32x4*)wgl)[i] = ((const GAS f32x4*)wg)[i]; }
    __syncthreads();
    const int gw = F.vcu * NWAVES + F.wave, NGW = F.G * NWAVES;
    for (int m0 = gw * 16; m0 < T; m0 += NGW * 16) {
        const int b = m0 >> 12;
        f32x4 gm[4], sh[4];
        { const GAS f32x4* g4 = (const GAS f32x4*)gain + F.lane;
          const GAS f32x4* sh4 = (const GAS f32x4*)(modl + (size_t)b * NMOD + shift_slot * D) + F.lane;
          const GAS f32x4* sc4 = (const GAS f32x4*)(modl + (size_t)b * NMOD + (shift_slot + 1) * D) + F.lane;
#pragma unroll
          for (int j = 0; j < 4; ++j) { gm[j] = g4[64 * j] * (sc4[64 * j] + 1.0f); sh[j] = sh4[64 * j]; } }
#pragma unroll 1
        for (int rb = 0; rb < 16; rb += 4) {
            f32x4 v[4][4]; float s[4];
#pragma unroll
            for (int r = 0; r < 4; ++r) { const GAS f32x4* xr = (const GAS f32x4*)(xsrc + (size_t)(m0 + rb + r) * D) + F.lane;
#pragma unroll
                for (int j = 0; j < 4; ++j) v[r][j] = xr[64 * j]; }
#pragma unroll
            for (int r = 0; r < 4; ++r) { float a = 0.f;
#pragma unroll
                for (int j = 0; j < 4; ++j) a += (v[r][j].x * v[r][j].x + v[r][j].y * v[r][j].y) + (v[r][j].z * v[r][j].z + v[r][j].w * v[r][j].w);
                s[r] = a; }
#pragma unroll
            for (int o = 1; o < 64; o <<= 1) {
#pragma unroll
                for (int r = 0; r < 4; ++r) s[r] += __shfl_xor(s[r], o); }
#pragma unroll
            for (int r = 0; r < 4; ++r) { const float rstd = __builtin_amdgcn_rsqf(s[r] * (1.f / D) + EPS);
                GAS unsigned long long* o8 = (GAS unsigned long long*)(hn + (size_t)(m0 + rb + r) * D) + F.lane;
#pragma unroll
                for (int j = 0; j < 4; ++j) { v[r][j] = (v[r][j] * rstd) * gm[j] + sh[j];
                    o8[64 * j] = (unsigned long long)pk2(v[r][j].x, v[r][j].y) | ((unsigned long long)pk2(v[r][j].z, v[r][j].w) << 32); } }
            if (wg) {
                float mine[4] = {0.f, 0.f, 0.f, 0.f};
#pragma unroll 1
                for (int g = 0; g < 12; ++g) { float d[4] = {0.f, 0.f, 0.f, 0.f};
#pragma unroll
                    for (int j = 0; j < 4; ++j) { const f32x4 w = ((const LAS f32x4*)(wgl + g * 1024))[F.lane + 64 * j];
#pragma unroll
                        for (int r = 0; r < 4; ++r) d[r] += (v[r][j].x * w.x + v[r][j].y * w.y) + (v[r][j].z * w.z + v[r][j].w * w.w); }
#pragma unroll
                    for (int o = 1; o < 64; o <<= 1) {
#pragma unroll
                        for (int r = 0; r < 4; ++r) d[r] += __shfl_xor(d[r], o); }
#pragma unroll
                    for (int r = 0; r < 4; ++r) mine[r] = (F.lane == g) ? d[r] : mine[r]; }
                if (F.lane < 12) {
#pragma unroll
                    for (int r = 0; r < 4; ++r) gates[(size_t)(m0 + rb + r) * 12 + F.lane] = mine[r]; }
                if (F.lane < 4) {
#pragma unroll
                    for (int r = 0; r < 4; ++r) fgt[(size_t)(b * NH + F.lane) * SEQ + ((m0 + rb + r) & (SEQ - 1))] = mine[r]; }
            }
        }
    }
}
__device__ __forceinline__ void fox_scan_wave(const float* fgt, const float* fbias, float* Fcum, int* kst, float smax, int bh, int lane_) {
    int lane = lane_; asm volatile("" : "+v"(lane));
    const int h = bh & 3; const float fb = fbias[h]; const GAS f32x4* g4 = (const GAS f32x4*)(fgt + (size_t)bh * SEQ + lane * 64);
    f32x4 lf[16]; float s = 0.f;
#pragma unroll
    for (int i = 0; i < 16; ++i) lf[i] = g4[i];
#pragma unroll
    for (int i = 0; i < 16; ++i) {
#pragma unroll
        for (int e = 0; e < 4; ++e) { lf[i][e] = logsigmoidf_(lf[i][e] + fb); s += lf[i][e]; } }
    float incl = s;
#pragma unroll
    for (int o = 1; o < 64; o <<= 1) { const float v = __shfl_up(incl, o); if (lane >= o) incl += v; }
    float run = incl - s; GAS f32x4* Fo = (GAS f32x4*)(Fcum + (size_t)bh * SEQ + lane * 64); float ffirst = 0.f;
#pragma unroll
    for (int i = 0; i < 16; ++i) { f32x4 o4;
#pragma unroll
        for (int e = 0; e < 4; ++e) { run += lf[i][e]; o4[e] = run; if (i == 0 && e == 0) ffirst = run; }
        Fo[i] = o4; }
    const float blast = -run * LOG2E;
    for (int qb = 0; qb < 16; ++qb) { const float bq0 = -__shfl(ffirst, 4 * qb) * LOG2E;
        const unsigned long long m = __ballot(blast < bq0 - 152.0f - 2.0f * smax);
        int ks = (int)__builtin_ctzll(~m); const int nt = 4 * qb + 4; ks = ks < nt - 4 ? ks : nt - 4; ks &= ~1;
        if (lane == 0) kst[bh * 16 + qb] = ks; }
}

__device__ __forceinline__ void fox_scan_block(const float* fgt, const float* fbias, float* Fcum, int* kst, float smax, int bh, LAS unsigned char* lds) {
    int tid_ = threadIdx.x; asm volatile("" : "+v"(tid_)); const int tid = tid_, lane = tid & 63, wave = tid >> 6;
    LAS float* Fl = (LAS float*)lds; LAS float* part = Fl + SEQ;
    const int h = bh & 3; const float fb = fbias[h];
    const GAS f32x4* g4 = (const GAS f32x4*)(fgt + (size_t)bh * SEQ + tid * 8);
    const f32x4 a = g4[0], b = g4[1];
    float v[8] = {a[0], a[1], a[2], a[3], b[0], b[1], b[2], b[3]}; float s = 0.f;
#pragma unroll
    for (int e = 0; e < 8; ++e) { s += logsigmoidf_(v[e] + fb); v[e] = s; }
    float incl = s;
#pragma unroll
    for (int o = 1; o < 64; o <<= 1) { const float t = __shfl_up(incl, o); if (lane >= o) incl += t; }
    if (lane == 63) part[wave] = incl;
    __syncthreads();
    float base = incl - s;
    for (int w = 0; w < wave; ++w) base += part[w];
    f32x4 o0, o1;
#pragma unroll
    for (int e = 0; e < 4; ++e) { o0[e] = base + v[e]; o1[e] = base + v[4 + e]; }
    GAS f32x4* Fo = (GAS f32x4*)(Fcum + (size_t)bh * SEQ + tid * 8); Fo[0] = o0; Fo[1] = o1;
    *(LAS f32x4*)(Fl + tid * 8) = o0; *(LAS f32x4*)(Fl + tid * 8 + 4) = o1;
    __syncthreads();
    if (wave == 0) {
        const float blast = -Fl[64 * lane + 63] * LOG2E;
        for (int qb = 0; qb < 16; ++qb) { const float bq0 = -Fl[256 * qb] * LOG2E;
            const unsigned long long m = __ballot(blast < bq0 - 152.0f - 2.0f * smax);
            int ks = (int)__builtin_ctzll(~m); const int nt = 4 * qb + 4; ks = ks < nt - 4 ? ks : nt - 4; ks &= ~1;
            if (lane == 0) kst[bh * 16 + qb] = ks; }
    }
    __syncthreads();
}

__device__ __forceinline__ void bias_gemv(Frame& F0, const bf16* Wt, int N, const float* shift, int sstride, float* out) {
    Frame F = F0; { int t_ = threadIdx.x; asm volatile("" : "+v"(t_)); F.tid = t_; F.lane = t_ & 63; }
    LAS float* sl = (LAS float*)(F.lds);
    __syncthreads();
    for (int i = F.tid; i < 8 * 1024; i += NWAVES * 64) sl[i] = shift[(size_t)(i >> 10) * sstride + (i & 1023)];
    __syncthreads();
    const int gw = F.vcu * NWAVES + F.wave, NGW = F.G * NWAVES;
    for (int n = gw; n < N; n += NGW) {
        float w[16];
#pragma unroll
        for (int j = 0; j < 4; ++j) { const unsigned long long q = *(const GAS unsigned long long*)(Wt + (size_t)n * 1024 + 256 * j + F.lane * 4);
#pragma unroll
            for (int e = 0; e < 4; ++e) w[j * 4 + e] = __builtin_bit_cast(float, (unsigned)((q >> (16 * e)) & 0xffffu) << 16); }
        float mine = 0.f;
#pragma unroll 1
        for (int b = 0; b < 8; ++b) { float d = 0.f;
#pragma unroll
            for (int j = 0; j < 4; ++j) { const f32x4 s4 = *(const LAS f32x4*)(sl + b * 1024 + 256 * j + F.lane * 4); d += (w[j * 4] * s4[0] + w[j * 4 + 1] * s4[1]) + (w[j * 4 + 2] * s4[2] + w[j * 4 + 3] * s4[3]); }
            d = wave_sum(d); mine = (F.lane == b) ? d : mine; }
        if (F.lane < 8) out[(size_t)F.lane * N + n] = mine;
    }
    __syncthreads();
}

__device__ __forceinline__ void prenorm0_phase(Frame& F0, const float* xsrc, const float* gm, bf16* hn, float* ss) {
    Frame F = F0; { int t_ = threadIdx.x; asm volatile("" : "+v"(t_)); F.tid = t_; F.lane = t_ & 63; }
    const int gw = F.vcu * NWAVES + F.wave, NGW = F.G * NWAVES;
    for (int m0 = gw * 16; m0 < T; m0 += NGW * 16) {
        const int b = m0 >> 12; f32x4 g[4];
        { const GAS f32x4* g4 = (const GAS f32x4*)(gm + (size_t)b * D) + F.lane;
#pragma unroll
          for (int j = 0; j < 4; ++j) g[j] = g4[64 * j]; }
#pragma unroll 1
        for (int rb = 0; rb < 16; rb += 4) {
            f32x4 v[4][4]; float s[4];
#pragma unroll
            for (int r = 0; r < 4; ++r) { const GAS f32x4* xr = (const GAS f32x4*)(xsrc + (size_t)(m0 + rb + r) * D) + F.lane;
#pragma unroll
                for (int j = 0; j < 4; ++j) v[r][j] = xr[64 * j]; }
#pragma unroll
            for (int r = 0; r < 4; ++r) { float a = 0.f;
#pragma unroll
                for (int j = 0; j < 4; ++j) a += (v[r][j].x * v[r][j].x + v[r][j].y * v[r][j].y) + (v[r][j].z * v[r][j].z + v[r][j].w * v[r][j].w);
                s[r] = a;
                GAS unsigned long long* o8 = (GAS unsigned long long*)(hn + (size_t)(m0 + rb + r) * D) + F.lane;
#pragma unroll
                for (int j = 0; j < 4; ++j) { const f32x4 a4 = v[r][j] * g[j]; o8[64 * j] = (unsigned long long)pk2(a4.x, a4.y) | ((unsigned long long)pk2(a4.z, a4.w) << 32); } }
#pragma unroll
            for (int o = 1; o < 64; o <<= 1) {
#pragma unroll
                for (int r = 0; r < 4; ++r) s[r] += __shfl_xor(s[r], o); }
            if (F.lane < 4) { const float mine = (F.lane == 0) ? s[0] : (F.lane == 1 ? s[1] : (F.lane == 2 ? s[2] : s[3]));
                *(GAS f32x4*)(ss + (size_t)(m0 + rb + F.lane) * 4) = (f32x4){mine, 0.f, 0.f, 0.f}; }
        }
    }
}

__device__ __forceinline__ void bias_all(Frame& F0, const bf16* Win_t, const bf16* W1_t, const float* mod, float* bias1, float* bias2) {
    Frame F = F0; { int t_ = threadIdx.x; asm volatile("" : "+v"(t_)); F.tid = t_; F.lane = t_ & 63; }
    LAS float* sl = (LAS float*)(F.lds);
    __syncthreads();
    for (int i = F.tid; i < 4 * 8192; i += NWAVES * 64) { const int set = i >> 13, l = set & 1, slot = (set >> 1) ? 3 : 0, b = (i >> 10) & 7, k = i & 1023;
        sl[i] = mod[(size_t)(l * 8 + b) * NMOD + slot * 1024 + k]; }
    __syncthreads();
    const int gw = F.vcu * NWAVES + F.wave, NGW = F.G * NWAVES;
    for (int r = gw; r < 4 * 4096; r += NGW) {
        const int set = r >> 12, n = r & 4095, l = set & 1;
        const bf16* wrow = ((set >> 1) ? W1_t : Win_t) + (size_t)(l * 4096 + n) * 1024; float* out = ((set >> 1) ? bias2 : bias1) + (size_t)l * 8 * 4096;
        float w[16];
#pragma unroll
        for (int j = 0; j < 4; ++j) { const unsigned long long q = *(const GAS unsigned long long*)(wrow + 256 * j + F.lane * 4);
#pragma unroll
            for (int e = 0; e < 4; ++e) w[j * 4 + e] = __builtin_bit_cast(float, (unsigned)((q >> (16 * e)) & 0xffffu) << 16); }
        float d[8];
#pragma unroll
        for (int b = 0; b < 8; ++b) { float a = 0.f;
#pragma unroll
            for (int j = 0; j < 4; ++j) { const f32x4 s4 = *(const LAS f32x4*)(sl + set * 8192 + b * 1024 + 256 * j + F.lane * 4); a += (w[j * 4] * s4[0] + w[j * 4 + 1] * s4[1]) + (w[j * 4 + 2] * s4[2] + w[j * 4 + 3] * s4[3]); }
            d[b] = a; }
#pragma unroll
        for (int o = 1; o < 64; o <<= 1) {
#pragma unroll
            for (int b = 0; b < 8; ++b) d[b] += __shfl_xor(d[b], o); }
        float mine = d[0];
#pragma unroll
        for (int b = 1; b < 8; ++b) mine = (F.lane == b) ? d[b] : mine;
        if (F.lane < 8) out[(size_t)F.lane * 4096 + n] = mine;
    }
    __syncthreads();
}
namespace att {
using bf16x8 = __attribute__((ext_vector_type(8))) short;
using s16x4 = __attribute__((ext_vector_type(4))) short;
using f32x16 = __attribute__((ext_vector_type(16))) float;
using f32x4v = __attribute__((ext_vector_type(4))) float;
using u32x4 = __attribute__((ext_vector_type(4))) unsigned;
constexpr int NW = 8, QBLK = 32, QB = QBLK * NW, KVBLK = 64, NQB = SEQ / QB, PITCH = ZP;
constexpr int SLOTB = 8192, LDS_K = 0, LDS_V = 3 * SLOTB, LDS_WS = 6 * SLOTB, LDS_OST = LDS_WS + NW * 256, LDS_TBL = LDS_OST + NW * 8192, LDS_END = LDS_TBL + SEQ * 4 + 256;
static_assert(LDS_END <= LDSCTL_OFF, "attention LDS map");
constexpr int THR = 48;
#define SBAR() __builtin_amdgcn_sched_barrier(0)
#define PIN(x) asm volatile("" : "+v"(x))
#define MFMA(a, b, c) __builtin_amdgcn_mfma_f32_32x32x16_bf16(a, b, c, 0, 0, 0)
#define WAIT_BAR(N) asm volatile("s_waitcnt vmcnt(" #N ") lgkmcnt(0)\n\ts_barrier" ::: "memory")
__device__ __forceinline__ int crow(int r, int hi) { return (r & 3) + 8 * (r >> 2) + 4 * hi; }
__device__ __forceinline__ unsigned cvtpk(float lo, float hi) { unsigned r; asm("v_cvt_pk_bf16_f32 %0, %1, %2\n\ts_nop 1" : "=v"(r) : "v"(lo), "v"(hi)); return r; }
__device__ __forceinline__ unsigned cvtpk_b(float lo, float hi) { const pg8::cv_f32x2 v = {lo, hi}; return __builtin_bit_cast(unsigned, __builtin_convertvector(v, pg8::cv_bf16x2)); }
__device__ __forceinline__ void glds16(const void* g, unsigned lds_base) {
    unsigned sv; asm volatile("s_mov_b32 %0, m0\n\ts_mov_b32 m0, %2\n\ts_nop 0\n\tglobal_load_lds_dwordx4 %1, off\n\ts_mov_b32 m0, %0" : "=&s"(sv) : "v"(g), "s"(lds_base) : "memory"); }
typedef __attribute__((address_space(3))) const char* lds_cptr;
typedef short v4i16_t __attribute__((ext_vector_type(4)));
__device__ __forceinline__ void kload2(bf16x8* kf, lds_cptr kp, int d0, int ko) { kf[2 * d0] = *(const __attribute__((address_space(3))) bf16x8*)(kp + ko); kf[2 * d0 + 1] = *(const __attribute__((address_space(3))) bf16x8*)(kp + ko + 4096); }
__device__ __forceinline__ s16x4 vtr(lds_cptr p) { return __builtin_bit_cast(s16x4, __builtin_amdgcn_ds_read_tr16_b64_v4i16((__attribute__((address_space(3))) v4i16_t*)p)); }
__device__ __forceinline__ f32x16 ldbias(lds_cptr p) {
    const f32x4v a = *(const __attribute__((address_space(3))) f32x4v*)(p), b = *(const __attribute__((address_space(3))) f32x4v*)(p + 32), c = *(const __attribute__((address_space(3))) f32x4v*)(p + 64), d = *(const __attribute__((address_space(3))) f32x4v*)(p + 96);
    return (f32x16){a[0], a[1], a[2], a[3], b[0], b[1], b[2], b[3], c[0], c[1], c[2], c[3], d[0], d[1], d[2], d[3]}; }
#define MX3(a, b, c) __builtin_fmaxf(__builtin_fmaxf((a), (b)), (c))
__device__ __forceinline__ float rowmax(const f32x16& p0, const f32x16& p1) {
    float a = MX3(p0[0], p0[1], p1[0]), b = MX3(p0[2], p0[3], p1[1]); a = MX3(a, p1[2], p1[3]);
#pragma unroll
    for (int r = 4; r < 16; r += 4) { a = MX3(a, p0[r], p0[r + 1]); b = MX3(b, p0[r + 2], p0[r + 3]); a = MX3(a, p1[r], p1[r + 1]); b = MX3(b, p1[r + 2], p1[r + 3]); }
    float m = __builtin_fmaxf(a, b); auto rr = __builtin_amdgcn_permlane32_swap(__float_as_uint(m), __float_as_uint(m), false, false);
    return __builtin_fmaxf(__uint_as_float(rr[0]), __uint_as_float(rr[1])); }
__device__ __forceinline__ void cmask(f32x16& p0, f32x16& p1, int jb, int qrel, int hi) {
    const int kb = 64 * jb + 4 * hi;
#pragma unroll
    for (int r = 0; r < 16; ++r) { const int kv = kb + (r & 3) + 8 * (r >> 2); if (kv > qrel) p0[r] = -INFINITY; if (kv + 32 > qrel) p1[r] = -INFINITY; } }

template <int ND0>
__device__ __forceinline__ void attn_pass(int b, int qb, int kst, const bf16* Z, int qcol, int kcol, int vcol, int kcoff, char* lds, f32x16 (&o)[2], float& l_out) {
    int tid_ = threadIdx.x; asm volatile("" : "+v"(tid_));
    const int tid = tid_, lane = tid & 63, r32 = lane & 31, hi = lane >> 5; const int wid = __builtin_amdgcn_readfirstlane(tid >> 6);
    const long rowbase = (long)b * SEQ; const int q0 = qb * QB, NT = (q0 + QB) / KVBLK - kst;
    const bf16* Qw = Z + (rowbase + q0 + wid * QBLK) * PITCH + qcol;
    const unsigned lds0 = (unsigned)(uintptr_t)lds; float* wsf = (float*)(lds + LDS_WS) + wid * 64;
    const bf16* ksrc = Z + (rowbase + (long)kst * KVBLK + 8 * wid + (lane >> 3)) * PITCH + kcol + ((lane & 7) ^ (lane >> 3)) * 8;
    const bf16* vsrc = Z + (rowbase + (long)kst * KVBLK) * PITCH + vcol + (long)(16 * (wid & 3) + (lane >> 2)) * PITCH + (wid >> 2) * 32 + (lane & 3) * 8;
    const unsigned kdst = lds0 + LDS_K + wid * 1024, vdst = lds0 + LDS_V + wid * 1024;
#define DMA_K(t, slot) glds16(ksrc + (long)(t) * KVBLK * PITCH, (unsigned)__builtin_amdgcn_readfirstlane(kdst + (slot)))
#define DMA_V(t, slot) glds16(vsrc + (long)(t) * KVBLK * PITCH, (unsigned)__builtin_amdgcn_readfirstlane(vdst + (slot)))
    const lds_cptr vp0 = (lds_cptr)lds + LDS_V + ((lane >> 4) & 1) * 32 + (lane & 3) * 8 + (4 * hi + ((lane & 15) >> 2)) * 64;
    const lds_cptr kp0 = (lds_cptr)lds + LDS_K + r32 * 128; const int kx = ((r32 & 7) ^ hi) << 4, kc16 = (kcoff >> 10) << 4;
#define KOFF(d0) ((kc16 + 32 * (d0)) ^ kx)
    const lds_cptr tb0 = (lds_cptr)lds + LDS_TBL + hi * 16 + kst * 256;
    DMA_K(0, 0); DMA_V(0, 0); DMA_K(1, SLOTB);
    bf16x8 qr[ND0];
#pragma unroll
    for (int d0 = 0; d0 < ND0; ++d0) qr[d0] = *reinterpret_cast<const bf16x8*>(&Qw[(long)r32 * PITCH + d0 * 16 + hi * 8]);
    float mhat = 0.f, l_reg = 0.f; o[0] = f32x16{}; o[1] = f32x16{};
    const int qrel = wid * QBLK + r32; bool resc = false;
    f32x16 pA0, pA1, pB0, pB1; bf16x8 kf[2 * ND0]; s16x4 vlo[8], vhi[8]; u32x4 pw0, pw1, pw2, pw3;
    int sl_prev = 0, sl_cur = 0, sl_next = SLOTB;
#define ROT() do { sl_prev = sl_cur; sl_cur = sl_next; sl_next = (sl_next == 2 * SLOTB) ? 0 : sl_next + SLOTB; } while (0)
#define EX(v) __builtin_amdgcn_exp2f((v) + nmh)
#define RESC() do { if (resc) { _Pragma("unroll") for (int d_ = 0; d_ < 2; ++d_) _Pragma("unroll") for (int r = 0; r < 16; ++r) o[d_][r] *= wsf[crow(r, hi)]; } } while (0)
    DMA_K(2, 2 * SLOTB);
    WAIT_BAR(3);
    _Pragma("unroll") for (int d0 = 0; d0 < ND0; ++d0) kload2(kf, kp0, d0, KOFF(d0));
    pA0 = ldbias(tb0); pA1 = ldbias(tb0 + 128);
    _Pragma("unroll") for (int d0 = 0; d0 < ND0; ++d0) { pA0 = MFMA(kf[2 * d0], qr[d0], pA0); pA1 = MFMA(kf[2 * d0 + 1], qr[d0], pA1); }
    if (NT == 4) cmask(pA0, pA1, 0, qrel, hi);
    { const float rm = rowmax(pA0, pA1); mhat = rm; const float nmh = -mhat;
#pragma unroll
      for (int r = 0; r < 16; ++r) { pA0[r] = EX(pA0[r]); pA1[r] = EX(pA1[r]); } }
    pB0 = ldbias(tb0 + 256); pB1 = ldbias(tb0 + 256 + 128);
    WAIT_BAR(0);
    DMA_K(3, 0); DMA_V(1, SLOTB); ROT();
    _Pragma("unroll") for (int d0 = 0; d0 < ND0; ++d0) kload2(kf, kp0 + sl_cur, d0, KOFF(d0));
    WAIT_BAR(2);
#define PKW(P, i) cvtpk_b(P[i], P[i + 1])
#define PAF(k) __builtin_bit_cast(bf16x8, pw##k)
#define VFR(i) (bf16x8){vlo[i][0], vlo[i][1], vlo[i][2], vlo[i][3], vhi[i][0], vhi[i][1], vhi[i][2], vhi[i][3]}
#define VRD(i) do { vlo[i] = vtr(vp_ + (((i) >> 2) * 4096 + ((i) & 3) * 1024)); vhi[i] = vtr(vp_ + (((i) >> 2) * 4096 + ((i) & 3) * 1024 + 512)); } while (0)
#define KRD(G, d0) do { if ((G) && (d0) < ND0) { kload2(kf, kp0 + sl_next, d0, KOFF(d0)); SBAR(); } } while (0)
#define QK(C, i) do { if constexpr ((i) < 2 * ND0) { C = MFMA(kf[(i) < 2 * ND0 ? (i) : 0], qr[(i) < 2 * ND0 ? (i) / 2 : 0], C); } } while (0)
#define GAPA(MF, a0, a1, a2, a3, W0, W1, PW) do { MF; sacc += a0; sacc += a1; sacc += a2; sacc += a3; W0; W1; PIN(PW); PIN(sacc); SBAR(); } while (0)
#define GAPB(MF, X, i) do { MF; X[i] = EX(X[i]); X[i + 1] = EX(X[i + 1]); X[i + 2] = EX(X[i + 2]); X[i + 3] = EX(X[i + 3]); PIN(X); SBAR(); } while (0)
#define STEP(C0, C1, P0, P1, t, MASK, GK, GV, GL) do { SBAR(); \
    const lds_cptr vp_ = vp0 + sl_prev; \
    VRD(0); SBAR(); float sacc = P0[0] + P0[1]; \
                    GAPA(QK(C0, 0), P0[2], P0[3], P0[4], P0[5],     pw0[0] = PKW(P0, 0),  pw0[1] = PKW(P0, 2),  pw0); \
    VRD(4); SBAR(); GAPA(QK(C1, 1), P0[6], P0[7], P0[8], P0[9],     pw0[2] = PKW(P0, 4),  pw0[3] = PKW(P0, 6),  pw0); \
    VRD(1); SBAR(); GAPA(QK(C0, 2), P0[10], P0[11], P0[12], P0[13], pw1[0] = PKW(P0, 8),  pw1[1] = PKW(P0, 10), pw1); \
    VRD(5); SBAR(); GAPA(QK(C1, 3), P0[14], P0[15], P1[0], P1[1],   pw1[2] = PKW(P0, 12), pw1[3] = PKW(P0, 14), pw1); \
    VRD(2); SBAR(); GAPA(QK(C0, 4), P1[2], P1[3], P1[4], P1[5],     pw2[0] = PKW(P1, 0),  pw2[1] = PKW(P1, 2),  pw2); \
    VRD(6); SBAR(); GAPA(QK(C1, 5), P1[6], P1[7], P1[8], P1[9],     pw2[2] = PKW(P1, 4),  pw2[3] = PKW(P1, 6),  pw2); \
    VRD(3); SBAR(); GAPA(QK(C0, 6), P1[10], P1[11], P1[12], P1[13], pw3[0] = PKW(P1, 8),  pw3[1] = PKW(P1, 10), pw3); \
    VRD(7); SBAR(); GAPA(QK(C1, 7), P1[14], P1[15], 0.f, 0.f,       pw3[2] = PKW(P1, 12), pw3[3] = PKW(P1, 14), pw3); \
    l_reg += sacc; \
    if (GK) DMA_K((t) + 3, sl_cur); if (GV) DMA_V((t) + 1, sl_next); \
    if (MASK) cmask(C0, C1, (t) - (NT - 4), qrel, hi); \
    { const float rm = rowmax(C0, C1) - mhat; resc = false; \
      if (__builtin_expect(__any(rm > (float)THR), 0)) { const float dl = __builtin_fmaxf(rm, 0.f); mhat += dl; \
          const float f = __builtin_amdgcn_exp2f(-dl); l_reg *= f; if (hi == 0) wsf[r32] = f; resc = true; } } \
    const float nmh = -mhat; SBAR(); \
    if (GL) { P0 = ldbias(tb0 + ((t) + 1) * 256); P1 = ldbias(tb0 + ((t) + 1) * 256 + 128); } SBAR(); \
    GAPB(o[0] = MFMA(PAF(0), VFR(0), o[0]), C0, 0);              GAPB(o[1] = MFMA(PAF(0), VFR(4), o[1]), C0, 4); \
    KRD(GL, 0); GAPB(o[0] = MFMA(PAF(1), VFR(1), o[0]), C0, 8);  KRD(GL, 1); GAPB(o[1] = MFMA(PAF(1), VFR(5), o[1]), C0, 12); \
    KRD(GL, 2); GAPB(o[0] = MFMA(PAF(2), VFR(2), o[0]), C1, 0);  KRD(GL, 3); GAPB(o[1] = MFMA(PAF(2), VFR(6), o[1]), C1, 4); \
    GAPB(o[0] = MFMA(PAF(3), VFR(3), o[0]), C1, 8);              GAPB(o[1] = MFMA(PAF(3), VFR(7), o[1]), C1, 12); \
    if (GL) { PIN(P0); PIN(P1); } \
    } while (0)
    int t = 1;
    for (; t + 5 < NT; t += 2) {
        STEP(pB0, pB1, pA0, pA1, t, false, true, true, true);     WAIT_BAR(2); RESC(); ROT();
        STEP(pA0, pA1, pB0, pB1, t + 1, false, true, true, true); WAIT_BAR(2); RESC(); ROT();
    }
#define ENDW(tt) do { if ((tt) + 3 < NT) { WAIT_BAR(2); } else if ((tt) + 2 < NT) { WAIT_BAR(1); } else { WAIT_BAR(0); } } while (0)
    for (; t + 1 < NT; t += 2) {
        STEP(pB0, pB1, pA0, pA1, t, true, (t + 3 < NT), (t + 1 < NT), (t + 1 < NT));         ENDW(t);     RESC(); ROT();
        STEP(pA0, pA1, pB0, pB1, t + 1, true, (t + 4 < NT), (t + 2 < NT), (t + 2 < NT));     ENDW(t + 1); RESC(); ROT();
    }
    STEP(pB0, pB1, pA0, pA1, NT - 1, true, false, false, false); RESC();
    { float sacc = pB0[0] + pB0[1];
#pragma unroll
      for (int r = 2; r < 16; ++r) sacc += pB0[r];
#pragma unroll
      for (int r = 0; r < 16; ++r) sacc += pB1[r];
      l_reg += sacc;
      pw0 = (u32x4){PKW(pB0, 0), PKW(pB0, 2), PKW(pB0, 4), PKW(pB0, 6)}; pw1 = (u32x4){PKW(pB0, 8), PKW(pB0, 10), PKW(pB0, 12), PKW(pB0, 14)};
      pw2 = (u32x4){PKW(pB1, 0), PKW(pB1, 2), PKW(pB1, 4), PKW(pB1, 6)}; pw3 = (u32x4){PKW(pB1, 8), PKW(pB1, 10), PKW(pB1, 12), PKW(pB1, 14)};
      const lds_cptr vp_ = vp0 + sl_cur; _Pragma("unroll") for (int i = 0; i < 8; ++i) VRD(i);
      o[0] = MFMA(PAF(0), VFR(0), o[0]); o[1] = MFMA(PAF(0), VFR(4), o[1]); o[0] = MFMA(PAF(1), VFR(1), o[0]); o[1] = MFMA(PAF(1), VFR(5), o[1]);
      o[0] = MFMA(PAF(2), VFR(2), o[0]); o[1] = MFMA(PAF(2), VFR(6), o[1]); o[0] = MFMA(PAF(3), VFR(3), o[0]); o[1] = MFMA(PAF(3), VFR(7), o[1]); }
    { auto rr = __builtin_amdgcn_permlane32_swap(__float_as_uint(l_reg), __float_as_uint(l_reg), false, false); l_reg = __uint_as_float(rr[0]) + __uint_as_float(rr[1]); }
    l_out = l_reg;
#undef DMA_K
#undef KOFF
#undef DMA_V
#undef ROT
#undef EX
#undef RESC
#undef PKW
#undef PAF
#undef VFR
#undef VRD
#undef KRD
#undef QK
#undef ENDW
#undef GAPA
#undef GAPB
#undef STEP
}

__device__ __forceinline__ void row_scales(float l_reg, float extra, float* wsf, int r32, int hi, float (&rli)[16]) {
    if (hi == 0) wsf[32 + r32] = l_reg; asm volatile("s_waitcnt lgkmcnt(0)" ::: "memory");
#pragma unroll
    for (int r = 0; r < 16; ++r) rli[r] = extra * __builtin_amdgcn_rcpf(wsf[32 + crow(r, hi)]);
    asm volatile("s_waitcnt lgkmcnt(0)" ::: "memory");
}

__device__ __forceinline__ void fox_unit(int b, int h, int qb, int kst, const bf16* Z, bf16* Y, char* lds) {
    int tid_ = threadIdx.x; asm volatile("" : "+v"(tid_));
    const int tid = tid_, lane = tid & 63, r32 = lane & 31, hi = lane >> 5; const int wid = __builtin_amdgcn_readfirstlane(tid >> 6);
    f32x16 o[2]; float l_reg;
    attn_pass<4>(b, qb, kst, Z, ZC_FQ + h * 64, ZC_FK + h * 64, ZC_FV + h * 64, 0, lds, o, l_reg);
    float* wsf = (float*)(lds + LDS_WS) + wid * 64; float rli[16]; row_scales(l_reg, 1.f, wsf, r32, hi, rli);
    const long row0 = (long)b * SEQ + qb * QB + wid * QBLK;
    unsigned short* stg = (unsigned short*)(lds + LDS_OST) + wid * 4096;
#pragma unroll
    for (int r = 0; r < 16; ++r) { const int orow = crow(r, hi);
#pragma unroll
        for (int d0 = 0; d0 < 2; ++d0) stg[orow * 64 + d0 * 32 + r32] = (unsigned short)f2bf(o[d0][r] * rli[r]); }
    asm volatile("s_waitcnt lgkmcnt(0)" ::: "memory");
#pragma unroll
    for (int i = 0; i < 4; ++i) { const int row = i * 8 + (lane >> 3), ch = lane & 7;
        const u32x4 ov = *(const u32x4*)(stg + row * 64 + ch * 8); const u32x4 gv = *(const u32x4*)(Z + (row0 + row) * PITCH + ZC_FG + h * 64 + ch * 8);
        u32x4 w;
#pragma unroll
        for (int e = 0; e < 4; ++e) { const float o0 = __uint_as_float(ov[e] << 16), o1 = __uint_as_float(ov[e] & 0xffff0000u), g0 = __uint_as_float(gv[e] << 16), g1 = __uint_as_float(gv[e] & 0xffff0000u);
            w[e] = pk2(o0 / (1.f + __expf(-g0)), o1 / (1.f + __expf(-g1))); }
        *(u32x4*)(Y + (row0 + row) * D + 512 + h * 64 + ch * 8) = w; }
    asm volatile("s_waitcnt lgkmcnt(0)\n\ts_barrier" ::: "memory");
}

__device__ __forceinline__ void diff_unit(int b, int h, int qb, int kst, const bf16* Z, bf16* Y, float lam, float oscale, const float* subg, char* lds) {
    int tid_ = threadIdx.x; asm volatile("" : "+v"(tid_));
    const int tid = tid_, lane = tid & 63, r32 = lane & 31, hi = lane >> 5; const int wid = __builtin_amdgcn_readfirstlane(tid >> 6);
    float* wsf = (float*)(lds + LDS_WS) + wid * 64; float* stg = (float*)(lds + LDS_OST) + wid * 2048;
    const long row0 = (long)b * SEQ + qb * QB + wid * QBLK;
    for (int c = 0; c < 2; ++c) {
        f32x16 o[2]; float l_reg;
        attn_pass<2>(b, qb, kst, Z, ZC_DQ + h * 64 + c * 32, ZC_DK + h * 64, ZC_DV + h * 64, c * 4096, lds, o, l_reg);
        float rli[16]; row_scales(l_reg, c == 0 ? 1.f : -lam, wsf, r32, hi, rli);
#pragma unroll
        for (int r = 0; r < 16; ++r) { const int orow = crow(r, hi);
#pragma unroll
            for (int d0 = 0; d0 < 2; ++d0) { float* p = stg + orow * 64 + d0 * 32 + r32; const float v = o[d0][r] * rli[r]; *p = (c == 0) ? v : (*p + v); } }
        asm volatile("s_waitcnt lgkmcnt(0)\n\ts_barrier" ::: "memory");
    }
#pragma unroll
    for (int i = 0; i < 4; ++i) { const int row = i * 8 + (lane >> 3), ch = lane & 7;
        const f32x4v a = *(const f32x4v*)(stg + row * 64 + ch * 8), c4 = *(const f32x4v*)(stg + row * 64 + ch * 8 + 4);
        float ss = (a[0] * a[0] + a[1] * a[1]) + (a[2] * a[2] + a[3] * a[3]) + (c4[0] * c4[0] + c4[1] * c4[1]) + (c4[2] * c4[2] + c4[3] * c4[3]);
        ss += __shfl_xor(ss, 1); ss += __shfl_xor(ss, 2); ss += __shfl_xor(ss, 4);
        const float rs = oscale / sqrtf(ss * (1.f / 64.f) + EPS);
        const f32x4v g0 = *(const f32x4v*)(subg + ch * 8), g1 = *(const f32x4v*)(subg + ch * 8 + 4);
        u32x4 w; w[0] = pk2(a[0] * rs * g0[0], a[1] * rs * g0[1]); w[1] = pk2(a[2] * rs * g0[2], a[3] * rs * g0[3]); w[2] = pk2(c4[0] * rs * g1[0], c4[1] * rs * g1[1]); w[3] = pk2(c4[2] * rs * g1[2], c4[3] * rs * g1[3]);
        *(u32x4*)(Y + (row0 + row) * D + 256 + h * 64 + ch * 8) = w; }
    asm volatile("s_waitcnt lgkmcnt(0)\n\ts_barrier" ::: "memory");
}
#undef SBAR
#undef PIN
#undef MFMA
#undef WAIT_BAR
#undef MX3
}
namespace rec {
using att::bf16x8; using att::s16x4; using att::f32x16; using att::f32x4v; using att::u32x4;
typedef __attribute__((address_space(3))) char* lptr;
typedef short v4i16_t __attribute__((ext_vector_type(4)));
constexpr int SEGL = 128, NSEG = SEQ / SEGL, NBLK = SEGL / 32, TSTR = 136;
constexpr int W_Q = 0, W_K = 32 * TSTR, W_V = 2 * 32 * TSTR, W_TAB = 3 * 32 * TSTR, W_BYTES = W_TAB + 512;
static_assert(W_BYTES * NWAVES <= RING_BYTES && W_TAB % 16 == 0, "rec LDS map");
constexpr int IMG_H = 4 * 16 * 64, IMG_M = 6 * 16 * 64;
#define RMFMA(a, b, c) __builtin_amdgcn_mfma_f32_32x32x16_bf16(a, b, c, 0, 0, 0)
#define LFENCE() asm volatile("s_waitcnt lgkmcnt(0)" ::: "memory")
__device__ __forceinline__ float fsig(float x) { return __builtin_amdgcn_rcpf(1.f + __builtin_amdgcn_exp2f(x * -1.44269504f)); }
constexpr float EMIN = 1.8048514e-35f;
__device__ __forceinline__ bf16x8 join(s16x4 a, s16x4 b) { return (bf16x8){a[0], a[1], a[2], a[3], b[0], b[1], b[2], b[3]}; }
__device__ __forceinline__ s16x4 vtr(lptr p) { return __builtin_bit_cast(s16x4, __builtin_amdgcn_ds_read_tr16_b64_v4i16((__attribute__((address_space(3))) v4i16_t*)p)); }
__device__ __forceinline__ bf16x8 rowfrag(lptr tile, int r32, int hi, int ks) {
    const lptr p = tile + r32 * TSTR + (16 * ks + 4 * hi) * 2;
    return join(*(const __attribute__((address_space(3))) s16x4*)p, *(const __attribute__((address_space(3))) s16x4*)(p + 16)); }
__device__ __forceinline__ bf16x8 trfrag(lptr tile, int lane, int ct, int ks) {
    const int hi = lane >> 5, i = lane & 15, gb = (lane >> 4) & 1;
    const lptr p = tile + (16 * ks + 4 * hi + (i >> 2)) * TSTR + (32 * ct + 16 * gb + 4 * (i & 3)) * 2;
    return join(vtr(p), vtr(p + 8 * TSTR)); }
__device__ __forceinline__ bf16x8 accfrag(const f32x16& x, int ks) {
    u32x4 w; w[0] = att::cvtpk_b(x[8 * ks], x[8 * ks + 1]); w[1] = att::cvtpk_b(x[8 * ks + 2], x[8 * ks + 3]); w[2] = att::cvtpk_b(x[8 * ks + 4], x[8 * ks + 5]); w[3] = att::cvtpk_b(x[8 * ks + 6], x[8 * ks + 7]);
    return __builtin_bit_cast(bf16x8, w); }

struct RecPtrs { const bf16* Z; const float* gates; bf16* Y; float* imgH; float* imgM; float* decH; float* decM;
                 const float* lbl; const float* ng; const float* convw; const float* ibias; const float* fbias; int layer; };

template <bool ML, bool FULL>
__device__ __forceinline__ void rec_unit(const RecPtrs& P, int bh, int seg, char* wlds) {
    constexpr int NVT = ML ? 3 : 2, NT = 2 * NVT;
    int lane_ = threadIdx.x & 63; asm volatile("" : "+v"(lane_));
    const int lane = lane_, r32 = lane & 31, hi = lane >> 5, h = bh & 3, b = bh >> 2;
    const lptr wl = (lptr)wlds; const lptr tq = wl + W_Q, tk = wl + W_K, tv = wl + W_V;
    __attribute__((address_space(3))) float* tab = (__attribute__((address_space(3))) float*)(wl + W_TAB);
    f32x16 S[NT];
    float* img = ML ? P.imgM + (size_t)(bh * NSEG + seg) * IMG_M : P.imgH + (size_t)(bh * NSEG + seg) * IMG_H;
    if (FULL) {
#pragma unroll
        for (int t = 0; t < NT; ++t)
#pragma unroll
            for (int g = 0; g < 16; ++g) S[t][g] = img[(t * 16 + g) * 64 + lane];
    } else {
#pragma unroll
        for (int t = 0; t < NT; ++t) S[t] = f32x16{};
    }
    float lb = 0.f, oml = 1.f, wq0 = 0.f, wq1 = 0.f, wq2 = 0.f, wq3 = 0.f, wk0 = 0.f, wk1 = 0.f, wk2 = 0.f, wk3 = 0.f, ib = 0.f, fb = 0.f;
    float q1 = 0.f, q2 = 0.f, q3 = 0.f, k1 = 0.f, k2 = 0.f, k3 = 0.f, dtot = 1.f;
    const int c = h * 64 + lane;
    const long rowS = (long)b * SEQ + seg * SEGL;
    if (!ML) {
        if (P.layer == 1) { const float a0 = P.lbl[c], a1 = P.lbl[256 + c]; const float mx = fmaxf(a0, a1); const float e0 = expf(a0 - mx), e1 = expf(a1 - mx); lb = e1 / (e0 + e1); }
        oml = 1.f - lb;
        if (FULL) tab[64 + lane] = P.ng[lane];
    } else {
        wk0 = P.convw[0 * 512 + 256 + c]; wk1 = P.convw[1 * 512 + 256 + c]; wk2 = P.convw[2 * 512 + 256 + c]; wk3 = P.convw[3 * 512 + 256 + c];
        if (FULL) { wq0 = P.convw[0 * 512 + c]; wq1 = P.convw[1 * 512 + c]; wq2 = P.convw[2 * 512 + c]; wq3 = P.convw[3 * 512 + c]; }
        ib = P.ibias[h]; fb = P.fbias[h];
        if (seg > 0) { const bf16* zp = P.Z + (rowS - 3) * ZP + c;
            k3 = bf2f(zp[ZC_MK]); k2 = bf2f(zp[ZP + ZC_MK]); k1 = bf2f(zp[2 * ZP + ZC_MK]);
            if (FULL) { q3 = bf2f(zp[ZC_MQ]); q2 = bf2f(zp[ZP + ZC_MQ]); q1 = bf2f(zp[2 * ZP + ZC_MQ]); } }
    }
    const bf16x8 ones = (r32 == 0) ? (bf16x8){0x3F80, 0x3F80, 0x3F80, 0x3F80, 0x3F80, 0x3F80, 0x3F80, 0x3F80} : (bf16x8){0, 0, 0, 0, 0, 0, 0, 0};
#define LOADV(VW, R0) do { _Pragma("unroll") for (int i_ = 0; i_ < 4; ++i_) VW[i_] = *(const u32x4*)(P.Z + ((R0) + (lane >> 3) + 8 * i_) * ZP + h * 64 + (lane & 7) * 8 + (ML ? ZC_MV : ZC_HI)); } while (0)
#define LOADG(GF, GI, R0) do { if (ML) { const float* gp_ = P.gates + (size_t)((R0) + (lane & 31)) * 12 + h; GF = gp_[8]; GI = gp_[4]; } } while (0)
#define RAWDMA(REGION, COL, R0) do { _Pragma("unroll") for (int j_ = 0; j_ < 4; ++j_) \
        __builtin_amdgcn_global_load_lds((const unsigned*)(P.Z + ((R0) + 8 * j_ + (lane >> 3)) * ZP + (COL) + h * 64 + (((lane & 7) ^ (lane >> 3)) * 8)), (__attribute__((address_space(3))) unsigned*)((REGION) + j_ * 1024), 16, 0, 0); } while (0)
#define WSTORE(TILE, W) do { _Pragma("unroll") for (int i_ = 0; i_ < 4; ++i_) { \
            __attribute__((address_space(3))) unsigned long long* dp_ = (__attribute__((address_space(3))) unsigned long long*)((TILE) + ((lane >> 3) + 8 * i_) * TSTR + (lane & 7) * 16); \
            dp_[0] = (unsigned long long)W[i_][0] | ((unsigned long long)W[i_][1] << 32); dp_[1] = (unsigned long long)W[i_][2] | ((unsigned long long)W[i_][3] << 32); } } while (0)
    const lptr rawK = tq, rawQ = tk;
    constexpr int COLK = ML ? ZC_MK : ZC_HF, COLQ = ML ? ZC_MQ : ZC_HQ;
    RAWDMA(rawK, COLK, rowS); if (FULL) RAWDMA(rawQ, COLQ, rowS);
    u32x4 vwN[4]; float glfN = 0.f, gliN = 0.f;
    if (!FULL) LOADV(vwN, rowS);
    LOADG(glfN, gliN, rowS);
    const int i16 = lane & 15, rr = i16 >> 2, pc = 2 * (lane >> 4) + ((i16 & 3) >> 1);
    const int troffE = rr * 128 + ((pc ^ rr) << 4) + (i16 & 1) * 8, troffO = rr * 128 + ((pc ^ (4 + rr)) << 4) + (i16 & 1) * 8;
    for (int blk = 0; blk < NBLK; ++blk) {
        const long row0 = rowS + blk * 32;
        u32x4 vw[4]; const float glf = glfN, gli = gliN;
        asm volatile("s_waitcnt vmcnt(0)" ::: "memory");
        if (FULL) LOADV(vw, row0);
        else {
#pragma unroll
            for (int i = 0; i < 4; ++i) vw[i] = vwN[i];
        }
        s16x4 ra4[8], rb4[8];
#pragma unroll
        for (int pb = 0; pb < 8; ++pb) { ra4[pb] = vtr(rawK + pb * 512 + ((pb & 1) ? troffO : troffE)); if (FULL) rb4[pb] = vtr(rawQ + pb * 512 + ((pb & 1) ? troffO : troffE)); }
        LFENCE();
        if (!FULL) { if (blk + 1 < NBLK) { RAWDMA(rawK, COLK, row0 + 32); LOADV(vwN, row0 + 32); LOADG(glfN, gliN, row0 + 32); }
            WSTORE(tv, vw); }
        float dec;
        if (!ML) {
            float E = 1.f;
#pragma unroll
            for (int t2 = 0; t2 < 16; ++t2) {
                float kq[2], qq[2];
#pragma unroll
                for (int u = 0; u < 2; ++u) { const int t = 2 * t2 + u;
                    const float f = lb + oml * fsig(bf2f((bf16)ra4[t >> 2][t & 3]));
                    E *= f; const float e = fmaxf(E, EMIN);
                    kq[u] = (1.f - f) * __builtin_amdgcn_rcpf(e);
                    if (FULL) qq[u] = bf2f((bf16)rb4[t >> 2][t & 3]) * e; }
                const unsigned wkk = att::cvtpk(kq[0], kq[1]);
                *(__attribute__((address_space(3))) bf16*)(tk + (2 * t2) * TSTR + lane * 2) = (bf16)(wkk & 0xffffu); *(__attribute__((address_space(3))) bf16*)(tk + (2 * t2 + 1) * TSTR + lane * 2) = (bf16)(wkk >> 16);
                if (FULL) { const unsigned wqq = att::cvtpk(qq[0], qq[1]);
                    *(__attribute__((address_space(3))) bf16*)(tq + (2 * t2) * TSTR + lane * 2) = (bf16)(wqq & 0xffffu); *(__attribute__((address_space(3))) bf16*)(tq + (2 * t2 + 1) * TSTR + lane * 2) = (bf16)(wqq >> 16); }
            }
            dec = fmaxf(E, EMIN);
            tab[lane] = dec;
        } else {
            float F = fsig(glf + fb);
            { float t_;
              t_ = __builtin_bit_cast(float, __builtin_amdgcn_update_dpp(0x3f800000, __builtin_bit_cast(int, F), 0x111, 0xf, 0xf, false)); F *= t_;
              t_ = __builtin_bit_cast(float, __builtin_amdgcn_update_dpp(0x3f800000, __builtin_bit_cast(int, F), 0x112, 0xf, 0xf, false)); F *= t_;
              t_ = __builtin_bit_cast(float, __builtin_amdgcn_update_dpp(0x3f800000, __builtin_bit_cast(int, F), 0x114, 0xf, 0xf, false)); F *= t_;
              t_ = __builtin_bit_cast(float, __builtin_amdgcn_update_dpp(0x3f800000, __builtin_bit_cast(int, F), 0x118, 0xf, 0xf, false)); F *= t_;
              const float r0 = __builtin_bit_cast(float, __builtin_amdgcn_readlane(__builtin_bit_cast(int, F), 15)); if (lane & 16) F *= r0; }
            const int ekb = __builtin_bit_cast(int, __builtin_amdgcn_exp2f((gli + ib) * LOG2E) * __builtin_amdgcn_rcpf(F)), eqb = __builtin_bit_cast(int, F * 0.125f);
            dec = fmaxf(__builtin_bit_cast(float, __builtin_amdgcn_readlane(__builtin_bit_cast(int, F), 31)), EMIN);
#pragma unroll
            for (int t2 = 0; t2 < 16; ++t2) {
                float kq[2], qq[2];
#pragma unroll
                for (int u = 0; u < 2; ++u) { const int t = 2 * t2 + u;
                    const float k0 = bf2f((bf16)ra4[t >> 2][t & 3]); float kc = wk3 * k0 + wk2 * k1 + wk1 * k2 + wk0 * k3; k3 = k2; k2 = k1; k1 = k0;
                    kq[u] = kc * fsig(kc) * __builtin_bit_cast(float, __builtin_amdgcn_readlane(ekb, t));
                    if (FULL) { const float q0 = bf2f((bf16)rb4[t >> 2][t & 3]); float qc = wq3 * q0 + wq2 * q1 + wq1 * q2 + wq0 * q3; q3 = q2; q2 = q1; q1 = q0;
                        qq[u] = qc * fsig(qc) * __builtin_bit_cast(float, __builtin_amdgcn_readlane(eqb, t)); } }
                const unsigned wkk = att::cvtpk(kq[0], kq[1]);
                *(__attribute__((address_space(3))) bf16*)(tk + (2 * t2) * TSTR + lane * 2) = (bf16)(wkk & 0xffffu); *(__attribute__((address_space(3))) bf16*)(tk + (2 * t2 + 1) * TSTR + lane * 2) = (bf16)(wkk >> 16);
                if (FULL) { const unsigned wqq = att::cvtpk(qq[0], qq[1]);
                    *(__attribute__((address_space(3))) bf16*)(tq + (2 * t2) * TSTR + lane * 2) = (bf16)(wqq & 0xffffu); *(__attribute__((address_space(3))) bf16*)(tq + (2 * t2 + 1) * TSTR + lane * 2) = (bf16)(wqq >> 16); }
            }
        }
        dtot *= dec;
        if (FULL) WSTORE(tv, vw);
        LFENCE();
        bf16x8 vf[NVT][2];
#pragma unroll
        for (int vt = 0; vt < 2; ++vt)
#pragma unroll
            for (int ks = 0; ks < 2; ++ks) vf[vt][ks] = trfrag(tv, lane, vt, ks);
        if (ML) { vf[NVT - 1][0] = ones; vf[NVT - 1][1] = ones; }
        if (FULL) {
            bf16x8 qf[4], kf[4];
#pragma unroll
            for (int ks = 0; ks < 4; ++ks) { qf[ks] = rowfrag(tq, r32, hi, ks); kf[ks] = rowfrag(tk, r32, hi, ks); }
            LFENCE();
            RAWDMA(tv, (ML ? ZC_MO : ZC_HG), row0);
            if (blk + 1 < NBLK) { RAWDMA(rawK, COLK, row0 + 32); LOADG(glfN, gliN, row0 + 32); }
            f32x16 x1 = f32x16{};
#pragma unroll
            for (int ks = 0; ks < 4; ++ks) x1 = RMFMA(kf[ks], qf[ks], x1);
#pragma unroll
            for (int g = 0; g < 16; ++g) if (att::crow(g, hi) > r32) x1[g] = 0.f;
            const bf16x8 xb0 = accfrag(x1, 0), xb1 = accfrag(x1, 1);
            f32x16 ot[NVT];
#pragma unroll
            for (int vt = 0; vt < NVT; ++vt) {
                ot[vt] = RMFMA(vf[vt][0], xb0, f32x16{}); ot[vt] = RMFMA(vf[vt][1], xb1, ot[vt]);
#pragma unroll
                for (int dt = 0; dt < 2; ++dt)
#pragma unroll
                    for (int ks = 0; ks < 2; ++ks) ot[vt] = RMFMA(accfrag(S[dt * NVT + vt], ks), qf[2 * dt + ks], ot[vt]);
            }
            asm volatile("s_waitcnt vmcnt(0)" ::: "memory");
            const lptr gy = tv + r32 * 128 + 8 * hi; const int gx = r32 & 7;
            float osc;
            if (!ML) {
                float ss = 0.f;
#pragma unroll
                for (int vt = 0; vt < 2; ++vt)
#pragma unroll
                    for (int g = 0; g < 16; ++g) ss += ot[vt][g] * ot[vt][g];
                { auto rr = __builtin_amdgcn_permlane32_swap(__float_as_uint(ss), __float_as_uint(ss), false, false); ss = __uint_as_float(rr[0]) + __uint_as_float(rr[1]); }
                osc = __builtin_amdgcn_rsqf(ss * (1.f / 64.f) + EPS);
            } else { const float den = __shfl(ot[NVT - 1][0], r32); osc = 1.f / fmaxf(fabsf(den), 1.f); }
#pragma unroll
            for (int vt = 0; vt < 2; ++vt)
#pragma unroll
                for (int g4 = 0; g4 < 4; ++g4) { const int v0 = 32 * vt + 8 * g4 + 4 * hi;
                    __attribute__((address_space(3))) unsigned long long* gp_ = (__attribute__((address_space(3))) unsigned long long*)(gy + (((4 * vt + g4) ^ gx) << 4));
                    const unsigned long long gw = *gp_;
                    float o4[4];
                    if (!ML) { const f32x4v gn = *(const __attribute__((address_space(3))) f32x4v*)(tab + 64 + v0);
#pragma unroll
                        for (int e = 0; e < 4; ++e) { const float gv = __uint_as_float((unsigned)((gw >> (16 * e)) & 0xffffu) << 16); o4[e] = ot[vt][4 * g4 + e] * osc * gn[e] * gv * fsig(gv); }
                    } else {
#pragma unroll
                        for (int e = 0; e < 4; ++e) { const float gv = __uint_as_float((unsigned)((gw >> (16 * e)) & 0xffffu) << 16); o4[e] = ot[vt][4 * g4 + e] * osc * fsig(gv); } }
                    *gp_ = (unsigned long long)att::cvtpk(o4[0], o4[1]) | ((unsigned long long)att::cvtpk(o4[2], o4[3]) << 32); }
            LFENCE();
#pragma unroll
            for (int j = 0; j < 4; ++j) { const int row = 8 * j + (lane >> 3), ch = lane & 7;
                const u32x4 yv = *(const __attribute__((address_space(3))) u32x4*)(tv + row * 128 + ((ch ^ (row & 7)) << 4));
                *(u32x4*)(P.Y + (row0 + row) * D + (ML ? 768 : 0) + h * 64 + ch * 8) = yv; }
        }
        {
            bf16x8 ktf[2][2];
#pragma unroll
            for (int dt = 0; dt < 2; ++dt)
#pragma unroll
                for (int ks = 0; ks < 2; ++ks) ktf[dt][ks] = trfrag(tk, lane, dt, ks);
            if (FULL) { LFENCE(); if (blk + 1 < NBLK) RAWDMA(rawQ, COLQ, row0 + 32); }
#pragma unroll
            for (int dt = 0; dt < 2; ++dt) {
                f32x4v dv[4];
                if (!ML) {
#pragma unroll
                    for (int g4 = 0; g4 < 4; ++g4) dv[g4] = *(const __attribute__((address_space(3))) f32x4v*)(tab + 32 * dt + 8 * g4 + 4 * hi);
                }
#pragma unroll
                for (int vt = 0; vt < NVT; ++vt) { f32x16 s = S[dt * NVT + vt];
                    s = RMFMA(ktf[dt][0], vf[vt][0], s); s = RMFMA(ktf[dt][1], vf[vt][1], s);
#pragma unroll
                    for (int g = 0; g < 16; ++g) s[g] *= ML ? dec : dv[g >> 2][g & 3];
                    S[dt * NVT + vt] = s; }
            }
        }
        LFENCE();
    }
    if (!FULL) {
#pragma unroll
        for (int t = 0; t < NT; ++t)
#pragma unroll
            for (int g = 0; g < 16; ++g) img[(t * 16 + g) * 64 + lane] = S[t][g];
        if (!ML) P.decH[(size_t)(bh * NSEG + seg) * 64 + lane] = dtot;
        else if (lane == 0) P.decM[bh * NSEG + seg] = dtot;
    }
}

__device__ __forceinline__ void scan_items(const RecPtrs& P, int item0, int nitem_stride) {
    int tid_ = threadIdx.x; asm volatile("" : "+v"(tid_)); const int tid = tid_;
    constexpr int ITEMS_H = BATCH * NH * (IMG_H / 512), ITEMS_M = BATCH * NH * (IMG_M / 512), NIT = ITEMS_H + ITEMS_M;
    for (int it0 = item0; it0 < NIT; it0 += 2 * nitem_stride) {
        const bool two = it0 + nitem_stride < NIT;
        float* basev[2]; const float* dpv[2]; int iszv[2], dstrv[2];
#pragma unroll
        for (int q = 0; q < 2; ++q) { const int it = (q == 1 && two) ? it0 + nitem_stride : it0;
            const bool ml = it >= ITEMS_H; const int r = ml ? it - ITEMS_H : it; const int per = ml ? IMG_M / 512 : IMG_H / 512;
            const int bh = r / per, e = (r % per) * 512 + tid; const int isz = ml ? IMG_M : IMG_H;
            basev[q] = (ml ? P.imgM : P.imgH) + (size_t)bh * NSEG * isz + e; iszv[q] = isz;
            const int tile = e >> 10, g = (e >> 6) & 15, ln = e & 63; const int dt = ml ? tile / 3 : tile >> 1; const int d = 32 * dt + att::crow(g, ln >> 5);
            dpv[q] = ml ? P.decM + bh * NSEG : P.decH + (size_t)bh * NSEG * 64 + d; dstrv[q] = ml ? 1 : 64; }
        float u0[NSEG], p0[NSEG], u1[NSEG], p1[NSEG];
#pragma unroll
        for (int j = 0; j < NSEG; ++j) { u0[j] = basev[0][(size_t)j * iszv[0]]; p0[j] = dpv[0][j * dstrv[0]]; }
        if (two) {
#pragma unroll
            for (int j = 0; j < NSEG; ++j) { u1[j] = basev[1][(size_t)j * iszv[1]]; p1[j] = dpv[1][j * dstrv[1]]; } }
        { float s = 0.f;
#pragma unroll
          for (int j = 0; j < NSEG; ++j) { basev[0][(size_t)j * iszv[0]] = s; s = p0[j] * s + u0[j]; } }
        if (two) { float s = 0.f;
#pragma unroll
          for (int j = 0; j < NSEG; ++j) { basev[1][(size_t)j * iszv[1]] = s; s = p1[j] * s + u1[j]; } }
    }
}
#undef LOADV
#undef LOADG
#undef RAWDMA
#undef WSTORE
#undef RMFMA
#undef LFENCE
}
__global__ void __launch_bounds__(NWAVES * 64, 2) mk_fwd(Args args) {
    extern __shared__ __attribute__((aligned(16))) unsigned char lds[];
    Frame F;
    F.lds = (LAS unsigned char*)lds; F.MISC = (volatile LAS unsigned*)(F.lds + MISC_OFF);
    F.tid = threadIdx.x; F.lane = F.tid & 63; F.wave = __builtin_amdgcn_readfirstlane(F.tid >> 6);
    F.G = gridDim.x; { const int bx = blockIdx.x; F.vcu = (F.G % 8 == 0) ? (bx % 8) * (F.G / 8) + bx / 8 : bx; }
    unsigned char* ws = args.ws;
    F.ctl = (gu32*)(ws + WS_CTL);
    for (int u = F.tid; u < (LDS_BYTES - LDSCTL_OFF) / 4; u += NWAVES * 64) ((LAS unsigned*)(F.lds + LDSCTL_OFF))[u] = 0u;
    __syncthreads();
    XcdBarrier bar = xcd_barrier_post((unsigned*)(F.ctl + CW_BAR) + args.li * XCD_BAR_WORDS, F.MISC + 8);
    const int lo = args.ph_lo, hi = args.ph_hi;
#ifdef PROBE_GROUP
    unsigned long long t_prev = __builtin_amdgcn_s_memrealtime(); unsigned long long t_acc = 0ull;
#define STAMP(grp) do { const unsigned long long t_now = __builtin_amdgcn_s_memrealtime(); if ((grp) == PROBE_GROUP) t_acc += t_now - t_prev; t_prev = t_now; } while (0)
#else
#define STAMP(grp) do {} while (0)
#endif
#define IN(k) (lo <= (k) && (k) < hi)
#define SEAM(k) do { if (IN(k) && IN((k) + 1)) xcd_barrier(bar); } while (0)
    float* mod = (float*)(ws + WS_MOD); float* wgw = (float*)(ws + WS_WG); float* gates = (float*)(ws + WS_GATES);
    bf16* HN = (bf16*)(ws + WS_HN); bf16* Z = (bf16*)(ws + WS_Z); bf16* Y = (bf16*)(ws + WS_Y); bf16* HB = (bf16*)(ws + WS_H); bf16* XB = (bf16*)(ws + WS_XB);
    if (IN(PH_PRO)) { p0_prologue(F, args); }
    SEAM(PH_PRO); STAMP(5);
    for (int l = 0; l < DEPTH; ++l) {
        const int pb = 1 + PH_PER_LAYER * l;
        const float* modl = mod + (size_t)l * 8 * NMOD;
        const float* xin = (l == 0) ? args.in[0] : args.out;
        if (IN(pb + PL_NORM1) && l == 0) {
            bias_all(F, (const bf16*)(ws + WS_WIN), (const bf16*)(ws + WS_W1), mod, (float*)(ws + WS_BIAS1), (float*)(ws + WS_BIAS2)); STAMP(8);
            prenorm0_phase(F, xin, (const float*)(ws + WS_GM1), HN, (float*)(ws + WS_SS1));
        }
        if (l == 0) { SEAM(pb + PL_NORM1); } STAMP(4);
        if (IN(pb + PL_INPROJ)) {
            pg8::Gemm g{HN, (const bf16*)(ws + WS_WIN) + (size_t)l * 4096 * 1024, T, 4096, D}; pg8::StaticOrder S; S.init(T, 4096, F.G, (int)blockIdx.x);
            pg8::EpiInProj E{Z, ZP, (const float*)(ws + WS_QKG) + l * 256, (LAS unsigned char*)(F.lds + XCH_OFF), (const float*)(ws + WS_SS1), (const float*)(ws + WS_BIAS1) + (size_t)l * 8 * 4096, gates, (float*)(ws + WS_FGT)};
            pg8::gemm_phase<pg8::EpiInProj, pg8::StaticOrder, true, true>(F.lds + RING_OFF, g, S, E);
        }
        SEAM(pb + PL_INPROJ); STAMP(11);
        rec::RecPtrs RP{Z, gates, Y, (float*)(ws + WS_IMGH), (float*)(ws + WS_IMGM), (float*)(ws + WS_DECH), (float*)(ws + WS_DECM),
                        args.in[8], args.in[9] + l * HD, args.in[17] + (size_t)l * 4 * 512, args.in[18] + l * NH, args.in[19] + l * NH, l};
        char* al = (char*)lds + RING_OFF; float* tbl = (float*)(al + att::LDS_TBL);
        if (IN(pb + PL_MIXA)) {
            for (int bh = blockIdx.x; bh < BATCH * NH; bh += F.G) fox_scan_block((const float*)(ws + WS_FGT), args.in[16] + l * NH, (float*)(ws + WS_FCUM), (int*)(ws + WS_KST), ((const float*)(ws + WS_SMAX))[l * 2], bh, F.lds);
            for (int w = F.vcu * NWAVES + F.wave; w < 2048; w += F.G * NWAVES) { const int rem = w >> 1;
                if ((((w & 1) ^ (F.wave >> 2)) & 1) == 0) rec::rec_unit<false, false>(RP, rem >> 5, rem & 31, al + F.wave * rec::W_BYTES);
                else rec::rec_unit<true, false>(RP, rem >> 5, rem & 31, al + F.wave * rec::W_BYTES); }
        }
        SEAM(pb + PL_MIXA); STAMP(3);
        if (IN(pb + PL_MIXB)) {
            const bool sched_blk = (F.G == 256) && ((F.vcu & 31) == 0);
            if (!sched_blk) { if (F.G == 256) rec::scan_items(RP, F.vcu - (F.vcu >> 5) - 1, 248); else rec::scan_items(RP, (int)blockIdx.x, F.G); }
            for (int vc = F.vcu; vc < 256; vc += F.G) if ((vc & 31) == 0) {
                int mt_ = threadIdx.x; asm volatile("" : "+v"(mt_));
                const int x = vc >> 5; const int* kstF = (const int*)(ws + WS_KST); const float smax_d = ((const float*)(ws + WS_SMAX))[l * 2 + 1];
                LAS int* cst = (LAS int*)(F.lds);
                __syncthreads();
                if (mt_ < 128) { const int v = mt_, ty = v >> 6, hh = (v >> 4) & 3, qb = v & 15, nt = 4 * qb + 4; int ks, c;
                    if (ty == 0) { ks = kstF[(4 * x + hh) * 16 + qb]; c = (nt - ks + 4) * 100; }
                    else { const float slope2 = exp2f(-2.0f * (float)(hh + 1)) * LOG2E; const float jf = ((float)(256 * qb) - (152.0f + 2.0f * smax_d) / slope2 - 63.0f) * (1.0f / 64.0f);
                        ks = jf > 0.f ? (int)jf : 0; ks = ks < nt - 4 ? ks : nt - 4; ks &= ~1; c = (nt - ks + 4) * 215; }
                    cst[v] = c; cst[128 + v] = ks; }
                cst[512 + mt_] = -1; cst[512 + 512 + mt_] = -1;
                __syncthreads();
                if (mt_ < 128) { const int c = cst[mt_]; int rank = 0;
                    for (int v4 = 0; v4 < 32; ++v4) { const v4u cc = *(const LAS v4u*)(cst + 4 * v4);
                        rank += ((int)cc.x > c || ((int)cc.x == c && 4 * v4 + 0 < mt_)) + ((int)cc.y > c || ((int)cc.y == c && 4 * v4 + 1 < mt_)) + ((int)cc.z > c || ((int)cc.z == c && 4 * v4 + 2 < mt_)) + ((int)cc.w > c || ((int)cc.w == c && 4 * v4 + 3 < mt_)); }
                    cst[256 + rank] = mt_; }
                __syncthreads();
                if (F.wave == 0) {
                    const int ln = mt_ & 63; int load = 0, own_lo = 0, own_hi = 0;
                    const int c_lo = cst[cst[256 + ln]], c_hi = cst[cst[256 + 64 + ln]];
                    for (int r = 0; r < 128; ++r) {
                        const int c = (r < 64) ? __builtin_amdgcn_readlane(c_lo, r & 63) : __builtin_amdgcn_readlane(c_hi, r & 63);
                        int m = (ln < 32) ? ((load << 5) | ln) : 0x7fffffff;
                        { int t2;
                          t2 = __builtin_amdgcn_update_dpp(0x7fffffff, m, 0x111, 0xf, 0xf, false); m = t2 < m ? t2 : m;
                          t2 = __builtin_amdgcn_update_dpp(0x7fffffff, m, 0x112, 0xf, 0xf, false); m = t2 < m ? t2 : m;
                          t2 = __builtin_amdgcn_update_dpp(0x7fffffff, m, 0x114, 0xf, 0xf, false); m = t2 < m ? t2 : m;
                          t2 = __builtin_amdgcn_update_dpp(0x7fffffff, m, 0x118, 0xf, 0xf, false); m = t2 < m ? t2 : m; }
                        const int m0 = __builtin_amdgcn_readlane(m, 15), m1 = __builtin_amdgcn_readlane(m, 31); const int o = (m0 < m1 ? m0 : m1) & 31;
                        load += (ln == o) ? c : 0;
                        if (r < 64) own_lo = (ln == r) ? o : own_lo; else own_hi = (ln == (r - 64)) ? o : own_hi; }
                    cst[384 + ln] = own_lo; cst[384 + 64 + ln] = own_hi;
                }
                __syncthreads();
                if (mt_ < 128) { const int o = cst[384 + mt_]; int pos = 0;
                    for (int r4 = 0; r4 < 32; ++r4) { const v4u oo = *(const LAS v4u*)(cst + 384 + 4 * r4);
                        pos += ((int)oo.x == o && 4 * r4 + 0 < mt_) + ((int)oo.y == o && 4 * r4 + 1 < mt_) + ((int)oo.z == o && 4 * r4 + 2 < mt_) + ((int)oo.w == o && 4 * r4 + 3 < mt_); }
                    const int v = cst[256 + mt_]; if (pos < 32) cst[512 + o * 32 + pos] = v | (cst[128 + v] << 8); }
                __syncthreads();
                int* gl = (int*)(ws + WS_SCHED) + x * 1024;
                for (int i = mt_; i < 1024; i += NWAVES * 64) gl[i] = cst[512 + i];
                __syncthreads();
            }
        }
        SEAM(pb + PL_MIXB); STAMP(6);
        if (IN(pb + PL_MIXC)) {
            for (int w = F.vcu * NWAVES + F.wave; w < 2048; w += F.G * NWAVES) { const int rem = w >> 1;
                if ((((w & 1) ^ (F.wave >> 2)) & 1) == 0) rec::rec_unit<false, true>(RP, rem >> 5, rem & 31, al + F.wave * rec::W_BYTES);
                else rec::rec_unit<true, true>(RP, rem >> 5, rem & 31, al + F.wave * rec::W_BYTES); }
            __syncthreads(); STAMP(7);
            int mt_ = threadIdx.x; asm volatile("" : "+v"(mt_));
            const float* Fc = (const float*)(ws + WS_FCUM); const int* kstF = (const int*)(ws + WS_KST);
            const float smax_d = ((const float*)(ws + WS_SMAX))[l * 2 + 1];
            const float lam_init = 0.8f - 0.6f * expf(-0.3f * (float)l);
            float lam; { const float* lv = args.in[12] + l * 128; float d01 = 0.f, d23 = 0.f; for (int i = 0; i < 32; ++i) { d01 += lv[i] * lv[32 + i]; d23 += lv[64 + i] * lv[96 + i]; } lam = expf(d01) - expf(d23) + lam_init; }
            LAS int* cst = (LAS int*)(F.lds + 134144);
            static_assert(att::LDS_END <= 134144 && 134144 + (384 + 1024) * 4 <= LDSCTL_OFF, "unit table placement");
            for (int vc = F.vcu; vc < 256; vc += F.G) {
                const int x = vc >> 5, j = vc & 31; const int* myl = (const int*)(ws + WS_SCHED) + (x * 32 + j) * 32;
                for (int k2 = 0; k2 < 64; ++k2) {
                    const int e = myl[k2 & 31]; if (e < 0) continue;
                    const int v = e & 255, ks = e >> 8; if ((v >> 6) != (k2 >> 5)) continue;
                    const int ty = v >> 6, h = (v >> 4) & 3, qb = v & 15, b = x, bh = 4 * x + h;
                    if (ty == 0) {
                        for (int i = ks * 64 + mt_; i < 256 * qb + 256; i += NWAVES * 64) tbl[i] = -Fc[(size_t)bh * SEQ + i] * LOG2E;
                        att::fox_unit(b, h, qb, ks, Z, Y, al);
                    } else {
                        const float slope2 = exp2f(-2.0f * (float)(h + 1)) * LOG2E;
                        for (int i = ks * 64 + mt_; i < 256 * qb + 256; i += NWAVES * 64) tbl[i] = slope2 * (float)i;
                        att::diff_unit(b, h, qb, ks, Z, Y, lam, 1.f - lam_init, args.in[13] + l * HD, al);
                    }
                }
            }
        }
        SEAM(pb + PL_MIXC); STAMP(2);
        if (IN(pb + PL_OUTPROJ)) {
            pg8::Gemm g{Y, (const bf16*)(ws + WS_WOUT) + (size_t)l * 1024 * 1024, T, D, D}; pg8::StaticOrder S; S.init(T, D, F.G, (int)blockIdx.x);
            if (l == 0) { pg8::EpiResGateN<false, true> E{args.in[0], XB, modl + 2 * D, (const float*)(ws + WS_GM2) + (size_t)l * 8 * D, HN, (float*)(ws + WS_SSQ), (LAS float*)(F.lds + XCH_OFF), (LAS unsigned char*)(F.lds + XCH_OFF + 4096)};
                pg8::gemm_phase<pg8::EpiResGateN<false, true>, pg8::StaticOrder, true, true>(F.lds + RING_OFF, g, S, E); }
            else { pg8::EpiResGateN<true, true> E{XB, XB, modl + 2 * D, (const float*)(ws + WS_GM2) + (size_t)l * 8 * D, HN, (float*)(ws + WS_SSQ), (LAS float*)(F.lds + XCH_OFF), (LAS unsigned char*)(F.lds + XCH_OFF + 4096)};
                pg8::gemm_phase<pg8::EpiResGateN<true, true>, pg8::StaticOrder, true, true>(F.lds + RING_OFF, g, S, E); }
        }
        SEAM(pb + PL_OUTPROJ); STAMP(12);
        if (IN(pb + PL_FF1)) {
            pg8::Gemm g{HN, (const bf16*)(ws + WS_W1) + (size_t)l * 4096 * 1024, T, FF, D}; pg8::StaticOrder S; S.init(T, FF, F.G, (int)blockIdx.x);
            pg8::EpiFF1 E{HB, FF, (const float*)(ws + WS_SSQ), (const float*)(ws + WS_BIAS2) + (size_t)l * 8 * FF, (LAS unsigned char*)(F.lds + XCH_OFF)};
            pg8::gemm_phase<pg8::EpiFF1, pg8::StaticOrder, true, true>(F.lds + RING_OFF, g, S, E);
        }
        SEAM(pb + PL_FF1); STAMP(13);
        if (IN(pb + PL_FF2)) {
            pg8::Gemm g{HB, (const bf16*)(ws + WS_W2) + (size_t)l * 1024 * 4096, T, D, FF}; pg8::StaticOrder S; S.init(T, D, F.G, (int)blockIdx.x);
            if (l + 1 < DEPTH) { pg8::EpiResGateN<true, true> E{XB, XB, modl + 5 * D, (const float*)(ws + WS_GM1) + (size_t)(l + 1) * 8 * D, HN, (float*)(ws + WS_SS1), (LAS float*)(F.lds + XCH_OFF), (LAS unsigned char*)(F.lds + XCH_OFF + 4096)};
                pg8::gemm_phase<pg8::EpiResGateN<true, true>, pg8::StaticOrder, true, true>(F.lds + RING_OFF, g, S, E); }
            else { pg8::EpiResGate<true, false> E{XB, args.out, modl + 5 * D};
                pg8::gemm_phase<pg8::EpiResGate<true, false>, pg8::StaticOrder, true, true>(F.lds + RING_OFF, g, S, E); }
        }
        SEAM(pb + PL_FF2); STAMP(14);
    }
#ifdef PROBE_GROUP
    if (blockIdx.x == 0) { const unsigned long long t_end = __builtin_amdgcn_s_memrealtime() + 4ull * t_acc; while (__builtin_amdgcn_s_memrealtime() < t_end) __builtin_amdgcn_s_sleep(8); }
#endif
#undef IN
#undef SEAM
}

extern "C" void kernel_launch(void* const* d_in, const int* in_sizes, int n_in, void* d_out, int out_size, void* d_ws, size_t ws_size, hipStream_t stream) {
    static int grid = 0;
    if (grid == 0) {
        if (n_in != 22 || in_sizes[0] != T * D || out_size != T * D || ws_size < WS_END) { fprintf(stderr, "kernel_launch: unexpected shapes (n_in %d, in0 %d, out %d, ws %zu)\n", n_in, n_in > 0 ? in_sizes[0] : -1, out_size, ws_size); grid = -1; return; }
        int dev = 0, cus = 0;
        if (hipGetDevice(&dev) != hipSuccess || hipDeviceGetAttribute(&cus, hipDeviceAttributeMultiprocessorCount, dev) != hipSuccess) { grid = -1; return; }
        if (hipFuncSetAttribute((const void*)mk_fwd, hipFuncAttributeMaxDynamicSharedMemorySize, LDS_BYTES) != hipSuccess) { fprintf(stderr, "kernel_launch: hipFuncSetAttribute failed\n"); grid = -1; return; }
        (void)hipGetLastError();
        grid = cus;
    }
    if (grid < 0) return;
    (void)hipMemsetAsync((char*)d_ws + WS_CTL, 0, CTL_ZERO_BYTES, stream);
    Args a{};
    for (int i = 0; i < 22; ++i) a.in[i] = (const float*)d_in[i];
    a.out = (float*)d_out; a.ws = (unsigned char*)d_ws;
    a.ph_lo = 0; a.ph_hi = NPH; a.li = 0;
    hipLaunchKernelGGL(mk_fwd, dim3(grid), dim3(NWAVES * 64), LDS_BYTES, stream, a);
}
```

```cpp
#include <hip/hip_runtime.h>
#include <cstdio>
#include <cstdint>
#include <cmath>
#define ATTN_IN_MK 1
#define NEWPREP_H 1
#define NEWPREP_M 1
namespace pg8 {
#define PG8_LAS __attribute__((address_space(3)))
typedef unsigned short bf16_t;
typedef short bf16x8 __attribute__((ext_vector_type(8)));
typedef float f32x4 __attribute__((ext_vector_type(4)));
typedef unsigned u32x4 __attribute__((ext_vector_type(4)));
constexpr int BM = 256, BK = 64, HALF = 128, HTB = HALF * BK * 2  , STAGE_BYTES = 8 * HTB, NXCD = 8, WGM = 8;

__host__ __device__ __forceinline__ int lds_byte(int r, int c) { const int st = (r >> 4) * 2 + (c >> 5), rr = r & 15, cc = c & 31, ob = rr * 64 + cc * 2; return st * 1024 + (ob ^ (((ob >> 9) & 1) << 5)); }
__host__ __device__ __forceinline__ void stage_rc(int b, int& R, int& C) { const int st = b / 1024, sb = b % 1024, swz = sb ^ (((sb >> 9) & 1) << 5); R = (st >> 1) * 16 + swz / 64; C = (st & 1) * 32 + (swz % 64) / 2; }
__host__ __device__ __forceinline__ int perm32(int rho) { const int n = rho >> 4, i = rho & 15; return 8 * (i >> 2) + 4 * n + (i & 3); }

struct Unit { int pm, pn; };
struct Gemm { const bf16_t* A; const bf16_t* Bt; int M, N, K; };

struct StaticOrder {
    int nM, nN, nwg, G, c;
    __host__ __device__ void init(int M, int N, int G_, int c_) { nM = M / BM; nN = N / BM; nwg = nM * nN; G = G_; c = c_; }
    __host__ __device__ bool next(int i, Unit& u) const {
        const long L = (long)i * G + c; if (L >= nwg) return false;
        int wgid = (int)L; { const int q = nwg / NXCD, r = nwg % NXCD, xcd = wgid % NXCD, off = wgid / NXCD; wgid = (xcd < r ? xcd * (q + 1) : r * (q + 1) + (xcd - r) * q) + off; }
        const int nig = WGM * nN, gid = wgid / nig, fm = gid * WGM, gsz = (nM - fm) < WGM ? (nM - fm) : WGM;
        u.pm = fm + ((wgid % nig) % gsz); u.pn = (wgid % nig) / gsz; return true;
    }
    __device__ __forceinline__ void a_ready(const Unit&) const {}
    __device__ __forceinline__ void done(const Unit&) const {}
};

typedef __bf16 cv_bf16x2 __attribute__((ext_vector_type(2))); typedef float cv_f32x2 __attribute__((ext_vector_type(2)));
__device__ __forceinline__ unsigned cvt_pk_bf16(float lo, float hi) { unsigned r; asm volatile("v_cvt_pk_bf16_f32 %0, %1, %2" : "=v"(r) : "v"(lo), "v"(hi)); return r; }
template <int ACT> struct EpiBf16 {
    static constexpr bool PERM = true, SWZ = false, AFTER_DRAIN = false;
    bf16_t* O; int ldc;
    __device__ __forceinline__ void operator()(const f32x4 (&acc)[2][2][4][2], const Unit& u, int wr, int wc, int fr, int fq) const {
        const int row0 = u.pm * BM + wr * 64 + fr; const int col0 = u.pn * BM + wc * 32 + 8 * fq;
#pragma unroll
        for (int ai = 0; ai < 2; ++ai)
#pragma unroll
            for (int m = 0; m < 4; ++m) { bf16_t* rowp = O + (size_t)(row0 + ai * HALF + m * 16) * ldc + col0;
#pragma unroll
                for (int bj = 0; bj < 2; ++bj) { f32x4 v0 = acc[ai][bj][m][0], v1 = acc[ai][bj][m][1];
                    if (ACT == 2) {
#pragma unroll
                        for (int e = 0; e < 4; ++e) { const float a = fmaxf(v0[e], 0.f), b = fmaxf(v1[e], 0.f); v0[e] = a * a; v1[e] = b * b; } }
                    u32x4 w; w.x = cvt_pk_bf16(v0[0], v0[1]); w.y = cvt_pk_bf16(v0[2], v0[3]); w.z = cvt_pk_bf16(v1[0], v1[1]); w.w = cvt_pk_bf16(v1[2], v1[3]);
                    *(u32x4*)(rowp + bj * HALF) = w; } }
    }
};
template <bool BF> __device__ __forceinline__ void ld_res8(const void* p, size_t idx, f32x4& lo, f32x4& hi) {
    if (BF) { const u32x4 w = *(const u32x4*)((const bf16_t*)p + idx);
        lo = (f32x4){__builtin_bit_cast(float, w.x << 16), __builtin_bit_cast(float, w.x & 0xffff0000u), __builtin_bit_cast(float, w.y << 16), __builtin_bit_cast(float, w.y & 0xffff0000u)};
        hi = (f32x4){__builtin_bit_cast(float, w.z << 16), __builtin_bit_cast(float, w.z & 0xffff0000u), __builtin_bit_cast(float, w.w << 16), __builtin_bit_cast(float, w.w & 0xffff0000u)}; }
    else { lo = *(const f32x4*)((const float*)p + idx); hi = *(const f32x4*)((const float*)p + idx + 4); } }
template <bool BF> __device__ __forceinline__ void st_res8(void* p, size_t idx, f32x4 lo, f32x4 hi) {
    if (BF) { u32x4 w; w.x = cvt_pk_bf16(lo[0], lo[1]); w.y = cvt_pk_bf16(lo[2], lo[3]); w.z = cvt_pk_bf16(hi[0], hi[1]); w.w = cvt_pk_bf16(hi[2], hi[3]); *(u32x4*)((bf16_t*)p + idx) = w; }
    else { *(f32x4*)((float*)p + idx) = lo; *(f32x4*)((float*)p + idx + 4) = hi; } }
template <bool BASE_BF, bool OUT_BF> struct EpiResGate {
    static constexpr bool PERM = true, SWZ = false, AFTER_DRAIN = false; static constexpr int CW = SWZ ? 64 : 32, BJ = SWZ ? 32 : HALF;
    const void* base; void* out; const float* gate;
    __device__ __forceinline__ void operator()(const f32x4 (&acc)[2][2][4][2], const Unit& u, int wr, int wc, int fr, int fq) const {
        const int col0 = u.pn * BM + wc * CW + 8 * fq; const int b = (u.pm * BM) >> 12;
        const float* gp = gate + (size_t)b * 6144 + col0;
        f32x4 gv[2][2];
#pragma unroll
        for (int bj = 0; bj < 2; ++bj)
#pragma unroll
            for (int n = 0; n < 2; ++n) gv[bj][n] = *(const f32x4*)(gp + bj * BJ + 4 * n);
#pragma unroll
        for (int ai = 0; ai < 2; ++ai)
#pragma unroll
            for (int m = 0; m < 4; ++m) { const size_t off = (size_t)(u.pm * BM + ai * HALF + wr * 64 + m * 16 + fr) * 1024 + col0;
#pragma unroll
                for (int bj = 0; bj < 2; ++bj) { f32x4 b0, b1; ld_res8<BASE_BF>(base, off + bj * BJ, b0, b1);
                    st_res8<OUT_BF>(out, off + bj * BJ, b0 + gv[bj][0] * acc[ai][bj][m][0], b1 + gv[bj][1] * acc[ai][bj][m][1]); }
                if (m & 1) asm volatile("" ::: "memory"); }
    }
};
template <bool BASE_BF, bool OUT_BF> struct EpiResGateN {
    static_assert(OUT_BF, "the staged stores write bf16");
    static constexpr bool PERM = true, SWZ = true, AFTER_DRAIN = false; static constexpr int CW = 64, BJ = 32;
    const void* base; void* out; const float* gate; const float* gm; bf16_t* hn; float* ssq; PG8_LAS float* xch; PG8_LAS unsigned char* stg;
    __device__ __forceinline__ void operator()(const f32x4 (&acc)[2][2][4][2], const Unit& u, int wr, int wc, int fr, int fq) const {
        const int col0 = u.pn * BM + wc * CW + 8 * fq; const int b = (u.pm * BM) >> 12;
        const float* gp = gate + (size_t)b * 6144 + col0; const float* mp = gm + (size_t)b * 1024 + col0;
        f32x4 gv[2][2], mv[2][2];
#pragma unroll
        for (int bj = 0; bj < 2; ++bj)
#pragma unroll
            for (int n = 0; n < 2; ++n) { gv[bj][n] = *(const f32x4*)(gp + bj * BJ + 4 * n); mv[bj][n] = *(const f32x4*)(mp + bj * BJ + 4 * n); }
        PG8_LAS unsigned char* sw = stg + (wr * 4 + wc) * 2048;
        const int lane_ = fq * 16 + fr, rr_ = lane_ >> 3, cc_ = lane_ & 7;
        PG8_LAS unsigned char* wp_ = sw + fr * 128; const int wx_ = fr & 7;
        PG8_LAS unsigned char* rp_ = sw + rr_ * 128 + ((cc_ ^ (rr_ & 7)) << 4);
        const size_t goff_ = (size_t)(u.pm * BM + wr * 64 + rr_) * 1024 + u.pn * BM + wc * 64 + cc_ * 8;
#define RG_PUT(bj, w) (*(PG8_LAS u32x4*)(wp_ + (((4 * (bj) + fq) ^ wx_) << 4)) = (w))
#define RG_FLUSH(dst, ai, m) do { asm volatile("s_waitcnt lgkmcnt(0)" ::: "memory"); const u32x4 o0_ = *(const PG8_LAS u32x4*)rp_, o1_ = *(const PG8_LAS u32x4*)(rp_ + 1024); asm volatile("s_waitcnt lgkmcnt(0)" ::: "memory"); \
            bf16_t* g_ = (dst) + goff_ + (size_t)((ai) * HALF + (m) * 16) * 1024; *(u32x4*)g_ = o0_; *(u32x4*)(g_ + (size_t)8 * 1024) = o1_; } while (0)
#pragma unroll
        for (int ai = 0; ai < 2; ++ai)
#pragma unroll
            for (int m = 0; m < 4; ++m) { const int rl = ai * HALF + wr * 64 + m * 16 + fr; const size_t off = (size_t)(u.pm * BM + rl) * 1024 + col0; float s = 0.f;
                u32x4 wxb[2], whn[2];
#pragma unroll
                for (int bj = 0; bj < 2; ++bj) { f32x4 b0, b1; ld_res8<BASE_BF>(base, off + bj * BJ, b0, b1);
                    const f32x4 x0 = b0 + gv[bj][0] * acc[ai][bj][m][0], x1 = b1 + gv[bj][1] * acc[ai][bj][m][1];
                    s += ((x0[0] * x0[0] + x0[1] * x0[1]) + (x0[2] * x0[2] + x0[3] * x0[3])) + ((x1[0] * x1[0] + x1[1] * x1[1]) + (x1[2] * x1[2] + x1[3] * x1[3]));
                    wxb[bj].x = cvt_pk_bf16(x0[0], x0[1]); wxb[bj].y = cvt_pk_bf16(x0[2], x0[3]); wxb[bj].z = cvt_pk_bf16(x1[0], x1[1]); wxb[bj].w = cvt_pk_bf16(x1[2], x1[3]);
                    const f32x4 h0 = x0 * mv[bj][0], h1 = x1 * mv[bj][1];
                    whn[bj].x = cvt_pk_bf16(h0[0], h0[1]); whn[bj].y = cvt_pk_bf16(h0[2], h0[3]); whn[bj].z = cvt_pk_bf16(h1[0], h1[1]); whn[bj].w = cvt_pk_bf16(h1[2], h1[3]); }
                RG_PUT(0, wxb[0]); RG_PUT(1, wxb[1]); RG_FLUSH((bf16_t*)out, ai, m);
                RG_PUT(0, whn[0]); RG_PUT(1, whn[1]); RG_FLUSH(hn, ai, m);
                s += __shfl_xor(s, 16); s += __shfl_xor(s, 32);
                if (fq == 0) xch[rl * 4 + wc] = s; }
#undef RG_PUT
#undef RG_FLUSH
        asm volatile("s_waitcnt lgkmcnt(0)" ::: "memory"); __builtin_amdgcn_s_barrier(); asm volatile("" ::: "memory");
        const int tid = (wr * 4 + wc) * 64 + fq * 16 + fr;
        if (tid < 256) { const f32x4 p = *(const PG8_LAS f32x4*)(xch + tid * 4); ssq[(size_t)(u.pm * BM + tid) * 4 + u.pn] = (p[0] + p[1]) + (p[2] + p[3]); }
    }
};
struct EpiFF1 {
    static constexpr bool PERM = true, SWZ = true, AFTER_DRAIN = false;
    bf16_t* O; int ldc; const float* ssq; const float* bias; PG8_LAS unsigned char* stg;
    __device__ __forceinline__ void operator()(const f32x4 (&acc)[2][2][4][2], const Unit& u, int wr, int wc, int fr, int fq) const {
        const int rowb = u.pm * BM + wr * 64; const int colw = u.pn * BM + wc * 64; const int b = (u.pm * BM) >> 12;
        const float* bp = bias + (size_t)b * 4096 + colw + 8 * fq;
        f32x4 bv[2][2];
#pragma unroll
        for (int bj = 0; bj < 2; ++bj)
#pragma unroll
            for (int n = 0; n < 2; ++n) bv[bj][n] = *(const f32x4*)(bp + bj * 32 + 4 * n);
        PG8_LAS unsigned char* sw = stg + (wr * 4 + wc) * 2048;
        const int lane = fq * 16 + fr, rr = lane >> 3, cc = lane & 7;
        PG8_LAS unsigned char* wp = sw + fr * 128; const int wx = fr & 7;
        PG8_LAS unsigned char* rp = sw + rr * 128 + ((cc ^ (rr & 7)) << 4);
        bf16_t* gp = O + (size_t)(rowb + rr) * ldc + colw + cc * 8;
#pragma unroll
        for (int ai = 0; ai < 2; ++ai)
#pragma unroll
            for (int m = 0; m < 4; ++m) { const int row = rowb + ai * HALF + m * 16 + fr;
                const f32x4 p = *(const f32x4*)(ssq + (size_t)row * 4); const float r = __builtin_amdgcn_rsqf(((p[0] + p[1]) + (p[2] + p[3])) * (1.f / 1024.f) + 1e-6f);
#pragma unroll
                for (int bj = 0; bj < 2; ++bj) { f32x4 v0 = acc[ai][bj][m][0] * r + bv[bj][0], v1 = acc[ai][bj][m][1] * r + bv[bj][1];
#pragma unroll
                    for (int e = 0; e < 4; ++e) { const float a = fmaxf(v0[e], 0.f), c = fmaxf(v1[e], 0.f); v0[e] = a * a; v1[e] = c * c; }
                    u32x4 w; w.x = cvt_pk_bf16(v0[0], v0[1]); w.y = cvt_pk_bf16(v0[2], v0[3]); w.z = cvt_pk_bf16(v1[0], v1[1]); w.w = cvt_pk_bf16(v1[2], v1[3]);
                    *(PG8_LAS u32x4*)(wp + (((4 * bj + fq) ^ wx) << 4)) = w; }
                asm volatile("s_waitcnt lgkmcnt(0)" ::: "memory");
                const u32x4 o0 = *(const PG8_LAS u32x4*)rp, o1 = *(const PG8_LAS u32x4*)(rp + 1024);
                asm volatile("s_waitcnt lgkmcnt(0)" ::: "memory");
                bf16_t* g = gp + (size_t)(ai * HALF + m * 16) * ldc;
                *(u32x4*)g = o0; *(u32x4*)(g + (size_t)8 * ldc) = o1; }
    }
};
struct EpiInProj {
    static constexpr bool PERM = true, SWZ = true, AFTER_DRAIN = false;
    bf16_t* O; int ldc; const float* qkg  ; PG8_LAS unsigned char* stg  ;
    const float* ssq  ; const float* bias  ; float* gates  ; float* fgt  ;
    __device__ __forceinline__ void operator()(f32x4 (&acc)[2][2][4][2], const Unit& u, int wr, int wc, int fr, int fq) const {
        asm volatile("" : "+v"(fr), "+v"(fq));
        const int row0 = u.pm * BM + wr * 64 + fr; const int col0 = u.pn * BM + wc * 64 + 8 * fq;
        const int pn = u.pn; const bool nrm = (pn == 4) | (pn == 5) | (pn == 7) | (pn == 8);
        { const int b = (u.pm * BM) >> 12; const float* bp = bias + (size_t)b * 4096 + col0;
          f32x4 bv[2][2];
#pragma unroll
          for (int bj = 0; bj < 2; ++bj)
#pragma unroll
              for (int n = 0; n < 2; ++n) bv[bj][n] = *(const f32x4*)(bp + bj * 32 + 4 * n);
#pragma unroll
          for (int ai = 0; ai < 2; ++ai)
#pragma unroll
              for (int m = 0; m < 4; ++m) { const f32x4 p = *(const f32x4*)(ssq + (size_t)(row0 + ai * HALF + m * 16) * 4); const float r = __builtin_amdgcn_rsqf(((p[0] + p[1]) + (p[2] + p[3])) * (1.f / 1024.f) + 1e-6f);
#pragma unroll
                  for (int bj = 0; bj < 2; ++bj)
#pragma unroll
                      for (int n = 0; n < 2; ++n) acc[ai][bj][m][n] = acc[ai][bj][m][n] * r + bv[bj][n]; } }
        if (pn == 15) {
            int fq2 = fq; asm volatile("" : "+v"(fq2));
            if (wc == 0 && fq2 < 2) { const int b = (u.pm * BM) >> 12;
#pragma unroll
                for (int ai = 0; ai < 2; ++ai)
#pragma unroll
                    for (int m = 0; m < 4; ++m) { const int row = row0 + ai * HALF + m * 16; float* gp = gates + (size_t)row * 12 + 8 * fq2;
                        *(f32x4*)gp = acc[ai][0][m][0]; if (fq2 == 0) { *(f32x4*)(gp + 4) = acc[ai][0][m][1];
#pragma unroll
                            for (int e = 0; e < 4; ++e) fgt[(size_t)(b * 4 + e) * 4096 + (row & 4095)] = acc[ai][0][m][0][e]; } } }
            return;
        }
        PG8_LAS unsigned char* sw = stg + (wr * 4 + wc) * 2048;
        const int lane_ = fq * 16 + fr, rr_ = lane_ >> 3, cc_ = lane_ & 7;
        PG8_LAS unsigned char* wp_ = sw + fr * 128; const int wx_ = fr & 7;
        PG8_LAS unsigned char* rp_ = sw + rr_ * 128 + ((cc_ ^ (rr_ & 7)) << 4);
        bf16_t* gp_ = O + (size_t)(u.pm * BM + wr * 64 + rr_) * ldc + u.pn * BM + wc * 64 + cc_ * 8;
#define INPROJ_PUT(bj, w) (*(PG8_LAS u32x4*)(wp_ + (((4 * (bj) + fq) ^ wx_) << 4)) = (w))
#define INPROJ_FLUSH(ai, m) do { asm volatile("s_waitcnt lgkmcnt(0)" ::: "memory"); const u32x4 o0_ = *(const PG8_LAS u32x4*)rp_, o1_ = *(const PG8_LAS u32x4*)(rp_ + 1024); asm volatile("s_waitcnt lgkmcnt(0)" ::: "memory"); \
            bf16_t* g_ = gp_ + (size_t)((ai) * HALF + (m) * 16) * ldc; *(u32x4*)g_ = o0_; *(u32x4*)(g_ + (size_t)8 * ldc) = o1_; } while (0)
        if (!nrm) {
#pragma unroll
            for (int ai = 0; ai < 2; ++ai)
#pragma unroll
                for (int m = 0; m < 4; ++m) {
#pragma unroll
                    for (int bj = 0; bj < 2; ++bj) { const f32x4 v0 = acc[ai][bj][m][0], v1 = acc[ai][bj][m][1];
                        u32x4 w; w.x = cvt_pk_bf16(v0[0], v0[1]); w.y = cvt_pk_bf16(v0[2], v0[3]); w.z = cvt_pk_bf16(v1[0], v1[1]); w.w = cvt_pk_bf16(v1[2], v1[3]);
                        INPROJ_PUT(bj, w); }
                    INPROJ_FLUSH(ai, m); }
            return;
        }
        const bool wide = (pn >= 7);
        const float inv_n = wide ? (1.f / 64.f) : (1.f / 32.f);
        const float* gp = qkg + ((pn == 4) ? 0 : (pn == 5 ? 64 : (pn == 7 ? 128 : 192)));
        f32x4 gq[2][2];
#pragma unroll
        for (int bj = 0; bj < 2; ++bj) { const int gcol = (wide ? 32 * bj : 0) + 8 * fq; gq[bj][0] = *(const f32x4*)(gp + gcol); gq[bj][1] = *(const f32x4*)(gp + gcol + 4); }
#pragma unroll
        for (int ai = 0; ai < 2; ++ai)
#pragma unroll
            for (int m = 0; m < 4; ++m) { float sg[2];
#pragma unroll
                for (int bj = 0; bj < 2; ++bj) { const f32x4 a = acc[ai][bj][m][0], b = acc[ai][bj][m][1];
                    float s = (a[0] * a[0] + a[1] * a[1]) + (a[2] * a[2] + a[3] * a[3]) + (b[0] * b[0] + b[1] * b[1]) + (b[2] * b[2] + b[3] * b[3]);
                    s += __shfl_xor(s, 16); s += __shfl_xor(s, 32); sg[bj] = s; }
                const float tot = sg[0] + sg[1];
#pragma unroll
                for (int bj = 0; bj < 2; ++bj) { const float r = __builtin_amdgcn_rsqf((wide ? tot : sg[bj]) * inv_n + 1e-6f);
                    const f32x4 v0 = acc[ai][bj][m][0] * gq[bj][0] * r, v1 = acc[ai][bj][m][1] * gq[bj][1] * r;
                    u32x4 w; w.x = cvt_pk_bf16(v0[0], v0[1]); w.y = cvt_pk_bf16(v0[2], v0[3]); w.z = cvt_pk_bf16(v1[0], v1[1]); w.w = cvt_pk_bf16(v1[2], v1[3]);
                    INPROJ_PUT(bj, w); }
                INPROJ_FLUSH(ai, m); }
#undef INPROJ_PUT
#undef INPROJ_FLUSH
    }
};
template <class Epi, class Sched, bool ALIGN_EPI = false, bool SP2 = false>
__device__ __forceinline__ void gemm_phase(PG8_LAS unsigned char* lds, const Gemm g, const Sched& S, const Epi& E) {
    int tid_ = threadIdx.x; asm volatile("" : "+v"(tid_));
    const int tid = tid_, wid = __builtin_amdgcn_readfirstlane(tid >> 6), lane = tid & 63, wr = wid >> 2, wc = wid & 3, fr = lane & 15, fq = lane >> 4;
    const int K = g.K, nt = K / BK;
    unsigned voffA[2], voffB[2];
#pragma unroll
    for (int i = 0; i < 2; ++i) { int R, C; stage_rc(tid * 16 + i * 8192, R, C); const int Rb = Epi::SWZ ? ((R >> 5) * 64 + perm32(R & 31)) : Epi::PERM ? ((R & ~31) + perm32(R & 31)) : R;
        voffA[i] = (unsigned)(R * K + C) * 2u; voffB[i] = (unsigned)(Rb * K + C) * 2u; }
    const size_t kstep = (size_t)(BK * 2);
    const size_t hstep = (size_t)HALF * K * 2;
    const size_t hstepB = Epi::SWZ ? (size_t)32 * K * 2 : hstep;
    const size_t tstep = 2 * hstep;
    const unsigned ldsw = (unsigned)wid * 1024u;
    const int aoff = lds_byte(wr * 64 + fr, fq * 8), boff = lds_byte(wc * 32 + fr, fq * 8);
#define PG8_SA(b, h) (((b) * 2 + (h)) * HTB)
#define PG8_SB(b, h) ((4 + (b) * 2 + (h)) * HTB)
#define PG8_STAGE(bufoff, gbase, voff) do { _Pragma("unroll") for (int _i = 0; _i < 2; ++_i) \
        __builtin_amdgcn_global_load_lds((const unsigned*)((const char*)(gbase) + (voff)[_i]), (PG8_LAS unsigned*)(lds + (bufoff) + ldsw + _i * 8192), 16, 0, 0); } while (0)
#define PG8_LDA(dst, b, h) do { _Pragma("unroll") for (int m = 0; m < 4; ++m) _Pragma("unroll") for (int k = 0; k < 2; ++k) dst[m][k] = *(const PG8_LAS bf16x8*)(lds + PG8_SA(b, h) + aoff + m * 2048 + k * 1024); } while (0)
#define PG8_LDB(dst, b, h) do { _Pragma("unroll") for (int n = 0; n < 2; ++n) _Pragma("unroll") for (int k = 0; k < 2; ++k) dst[n][k] = *(const PG8_LAS bf16x8*)(lds + PG8_SB(b, h) + boff + n * 2048 + k * 1024); } while (0)
#define PG8_MMA(ai, bj, At, Bt) do { __builtin_amdgcn_s_setprio(1); _Pragma("unroll") for (int m = 0; m < 4; ++m) _Pragma("unroll") for (int n = 0; n < 2; ++n) _Pragma("unroll") for (int k = 0; k < 2; ++k) \
        acc[ai][bj][m][n] = __builtin_amdgcn_mfma_f32_16x16x32_bf16(Bt[n][k], At[m][k], acc[ai][bj][m][n], 0, 0, 0); __builtin_amdgcn_s_setprio(0); } while (0)
#define PG8_WAIT_V(n) asm volatile("s_waitcnt vmcnt(" #n ")" ::: "memory")
#define PG8_WAIT_L(n) asm volatile("s_waitcnt lgkmcnt(" #n ")" ::: "memory")
#define PG8_BAR __builtin_amdgcn_s_barrier()
#define PG8_SCHED __builtin_amdgcn_sched_barrier(0)
    Unit cur, nxt; int ui = 0;
    if (!S.next(0, cur)) return;
    f32x4 acc[2][2][4][2];
#pragma unroll
    for (int a = 0; a < 2; ++a)
#pragma unroll
        for (int b = 0; b < 2; ++b)
#pragma unroll
            for (int m = 0; m < 4; ++m)
#pragma unroll
                for (int n = 0; n < 2; ++n) acc[a][b][m][n] = (f32x4){0.f, 0.f, 0.f, 0.f};
    bf16x8 At[4][2], B0[2][2], B1[2][2];
    const char* cA = (const char*)g.A + (size_t)cur.pm * tstep; const char* cB = (const char*)g.Bt + (size_t)cur.pn * tstep;
    S.a_ready(cur);
    if constexpr (SP2) {
        PG8_STAGE(PG8_SB(0, 0), cB, voffB); PG8_STAGE(PG8_SB(0, 1), cB + hstepB, voffB); PG8_STAGE(PG8_SA(0, 0), cA, voffA); PG8_STAGE(PG8_SA(0, 1), cA + hstep, voffA);
        if (wr == 1) PG8_BAR;
        PG8_WAIT_V(2); PG8_BAR;
        PG8_STAGE(PG8_SB(1, 0), cB + kstep, voffB); PG8_STAGE(PG8_SA(1, 0), cA + kstep, voffA); PG8_STAGE(PG8_SB(1, 1), cB + hstepB + kstep, voffB);
        PG8_WAIT_V(6); PG8_BAR;
    } else {
        PG8_STAGE(PG8_SB(0, 0), cB, voffB); PG8_STAGE(PG8_SA(0, 0), cA, voffA); PG8_STAGE(PG8_SB(0, 1), cB + hstepB, voffB); PG8_STAGE(PG8_SA(0, 1), cA + hstep, voffA);
        if (wr == 1) PG8_BAR;
        PG8_WAIT_V(4); PG8_BAR;
        PG8_STAGE(PG8_SB(1, 0), cB + kstep, voffB); PG8_STAGE(PG8_SA(1, 0), cA + kstep, voffA); PG8_STAGE(PG8_SB(1, 1), cB + hstepB + kstep, voffB);
        PG8_WAIT_V(6); PG8_BAR;
    }
    for (;;) {
        const bool has_next = S.next(ui + 1, nxt);
        const char* nA = has_next ? (const char*)g.A + (size_t)nxt.pm * tstep : cA; const char* nB = has_next ? (const char*)g.Bt + (size_t)nxt.pn * tstep : cB;
        for (int t = 0; t < nt; t += 2) {
            const bool last = (t == nt - 2);
            const char* a1 = cA + (size_t)(t + 1) * kstep;
            const char* a2 = last ? nA : cA + (size_t)(t + 2) * kstep; const char* b2 = last ? nB : cB + (size_t)(t + 2) * kstep;
            const char* a3 = a2 + kstep; const char* b3 = b2 + kstep;
            if (last && has_next) S.a_ready(nxt);
            if constexpr (SP2) {
            PG8_LDB(B0, 0, 0); PG8_LDB(B1, 0, 1); PG8_SCHED; PG8_LDA(At, 0, 0); PG8_STAGE(PG8_SA(1, 1), a1 + hstep, voffA);
            PG8_WAIT_V(8); PG8_WAIT_L(0); PG8_BAR; PG8_MMA(0, 0, At, B0); PG8_MMA(0, 1, At, B1); PG8_BAR; PG8_SCHED;
            PG8_LDA(At, 0, 1); PG8_STAGE(PG8_SB(0, 0), b2, voffB); PG8_STAGE(PG8_SB(0, 1), b2 + hstepB, voffB); PG8_STAGE(PG8_SA(0, 0), a2, voffA);
            PG8_WAIT_V(8); PG8_WAIT_L(0); PG8_BAR; PG8_MMA(1, 0, At, B0); PG8_MMA(1, 1, At, B1); PG8_BAR; PG8_SCHED;
            PG8_LDB(B0, 1, 0); PG8_LDB(B1, 1, 1); PG8_SCHED; PG8_LDA(At, 1, 0); PG8_STAGE(PG8_SA(0, 1), a2 + hstep, voffA);
            PG8_WAIT_V(8); PG8_WAIT_L(0); PG8_BAR; PG8_MMA(0, 0, At, B0); PG8_MMA(0, 1, At, B1); PG8_BAR; PG8_SCHED;
            PG8_LDA(At, 1, 1); PG8_STAGE(PG8_SB(1, 0), b3, voffB); PG8_STAGE(PG8_SB(1, 1), b3 + hstepB, voffB); PG8_STAGE(PG8_SA(1, 0), a3, voffA);
            PG8_WAIT_V(8); PG8_WAIT_L(0); PG8_BAR; PG8_MMA(1, 0, At, B0); PG8_MMA(1, 1, At, B1); PG8_BAR; PG8_SCHED;
            } else {
            PG8_LDB(B0, 0, 0); PG8_SCHED; PG8_LDA(At, 0, 0); PG8_STAGE(PG8_SA(1, 1), a1 + hstep, voffA);
            PG8_WAIT_L(8); PG8_BAR; PG8_WAIT_L(0); PG8_MMA(0, 0, At, B0); PG8_BAR; PG8_SCHED;
            PG8_LDB(B1, 0, 1); PG8_STAGE(PG8_SB(0, 0), b2, voffB);
            PG8_BAR; PG8_WAIT_L(0); PG8_MMA(0, 1, At, B1); PG8_BAR;
            PG8_LDA(At, 0, 1); PG8_STAGE(PG8_SA(0, 0), a2, voffA);
            PG8_BAR; PG8_WAIT_L(0); PG8_MMA(1, 0, At, B0); PG8_BAR; PG8_SCHED;
            PG8_STAGE(PG8_SB(0, 1), b2 + hstepB, voffB);
            PG8_WAIT_V(6); PG8_BAR; PG8_MMA(1, 1, At, B1); PG8_BAR;
            PG8_LDB(B0, 1, 0); PG8_SCHED; PG8_LDA(At, 1, 0); PG8_STAGE(PG8_SA(0, 1), a2 + hstep, voffA);
            PG8_WAIT_L(8); PG8_BAR; PG8_WAIT_L(0); PG8_MMA(0, 0, At, B0); PG8_BAR; PG8_SCHED;
            PG8_LDB(B1, 1, 1); PG8_STAGE(PG8_SB(1, 0), b3, voffB);
            PG8_BAR; PG8_WAIT_L(0); PG8_MMA(0, 1, At, B1); PG8_BAR;
            PG8_LDA(At, 1, 1); PG8_STAGE(PG8_SA(1, 0), a3, voffA);
            PG8_BAR; PG8_WAIT_L(0); PG8_MMA(1, 0, At, B0); PG8_BAR; PG8_SCHED;
            PG8_STAGE(PG8_SB(1, 1), b3 + hstepB, voffB);
            PG8_WAIT_V(6); PG8_BAR; PG8_MMA(1, 1, At, B1); PG8_BAR;
            }
        }
        if constexpr (ALIGN_EPI) { if (wr == 0) PG8_BAR; }
        if constexpr (!Epi::AFTER_DRAIN) { E(acc, cur, wr, wc, fr, fq); S.done(cur); }
        if (!has_next) break;
#pragma unroll
        for (int a = 0; a < 2; ++a)
#pragma unroll
            for (int b = 0; b < 2; ++b)
#pragma unroll
                for (int m = 0; m < 4; ++m)
#pragma unroll
                    for (int n = 0; n < 2; ++n) acc[a][b][m][n] = (f32x4){0.f, 0.f, 0.f, 0.f};
        cur = nxt; cA = nA; cB = nB; ++ui;
        if constexpr (ALIGN_EPI) { if (wr == 1) PG8_BAR; }
    }
    PG8_WAIT_V(0);
    if constexpr (!ALIGN_EPI) { if (wr == 0) PG8_BAR; }
    PG8_BAR;
    if constexpr (Epi::AFTER_DRAIN) { E.fused(acc, cur, wr, wc, fr, fq, lds, wid, lane); S.done(cur); }
#undef PG8_SA
#undef PG8_SB
#undef PG8_STAGE
#undef PG8_LDA
#undef PG8_LDB
#undef PG8_MMA
#undef PG8_WAIT_V
#undef PG8_WAIT_L
#undef PG8_BAR
#undef PG8_SCHED
}
}
#define GAS __attribute__((address_space(1)))
#define LAS __attribute__((address_space(3)))
typedef unsigned short bf16;
typedef unsigned v4u __attribute__((ext_vector_type(4)));
typedef float f32x4 __attribute__((ext_vector_type(4)));
typedef short bf16x8 __attribute__((ext_vector_type(8)));
typedef GAS unsigned gu32;
typedef GAS unsigned long long gu64;
#define RLX_AGENT __ATOMIC_RELAXED, __HIP_MEMORY_SCOPE_AGENT
#define LDS_WAIT() asm volatile("s_waitcnt lgkmcnt(0)" ::: "memory")
#define VM_WAIT() asm volatile("s_waitcnt vmcnt(0)" ::: "memory")
__device__ __forceinline__ unsigned long long rt() { return __builtin_amdgcn_s_memrealtime(); }
__device__ __forceinline__ unsigned f2bf(float f) { unsigned u = __builtin_bit_cast(unsigned, f); return (u + 0x7fffu + ((u >> 16) & 1u)) >> 16; }
__device__ __forceinline__ unsigned pk2(float lo, float hi) { return f2bf(lo) | (f2bf(hi) << 16); }

#define XB_TMO      128
#define XB_XCNT(j)  (256  + 64 * (j))
#define XB_XSUB(j)  (1280 + 64 * (j))
#define XB_XGEN(j)  (2304 + 64 * (j))
#define XB_TOP      3328
#define XB_TOPGEN   3392
#define XCD_BAR_WORDS 3456
#define XB_SPIN_CAP (1u << 18)

__device__ __forceinline__ unsigned xb_ld(unsigned* p)              { return __hip_atomic_load(p, __ATOMIC_RELAXED, __HIP_MEMORY_SCOPE_AGENT); }
__device__ __forceinline__ unsigned xb_add(unsigned* p, unsigned v) { return __hip_atomic_fetch_add(p, v, __ATOMIC_RELAXED, __HIP_MEMORY_SCOPE_AGENT); }
__device__ __forceinline__ unsigned xb_xcc_id() { return (unsigned)__builtin_amdgcn_s_getreg((3 << 11) | 20) & 0xFu; }
#define XB_SPIN(cond, bar) do { unsigned _sp = 0; while (cond) { __builtin_amdgcn_s_sleep(1); \
    if ((++_sp & 255u) == 0u) { if (xb_ld(&(bar)[XB_TMO])) break; if (_sp > XB_SPIN_CAP) { atomicAdd(&(bar)[XB_TMO], 1u); break; } } } } while (0)

struct XcdBarrier {
    unsigned* bar; unsigned x;
    volatile LAS unsigned* st;
};

__device__ __forceinline__ XcdBarrier xcd_barrier_post(unsigned* bar, volatile LAS unsigned* st) {
    XcdBarrier b; b.bar = bar; b.x = xb_xcc_id(); b.st = st;
    if (threadIdx.x == 0) (void)xb_add(&bar[XB_XCNT(b.x)], 1u);
    return b;
}
__device__ __forceinline__ void xcd_barrier_complete(unsigned* bar, unsigned x, unsigned& nloc, unsigned& nx) {
    const unsigned G = gridDim.x * gridDim.y * gridDim.z;
    unsigned sum, cnt, mine, sp = 0u;
    for (;;) {
        sum = 0u; cnt = 0u; mine = 0u;
#pragma unroll
        for (unsigned j = 0; j < 16; ++j) { const unsigned c = xb_ld(&bar[XB_XCNT(j)]); sum += c; cnt += (c > 0u) ? 1u : 0u; mine = (j == x) ? c : mine; }
        if (sum == G) break;
        __builtin_amdgcn_s_sleep(1);
        if ((++sp & 255u) == 0u) { if (xb_ld(&bar[XB_TMO])) break; if (sp > XB_SPIN_CAP) { atomicAdd(&bar[XB_TMO], 1u); break; } }
    }
    nloc = mine > 0u ? mine : 1u; nx = cnt > 0u ? cnt : 1u;
}

__device__ __forceinline__ void xcd_barrier(const XcdBarrier& b) {
    asm volatile("s_waitcnt vmcnt(0)" ::: "memory");
    __syncthreads();
    if (threadIdx.x == 0) {
        unsigned* bar = b.bar;
        __builtin_amdgcn_s_waitcnt(0);
        unsigned nloc = b.st[0], nx = b.st[1];
        if (nloc == 0u) { xcd_barrier_complete(bar, b.x, nloc, nx); b.st[0] = nloc; b.st[1] = nx; }
        const unsigned old = xb_add(&bar[XB_XSUB(b.x)], 1u);
        const unsigned gen = old / nloc;
        if (old + 1u == (gen + 1u) * nloc) {
            __builtin_amdgcn_fence(__ATOMIC_RELEASE, "agent");
            asm volatile("s_waitcnt vmcnt(0)" ::: "memory");
            const unsigned og = xb_add(&bar[XB_TOP], 1u);
            const unsigned tg = og / nx;
            if (og + 1u == (tg + 1u) * nx) xb_add(&bar[XB_TOPGEN], 1u);
            else XB_SPIN(xb_ld(&bar[XB_TOPGEN]) == tg, bar);
            __builtin_amdgcn_fence(__ATOMIC_ACQUIRE, "agent");
            xb_add(&bar[XB_XGEN(b.x)], 1u);
            asm volatile("s_waitcnt vmcnt(0)" ::: "memory");
        } else {
            XB_SPIN(xb_ld(&bar[XB_XGEN(b.x)]) == gen, bar);
            __builtin_amdgcn_fence(__ATOMIC_ACQUIRE, "agent");
            asm volatile("s_waitcnt vmcnt(0)" ::: "memory");
        }
    }
    __syncthreads();
}
constexpr int NWAVES = 8;
constexpr int BATCH = 8, SEQ = 4096, D = 1024, FF = 4096, DEPTH = 2, T = BATCH * SEQ, NH = 4, HD = 64;
constexpr int INC = 3852, ZP = 3840, NMOD = 6 * D;
constexpr float EPS = 1e-6f;
constexpr int ZC_HQ = 0, ZC_HF = 256, ZC_HI = 512, ZC_HG = 768, ZC_DQ = 1024, ZC_DK = 1280, ZC_DV = 1536, ZC_FQ = 1792, ZC_FK = 2048, ZC_FV = 2304, ZC_FG = 2560, ZC_MQ = 2816, ZC_MK = 3072, ZC_MV = 3328, ZC_MO = 3584;
constexpr size_t MiB = 1u << 20;
constexpr size_t WS_CTL = 0, CTL_ZERO_BYTES = 1 * MiB;
constexpr size_t WS_MOD = 1 * MiB;
constexpr size_t WS_WG = 1 * MiB + 512 * 1024;
constexpr size_t WS_QKG = 1 * MiB + 768 * 1024;
constexpr size_t WS_SMAX = 1 * MiB + 896 * 1024;
constexpr size_t WS_SCHED = 1 * MiB + 904 * 1024;
constexpr size_t WS_KST = 1 * MiB + 900 * 1024;
constexpr size_t WS_FGT = 3 * MiB + 512 * 1024;
constexpr size_t WS_GATES = 2 * MiB;
constexpr size_t WS_FCUM = 4 * MiB;
constexpr size_t WS_GM1 = 4 * MiB + 768 * 1024;
constexpr size_t WS_BIAS1 = 7 * MiB;
constexpr size_t WS_SS1 = 6 * MiB + 512 * 1024;
constexpr size_t WS_GM2 = 4 * MiB + 512 * 1024;
constexpr size_t WS_BIAS2 = 5 * MiB;
constexpr size_t WS_SSQ = 6 * MiB;
constexpr size_t WS_WIN = 8 * MiB, WS_WOUT = 24 * MiB, WS_W1 = 28 * MiB, WS_W2 = 44 * MiB;
constexpr size_t WS_HN = 64 * MiB;
constexpr size_t WS_Z = 128 * MiB;
constexpr size_t WS_H = 128 * MiB;
constexpr size_t WS_XB = 384 * MiB;
constexpr size_t WS_Y = 448 * MiB;
constexpr size_t WS_DECH = 7 * MiB + 512 * 1024, WS_DECM = 7 * MiB + 800 * 1024;
constexpr size_t WS_END = 512 * MiB;
constexpr size_t WS_IMGH = WS_HN, WS_IMGM = WS_HN + 16 * MiB;
static_assert(16 * MiB + (size_t)32 * 32 * 4160 * 4 <= 64 * MiB, "state images fit HN");
static_assert(WS_Z + (size_t)T * ZP * 2 <= WS_XB && WS_H + (size_t)T * FF * 2 <= WS_XB && WS_XB + (size_t)T * D * 2 <= WS_Y && WS_Y + (size_t)T * D * 2 <= WS_END, "ws map");
constexpr int CW_TMO = 0, CW_BAR = 4096;
constexpr int RING_OFF = 0, RING_BYTES = 131072, LDS_BYTES = 152576, LDSCTL_OFF = LDS_BYTES - 1024, MISC_OFF = LDSCTL_OFF + 320, XCH_OFF = RING_BYTES;
constexpr float LOG2E = 1.4426950408889634f;
static_assert(XCH_OFF + 256 * 8 * 4 <= LDSCTL_OFF && XCH_OFF + 4096 + 8 * 2048 <= LDSCTL_OFF, "exchange / store-staging area");
constexpr int PH_PRO = 0, PH_PER_LAYER = 8, NPH = 1 + 2 * PH_PER_LAYER;
constexpr int PL_NORM1 = 0, PL_INPROJ = 1, PL_MIXA = 2, PL_MIXB = 3, PL_MIXC = 4, PL_OUTPROJ = 5, PL_FF1 = 6, PL_FF2 = 7;

struct Frame {
    LAS unsigned char* lds; volatile LAS unsigned* MISC; gu32* ctl;
    int tid, lane, wave, vcu, G;
};
__device__ __forceinline__ float wave_sum(float v) {
#pragma unroll
    for (int o = 1; o < 64; o <<= 1) v += __shfl_xor(v, o);
    return v;
}
__device__ __forceinline__ float bf2f(bf16 v) { return __builtin_bit_cast(float, (unsigned)v << 16); }
__device__ __forceinline__ float sigmoidf_(float x) { return 1.f / (1.f + __expf(-x)); }
__device__ __forceinline__ float logsigmoidf_(float x) { return fminf(x, 0.f) - log1pf(expf(-fabsf(x))); }

__device__ __forceinline__ void p0_transpose_item(const float* W, int K, int pitch, int nblk, bf16* WT, LAS float* scr, int item, int lane) {
    const int kb = item / nblk, nb = item % nblk, k0 = 64 * kb, n0 = 32 * nb;
    float v_[32];
#pragma unroll
    for (int i = 0; i < 32; ++i) v_[i] = W[(size_t)(k0 + 2 * i + (lane >> 5)) * pitch + n0 + (lane & 31)];
#pragma unroll
    for (int i = 0; i < 32; ++i) scr[(2 * i + (lane >> 5)) * 33 + (lane & 31)] = v_[i];
    LDS_WAIT(); asm volatile("" ::: "memory");
    const int c = lane & 7;
#pragma unroll
    for (int j = 0; j < 4; ++j) { const int n = (lane >> 3) + 8 * j; const LAS float* s = scr + (8 * c) * 33 + n;
        v4u o; o.x = pk2(s[0 * 33], s[1 * 33]); o.y = pk2(s[2 * 33], s[3 * 33]); o.z = pk2(s[4 * 33], s[5 * 33]); o.w = pk2(s[6 * 33], s[7 * 33]);
        *(GAS v4u*)(WT + (size_t)(n0 + n) * K + k0 + 8 * c) = o; }
    LDS_WAIT(); asm volatile("" ::: "memory");
}

struct Args { const float* in[22]; float* out; unsigned char* ws; int ph_lo, ph_hi, li, pad; };

__device__ __forceinline__ void p0_transposes(Frame& F0, const Args& A, int it0, int it1, int gw, int NGW) {
    Frame F = F0; { int t_ = threadIdx.x; asm volatile("" : "+v"(t_)); F.tid = t_; F.lane = t_ & 63; }
    unsigned char* ws = A.ws; const float* w_in = A.in[6];
    LAS float* scr = (LAS float*)(F.lds + RING_OFF + F.wave * 16384);
    constexpr int I_A = 16 * 88, I_B = 16 * 32, I_O = 16 * 32, I_1 = 16 * 128, I_2 = 64 * 32, I_L = I_A + I_B + I_O + I_1 + I_2;
    bf16* Win_t = (bf16*)(ws + WS_WIN); bf16* Wout_t = (bf16*)(ws + WS_WOUT); bf16* W1_t = (bf16*)(ws + WS_W1); bf16* W2_t = (bf16*)(ws + WS_W2);
    for (int it = it0 + gw; it < it1; it += NGW) {
        const int l = it / I_L; int r = it % I_L;
        if (r < I_A) { p0_transpose_item(w_in + (size_t)l * 1024 * INC, 1024, INC, 88, Win_t + (size_t)l * 4096 * 1024, scr, r, F.lane); continue; } r -= I_A;
        if (r < I_B) { p0_transpose_item(w_in + (size_t)l * 1024 * INC + 2820, 1024, INC, 32, Win_t + (size_t)l * 4096 * 1024 + (size_t)2816 * 1024, scr, r, F.lane); continue; } r -= I_B;
        if (r < I_O) { p0_transpose_item(A.in[7] + (size_t)l * 1024 * 1024, 1024, 1024, 32, Wout_t + (size_t)l * 1024 * 1024, scr, r, F.lane); continue; } r -= I_O;
        if (r < I_1) { p0_transpose_item(A.in[20] + (size_t)l * 1024 * 4096, 1024, 4096, 128, W1_t + (size_t)l * 4096 * 1024, scr, r, F.lane); continue; } r -= I_1;
        p0_transpose_item(A.in[21] + (size_t)l * 4096 * 1024, 4096, 1024, 32, W2_t + (size_t)l * 1024 * 4096, scr, r, F.lane);
    }
}
constexpr int TR_ITEMS_L = 16 * 88 + 16 * 32 + 16 * 32 + 16 * 128 + 64 * 32;


__device__ __forceinline__ void p0_prologue(Frame& F0, const Args& A) {
    Frame F = F0; { int t_ = threadIdx.x; asm volatile("" : "+v"(t_)); F.tid = t_; F.lane = t_ & 63; }
    unsigned char* ws = A.ws;
    const float* c_in = A.in[1]; const float* w_ada = A.in[2]; const float* b_ada = A.in[3]; const float* w_in = A.in[6];
    float* mod = (float*)(ws + WS_MOD); float* wg = (float*)(ws + WS_WG);
    {
        LAS float* cact = (LAS float*)(F.lds); LAS float* red = (LAS float*)(F.lds + 32768);
        bool staged = false;
        for (int unit = blockIdx.x; unit < 192; unit += F.G) {
            if (!staged) { for (int i = F.tid; i < 8192; i += NWAVES * 64) { const int b = i >> 10, k = i & 1023; const float v = c_in[b * 1024 + k]; cact[k * 8 + b] = v / (1.f + expf(-v)); } staged = true; }
            __syncthreads();
            const int l = unit / 96, n0 = (unit % 96) * 64;
            const float* W = w_ada + (size_t)l * 1024 * NMOD + n0 + F.lane;
            float acc[8];
#pragma unroll
            for (int b = 0; b < 8; ++b) acc[b] = 0.f;
            const int k0 = F.wave * 128;
#pragma unroll 32
            for (int kk = 0; kk < 128; ++kk) { const int k = k0 + kk; const float w = W[(size_t)k * NMOD];
                const f32x4 c0 = *(const LAS f32x4*)(cact + k * 8), c1 = *(const LAS f32x4*)(cact + k * 8 + 4);
                acc[0] += w * c0[0]; acc[1] += w * c0[1]; acc[2] += w * c0[2]; acc[3] += w * c0[3]; acc[4] += w * c1[0]; acc[5] += w * c1[1]; acc[6] += w * c1[2]; acc[7] += w * c1[3]; }
#pragma unroll
            for (int b = 0; b < 8; ++b) red[(F.wave * 8 + b) * 64 + F.lane] = acc[b];
            __syncthreads();
            { const int b = F.tid >> 6, col = F.tid & 63; float s = b_ada[l * NMOD + n0 + col];
#pragma unroll
              for (int w = 0; w < 8; ++w) s += red[(w * 8 + b) * 64 + col];
              mod[(size_t)(l * 8 + b) * NMOD + n0 + col] = s;
              if (n0 >= 1 * D && n0 < 2 * D) ((float*)(ws + WS_GM1))[(size_t)(l * 8 + b) * D + (n0 - 1 * D) + col] = A.in[4][l * D + (n0 - 1 * D) + col] * (1.f + s);
              if (n0 >= 4 * D && n0 < 5 * D) ((float*)(ws + WS_GM2))[(size_t)(l * 8 + b) * D + (n0 - 4 * D) + col] = A.in[5][l * D + (n0 - 4 * D) + col] * (1.f + s); }
            __syncthreads();
        }
    }
    __syncthreads();
    for (int idx = blockIdx.x * (NWAVES * 64) + F.tid; idx < 2 * 12 * 1024; idx += F.G * NWAVES * 64) {
        const int l = idx / 12288, r = idx % 12288, j = r >> 10, k = r & 1023;
        const int col = (j < 4) ? 2816 + j : (j < 8 ? 3844 + (j - 4) : 3848 + (j - 8));
        const float wv = w_in[(size_t)l * 1024 * INC + (size_t)k * INC + col]; wg[idx] = wv;
        ((bf16*)(ws + WS_WIN))[(size_t)l * 4096 * 1024 + (size_t)(3840 + j) * 1024 + k] = (bf16)f2bf(wv);
    }
    for (int idx = blockIdx.x * (NWAVES * 64) + F.tid; idx < 2 * 244 * 1024 / 8; idx += F.G * NWAVES * 64) {
        const int l = idx / (244 * 128), r = idx % (244 * 128);
        ((GAS v4u*)((bf16*)(ws + WS_WIN) + (size_t)l * 4096 * 1024 + (size_t)3852 * 1024))[r] = (v4u){0u, 0u, 0u, 0u};
    }
    if (blockIdx.x == F.G - 1 && F.tid < 2 * 4 * 64) {
        const int l = F.tid >> 8, k = (F.tid >> 6) & 3, d = F.tid & 63; float v;
        if (k == 0) v = A.in[10][l * 32 + (d & 31)] * (0.17677669529663687f * LOG2E);
        else if (k == 1) v = A.in[11][l * 32 + (d & 31)];
        else if (k == 2) v = A.in[14][l * 64 + d] * (0.125f * LOG2E);
        else v = A.in[15][l * 64 + d];
        ((float*)(ws + WS_QKG))[F.tid] = v;
    }
    if (blockIdx.x == F.G - 2 && F.tid < 4) {
        const int l = F.tid >> 1, k = F.tid & 1; float mq = 0.f, mk = 0.f;
        if (k == 0) { for (int d = 0; d < 64; ++d) { mq = fmaxf(mq, fabsf(A.in[14][l * 64 + d])); mk = fmaxf(mk, fabsf(A.in[15][l * 64 + d])); } }
        else { for (int d = 0; d < 32; ++d) { mq = fmaxf(mq, fabsf(A.in[10][l * 32 + d])); mk = fmaxf(mk, fabsf(A.in[11][l * 32 + d])); } }
        ((float*)(ws + WS_SMAX))[F.tid] = (k == 0 ? 8.0f : 5.656854249f) * LOG2E * mq * mk * 1.02f + 0.5f;
    }
    if (F.G == 256) { constexpr int N1 = 192 * NWAVES * 6;
        if (blockIdx.x < 192) p0_transposes(F, A, 0, N1, (int)blockIdx.x * NWAVES + F.wave, 192 * NWAVES);
        else p0_transposes(F, A, N1, 2 * TR_ITEMS_L, ((int)blockIdx.x - 192) * NWAVES + F.wave, 64 * NWAVES); }
    else p0_transposes(F, A, 0, 2 * TR_ITEMS_L, F.vcu * NWAVES + F.wave, F.G * NWAVES);
}

__device__ __forceinline__ void norm_phase(Frame& F0, const float* xsrc, const float* gain, const float* modl, int shift_slot, bf16* hn, const float* wg, float* gates, float* fgt) {
    Frame F = F0; { int t_ = threadIdx.x; asm volatile("" : "+v"(t_)); F.tid = t_; F.lane = t_ & 63; }
    LAS float* wgl = (LAS float*)(F.lds);
    if (wg) { for (int i = F.tid; i < 12 * 1024 / 4; i += NWAVES * 64) ((LAS f32x4*)wgl)[i] = ((const GAS f32x4*)wg)[i]; }
    __syncthreads();
    const int gw = F.vcu * NWAVES + F.wave, NGW = F.G * NWAVES;
    for (int m0 = gw * 16; m0 < T; m0 += NGW * 16) {
        const int b = m0 >> 12;
        f32x4 gm[4], sh[4];
        { const GAS f32x4* g4 = (const GAS f32x4*)gain + F.lane;
          const GAS f32x4* sh4 = (const GAS f32x4*)(modl + (size_t)b * NMOD + shift_slot * D) + F.lane;
          const GAS f32x4* sc4 = (const GAS f32x4*)(modl + (size_t)b * NMOD + (shift_slot + 1) * D) + F.lane;
#pragma unroll
          for (int j = 0; j < 4; ++j) { gm[j] = g4[64 * j] * (sc4[64 * j] + 1.0f); sh[j] = sh4[64 * j]; } }
#pragma unroll 1
        for (int rb = 0; rb < 16; rb += 4) {
            f32x4 v[4][4]; float s[4];
#pragma unroll
            for (int r = 0; r < 4; ++r) { const GAS f32x4* xr = (const GAS f32x4*)(xsrc + (size_t)(m0 + rb + r) * D) + F.lane;
#pragma unroll
                for (int j = 0; j < 4; ++j) v[r][j] = xr[64 * j]; }
#pragma unroll
            for (int r = 0; r < 4; ++r) { float a = 0.f;
#pragma unroll
                for (int j = 0; j < 4; ++j) a += (v[r][j].x * v[r][j].x + v[r][j].y * v[r][j].y) + (v[r][j].z * v[r][j].z + v[r][j].w * v[r][j].w);
                s[r] = a; }
#pragma unroll
            for (int o = 1; o < 64; o <<= 1) {
#pragma unroll
                for (int r = 0; r < 4; ++r) s[r] += __shfl_xor(s[r], o); }
#pragma unroll
            for (int r = 0; r < 4; ++r) { const float rstd = __builtin_amdgcn_rsqf(s[r] * (1.f / D) + EPS);
                GAS unsigned long long* o8 = (GAS unsigned long long*)(hn + (size_t)(m0 + rb + r) * D) + F.lane;
#pragma unroll
                for (int j = 0; j < 4; ++j) { v[r][j] = (v[r][j] * rstd) * gm[j] + sh[j];
                    o8[64 * j] = (unsigned long long)pk2(v[r][j].x, v[r][j].y) | ((unsigned long long)pk2(v[r][j].z, v[r][j].w) << 32); } }
            if (wg) {
                float mine[4] = {0.f, 0.f, 0.f, 0.f};
#pragma unroll 1
                for (int g = 0; g < 12; ++g) { float d[4] = {0.f, 0.f, 0.f, 0.f};
#pragma unroll
                    for (int j = 0; j < 4; ++j) { const f32x4 w = ((const LAS f32x4*)(wgl + g * 1024))[F.lane + 64 * j];
#pragma unroll
                        for (int r = 0; r < 4; ++r) d[r] += (v[r][j].x * w.x + v[r][j].y * w.y) + (v[r][j].z * w.z + v[r][j].w * w.w); }
#pragma unroll
                    for (int o = 1; o < 64; o <<= 1) {
#pragma unroll
                        for (int r = 0; r < 4; ++r) d[r] += __shfl_xor(d[r], o); }
#pragma unroll
                    for (int r = 0; r < 4; ++r) mine[r] = (F.lane == g) ? d[r] : mine[r]; }
                if (F.lane < 12) {
#pragma unroll
                    for (int r = 0; r < 4; ++r) gates[(size_t)(m0 + rb + r) * 12 + F.lane] = mine[r]; }
                if (F.lane < 4) {
#pragma unroll
                    for (int r = 0; r < 4; ++r) fgt[(size_t)(b * NH + F.lane) * SEQ + ((m0 + rb + r) & (SEQ - 1))] = mine[r]; }
            }
        }
    }
}
__device__ __forceinline__ void fox_scan_wave(const float* fgt, const float* fbias, float* Fcum, int* kst, float smax, int bh, int lane_) {
    int lane = lane_; asm volatile("" : "+v"(lane));
    const int h = bh & 3; const float fb = fbias[h]; const GAS f32x4* g4 = (const GAS f32x4*)(fgt + (size_t)bh * SEQ + lane * 64);
    f32x4 lf[16]; float s = 0.f;
#pragma unroll
    for (int i = 0; i < 16; ++i) lf[i] = g4[i];
#pragma unroll
    for (int i = 0; i < 16; ++i) {
#pragma unroll
        for (int e = 0; e < 4; ++e) { lf[i][e] = logsigmoidf_(lf[i][e] + fb); s += lf[i][e]; } }
    float incl = s;
#pragma unroll
    for (int o = 1; o < 64; o <<= 1) { const float v = __shfl_up(incl, o); if (lane >= o) incl += v; }
    float run = incl - s; GAS f32x4* Fo = (GAS f32x4*)(Fcum + (size_t)bh * SEQ + lane * 64); float ffirst = 0.f;
#pragma unroll
    for (int i = 0; i < 16; ++i) { f32x4 o4;
#pragma unroll
        for (int e = 0; e < 4; ++e) { run += lf[i][e]; o4[e] = run; if (i == 0 && e == 0) ffirst = run; }
        Fo[i] = o4; }
    const float blast = -run * LOG2E;
    for (int qb = 0; qb < 16; ++qb) { const float bq0 = -__shfl(ffirst, 4 * qb) * LOG2E;
        const unsigned long long m = __ballot(blast < bq0 - 152.0f - 2.0f * smax);
        int ks = (int)__builtin_ctzll(~m); const int nt = 4 * qb + 4; ks = ks < nt - 4 ? ks : nt - 4; ks &= ~1;
        if (lane == 0) kst[bh * 16 + qb] = ks; }
}

__device__ __forceinline__ void fox_scan_block(const float* fgt, const float* fbias, float* Fcum, int* kst, float smax, int bh, LAS unsigned char* lds) {
    int tid_ = threadIdx.x; asm volatile("" : "+v"(tid_)); const int tid = tid_, lane = tid & 63, wave = tid >> 6;
    LAS float* Fl = (LAS float*)lds; LAS float* part = Fl + SEQ;
    const int h = bh & 3; const float fb = fbias[h];
    const GAS f32x4* g4 = (const GAS f32x4*)(fgt + (size_t)bh * SEQ + tid * 8);
    const f32x4 a = g4[0], b = g4[1];
    float v[8] = {a[0], a[1], a[2], a[3], b[0], b[1], b[2], b[3]}; float s = 0.f;
#pragma unroll
    for (int e = 0; e < 8; ++e) { s += logsigmoidf_(v[e] + fb); v[e] = s; }
    float incl = s;
#pragma unroll
    for (int o = 1; o < 64; o <<= 1) { const float t = __shfl_up(incl, o); if (lane >= o) incl += t; }
    if (lane == 63) part[wave] = incl;
    __syncthreads();
    float base = incl - s;
    for (int w = 0; w < wave; ++w) base += part[w];
    f32x4 o0, o1;
#pragma unroll
    for (int e = 0; e < 4; ++e) { o0[e] = base + v[e]; o1[e] = base + v[4 + e]; }
    GAS f32x4* Fo = (GAS f32x4*)(Fcum + (size_t)bh * SEQ + tid * 8); Fo[0] = o0; Fo[1] = o1;
    *(LAS f32x4*)(Fl + tid * 8) = o0; *(LAS f32x4*)(Fl + tid * 8 + 4) = o1;
    __syncthreads();
    if (wave == 0) {
        const float blast = -Fl[64 * lane + 63] * LOG2E;
        for (int qb = 0; qb < 16; ++qb) { const float bq0 = -Fl[256 * qb] * LOG2E;
            const unsigned long long m = __ballot(blast < bq0 - 152.0f - 2.0f * smax);
            int ks = (int)__builtin_ctzll(~m); const int nt = 4 * qb + 4; ks = ks < nt - 4 ? ks : nt - 4; ks &= ~1;
            if (lane == 0) kst[bh * 16 + qb] = ks; }
    }
    __syncthreads();
}

__device__ __forceinline__ void bias_gemv(Frame& F0, const bf16* Wt, int N, const float* shift, int sstride, float* out) {
    Frame F = F0; { int t_ = threadIdx.x; asm volatile("" : "+v"(t_)); F.tid = t_; F.lane = t_ & 63; }
    LAS float* sl = (LAS float*)(F.lds);
    __syncthreads();
    for (int i = F.tid; i < 8 * 1024; i += NWAVES * 64) sl[i] = shift[(size_t)(i >> 10) * sstride + (i & 1023)];
    __syncthreads();
    const int gw = F.vcu * NWAVES + F.wave, NGW = F.G * NWAVES;
    for (int n = gw; n < N; n += NGW) {
        float w[16];
#pragma unroll
        for (int j = 0; j < 4; ++j) { const unsigned long long q = *(const GAS unsigned long long*)(Wt + (size_t)n * 1024 + 256 * j + F.lane * 4);
#pragma unroll
            for (int e = 0; e < 4; ++e) w[j * 4 + e] = __builtin_bit_cast(float, (unsigned)((q >> (16 * e)) & 0xffffu) << 16); }
        float mine = 0.f;
#pragma unroll 1
        for (int b = 0; b < 8; ++b) { float d = 0.f;
#pragma unroll
            for (int j = 0; j < 4; ++j) { const f32x4 s4 = *(const LAS f32x4*)(sl + b * 1024 + 256 * j + F.lane * 4); d += (w[j * 4] * s4[0] + w[j * 4 + 1] * s4[1]) + (w[j * 4 + 2] * s4[2] + w[j * 4 + 3] * s4[3]); }
            d = wave_sum(d); mine = (F.lane == b) ? d : mine; }
        if (F.lane < 8) out[(size_t)F.lane * N + n] = mine;
    }
    __syncthreads();
}

__device__ __forceinline__ void prenorm0_phase(Frame& F0, const float* xsrc, const float* gm, bf16* hn, float* ss) {
    Frame F = F0; { int t_ = threadIdx.x; asm volatile("" : "+v"(t_)); F.tid = t_; F.lane = t_ & 63; }
    const int gw = F.vcu * NWAVES + F.wave, NGW = F.G * NWAVES;
    for (int m0 = gw * 16; m0 < T; m0 += NGW * 16) {
        const int b = m0 >> 12; f32x4 g[4];
        { const GAS f32x4* g4 = (const GAS f32x4*)(gm + (size_t)b * D) + F.lane;
#pragma unroll
          for (int j = 0; j < 4; ++j) g[j] = g4[64 * j]; }
#pragma unroll 1
        for (int rb = 0; rb < 16; rb += 4) {
            f32x4 v[4][4]; float s[4];
#pragma unroll
            for (int r = 0; r < 4; ++r) { const GAS f32x4* xr = (const GAS f32x4*)(xsrc + (size_t)(m0 + rb + r) * D) + F.lane;
#pragma unroll
                for (int j = 0; j < 4; ++j) v[r][j] = xr[64 * j]; }
#pragma unroll
            for (int r = 0; r < 4; ++r) { float a = 0.f;
#pragma unroll
                for (int j = 0; j < 4; ++j) a += (v[r][j].x * v[r][j].x + v[r][j].y * v[r][j].y) + (v[r][j].z * v[r][j].z + v[r][j].w * v[r][j].w);
                s[r] = a;
                GAS unsigned long long* o8 = (GAS unsigned long long*)(hn + (size_t)(m0 + rb + r) * D) + F.lane;
#pragma unroll
                for (int j = 0; j < 4; ++j) { const f32x4 a4 = v[r][j] * g[j]; o8[64 * j] = (unsigned long long)pk2(a4.x, a4.y) | ((unsigned long long)pk2(a4.z, a4.w) << 32); } }
#pragma unroll
            for (int o = 1; o < 64; o <<= 1) {
#pragma unroll
                for (int r = 0; r < 4; ++r) s[r] += __shfl_xor(s[r], o); }
            if (F.lane < 4) { const float mine = (F.lane == 0) ? s[0] : (F.lane == 1 ? s[1] : (F.lane == 2 ? s[2] : s[3]));
                *(GAS f32x4*)(ss + (size_t)(m0 + rb + F.lane) * 4) = (f32x4){mine, 0.f, 0.f, 0.f}; }
        }
    }
}

__device__ __forceinline__ void bias_all(Frame& F0, const bf16* Win_t, const bf16* W1_t, const float* mod, float* bias1, float* bias2) {
    Frame F = F0; { int t_ = threadIdx.x; asm volatile("" : "+v"(t_)); F.tid = t_; F.lane = t_ & 63; }
    LAS float* sl = (LAS float*)(F.lds);
    __syncthreads();
    for (int i = F.tid; i < 4 * 8192; i += NWAVES * 64) { const int set = i >> 13, l = set & 1, slot = (set >> 1) ? 3 : 0, b = (i >> 10) & 7, k = i & 1023;
        sl[i] = mod[(size_t)(l * 8 + b) * NMOD + slot * 1024 + k]; }
    __syncthreads();
    const int gw = F.vcu * NWAVES + F.wave, NGW = F.G * NWAVES;
    for (int r = gw; r < 4 * 4096; r += NGW) {
        const int set = r >> 12, n = r & 4095, l = set & 1;
        const bf16* wrow = ((set >> 1) ? W1_t : Win_t) + (size_t)(l * 4096 + n) * 1024; float* out = ((set >> 1) ? bias2 : bias1) + (size_t)l * 8 * 4096;
        float w[16];
#pragma unroll
        for (int j = 0; j < 4; ++j) { const unsigned long long q = *(const GAS unsigned long long*)(wrow + 256 * j + F.lane * 4);
#pragma unroll
            for (int e = 0; e < 4; ++e) w[j * 4 + e] = __builtin_bit_cast(float, (unsigned)((q >> (16 * e)) & 0xffffu) << 16); }
        float d[8];
#pragma unroll
        for (int b = 0; b < 8; ++b) { float a = 0.f;
#pragma unroll
            for (int j = 0; j < 4; ++j) { const f32x4 s4 = *(const LAS f32x4*)(sl + set * 8192 + b * 1024 + 256 * j + F.lane * 4); a += (w[j * 4] * s4[0] + w[j * 4 + 1] * s4[1]) + (w[j * 4 + 2] * s4[2] + w[j * 4 + 3] * s4[3]); }
            d[b] = a; }
#pragma unroll
        for (int o = 1; o < 64; o <<= 1) {
#pragma unroll
            for (int b = 0; b < 8; ++b) d[b] += __shfl_xor(d[b], o); }
        float mine = d[0];
#pragma unroll
        for (int b = 1; b < 8; ++b) mine = (F.lane == b) ? d[b] : mine;
        if (F.lane < 8) out[(size_t)F.lane * 4096 + n] = mine;
    }
    __syncthreads();
}
namespace att {
using bf16x8 = __attribute__((ext_vector_type(8))) short;
using s16x4 = __attribute__((ext_vector_type(4))) short;
using f32x16 = __attribute__((ext_vector_type(16))) float;
using f32x4v = __attribute__((ext_vector_type(4))) float;
using u32x4 = __attribute__((ext_vector_type(4))) unsigned;
constexpr int NW = 8, QBLK = 32, QB = QBLK * NW, KVBLK = 64, NQB = SEQ / QB, PITCH = ZP;
constexpr int SLOTB = 8192, LDS_K = 0, LDS_V = 3 * SLOTB, LDS_WS = 6 * SLOTB, LDS_OST = LDS_WS + NW * 256, LDS_TBL = LDS_OST + NW * 8192, LDS_END = LDS_TBL + SEQ * 4 + 256;
static_assert(LDS_END <= LDSCTL_OFF, "attention LDS map");
constexpr int THR = 48;
#define SBAR() __builtin_amdgcn_sched_barrier(0)
#define PIN(x) asm volatile("" : "+v"(x))
#define MFMA(a, b, c) __builtin_amdgcn_mfma_f32_32x32x16_bf16(a, b, c, 0, 0, 0)
#define WAIT_BAR(N) asm volatile("s_waitcnt vmcnt(" #N ") lgkmcnt(0)\n\ts_barrier" ::: "memory")
__device__ __forceinline__ int crow(int r, int hi) { return (r & 3) + 8 * (r >> 2) + 4 * hi; }
__device__ __forceinline__ unsigned cvtpk(float lo, float hi) { unsigned r; asm("v_cvt_pk_bf16_f32 %0, %1, %2\n\ts_nop 1" : "=v"(r) : "v"(lo), "v"(hi)); return r; }
__device__ __forceinline__ unsigned cvtpk_b(float lo, float hi) { const pg8::cv_f32x2 v = {lo, hi}; return __builtin_bit_cast(unsigned, __builtin_convertvector(v, pg8::cv_bf16x2)); }
__device__ __forceinline__ void glds16(const void* g, unsigned lds_base) {
    unsigned sv; asm volatile("s_mov_b32 %0, m0\n\ts_mov_b32 m0, %2\n\ts_nop 0\n\tglobal_load_lds_dwordx4 %1, off\n\ts_mov_b32 m0, %0" : "=&s"(sv) : "v"(g), "s"(lds_base) : "memory"); }
typedef __attribute__((address_space(3))) const char* lds_cptr;
typedef short v4i16_t __attribute__((ext_vector_type(4)));
__device__ __forceinline__ void kload2(bf16x8* kf, lds_cptr kp, int d0, int ko) { kf[2 * d0] = *(const __attribute__((address_space(3))) bf16x8*)(kp + ko); kf[2 * d0 + 1] = *(const __attribute__((address_space(3))) bf16x8*)(kp + ko + 4096); }
__device__ __forceinline__ s16x4 vtr(lds_cptr p) { return __builtin_bit_cast(s16x4, __builtin_amdgcn_ds_read_tr16_b64_v4i16((__attribute__((address_space(3))) v4i16_t*)p)); }
__device__ __forceinline__ f32x16 ldbias(lds_cptr p) {
    const f32x4v a = *(const __attribute__((address_space(3))) f32x4v*)(p), b = *(const __attribute__((address_space(3))) f32x4v*)(p + 32), c = *(const __attribute__((address_space(3))) f32x4v*)(p + 64), d = *(const __attribute__((address_space(3))) f32x4v*)(p + 96);
    return (f32x16){a[0], a[1], a[2], a[3], b[0], b[1], b[2], b[3], c[0], c[1], c[2], c[3], d[0], d[1], d[2], d[3]}; }
#define MX3(a, b, c) __builtin_fmaxf(__builtin_fmaxf((a), (b)), (c))
__device__ __forceinline__ float rowmax(const f32x16& p0, const f32x16& p1) {
    float a = MX3(p0[0], p0[1], p1[0]), b = MX3(p0[2], p0[3], p1[1]); a = MX3(a, p1[2], p1[3]);
#pragma unroll
    for (int r = 4; r < 16; r += 4) { a = MX3(a, p0[r], p0[r + 1]); b = MX3(b, p0[r + 2], p0[r + 3]); a = MX3(a, p1[r], p1[r + 1]); b = MX3(b, p1[r + 2], p1[r + 3]); }
    float m = __builtin_fmaxf(a, b); auto rr = __builtin_amdgcn_permlane32_swap(__float_as_uint(m), __float_as_uint(m), false, false);
    return __builtin_fmaxf(__uint_as_float(rr[0]), __uint_as_float(rr[1])); }
__device__ __forceinline__ void cmask(f32x16& p0, f32x16& p1, int jb, int qrel, int hi) {
    const int kb = 64 * jb + 4 * hi;
#pragma unroll
    for (int r = 0; r < 16; ++r) { const int kv = kb + (r & 3) + 8 * (r >> 2); if (kv > qrel) p0[r] = -INFINITY; if (kv + 32 > qrel) p1[r] = -INFINITY; } }

template <int ND0>
__device__ __forceinline__ void attn_pass(int b, int qb, int kst, const bf16* Z, int qcol, int kcol, int vcol, int kcoff, char* lds, f32x16 (&o)[2], float& l_out) {
    int tid_ = threadIdx.x; asm volatile("" : "+v"(tid_));
    const int tid = tid_, lane = tid & 63, r32 = lane & 31, hi = lane >> 5; const int wid = __builtin_amdgcn_readfirstlane(tid >> 6);
    const long rowbase = (long)b * SEQ; const int q0 = qb * QB, NT = (q0 + QB) / KVBLK - kst;
    const bf16* Qw = Z + (rowbase + q0 + wid * QBLK) * PITCH + qcol;
    const unsigned lds0 = (unsigned)(uintptr_t)lds; float* wsf = (float*)(lds + LDS_WS) + wid * 64;
    const bf16* ksrc = Z + (rowbase + (long)kst * KVBLK + 8 * wid + (lane >> 3)) * PITCH + kcol + ((lane & 7) ^ ((4 * wid + (lane >> 4)) & 7)) * 8;
    const bf16* vsrc = Z + (rowbase + (long)kst * KVBLK) * PITCH + vcol + (long)(16 * (wid & 3) + (lane >> 2)) * PITCH + (wid >> 2) * 32 + (lane & 3) * 8;
    const unsigned kdst = lds0 + LDS_K + wid * 1024, vdst = lds0 + LDS_V + wid * 1024;
#define DMA_K(t, slot) glds16(ksrc + (long)(t) * KVBLK * PITCH, (unsigned)__builtin_amdgcn_readfirstlane(kdst + (slot)))
#define DMA_V(t, slot) glds16(vsrc + (long)(t) * KVBLK * PITCH, (unsigned)__builtin_amdgcn_readfirstlane(vdst + (slot)))
    const lds_cptr vp0 = (lds_cptr)lds + LDS_V + ((lane >> 4) & 1) * 32 + (lane & 3) * 8 + (4 * hi + ((lane & 15) >> 2)) * 64;
    const lds_cptr kp0 = (lds_cptr)lds + LDS_K + r32 * 128; const int kx = (((r32 >> 1) & 7) ^ hi) << 4, kc16 = (kcoff >> 10) << 4;
#define KOFF(d0) ((kc16 + 32 * (d0)) ^ kx)
    const lds_cptr tb0 = (lds_cptr)lds + LDS_TBL + hi * 16 + kst * 256;
    DMA_K(0, 0); DMA_V(0, 0); DMA_K(1, SLOTB);
    bf16x8 qr[ND0];
#pragma unroll
    for (int d0 = 0; d0 < ND0; ++d0) qr[d0] = *reinterpret_cast<const bf16x8*>(&Qw[(long)r32 * PITCH + d0 * 16 + hi * 8]);
    float mhat = 0.f, l_reg = 0.f; o[0] = f32x16{}; o[1] = f32x16{};
    const int qrel = wid * QBLK + r32; bool resc = false;
    f32x16 pA0, pA1, pB0, pB1; bf16x8 kf[2 * ND0]; s16x4 vlo[8], vhi[8]; u32x4 pw0, pw1, pw2, pw3;
    int sl_prev = 0, sl_cur = 0, sl_next = SLOTB;
#define ROT() do { sl_prev = sl_cur; sl_cur = sl_next; sl_next = (sl_next == 2 * SLOTB) ? 0 : sl_next + SLOTB; } while (0)
#define EX(v) __builtin_amdgcn_exp2f((v) + nmh)
#define RESC() do { if (resc) { _Pragma("unroll") for (int d_ = 0; d_ < 2; ++d_) _Pragma("unroll") for (int r = 0; r < 16; ++r) o[d_][r] *= wsf[crow(r, hi)]; } } while (0)
    DMA_K(2, 2 * SLOTB);
    WAIT_BAR(3);
    _Pragma("unroll") for (int d0 = 0; d0 < ND0; ++d0) kload2(kf, kp0, d0, KOFF(d0));
    pA0 = ldbias(tb0); pA1 = ldbias(tb0 + 128);
    _Pragma("unroll") for (int d0 = 0; d0 < ND0; ++d0) { pA0 = MFMA(kf[2 * d0], qr[d0], pA0); pA1 = MFMA(kf[2 * d0 + 1], qr[d0], pA1); }
    if (NT == 4) cmask(pA0, pA1, 0, qrel, hi);
    { const float rm = rowmax(pA0, pA1); mhat = rm; const float nmh = -mhat;
#pragma unroll
      for (int r = 0; r < 16; ++r) { pA0[r] = EX(pA0[r]); pA1[r] = EX(pA1[r]); } }
    pB0 = ldbias(tb0 + 256); pB1 = ldbias(tb0 + 256 + 128);
    WAIT_BAR(0);
    DMA_K(3, 0); DMA_V(1, SLOTB); ROT();
    _Pragma("unroll") for (int d0 = 0; d0 < ND0; ++d0) kload2(kf, kp0 + sl_cur, d0, KOFF(d0));
    WAIT_BAR(2);
#define PKW(P, i) cvtpk_b(P[i], P[i + 1])
#define PAF(k) __builtin_bit_cast(bf16x8, pw##k)
#define VFR(i) (bf16x8){vlo[i][0], vlo[i][1], vlo[i][2], vlo[i][3], vhi[i][0], vhi[i][1], vhi[i][2], vhi[i][3]}
#define VRD(i) do { vlo[i] = vtr(vp_ + (((i) >> 2) * 4096 + ((i) & 3) * 1024)); vhi[i] = vtr(vp_ + (((i) >> 2) * 4096 + ((i) & 3) * 1024 + 512)); } while (0)
#define KRD(G, d0) do { if ((G) && (d0) < ND0) { kload2(kf, kp0 + sl_next, d0, KOFF(d0)); SBAR(); } } while (0)
#define QK(C, i) do { if constexpr ((i) < 2 * ND0) { C = MFMA(kf[(i) < 2 * ND0 ? (i) : 0], qr[(i) < 2 * ND0 ? (i) / 2 : 0], C); } } while (0)
#define GAPA(MF, a0, a1, a2, a3, W0, W1, PW) do { MF; sacc += a0; sacc += a1; sacc += a2; sacc += a3; W0; W1; PIN(PW); PIN(sacc); SBAR(); } while (0)
#define GAPB(MF, X, i) do { MF; X[i] = EX(X[i]); X[i + 1] = EX(X[i + 1]); X[i + 2] = EX(X[i + 2]); X[i + 3] = EX(X[i + 3]); PIN(X); SBAR(); } while (0)
#define STEP(C0, C1, P0, P1, t, MASK, GK, GV, GL) do { SBAR(); \
    const lds_cptr vp_ = vp0 + sl_prev; \
    VRD(0); SBAR(); float sacc = P0[0] + P0[1]; \
                    GAPA(QK(C0, 0), P0[2], P0[3], P0[4], P0[5],     pw0[0] = PKW(P0, 0),  pw0[1] = PKW(P0, 2),  pw0); \
    VRD(4); SBAR(); GAPA(QK(C1, 1), P0[6], P0[7], P0[8], P0[9],     pw0[2] = PKW(P0, 4),  pw0[3] = PKW(P0, 6),  pw0); \
    VRD(1); SBAR(); GAPA(QK(C0, 2), P0[10], P0[11], P0[12], P0[13], pw1[0] = PKW(P0, 8),  pw1[1] = PKW(P0, 10), pw1); \
    VRD(5); SBAR(); GAPA(QK(C1, 3), P0[14], P0[15], P1[0], P1[1],   pw1[2] = PKW(P0, 12), pw1[3] = PKW(P0, 14), pw1); \
    VRD(2); SBAR(); GAPA(QK(C0, 4), P1[2], P1[3], P1[4], P1[5],     pw2[0] = PKW(P1, 0),  pw2[1] = PKW(P1, 2),  pw2); \
    VRD(6); SBAR(); GAPA(QK(C1, 5), P1[6], P1[7], P1[8], P1[9],     pw2[2] = PKW(P1, 4),  pw2[3] = PKW(P1, 6),  pw2); \
    VRD(3); SBAR(); GAPA(QK(C0, 6), P1[10], P1[11], P1[12], P1[13], pw3[0] = PKW(P1, 8),  pw3[1] = PKW(P1, 10), pw3); \
    VRD(7); SBAR(); GAPA(QK(C1, 7), P1[14], P1[15], 0.f, 0.f,       pw3[2] = PKW(P1, 12), pw3[3] = PKW(P1, 14), pw3); \
    l_reg += sacc; \
    if (GK) DMA_K((t) + 3, sl_cur); if (GV) DMA_V((t) + 1, sl_next); \
    if (MASK) cmask(C0, C1, (t) - (NT - 4), qrel, hi); \
    { const float rm = rowmax(C0, C1) - mhat; resc = false; \
      if (__builtin_expect(__any(rm > (float)THR), 0)) { const float dl = __builtin_fmaxf(rm, 0.f); mhat += dl; \
          const float f = __builtin_amdgcn_exp2f(-dl); l_reg *= f; if (hi == 0) wsf[r32] = f; resc = true; } } \
    const float nmh = -mhat; SBAR(); \
    if (GL) { P0 = ldbias(tb0 + ((t) + 1) * 256); P1 = ldbias(tb0 + ((t) + 1) * 256 + 128); } SBAR(); \
    GAPB(o[0] = MFMA(PAF(0), VFR(0), o[0]), C0, 0);              GAPB(o[1] = MFMA(PAF(0), VFR(4), o[1]), C0, 4); \
    KRD(GL, 0); GAPB(o[0] = MFMA(PAF(1), VFR(1), o[0]), C0, 8);  KRD(GL, 1); GAPB(o[1] = MFMA(PAF(1), VFR(5), o[1]), C0, 12); \
    KRD(GL, 2); GAPB(o[0] = MFMA(PAF(2), VFR(2), o[0]), C1, 0);  KRD(GL, 3); GAPB(o[1] = MFMA(PAF(2), VFR(6), o[1]), C1, 4); \
    GAPB(o[0] = MFMA(PAF(3), VFR(3), o[0]), C1, 8);              GAPB(o[1] = MFMA(PAF(3), VFR(7), o[1]), C1, 12); \
    if (GL) { PIN(P0); PIN(P1); } \
    } while (0)
    int t = 1;
    for (; t + 5 < NT; t += 2) {
        STEP(pB0, pB1, pA0, pA1, t, false, true, true, true);     WAIT_BAR(2); RESC(); ROT();
        STEP(pA0, pA1, pB0, pB1, t + 1, false, true, true, true); WAIT_BAR(2); RESC(); ROT();
    }
#define ENDW(tt) do { if ((tt) + 3 < NT) { WAIT_BAR(2); } else if ((tt) + 2 < NT) { WAIT_BAR(1); } else { WAIT_BAR(0); } } while (0)
    for (; t + 1 < NT; t += 2) {
        STEP(pB0, pB1, pA0, pA1, t, true, (t + 3 < NT), (t + 1 < NT), (t + 1 < NT));         ENDW(t);     RESC(); ROT();
        STEP(pA0, pA1, pB0, pB1, t + 1, true, (t + 4 < NT), (t + 2 < NT), (t + 2 < NT));     ENDW(t + 1); RESC(); ROT();
    }
    STEP(pB0, pB1, pA0, pA1, NT - 1, true, false, false, false); RESC();
    { float sacc = pB0[0] + pB0[1];
#pragma unroll
      for (int r = 2; r < 16; ++r) sacc += pB0[r];
#pragma unroll
      for (int r = 0; r < 16; ++r) sacc += pB1[r];
      l_reg += sacc;
      pw0 = (u32x4){PKW(pB0, 0), PKW(pB0, 2), PKW(pB0, 4), PKW(pB0, 6)}; pw1 = (u32x4){PKW(pB0, 8), PKW(pB0, 10), PKW(pB0, 12), PKW(pB0, 14)};
      pw2 = (u32x4){PKW(pB1, 0), PKW(pB1, 2), PKW(pB1, 4), PKW(pB1, 6)}; pw3 = (u32x4){PKW(pB1, 8), PKW(pB1, 10), PKW(pB1, 12), PKW(pB1, 14)};
      const lds_cptr vp_ = vp0 + sl_cur; _Pragma("unroll") for (int i = 0; i < 8; ++i) VRD(i);
      o[0] = MFMA(PAF(0), VFR(0), o[0]); o[1] = MFMA(PAF(0), VFR(4), o[1]); o[0] = MFMA(PAF(1), VFR(1), o[0]); o[1] = MFMA(PAF(1), VFR(5), o[1]);
      o[0] = MFMA(PAF(2), VFR(2), o[0]); o[1] = MFMA(PAF(2), VFR(6), o[1]); o[0] = MFMA(PAF(3), VFR(3), o[0]); o[1] = MFMA(PAF(3), VFR(7), o[1]); }
    { auto rr = __builtin_amdgcn_permlane32_swap(__float_as_uint(l_reg), __float_as_uint(l_reg), false, false); l_reg = __uint_as_float(rr[0]) + __uint_as_float(rr[1]); }
    l_out = l_reg;
#undef DMA_K
#undef KOFF
#undef DMA_V
#undef ROT
#undef EX
#undef RESC
#undef PKW
#undef PAF
#undef VFR
#undef VRD
#undef KRD
#undef QK
#undef ENDW
#undef GAPA
#undef GAPB
#undef STEP
}

__device__ __forceinline__ void row_scales(float l_reg, float extra, float* wsf, int r32, int hi, float (&rli)[16]) {
    if (hi == 0) wsf[32 + r32] = l_reg; asm volatile("s_waitcnt lgkmcnt(0)" ::: "memory");
#pragma unroll
    for (int r = 0; r < 16; ++r) rli[r] = extra * __builtin_amdgcn_rcpf(wsf[32 + crow(r, hi)]);
    asm volatile("s_waitcnt lgkmcnt(0)" ::: "memory");
}

__device__ __forceinline__ void fox_unit(int b, int h, int qb, int kst, const bf16* Z, bf16* Y, char* lds) {
    int tid_ = threadIdx.x; asm volatile("" : "+v"(tid_));
    const int tid = tid_, lane = tid & 63, r32 = lane & 31, hi = lane >> 5; const int wid = __builtin_amdgcn_readfirstlane(tid >> 6);
    f32x16 o[2]; float l_reg;
    attn_pass<4>(b, qb, kst, Z, ZC_FQ + h * 64, ZC_FK + h * 64, ZC_FV + h * 64, 0, lds, o, l_reg);
    float* wsf = (float*)(lds + LDS_WS) + wid * 64; float rli[16]; row_scales(l_reg, 1.f, wsf, r32, hi, rli);
    const long row0 = (long)b * SEQ + qb * QB + wid * QBLK;
    unsigned short* stg = (unsigned short*)(lds + LDS_OST) + wid * 4096;
#pragma unroll
    for (int r = 0; r < 16; ++r) { const int orow = crow(r, hi);
#pragma unroll
        for (int d0 = 0; d0 < 2; ++d0) stg[orow * 64 + d0 * 32 + r32] = (unsigned short)f2bf(o[d0][r] * rli[r]); }
    asm volatile("s_waitcnt lgkmcnt(0)" ::: "memory");
#pragma unroll
    for (int i = 0; i < 4; ++i) { const int row = i * 8 + (lane >> 3), ch = lane & 7;
        const u32x4 ov = *(const u32x4*)(stg + row * 64 + ch * 8); const u32x4 gv = *(const u32x4*)(Z + (row0 + row) * PITCH + ZC_FG + h * 64 + ch * 8);
        u32x4 w;
#pragma unroll
        for (int e = 0; e < 4; ++e) { const float o0 = __uint_as_float(ov[e] << 16), o1 = __uint_as_float(ov[e] & 0xffff0000u), g0 = __uint_as_float(gv[e] << 16), g1 = __uint_as_float(gv[e] & 0xffff0000u);
            w[e] = pk2(o0 / (1.f + __expf(-g0)), o1 / (1.f + __expf(-g1))); }
        *(u32x4*)(Y + (row0 + row) * D + 512 + h * 64 + ch * 8) = w; }
    asm volatile("s_waitcnt lgkmcnt(0)\n\ts_barrier" ::: "memory");
}

__device__ __forceinline__ void diff_unit(int b, int h, int qb, int kst, const bf16* Z, bf16* Y, float lam, float oscale, const float* subg, char* lds) {
    int tid_ = threadIdx.x; asm volatile("" : "+v"(tid_));
    const int tid = tid_, lane = tid & 63, r32 = lane & 31, hi = lane >> 5; const int wid = __builtin_amdgcn_readfirstlane(tid >> 6);
    float* wsf = (float*)(lds + LDS_WS) + wid * 64; float* stg = (float*)(lds + LDS_OST) + wid * 2048;
    const long row0 = (long)b * SEQ + qb * QB + wid * QBLK;
    for (int c = 0; c < 2; ++c) {
        f32x16 o[2]; float l_reg;
        attn_pass<2>(b, qb, kst, Z, ZC_DQ + h * 64 + c * 32, ZC_DK + h * 64, ZC_DV + h * 64, c * 4096, lds, o, l_reg);
        float rli[16]; row_scales(l_reg, c == 0 ? 1.f : -lam, wsf, r32, hi, rli);
#pragma unroll
        for (int r = 0; r < 16; ++r) { const int orow = crow(r, hi);
#pragma unroll
            for (int d0 = 0; d0 < 2; ++d0) { float* p = stg + orow * 64 + d0 * 32 + r32; const float v = o[d0][r] * rli[r]; *p = (c == 0) ? v : (*p + v); } }
        asm volatile("s_waitcnt lgkmcnt(0)\n\ts_barrier" ::: "memory");
    }
#pragma unroll
    for (int i = 0; i < 4; ++i) { const int row = i * 8 + (lane >> 3), ch = lane & 7;
        const f32x4v a = *(const f32x4v*)(stg + row * 64 + ch * 8), c4 = *(const f32x4v*)(stg + row * 64 + ch * 8 + 4);
        float ss = (a[0] * a[0] + a[1] * a[1]) + (a[2] * a[2] + a[3] * a[3]) + (c4[0] * c4[0] + c4[1] * c4[1]) + (c4[2] * c4[2] + c4[3] * c4[3]);
        ss += __shfl_xor(ss, 1); ss += __shfl_xor(ss, 2); ss += __shfl_xor(ss, 4);
        const float rs = oscale / sqrtf(ss * (1.f / 64.f) + EPS);
        const f32x4v g0 = *(const f32x4v*)(subg + ch * 8), g1 = *(const f32x4v*)(subg + ch * 8 + 4);
        u32x4 w; w[0] = pk2(a[0] * rs * g0[0], a[1] * rs * g0[1]); w[1] = pk2(a[2] * rs * g0[2], a[3] * rs * g0[3]); w[2] = pk2(c4[0] * rs * g1[0], c4[1] * rs * g1[1]); w[3] = pk2(c4[2] * rs * g1[2], c4[3] * rs * g1[3]);
        *(u32x4*)(Y + (row0 + row) * D + 256 + h * 64 + ch * 8) = w; }
    asm volatile("s_waitcnt lgkmcnt(0)\n\ts_barrier" ::: "memory");
}
#undef SBAR
#undef PIN
#undef MFMA
#undef WAIT_BAR
#undef MX3
}
namespace rec {
using att::bf16x8; using att::s16x4; using att::f32x16; using att::f32x4v; using att::u32x4;
typedef __attribute__((address_space(3))) char* lptr;
typedef short v4i16_t __attribute__((ext_vector_type(4)));
constexpr int SEGL = 128, NSEG = SEQ / SEGL, NBLK = SEGL / 32, TSTR = 136;
constexpr int W_Q = 0, W_K = 32 * TSTR, W_V = 2 * 32 * TSTR, W_TAB = 3 * 32 * TSTR, W_BYTES = W_TAB + 512;
static_assert(W_BYTES * NWAVES <= RING_BYTES && W_TAB % 16 == 0, "rec LDS map");
constexpr int IMG_H = 4 * 16 * 64, IMG_M = 6 * 16 * 64;
#define RMFMA(a, b, c) __builtin_amdgcn_mfma_f32_32x32x16_bf16(a, b, c, 0, 0, 0)
#define LFENCE() asm volatile("s_waitcnt lgkmcnt(0)" ::: "memory")
__device__ __forceinline__ float fsig(float x) { return __builtin_amdgcn_rcpf(1.f + __builtin_amdgcn_exp2f(x * -1.44269504f)); }
constexpr float EMIN = 1.8048514e-35f;
__device__ __forceinline__ bf16x8 join(s16x4 a, s16x4 b) { return (bf16x8){a[0], a[1], a[2], a[3], b[0], b[1], b[2], b[3]}; }
__device__ __forceinline__ s16x4 vtr(lptr p) { return __builtin_bit_cast(s16x4, __builtin_amdgcn_ds_read_tr16_b64_v4i16((__attribute__((address_space(3))) v4i16_t*)p)); }
__device__ __forceinline__ bf16x8 rowfrag(lptr tile, int r32, int hi, int ks) {
    const lptr p = tile + r32 * TSTR + (16 * ks + 4 * hi) * 2;
    return join(*(const __attribute__((address_space(3))) s16x4*)p, *(const __attribute__((address_space(3))) s16x4*)(p + 16)); }
__device__ __forceinline__ bf16x8 trfrag(lptr tile, int lane, int ct, int ks) {
    const int hi = lane >> 5, i = lane & 15, gb = (lane >> 4) & 1;
    const lptr p = tile + (16 * ks + 4 * hi + (i >> 2)) * TSTR + (32 * ct + 16 * gb + 4 * (i & 3)) * 2;
    return join(vtr(p), vtr(p + 8 * TSTR)); }
__device__ __forceinline__ bf16x8 accfrag(const f32x16& x, int ks) {
    u32x4 w; w[0] = att::cvtpk_b(x[8 * ks], x[8 * ks + 1]); w[1] = att::cvtpk_b(x[8 * ks + 2], x[8 * ks + 3]); w[2] = att::cvtpk_b(x[8 * ks + 4], x[8 * ks + 5]); w[3] = att::cvtpk_b(x[8 * ks + 6], x[8 * ks + 7]);
    return __builtin_bit_cast(bf16x8, w); }

struct RecPtrs { const bf16* Z; const float* gates; bf16* Y; float* imgH; float* imgM; float* decH; float* decM;
                 const float* lbl; const float* ng; const float* convw; const float* ibias; const float* fbias; int layer; };

template <bool ML, bool FULL>
__device__ __forceinline__ void rec_unit(const RecPtrs& P, int bh, int seg, char* wlds) {
    constexpr int NVT = ML ? 3 : 2, NT = 2 * NVT;
    int lane_ = threadIdx.x & 63; asm volatile("" : "+v"(lane_));
    const int lane = lane_, r32 = lane & 31, hi = lane >> 5, h = bh & 3, b = bh >> 2;
    const lptr wl = (lptr)wlds; const lptr tq = wl + W_Q, tk = wl + W_K, tv = wl + W_V;
    __attribute__((address_space(3))) float* tab = (__attribute__((address_space(3))) float*)(wl + W_TAB);
    f32x16 S[NT];
    float* img = ML ? P.imgM + (size_t)(bh * NSEG + seg) * IMG_M : P.imgH + (size_t)(bh * NSEG + seg) * IMG_H;
    if (FULL) {
#pragma unroll
        for (int t = 0; t < NT; ++t)
#pragma unroll
            for (int g = 0; g < 16; ++g) S[t][g] = img[(t * 16 + g) * 64 + lane];
    } else {
#pragma unroll
        for (int t = 0; t < NT; ++t) S[t] = f32x16{};
    }
    float lb = 0.f, oml = 1.f, wq0 = 0.f, wq1 = 0.f, wq2 = 0.f, wq3 = 0.f, wk0 = 0.f, wk1 = 0.f, wk2 = 0.f, wk3 = 0.f, ib = 0.f, fb = 0.f;
    float q1 = 0.f, q2 = 0.f, q3 = 0.f, k1 = 0.f, k2 = 0.f, k3 = 0.f, dtot = 1.f;
    const int c = h * 64 + lane;
    const long rowS = (long)b * SEQ + seg * SEGL;
    if (!ML) {
        if (P.layer == 1) { const float a0 = P.lbl[c], a1 = P.lbl[256 + c]; const float mx = fmaxf(a0, a1); const float e0 = expf(a0 - mx), e1 = expf(a1 - mx); lb = e1 / (e0 + e1); }
        oml = 1.f - lb;
        if (FULL) tab[64 + lane] = P.ng[lane];
    } else {
        wk0 = P.convw[0 * 512 + 256 + c]; wk1 = P.convw[1 * 512 + 256 + c]; wk2 = P.convw[2 * 512 + 256 + c]; wk3 = P.convw[3 * 512 + 256 + c];
        if (FULL) { wq0 = P.convw[0 * 512 + c]; wq1 = P.convw[1 * 512 + c]; wq2 = P.convw[2 * 512 + c]; wq3 = P.convw[3 * 512 + c]; }
        ib = P.ibias[h]; fb = P.fbias[h];
        if (seg > 0) { const bf16* zp = P.Z + (rowS - 3) * ZP + c;
            k3 = bf2f(zp[ZC_MK]); k2 = bf2f(zp[ZP + ZC_MK]); k1 = bf2f(zp[2 * ZP + ZC_MK]);
            if (FULL) { q3 = bf2f(zp[ZC_MQ]); q2 = bf2f(zp[ZP + ZC_MQ]); q1 = bf2f(zp[2 * ZP + ZC_MQ]); } }
    }
    const bf16x8 ones = (r32 == 0) ? (bf16x8){0x3F80, 0x3F80, 0x3F80, 0x3F80, 0x3F80, 0x3F80, 0x3F80, 0x3F80} : (bf16x8){0, 0, 0, 0, 0, 0, 0, 0};
#define LOADV(VW, R0) do { _Pragma("unroll") for (int i_ = 0; i_ < 4; ++i_) VW[i_] = *(const u32x4*)(P.Z + ((R0) + (lane >> 3) + 8 * i_) * ZP + h * 64 + (lane & 7) * 8 + (ML ? ZC_MV : ZC_HI)); } while (0)
#define LOADG(GF, GI, R0) do { if (ML) { const float* gp_ = P.gates + (size_t)((R0) + (lane & 31)) * 12 + h; GF = gp_[8]; GI = gp_[4]; } } while (0)
#define RAWDMA(REGION, COL, R0) do { _Pragma("unroll") for (int j_ = 0; j_ < 4; ++j_) \
        __builtin_amdgcn_global_load_lds((const unsigned*)(P.Z + ((R0) + 8 * j_ + (lane >> 3)) * ZP + (COL) + h * 64 + (((lane & 7) ^ (lane >> 3)) * 8)), (__attribute__((address_space(3))) unsigned*)((REGION) + j_ * 1024), 16, 0, 0); } while (0)
#define WSTORE(TILE, W) do { _Pragma("unroll") for (int i_ = 0; i_ < 4; ++i_) { \
            __attribute__((address_space(3))) unsigned long long* dp_ = (__attribute__((address_space(3))) unsigned long long*)((TILE) + ((lane >> 3) + 8 * i_) * TSTR + (lane & 7) * 16); \
            dp_[0] = (unsigned long long)W[i_][0] | ((unsigned long long)W[i_][1] << 32); dp_[1] = (unsigned long long)W[i_][2] | ((unsigned long long)W[i_][3] << 32); } } while (0)
    const lptr rawK = tq, rawQ = tk;
    constexpr int COLK = ML ? ZC_MK : ZC_HF, COLQ = ML ? ZC_MQ : ZC_HQ;
    RAWDMA(rawK, COLK, rowS); if (FULL) RAWDMA(rawQ, COLQ, rowS);
    u32x4 vwN[4]; float glfN = 0.f, gliN = 0.f;
    if (!FULL) LOADV(vwN, rowS);
    LOADG(glfN, gliN, rowS);
    const int i16 = lane & 15, rr = i16 >> 2, pc = 2 * (lane >> 4) + ((i16 & 3) >> 1);
    const int troffE = rr * 128 + ((pc ^ rr) << 4) + (i16 & 1) * 8, troffO = rr * 128 + ((pc ^ (4 + rr)) << 4) + (i16 & 1) * 8;
    for (int blk = 0; blk < NBLK; ++blk) {
        const long row0 = rowS + blk * 32;
        u32x4 vw[4]; const float glf = glfN, gli = gliN;
        asm volatile("s_waitcnt vmcnt(0)" ::: "memory");
        if (FULL) LOADV(vw, row0);
        else {
#pragma unroll
            for (int i = 0; i < 4; ++i) vw[i] = vwN[i];
        }
        s16x4 ra4[8], rb4[8];
#pragma unroll
        for (int pb = 0; pb < 8; ++pb) { ra4[pb] = vtr(rawK + pb * 512 + ((pb & 1) ? troffO : troffE)); if (FULL) rb4[pb] = vtr(rawQ + pb * 512 + ((pb & 1) ? troffO : troffE)); }
        LFENCE();
        if (!FULL) { if (blk + 1 < NBLK) { RAWDMA(rawK, COLK, row0 + 32); LOADV(vwN, row0 + 32); LOADG(glfN, gliN, row0 + 32); }
            WSTORE(tv, vw); }
        float dec;
        if (!ML) {
            float E = 1.f;
#pragma unroll
            for (int t2 = 0; t2 < 16; ++t2) {
                float kq[2], qq[2];
#pragma unroll
                for (int u = 0; u < 2; ++u) { const int t = 2 * t2 + u;
                    const float f = lb + oml * fsig(bf2f((bf16)ra4[t >> 2][t & 3]));
                    E *= f; const float e = fmaxf(E, EMIN);
                    kq[u] = (1.f - f) * __builtin_amdgcn_rcpf(e);
                    if (FULL) qq[u] = bf2f((bf16)rb4[t >> 2][t & 3]) * e; }
                const unsigned wkk = att::cvtpk(kq[0], kq[1]);
                *(__attribute__((address_space(3))) bf16*)(tk + (2 * t2) * TSTR + lane * 2) = (bf16)(wkk & 0xffffu); *(__attribute__((address_space(3))) bf16*)(tk + (2 * t2 + 1) * TSTR + lane * 2) = (bf16)(wkk >> 16);
                if (FULL) { const unsigned wqq = att::cvtpk(qq[0], qq[1]);
                    *(__attribute__((address_space(3))) bf16*)(tq + (2 * t2) * TSTR + lane * 2) = (bf16)(wqq & 0xffffu); *(__attribute__((address_space(3))) bf16*)(tq + (2 * t2 + 1) * TSTR + lane * 2) = (bf16)(wqq >> 16); }
            }
            dec = fmaxf(E, EMIN);
            tab[lane] = dec;
        } else {
            float F = fsig(glf + fb);
            { float t_;
              t_ = __builtin_bit_cast(float, __builtin_amdgcn_update_dpp(0x3f800000, __builtin_bit_cast(int, F), 0x111, 0xf, 0xf, false)); F *= t_;
              t_ = __builtin_bit_cast(float, __builtin_amdgcn_update_dpp(0x3f800000, __builtin_bit_cast(int, F), 0x112, 0xf, 0xf, false)); F *= t_;
              t_ = __builtin_bit_cast(float, __builtin_amdgcn_update_dpp(0x3f800000, __builtin_bit_cast(int, F), 0x114, 0xf, 0xf, false)); F *= t_;
              t_ = __builtin_bit_cast(float, __builtin_amdgcn_update_dpp(0x3f800000, __builtin_bit_cast(int, F), 0x118, 0xf, 0xf, false)); F *= t_;
              const float r0 = __builtin_bit_cast(float, __builtin_amdgcn_readlane(__builtin_bit_cast(int, F), 15)); if (lane & 16) F *= r0; }
            const int ekb = __builtin_bit_cast(int, __builtin_amdgcn_exp2f((gli + ib) * LOG2E) * __builtin_amdgcn_rcpf(F)), eqb = __builtin_bit_cast(int, F * 0.125f);
            dec = fmaxf(__builtin_bit_cast(float, __builtin_amdgcn_readlane(__builtin_bit_cast(int, F), 31)), EMIN);
#pragma unroll
            for (int t2 = 0; t2 < 16; ++t2) {
                float kq[2], qq[2];
#pragma unroll
                for (int u = 0; u < 2; ++u) { const int t = 2 * t2 + u;
                    const float k0 = bf2f((bf16)ra4[t >> 2][t & 3]); float kc = wk3 * k0 + wk2 * k1 + wk1 * k2 + wk0 * k3; k3 = k2; k2 = k1; k1 = k0;
                    kq[u] = kc * fsig(kc) * __builtin_bit_cast(float, __builtin_amdgcn_readlane(ekb, t));
                    if (FULL) { const float q0 = bf2f((bf16)rb4[t >> 2][t & 3]); float qc = wq3 * q0 + wq2 * q1 + wq1 * q2 + wq0 * q3; q3 = q2; q2 = q1; q1 = q0;
                        qq[u] = qc * fsig(qc) * __builtin_bit_cast(float, __builtin_amdgcn_readlane(eqb, t)); } }
                const unsigned wkk = att::cvtpk(kq[0], kq[1]);
                *(__attribute__((address_space(3))) bf16*)(tk + (2 * t2) * TSTR + lane * 2) = (bf16)(wkk & 0xffffu); *(__attribute__((address_space(3))) bf16*)(tk + (2 * t2 + 1) * TSTR + lane * 2) = (bf16)(wkk >> 16);
                if (FULL) { const unsigned wqq = att::cvtpk(qq[0], qq[1]);
                    *(__attribute__((address_space(3))) bf16*)(tq + (2 * t2) * TSTR + lane * 2) = (bf16)(wqq & 0xffffu); *(__attribute__((address_space(3))) bf16*)(tq + (2 * t2 + 1) * TSTR + lane * 2) = (bf16)(wqq >> 16); }
            }
        }
        dtot *= dec;
        if (FULL) WSTORE(tv, vw);
        LFENCE();
        bf16x8 vf[NVT][2];
#pragma unroll
        for (int vt = 0; vt < 2; ++vt)
#pragma unroll
            for (int ks = 0; ks < 2; ++ks) vf[vt][ks] = trfrag(tv, lane, vt, ks);
        if (ML) { vf[NVT - 1][0] = ones; vf[NVT - 1][1] = ones; }
        if (FULL) {
            bf16x8 qf[4], kf[4];
#pragma unroll
            for (int ks = 0; ks < 4; ++ks) { qf[ks] = rowfrag(tq, r32, hi, ks); kf[ks] = rowfrag(tk, r32, hi, ks); }
            LFENCE();
            RAWDMA(tv, (ML ? ZC_MO : ZC_HG), row0);
            if (blk + 1 < NBLK) { RAWDMA(rawK, COLK, row0 + 32); LOADG(glfN, gliN, row0 + 32); }
            f32x16 x1 = f32x16{};
#pragma unroll
            for (int ks = 0; ks < 4; ++ks) x1 = RMFMA(kf[ks], qf[ks], x1);
#pragma unroll
            for (int g = 0; g < 16; ++g) if (att::crow(g, hi) > r32) x1[g] = 0.f;
            const bf16x8 xb0 = accfrag(x1, 0), xb1 = accfrag(x1, 1);
            f32x16 ot[NVT];
#pragma unroll
            for (int vt = 0; vt < NVT; ++vt) {
                ot[vt] = RMFMA(vf[vt][0], xb0, f32x16{}); ot[vt] = RMFMA(vf[vt][1], xb1, ot[vt]);
#pragma unroll
                for (int dt = 0; dt < 2; ++dt)
#pragma unroll
                    for (int ks = 0; ks < 2; ++ks) ot[vt] = RMFMA(accfrag(S[dt * NVT + vt], ks), qf[2 * dt + ks], ot[vt]);
            }
            asm volatile("s_waitcnt vmcnt(0)" ::: "memory");
            const lptr gy = tv + r32 * 128 + 8 * hi; const int gx = r32 & 7;
            float osc;
            if (!ML) {
                float ss = 0.f;
#pragma unroll
                for (int vt = 0; vt < 2; ++vt)
#pragma unroll
                    for (int g = 0; g < 16; ++g) ss += ot[vt][g] * ot[vt][g];
                { auto rr = __builtin_amdgcn_permlane32_swap(__float_as_uint(ss), __float_as_uint(ss), false, false); ss = __uint_as_float(rr[0]) + __uint_as_float(rr[1]); }
                osc = __builtin_amdgcn_rsqf(ss * (1.f / 64.f) + EPS);
            } else { const float den = __shfl(ot[NVT - 1][0], r32); osc = 1.f / fmaxf(fabsf(den), 1.f); }
#pragma unroll
            for (int vt = 0; vt < 2; ++vt)
#pragma unroll
                for (int g4 = 0; g4 < 4; ++g4) { const int v0 = 32 * vt + 8 * g4 + 4 * hi;
                    __attribute__((address_space(3))) unsigned long long* gp_ = (__attribute__((address_space(3))) unsigned long long*)(gy + (((4 * vt + g4) ^ gx) << 4));
                    const unsigned long long gw = *gp_;
                    float o4[4];
                    if (!ML) { const f32x4v gn = *(const __attribute__((address_space(3))) f32x4v*)(tab + 64 + v0);
#pragma unroll
                        for (int e = 0; e < 4; ++e) { const float gv = __uint_as_float((unsigned)((gw >> (16 * e)) & 0xffffu) << 16); o4[e] = ot[vt][4 * g4 + e] * osc * gn[e] * gv * fsig(gv); }
                    } else {
#pragma unroll
                        for (int e = 0; e < 4; ++e) { const float gv = __uint_as_float((unsigned)((gw >> (16 * e)) & 0xffffu) << 16); o4[e] = ot[vt][4 * g4 + e] * osc * fsig(gv); } }
                    *gp_ = (unsigned long long)att::cvtpk(o4[0], o4[1]) | ((unsigned long long)att::cvtpk(o4[2], o4[3]) << 32); }
            LFENCE();
#pragma unroll
            for (int j = 0; j < 4; ++j) { const int row = 8 * j + (lane >> 3), ch = lane & 7;
                const u32x4 yv = *(const __attribute__((address_space(3))) u32x4*)(tv + row * 128 + ((ch ^ (row & 7)) << 4));
                *(u32x4*)(P.Y + (row0 + row) * D + (ML ? 768 : 0) + h * 64 + ch * 8) = yv; }
        }
        {
            bf16x8 ktf[2][2];
#pragma unroll
            for (int dt = 0; dt < 2; ++dt)
#pragma unroll
                for (int ks = 0; ks < 2; ++ks) ktf[dt][ks] = trfrag(tk, lane, dt, ks);
            if (FULL) { LFENCE(); if (blk + 1 < NBLK) RAWDMA(rawQ, COLQ, row0 + 32); }
#pragma unroll
            for (int dt = 0; dt < 2; ++dt) {
                f32x4v dv[4];
                if (!ML) {
#pragma unroll
                    for (int g4 = 0; g4 < 4; ++g4) dv[g4] = *(const __attribute__((address_space(3))) f32x4v*)(tab + 32 * dt + 8 * g4 + 4 * hi);
                }
#pragma unroll
                for (int vt = 0; vt < NVT; ++vt) { f32x16 s = S[dt * NVT + vt];
                    s = RMFMA(ktf[dt][0], vf[vt][0], s); s = RMFMA(ktf[dt][1], vf[vt][1], s);
#pragma unroll
                    for (int g = 0; g < 16; ++g) s[g] *= ML ? dec : dv[g >> 2][g & 3];
                    S[dt * NVT + vt] = s; }
            }
        }
        LFENCE();
    }
    if (!FULL) {
#pragma unroll
        for (int t = 0; t < NT; ++t)
#pragma unroll
            for (int g = 0; g < 16; ++g) img[(t * 16 + g) * 64 + lane] = S[t][g];
        if (!ML) P.decH[(size_t)(bh * NSEG + seg) * 64 + lane] = dtot;
        else if (lane == 0) P.decM[bh * NSEG + seg] = dtot;
    }
}

__device__ __forceinline__ void scan_items(const RecPtrs& P, int item0, int nitem_stride) {
    int tid_ = threadIdx.x; asm volatile("" : "+v"(tid_)); const int tid = tid_;
    constexpr int ITEMS_H = BATCH * NH * (IMG_H / 512), ITEMS_M = BATCH * NH * (IMG_M / 512), NIT = ITEMS_H + ITEMS_M;
    for (int it0 = item0; it0 < NIT; it0 += 2 * nitem_stride) {
        const bool two = it0 + nitem_stride < NIT;
        float* basev[2]; const float* dpv[2]; int iszv[2], dstrv[2];
#pragma unroll
        for (int q = 0; q < 2; ++q) { const int it = (q == 1 && two) ? it0 + nitem_stride : it0;
            const bool ml = it >= ITEMS_H; const int r = ml ? it - ITEMS_H : it; const int per = ml ? IMG_M / 512 : IMG_H / 512;
            const int bh = r / per, e = (r % per) * 512 + tid; const int isz = ml ? IMG_M : IMG_H;
            basev[q] = (ml ? P.imgM : P.imgH) + (size_t)bh * NSEG * isz + e; iszv[q] = isz;
            const int tile = e >> 10, g = (e >> 6) & 15, ln = e & 63; const int dt = ml ? tile / 3 : tile >> 1; const int d = 32 * dt + att::crow(g, ln >> 5);
            dpv[q] = ml ? P.decM + bh * NSEG : P.decH + (size_t)bh * NSEG * 64 + d; dstrv[q] = ml ? 1 : 64; }
        float u0[NSEG], p0[NSEG], u1[NSEG], p1[NSEG];
#pragma unroll
        for (int j = 0; j < NSEG; ++j) { u0[j] = basev[0][(size_t)j * iszv[0]]; p0[j] = dpv[0][j * dstrv[0]]; }
        if (two) {
#pragma unroll
            for (int j = 0; j < NSEG; ++j) { u1[j] = basev[1][(size_t)j * iszv[1]]; p1[j] = dpv[1][j * dstrv[1]]; } }
        { float s = 0.f;
#pragma unroll
          for (int j = 0; j < NSEG; ++j) { basev[0][(size_t)j * iszv[0]] = s; s = p0[j] * s + u0[j]; } }
        if (two) { float s = 0.f;
#pragma unroll
          for (int j = 0; j < NSEG; ++j) { basev[1][(size_t)j * iszv[1]] = s; s = p1[j] * s + u1[j]; } }
    }
}
#undef LOADV
#undef LOADG
#undef RAWDMA
#undef WSTORE
#undef RMFMA
#undef LFENCE
}
__global__ void __launch_bounds__(NWAVES * 64, 2) mk_fwd(Args args) {
    extern __shared__ __attribute__((aligned(16))) unsigned char lds[];
    Frame F;
    F.lds = (LAS unsigned char*)lds; F.MISC = (volatile LAS unsigned*)(F.lds + MISC_OFF);
    F.tid = threadIdx.x; F.lane = F.tid & 63; F.wave = __builtin_amdgcn_readfirstlane(F.tid >> 6);
    F.G = gridDim.x; { const int bx = blockIdx.x; F.vcu = (F.G % 8 == 0) ? (bx % 8) * (F.G / 8) + bx / 8 : bx; }
    unsigned char* ws = args.ws;
    F.ctl = (gu32*)(ws + WS_CTL);
    for (int u = F.tid; u < (LDS_BYTES - LDSCTL_OFF) / 4; u += NWAVES * 64) ((LAS unsigned*)(F.lds + LDSCTL_OFF))[u] = 0u;
    __syncthreads();
    XcdBarrier bar = xcd_barrier_post((unsigned*)(F.ctl + CW_BAR) + args.li * XCD_BAR_WORDS, F.MISC + 8);
    const int lo = args.ph_lo, hi = args.ph_hi;
#ifdef PROBE_GROUP
    unsigned long long t_prev = __builtin_amdgcn_s_memrealtime(); unsigned long long t_acc = 0ull;
#define STAMP(grp) do { const unsigned long long t_now = __builtin_amdgcn_s_memrealtime(); if ((grp) == PROBE_GROUP) t_acc += t_now - t_prev; t_prev = t_now; } while (0)
#else
#define STAMP(grp) do {} while (0)
#endif
#define IN(k) (lo <= (k) && (k) < hi)
#define SEAM(k) do { if (IN(k) && IN((k) + 1)) xcd_barrier(bar); } while (0)
    float* mod = (float*)(ws + WS_MOD); float* wgw = (float*)(ws + WS_WG); float* gates = (float*)(ws + WS_GATES);
    bf16* HN = (bf16*)(ws + WS_HN); bf16* Z = (bf16*)(ws + WS_Z); bf16* Y = (bf16*)(ws + WS_Y); bf16* HB = (bf16*)(ws + WS_H); bf16* XB = (bf16*)(ws + WS_XB);
    if (IN(PH_PRO)) { p0_prologue(F, args); }
    SEAM(PH_PRO); STAMP(5);
    for (int l = 0; l < DEPTH; ++l) {
        const int pb = 1 + PH_PER_LAYER * l;
        const float* modl = mod + (size_t)l * 8 * NMOD;
        const float* xin = (l == 0) ? args.in[0] : args.out;
        if (IN(pb + PL_NORM1) && l == 0) {
            bias_all(F, (const bf16*)(ws + WS_WIN), (const bf16*)(ws + WS_W1), mod, (float*)(ws + WS_BIAS1), (float*)(ws + WS_BIAS2)); STAMP(8);
            prenorm0_phase(F, xin, (const float*)(ws + WS_GM1), HN, (float*)(ws + WS_SS1));
        }
        if (l == 0) { SEAM(pb + PL_NORM1); } STAMP(4);
        if (IN(pb + PL_INPROJ)) {
            pg8::Gemm g{HN, (const bf16*)(ws + WS_WIN) + (size_t)l * 4096 * 1024, T, 4096, D}; pg8::StaticOrder S; S.init(T, 4096, F.G, (int)blockIdx.x);
            pg8::EpiInProj E{Z, ZP, (const float*)(ws + WS_QKG) + l * 256, (LAS unsigned char*)(F.lds + XCH_OFF), (const float*)(ws + WS_SS1), (const float*)(ws + WS_BIAS1) + (size_t)l * 8 * 4096, gates, (float*)(ws + WS_FGT)};
            pg8::gemm_phase<pg8::EpiInProj, pg8::StaticOrder, true, true>(F.lds + RING_OFF, g, S, E);
        }
        SEAM(pb + PL_INPROJ); STAMP(11);
        rec::RecPtrs RP{Z, gates, Y, (float*)(ws + WS_IMGH), (float*)(ws + WS_IMGM), (float*)(ws + WS_DECH), (float*)(ws + WS_DECM),
                        args.in[8], args.in[9] + l * HD, args.in[17] + (size_t)l * 4 * 512, args.in[18] + l * NH, args.in[19] + l * NH, l};
        char* al = (char*)lds + RING_OFF; float* tbl = (float*)(al + att::LDS_TBL);
        if (IN(pb + PL_MIXA)) {
            for (int bh = blockIdx.x; bh < BATCH * NH; bh += F.G) fox_scan_block((const float*)(ws + WS_FGT), args.in[16] + l * NH, (float*)(ws + WS_FCUM), (int*)(ws + WS_KST), ((const float*)(ws + WS_SMAX))[l * 2], bh, F.lds);
            for (int w = F.vcu * NWAVES + F.wave; w < 2048; w += F.G * NWAVES) { const int rem = w >> 1;
                if ((((w & 1) ^ (F.wave >> 2)) & 1) == 0) rec::rec_unit<false, false>(RP, rem >> 5, rem & 31, al + F.wave * rec::W_BYTES);
                else rec::rec_unit<true, false>(RP, rem >> 5, rem & 31, al + F.wave * rec::W_BYTES); }
        }
        SEAM(pb + PL_MIXA); STAMP(3);
        if (IN(pb + PL_MIXB)) {
            const bool sched_blk = (F.G == 256) && ((F.vcu & 31) == 0);
            if (!sched_blk) { if (F.G == 256) rec::scan_items(RP, F.vcu - (F.vcu >> 5) - 1, 248); else rec::scan_items(RP, (int)blockIdx.x, F.G); }
            for (int vc = F.vcu; vc < 256; vc += F.G) if ((vc & 31) == 0) {
                int mt_ = threadIdx.x; asm volatile("" : "+v"(mt_));
                const int x = vc >> 5; const int* kstF = (const int*)(ws + WS_KST); const float smax_d = ((const float*)(ws + WS_SMAX))[l * 2 + 1];
                LAS int* cst = (LAS int*)(F.lds);
                __syncthreads();
                if (mt_ < 128) { const int v = mt_, ty = v >> 6, hh = (v >> 4) & 3, qb = v & 15, nt = 4 * qb + 4; int ks, c;
                    if (ty == 0) { ks = kstF[(4 * x + hh) * 16 + qb]; c = (nt - ks + 4) * 100; }
                    else { const float slope2 = exp2f(-2.0f * (float)(hh + 1)) * LOG2E; const float jf = ((float)(256 * qb) - (152.0f + 2.0f * smax_d) / slope2 - 63.0f) * (1.0f / 64.0f);
                        ks = jf > 0.f ? (int)jf : 0; ks = ks < nt - 4 ? ks : nt - 4; ks &= ~1; c = (nt - ks + 4) * 215; }
                    cst[v] = c; cst[128 + v] = ks; }
                cst[512 + mt_] = -1; cst[512 + 512 + mt_] = -1;
                __syncthreads();
                if (mt_ < 128) { const int c = cst[mt_]; int rank = 0;
                    for (int v4 = 0; v4 < 32; ++v4) { const v4u cc = *(const LAS v4u*)(cst + 4 * v4);
                        rank += ((int)cc.x > c || ((int)cc.x == c && 4 * v4 + 0 < mt_)) + ((int)cc.y > c || ((int)cc.y == c && 4 * v4 + 1 < mt_)) + ((int)cc.z > c || ((int)cc.z == c && 4 * v4 + 2 < mt_)) + ((int)cc.w > c || ((int)cc.w == c && 4 * v4 + 3 < mt_)); }
                    cst[256 + rank] = mt_; }
                __syncthreads();
                if (F.wave == 0) {
                    const int ln = mt_ & 63; int load = 0, own_lo = 0, own_hi = 0;
                    const int c_lo = cst[cst[256 + ln]], c_hi = cst[cst[256 + 64 + ln]];
                    for (int r = 0; r < 128; ++r) {
                        const int c = (r < 64) ? __builtin_amdgcn_readlane(c_lo, r & 63) : __builtin_amdgcn_readlane(c_hi, r & 63);
                        int m = (ln < 32) ? ((load << 5) | ln) : 0x7fffffff;
                        { int t2;
                          t2 = __builtin_amdgcn_update_dpp(0x7fffffff, m, 0x111, 0xf, 0xf, false); m = t2 < m ? t2 : m;
                          t2 = __builtin_amdgcn_update_dpp(0x7fffffff, m, 0x112, 0xf, 0xf, false); m = t2 < m ? t2 : m;
                          t2 = __builtin_amdgcn_update_dpp(0x7fffffff, m, 0x114, 0xf, 0xf, false); m = t2 < m ? t2 : m;
                          t2 = __builtin_amdgcn_update_dpp(0x7fffffff, m, 0x118, 0xf, 0xf, false); m = t2 < m ? t2 : m; }
                        const int m0 = __builtin_amdgcn_readlane(m, 15), m1 = __builtin_amdgcn_readlane(m, 31); const int o = (m0 < m1 ? m0 : m1) & 31;
                        load += (ln == o) ? c : 0;
                        if (r < 64) own_lo = (ln == r) ? o : own_lo; else own_hi = (ln == (r - 64)) ? o : own_hi; }
                    cst[384 + ln] = own_lo; cst[384 + 64 + ln] = own_hi;
                }
                __syncthreads();
                if (mt_ < 128) { const int o = cst[384 + mt_]; int pos = 0;
                    for (int r4 = 0; r4 < 32; ++r4) { const v4u oo = *(const LAS v4u*)(cst + 384 + 4 * r4);
                        pos += ((int)oo.x == o && 4 * r4 + 0 < mt_) + ((int)oo.y == o && 4 * r4 + 1 < mt_) + ((int)oo.z == o && 4 * r4 + 2 < mt_) + ((int)oo.w == o && 4 * r4 + 3 < mt_); }
                    const int v = cst[256 + mt_]; if (pos < 32) cst[512 + o * 32 + pos] = v | (cst[128 + v] << 8); }
                __syncthreads();
                int* gl = (int*)(ws + WS_SCHED) + x * 1024;
                for (int i = mt_; i < 1024; i += NWAVES * 64) gl[i] = cst[512 + i];
                __syncthreads();
            }
        }
        SEAM(pb + PL_MIXB); STAMP(6);
        if (IN(pb + PL_MIXC)) {
            for (int w = F.vcu * NWAVES + F.wave; w < 2048; w += F.G * NWAVES) { const int rem = w >> 1;
                if ((((w & 1) ^ (F.wave >> 2)) & 1) == 0) rec::rec_unit<false, true>(RP, rem >> 5, rem & 31, al + F.wave * rec::W_BYTES);
                else rec::rec_unit<true, true>(RP, rem >> 5, rem & 31, al + F.wave * rec::W_BYTES); }
            __syncthreads(); STAMP(7);
            int mt_ = threadIdx.x; asm volatile("" : "+v"(mt_));
            const float* Fc = (const float*)(ws + WS_FCUM); const int* kstF = (const int*)(ws + WS_KST);
            const float smax_d = ((const float*)(ws + WS_SMAX))[l * 2 + 1];
            const float lam_init = 0.8f - 0.6f * expf(-0.3f * (float)l);
            float lam; { const float* lv = args.in[12] + l * 128; float d01 = 0.f, d23 = 0.f; for (int i = 0; i < 32; ++i) { d01 += lv[i] * lv[32 + i]; d23 += lv[64 + i] * lv[96 + i]; } lam = expf(d01) - expf(d23) + lam_init; }
            LAS int* cst = (LAS int*)(F.lds + 134144);
            static_assert(att::LDS_END <= 134144 && 134144 + (384 + 1024) * 4 <= LDSCTL_OFF, "unit table placement");
            for (int vc = F.vcu; vc < 256; vc += F.G) {
                const int x = vc >> 5, j = vc & 31; const int* myl = (const int*)(ws + WS_SCHED) + (x * 32 + j) * 32;
                for (int k2 = 0; k2 < 64; ++k2) {
                    const int e = myl[k2 & 31]; if (e < 0) continue;
                    const int v = e & 255, ks = e >> 8; if ((v >> 6) != (k2 >> 5)) continue;
                    const int ty = v >> 6, h = (v >> 4) & 3, qb = v & 15, b = x, bh = 4 * x + h;
                    if (ty == 0) {
                        for (int i = ks * 64 + mt_; i < 256 * qb + 256; i += NWAVES * 64) tbl[i] = -Fc[(size_t)bh * SEQ + i] * LOG2E;
                        att::fox_unit(b, h, qb, ks, Z, Y, al);
                    } else {
                        const float slope2 = exp2f(-2.0f * (float)(h + 1)) * LOG2E;
                        for (int i = ks * 64 + mt_; i < 256 * qb + 256; i += NWAVES * 64) tbl[i] = slope2 * (float)i;
                        att::diff_unit(b, h, qb, ks, Z, Y, lam, 1.f - lam_init, args.in[13] + l * HD, al);
                    }
                }
            }
        }
        SEAM(pb + PL_MIXC); STAMP(2);
        if (IN(pb + PL_OUTPROJ)) {
            pg8::Gemm g{Y, (const bf16*)(ws + WS_WOUT) + (size_t)l * 1024 * 1024, T, D, D}; pg8::StaticOrder S; S.init(T, D, F.G, (int)blockIdx.x);
            if (l == 0) { pg8::EpiResGateN<false, true> E{args.in[0], XB, modl + 2 * D, (const float*)(ws + WS_GM2) + (size_t)l * 8 * D, HN, (float*)(ws + WS_SSQ), (LAS float*)(F.lds + XCH_OFF), (LAS unsigned char*)(F.lds + XCH_OFF + 4096)};
                pg8::gemm_phase<pg8::EpiResGateN<false, true>, pg8::StaticOrder, true, true>(F.lds + RING_OFF, g, S, E); }
            else { pg8::EpiResGateN<true, true> E{XB, XB, modl + 2 * D, (const float*)(ws + WS_GM2) + (size_t)l * 8 * D, HN, (float*)(ws + WS_SSQ), (LAS float*)(F.lds + XCH_OFF), (LAS unsigned char*)(F.lds + XCH_OFF + 4096)};
                pg8::gemm_phase<pg8::EpiResGateN<true, true>, pg8::StaticOrder, true, true>(F.lds + RING_OFF, g, S, E); }
        }
        SEAM(pb + PL_OUTPROJ); STAMP(12);
        if (IN(pb + PL_FF1)) {
            pg8::Gemm g{HN, (const bf16*)(ws + WS_W1) + (size_t)l * 4096 * 1024, T, FF, D}; pg8::StaticOrder S; S.init(T, FF, F.G, (int)blockIdx.x);
            pg8::EpiFF1 E{HB, FF, (const float*)(ws + WS_SSQ), (const float*)(ws + WS_BIAS2) + (size_t)l * 8 * FF, (LAS unsigned char*)(F.lds + XCH_OFF)};
            pg8::gemm_phase<pg8::EpiFF1, pg8::StaticOrder, true, true>(F.lds + RING_OFF, g, S, E);
        }
        SEAM(pb + PL_FF1); STAMP(13);
        if (IN(pb + PL_FF2)) {
            pg8::Gemm g{HB, (const bf16*)(ws + WS_W2) + (size_t)l * 1024 * 4096, T, D, FF}; pg8::StaticOrder S; S.init(T, D, F.G, (int)blockIdx.x);
            if (l + 1 < DEPTH) { pg8::EpiResGateN<true, true> E{XB, XB, modl + 5 * D, (const float*)(ws + WS_GM1) + (size_t)(l + 1) * 8 * D, HN, (float*)(ws + WS_SS1), (LAS float*)(F.lds + XCH_OFF), (LAS unsigned char*)(F.lds + XCH_OFF + 4096)};
                pg8::gemm_phase<pg8::EpiResGateN<true, true>, pg8::StaticOrder, true, true>(F.lds + RING_OFF, g, S, E); }
            else { pg8::EpiResGate<true, false> E{XB, args.out, modl + 5 * D};
                pg8::gemm_phase<pg8::EpiResGate<true, false>, pg8::StaticOrder, true, true>(F.lds + RING_OFF, g, S, E); }
        }
        SEAM(pb + PL_FF2); STAMP(14);
    }
#ifdef PROBE_GROUP
    if (blockIdx.x == 0) { const unsigned long long t_end = __builtin_amdgcn_s_memrealtime() + 4ull * t_acc; while (__builtin_amdgcn_s_memrealtime() < t_end) __builtin_amdgcn_s_sleep(8); }
#endif
#undef IN
#undef SEAM
}

extern "C" void kernel_launch(void* const* d_in, const int* in_sizes, int n_in, void* d_out, int out_size, void* d_ws, size_t ws_size, hipStream_t stream) {
    static int grid = 0;
    if (grid == 0) {
        if (n_in != 22 || in_sizes[0] != T * D || out_size != T * D || ws_size < WS_END) { fprintf(stderr, "kernel_launch: unexpected shapes (n_in %d, in0 %d, out %d, ws %zu)\n", n_in, n_in > 0 ? in_sizes[0] : -1, out_size, ws_size); grid = -1; return; }
        int dev = 0, cus = 0;
        if (hipGetDevice(&dev) != hipSuccess || hipDeviceGetAttribute(&cus, hipDeviceAttributeMultiprocessorCount, dev) != hipSuccess) { grid = -1; return; }
        if (hipFuncSetAttribute((const void*)mk_fwd, hipFuncAttributeMaxDynamicSharedMemorySize, LDS_BYTES) != hipSuccess) { fprintf(stderr, "kernel_launch: hipFuncSetAttribute failed\n"); grid = -1; return; }
        (void)hipGetLastError();
        grid = cus;
    }
    if (grid < 0) return;
    (void)hipMemsetAsync((char*)d_ws + WS_CTL, 0, CTL_ZERO_BYTES, stream);
    Args a{};
    for (int i = 0; i < 22; ++i) a.in[i] = (const float*)d_in[i];
    a.out = (float*)d_out; a.ws = (unsigned char*)d_ws;
    a.ph_lo = 0; a.ph_hi = NPH; a.li = 0;
    hipLaunchKernelGGL(mk_fwd, dim3(grid), dim3(NWAVES * 64), LDS_BYTES, stream, a);
}
```

```cpp
#include <hip/hip_runtime.h>
#include <cstdio>
#include <cstdint>
#include <cmath>
#define ATTN_IN_MK 1
#define NEWPREP_H 1
#define NEWPREP_M 1
namespace pg8 {
#define PG8_LAS __attribute__((address_space(3)))
typedef unsigned short bf16_t;
typedef short bf16x8 __attribute__((ext_vector_type(8)));
typedef float f32x4 __attribute__((ext_vector_type(4)));
typedef unsigned u32x4 __attribute__((ext_vector_type(4)));
constexpr int BM = 256, BK = 64, HALF = 128, HTB = HALF * BK * 2  , STAGE_BYTES = 8 * HTB, NXCD = 8, WGM = 8;

__host__ __device__ __forceinline__ int lds_byte(int r, int c) { const int st = (r >> 4) * 2 + (c >> 5), rr = r & 15, cc = c & 31, ob = rr * 64 + cc * 2; return st * 1024 + (ob ^ (((ob >> 9) & 1) << 5)); }
__host__ __device__ __forceinline__ void stage_rc(int b, int& R, int& C) { const int st = b / 1024, sb = b % 1024, swz = sb ^ (((sb >> 9) & 1) << 5); R = (st >> 1) * 16 + swz / 64; C = (st & 1) * 32 + (swz % 64) / 2; }
__host__ __device__ __forceinline__ int perm32(int rho) { const int n = rho >> 4, i = rho & 15; return 8 * (i >> 2) + 4 * n + (i & 3); }

struct Unit { int pm, pn; };
struct Gemm { const bf16_t* A; const bf16_t* Bt; int M, N, K; };

struct StaticOrder {
    int nM, nN, nwg, G, c;
    __host__ __device__ void init(int M, int N, int G_, int c_) { nM = M / BM; nN = N / BM; nwg = nM * nN; G = G_; c = c_; }
    __host__ __device__ bool next(int i, Unit& u) const {
        const long L = (long)i * G + c; if (L >= nwg) return false;
        int wgid = (int)L; { const int q = nwg / NXCD, r = nwg % NXCD, xcd = wgid % NXCD, off = wgid / NXCD; wgid = (xcd < r ? xcd * (q + 1) : r * (q + 1) + (xcd - r) * q) + off; }
        const int nig = WGM * nN, gid = wgid / nig, fm = gid * WGM, gsz = (nM - fm) < WGM ? (nM - fm) : WGM;
        u.pm = fm + ((wgid % nig) % gsz); u.pn = (wgid % nig) / gsz; return true;
    }
    __device__ __forceinline__ void a_ready(const Unit&) const {}
    __device__ __forceinline__ void done(const Unit&) const {}
};

typedef __bf16 cv_bf16x2 __attribute__((ext_vector_type(2))); typedef float cv_f32x2 __attribute__((ext_vector_type(2)));
__device__ __forceinline__ unsigned cvt_pk_bf16(float lo, float hi) { unsigned r; asm volatile("v_cvt_pk_bf16_f32 %0, %1, %2" : "=v"(r) : "v"(lo), "v"(hi)); return r; }
template <int ACT> struct EpiBf16 {
    static constexpr bool PERM = true, SWZ = false, AFTER_DRAIN = false;
    bf16_t* O; int ldc;
    __device__ __forceinline__ void operator()(const f32x4 (&acc)[2][2][4][2], const Unit& u, int wr, int wc, int fr, int fq) const {
        const int row0 = u.pm * BM + wr * 64 + fr; const int col0 = u.pn * BM + wc * 32 + 8 * fq;
#pragma unroll
        for (int ai = 0; ai < 2; ++ai)
#pragma unroll
            for (int m = 0; m < 4; ++m) { bf16_t* rowp = O + (size_t)(row0 + ai * HALF + m * 16) * ldc + col0;
#pragma unroll
                for (int bj = 0; bj < 2; ++bj) { f32x4 v0 = acc[ai][bj][m][0], v1 = acc[ai][bj][m][1];
                    if (ACT == 2) {
#pragma unroll
                        for (int e = 0; e < 4; ++e) { const float a = fmaxf(v0[e], 0.f), b = fmaxf(v1[e], 0.f); v0[e] = a * a; v1[e] = b * b; } }
                    u32x4 w; w.x = cvt_pk_bf16(v0[0], v0[1]); w.y = cvt_pk_bf16(v0[2], v0[3]); w.z = cvt_pk_bf16(v1[0], v1[1]); w.w = cvt_pk_bf16(v1[2], v1[3]);
                    *(u32x4*)(rowp + bj * HALF) = w; } }
    }
};
template <bool BF> __device__ __forceinline__ void ld_res8(const void* p, size_t idx, f32x4& lo, f32x4& hi) {
    if (BF) { const u32x4 w = *(const u32x4*)((const bf16_t*)p + idx);
        lo = (f32x4){__builtin_bit_cast(float, w.x << 16), __builtin_bit_cast(float, w.x & 0xffff0000u), __builtin_bit_cast(float, w.y << 16), __builtin_bit_cast(float, w.y & 0xffff0000u)};
        hi = (f32x4){__builtin_bit_cast(float, w.z << 16), __builtin_bit_cast(float, w.z & 0xffff0000u), __builtin_bit_cast(float, w.w << 16), __builtin_bit_cast(float, w.w & 0xffff0000u)}; }
    else { lo = *(const f32x4*)((const float*)p + idx); hi = *(const f32x4*)((const float*)p + idx + 4); } }
template <bool BF> __device__ __forceinline__ void st_res8(void* p, size_t idx, f32x4 lo, f32x4 hi) {
    if (BF) { u32x4 w; w.x = cvt_pk_bf16(lo[0], lo[1]); w.y = cvt_pk_bf16(lo[2], lo[3]); w.z = cvt_pk_bf16(hi[0], hi[1]); w.w = cvt_pk_bf16(hi[2], hi[3]); *(u32x4*)((bf16_t*)p + idx) = w; }
    else { *(f32x4*)((float*)p + idx) = lo; *(f32x4*)((float*)p + idx + 4) = hi; } }
template <bool BASE_BF, bool OUT_BF> struct EpiResGate {
    static_assert(BASE_BF && !OUT_BF, "final epilogue: bf16 residual in, f32 out");
    static constexpr bool PERM = true, SWZ = true, AFTER_DRAIN = false; static constexpr int CW = 64, BJ = 32;
    const void* base; void* out; const float* gate; PG8_LAS unsigned char* stg;
    __device__ __forceinline__ void operator()(const f32x4 (&acc)[2][2][4][2], const Unit& u, int wr, int wc, int fr, int fq) const {
        const int col0 = u.pn * BM + wc * CW + 8 * fq; const int b = (u.pm * BM) >> 12;
        const float* gp = gate + (size_t)b * 6144 + col0;
        f32x4 gv[2][2];
#pragma unroll
        for (int bj = 0; bj < 2; ++bj)
#pragma unroll
            for (int n = 0; n < 2; ++n) gv[bj][n] = *(const f32x4*)(gp + bj * BJ + 4 * n);
        PG8_LAS unsigned char* sw = stg + (wr * 4 + wc) * 2048;
        const int lane_ = fq * 16 + fr, rr_ = lane_ >> 3, cc_ = lane_ & 7;
        PG8_LAS unsigned char* wp_ = sw + fr * 128; const int wx_ = fr & 7;
        PG8_LAS unsigned char* rp_ = sw + rr_ * 128 + ((cc_ ^ (rr_ & 7)) << 4);
        float* gout_ = (float*)out + (size_t)(u.pm * BM + wr * 64 + rr_) * 1024 + u.pn * BM + wc * 64 + cc_ * 4;
#pragma unroll
        for (int ai = 0; ai < 2; ++ai)
#pragma unroll
            for (int m = 0; m < 4; ++m) { const size_t off = (size_t)(u.pm * BM + ai * HALF + wr * 64 + m * 16 + fr) * 1024 + col0;
#pragma unroll
                for (int bj = 0; bj < 2; ++bj) { f32x4 b0, b1; ld_res8<true>(base, off + bj * BJ, b0, b1);
                    const f32x4 x0 = b0 + gv[bj][0] * acc[ai][bj][m][0], x1 = b1 + gv[bj][1] * acc[ai][bj][m][1];
                    *(PG8_LAS f32x4*)(wp_ + (((2 * fq) ^ wx_) << 4)) = x0; *(PG8_LAS f32x4*)(wp_ + (((2 * fq + 1) ^ wx_) << 4)) = x1;
                    asm volatile("s_waitcnt lgkmcnt(0)" ::: "memory");
                    const f32x4 o0 = *(const PG8_LAS f32x4*)rp_, o1 = *(const PG8_LAS f32x4*)(rp_ + 1024);
                    asm volatile("s_waitcnt lgkmcnt(0)" ::: "memory");
                    float* g_ = gout_ + (size_t)(ai * HALF + m * 16) * 1024 + bj * BJ; *(f32x4*)g_ = o0; *(f32x4*)(g_ + (size_t)8 * 1024) = o1; } }
    }
};
template <bool BASE_BF, bool OUT_BF> struct EpiResGateN {
    static_assert(OUT_BF, "the staged stores write bf16");
    static constexpr bool PERM = true, SWZ = true, AFTER_DRAIN = false; static constexpr int CW = 64, BJ = 32;
    const void* base; void* out; const float* gate; const float* gm; bf16_t* hn; float* ssq; PG8_LAS float* xch; PG8_LAS unsigned char* stg;
    __device__ __forceinline__ void operator()(const f32x4 (&acc)[2][2][4][2], const Unit& u, int wr, int wc, int fr, int fq) const {
        const int col0 = u.pn * BM + wc * CW + 8 * fq; const int b = (u.pm * BM) >> 12;
        const float* gp = gate + (size_t)b * 6144 + col0; const float* mp = gm + (size_t)b * 1024 + col0;
        f32x4 gv[2][2], mv[2][2];
#pragma unroll
        for (int bj = 0; bj < 2; ++bj)
#pragma unroll
            for (int n = 0; n < 2; ++n) { gv[bj][n] = *(const f32x4*)(gp + bj * BJ + 4 * n); mv[bj][n] = *(const f32x4*)(mp + bj * BJ + 4 * n); }
        PG8_LAS unsigned char* sw = stg + (wr * 4 + wc) * 2048;
        const int lane_ = fq * 16 + fr, rr_ = lane_ >> 3, cc_ = lane_ & 7;
        PG8_LAS unsigned char* wp_ = sw + fr * 128; const int wx_ = fr & 7;
        PG8_LAS unsigned char* rp_ = sw + rr_ * 128 + ((cc_ ^ (rr_ & 7)) << 4);
        const size_t goff_ = (size_t)(u.pm * BM + wr * 64 + rr_) * 1024 + u.pn * BM + wc * 64 + cc_ * 8;
#define RG_PUT(bj, w) (*(PG8_LAS u32x4*)(wp_ + (((4 * (bj) + fq) ^ wx_) << 4)) = (w))
#define RG_FLUSH(dst, ai, m) do { asm volatile("s_waitcnt lgkmcnt(0)" ::: "memory"); const u32x4 o0_ = *(const PG8_LAS u32x4*)rp_, o1_ = *(const PG8_LAS u32x4*)(rp_ + 1024); asm volatile("s_waitcnt lgkmcnt(0)" ::: "memory"); \
            bf16_t* g_ = (dst) + goff_ + (size_t)((ai) * HALF + (m) * 16) * 1024; *(u32x4*)g_ = o0_; *(u32x4*)(g_ + (size_t)8 * 1024) = o1_; } while (0)
#pragma unroll
        for (int ai = 0; ai < 2; ++ai)
#pragma unroll
            for (int m = 0; m < 4; ++m) { const int rl = ai * HALF + wr * 64 + m * 16 + fr; const size_t off = (size_t)(u.pm * BM + rl) * 1024 + col0; float s = 0.f;
                u32x4 wxb[2], whn[2];
#pragma unroll
                for (int bj = 0; bj < 2; ++bj) { f32x4 b0, b1; ld_res8<BASE_BF>(base, off + bj * BJ, b0, b1);
                    const f32x4 x0 = b0 + gv[bj][0] * acc[ai][bj][m][0], x1 = b1 + gv[bj][1] * acc[ai][bj][m][1];
                    s += ((x0[0] * x0[0] + x0[1] * x0[1]) + (x0[2] * x0[2] + x0[3] * x0[3])) + ((x1[0] * x1[0] + x1[1] * x1[1]) + (x1[2] * x1[2] + x1[3] * x1[3]));
                    wxb[bj].x = cvt_pk_bf16(x0[0], x0[1]); wxb[bj].y = cvt_pk_bf16(x0[2], x0[3]); wxb[bj].z = cvt_pk_bf16(x1[0], x1[1]); wxb[bj].w = cvt_pk_bf16(x1[2], x1[3]);
                    const f32x4 h0 = x0 * mv[bj][0], h1 = x1 * mv[bj][1];
                    whn[bj].x = cvt_pk_bf16(h0[0], h0[1]); whn[bj].y = cvt_pk_bf16(h0[2], h0[3]); whn[bj].z = cvt_pk_bf16(h1[0], h1[1]); whn[bj].w = cvt_pk_bf16(h1[2], h1[3]); }
                RG_PUT(0, wxb[0]); RG_PUT(1, wxb[1]); RG_FLUSH((bf16_t*)out, ai, m);
                RG_PUT(0, whn[0]); RG_PUT(1, whn[1]); RG_FLUSH(hn, ai, m);
                s += __shfl_xor(s, 16); s += __shfl_xor(s, 32);
                if (fq == 0) xch[rl * 4 + wc] = s; }
#undef RG_PUT
#undef RG_FLUSH
        asm volatile("s_waitcnt lgkmcnt(0)" ::: "memory"); __builtin_amdgcn_s_barrier(); asm volatile("" ::: "memory");
        const int tid = (wr * 4 + wc) * 64 + fq * 16 + fr;
        if (tid < 256) { const f32x4 p = *(const PG8_LAS f32x4*)(xch + tid * 4); ssq[(size_t)(u.pm * BM + tid) * 4 + u.pn] = (p[0] + p[1]) + (p[2] + p[3]); }
    }
};
struct EpiFF1 {
    static constexpr bool PERM = true, SWZ = true, AFTER_DRAIN = false;
    bf16_t* O; int ldc; const float* ssq; const float* bias; PG8_LAS unsigned char* stg;
    __device__ __forceinline__ void operator()(const f32x4 (&acc)[2][2][4][2], const Unit& u, int wr, int wc, int fr, int fq) const {
        const int rowb = u.pm * BM + wr * 64; const int colw = u.pn * BM + wc * 64; const int b = (u.pm * BM) >> 12;
        const float* bp = bias + (size_t)b * 4096 + colw + 8 * fq;
        f32x4 bv[2][2];
#pragma unroll
        for (int bj = 0; bj < 2; ++bj)
#pragma unroll
            for (int n = 0; n < 2; ++n) bv[bj][n] = *(const f32x4*)(bp + bj * 32 + 4 * n);
        PG8_LAS unsigned char* sw = stg + (wr * 4 + wc) * 2048;
        const int lane = fq * 16 + fr, rr = lane >> 3, cc = lane & 7;
        PG8_LAS unsigned char* wp = sw + fr * 128; const int wx = fr & 7;
        PG8_LAS unsigned char* rp = sw + rr * 128 + ((cc ^ (rr & 7)) << 4);
        bf16_t* gp = O + (size_t)(rowb + rr) * ldc + colw + cc * 8;
#pragma unroll
        for (int ai = 0; ai < 2; ++ai)
#pragma unroll
            for (int m = 0; m < 4; ++m) { const int row = rowb + ai * HALF + m * 16 + fr;
                const f32x4 p = *(const f32x4*)(ssq + (size_t)row * 4); const float r = __builtin_amdgcn_rsqf(((p[0] + p[1]) + (p[2] + p[3])) * (1.f / 1024.f) + 1e-6f);
#pragma unroll
                for (int bj = 0; bj < 2; ++bj) { f32x4 v0 = acc[ai][bj][m][0] * r + bv[bj][0], v1 = acc[ai][bj][m][1] * r + bv[bj][1];
#pragma unroll
                    for (int e = 0; e < 4; ++e) { const float a = fmaxf(v0[e], 0.f), c = fmaxf(v1[e], 0.f); v0[e] = a * a; v1[e] = c * c; }
                    u32x4 w; w.x = cvt_pk_bf16(v0[0], v0[1]); w.y = cvt_pk_bf16(v0[2], v0[3]); w.z = cvt_pk_bf16(v1[0], v1[1]); w.w = cvt_pk_bf16(v1[2], v1[3]);
                    *(PG8_LAS u32x4*)(wp + (((4 * bj + fq) ^ wx) << 4)) = w; }
                asm volatile("s_waitcnt lgkmcnt(0)" ::: "memory");
                const u32x4 o0 = *(const PG8_LAS u32x4*)rp, o1 = *(const PG8_LAS u32x4*)(rp + 1024);
                asm volatile("s_waitcnt lgkmcnt(0)" ::: "memory");
                bf16_t* g = gp + (size_t)(ai * HALF + m * 16) * ldc;
                *(u32x4*)g = o0; *(u32x4*)(g + (size_t)8 * ldc) = o1; }
    }
};
struct EpiInProj {
    static constexpr bool PERM = true, SWZ = true, AFTER_DRAIN = false;
    bf16_t* O; int ldc; const float* qkg  ; PG8_LAS unsigned char* stg  ;
    const float* ssq  ; const float* bias  ; float* gates  ; float* fgt  ;
    __device__ __forceinline__ void operator()(f32x4 (&acc)[2][2][4][2], const Unit& u, int wr, int wc, int fr, int fq) const {
        asm volatile("" : "+v"(fr), "+v"(fq));
        const int row0 = u.pm * BM + wr * 64 + fr; const int col0 = u.pn * BM + wc * 64 + 8 * fq;
        const int pn = u.pn; const bool nrm = (pn == 4) | (pn == 5) | (pn == 7) | (pn == 8);
        { const int b = (u.pm * BM) >> 12; const float* bp = bias + (size_t)b * 4096 + col0;
          f32x4 bv[2][2];
#pragma unroll
          for (int bj = 0; bj < 2; ++bj)
#pragma unroll
              for (int n = 0; n < 2; ++n) bv[bj][n] = *(const f32x4*)(bp + bj * 32 + 4 * n);
#pragma unroll
          for (int ai = 0; ai < 2; ++ai)
#pragma unroll
              for (int m = 0; m < 4; ++m) { const f32x4 p = *(const f32x4*)(ssq + (size_t)(row0 + ai * HALF + m * 16) * 4); const float r = __builtin_amdgcn_rsqf(((p[0] + p[1]) + (p[2] + p[3])) * (1.f / 1024.f) + 1e-6f);
#pragma unroll
                  for (int bj = 0; bj < 2; ++bj)
#pragma unroll
                      for (int n = 0; n < 2; ++n) acc[ai][bj][m][n] = acc[ai][bj][m][n] * r + bv[bj][n]; } }
        if (pn == 15) {
            int fq2 = fq; asm volatile("" : "+v"(fq2));
            if (wc == 0 && fq2 < 2) { const int b = (u.pm * BM) >> 12;
#pragma unroll
                for (int ai = 0; ai < 2; ++ai)
#pragma unroll
                    for (int m = 0; m < 4; ++m) { const int row = row0 + ai * HALF + m * 16; float* gp = gates + (size_t)row * 12 + 8 * fq2;
                        *(f32x4*)gp = acc[ai][0][m][0]; if (fq2 == 0) { *(f32x4*)(gp + 4) = acc[ai][0][m][1];
#pragma unroll
                            for (int e = 0; e < 4; ++e) fgt[(size_t)(b * 4 + e) * 4096 + (row & 4095)] = acc[ai][0][m][0][e]; } } }
            return;
        }
        PG8_LAS unsigned char* sw = stg + (wr * 4 + wc) * 2048;
        const int lane_ = fq * 16 + fr, rr_ = lane_ >> 3, cc_ = lane_ & 7;
        PG8_LAS unsigned char* wp_ = sw + fr * 128; const int wx_ = fr & 7;
        PG8_LAS unsigned char* rp_ = sw + rr_ * 128 + ((cc_ ^ (rr_ & 7)) << 4);
        bf16_t* gp_ = O + (size_t)(u.pm * BM + wr * 64 + rr_) * ldc + u.pn * BM + wc * 64 + cc_ * 8;
#define INPROJ_PUT(bj, w) (*(PG8_LAS u32x4*)(wp_ + (((4 * (bj) + fq) ^ wx_) << 4)) = (w))
#define INPROJ_FLUSH(ai, m) do { asm volatile("s_waitcnt lgkmcnt(0)" ::: "memory"); const u32x4 o0_ = *(const PG8_LAS u32x4*)rp_, o1_ = *(const PG8_LAS u32x4*)(rp_ + 1024); asm volatile("s_waitcnt lgkmcnt(0)" ::: "memory"); \
            bf16_t* g_ = gp_ + (size_t)((ai) * HALF + (m) * 16) * ldc; *(u32x4*)g_ = o0_; *(u32x4*)(g_ + (size_t)8 * ldc) = o1_; } while (0)
        if (!nrm) {
#pragma unroll
            for (int ai = 0; ai < 2; ++ai)
#pragma unroll
                for (int m = 0; m < 4; ++m) {
#pragma unroll
                    for (int bj = 0; bj < 2; ++bj) { const f32x4 v0 = acc[ai][bj][m][0], v1 = acc[ai][bj][m][1];
                        u32x4 w; w.x = cvt_pk_bf16(v0[0], v0[1]); w.y = cvt_pk_bf16(v0[2], v0[3]); w.z = cvt_pk_bf16(v1[0], v1[1]); w.w = cvt_pk_bf16(v1[2], v1[3]);
                        INPROJ_PUT(bj, w); }
                    INPROJ_FLUSH(ai, m); }
            return;
        }
        const bool wide = (pn >= 7);
        const float inv_n = wide ? (1.f / 64.f) : (1.f / 32.f);
        const float* gp = qkg + ((pn == 4) ? 0 : (pn == 5 ? 64 : (pn == 7 ? 128 : 192)));
        f32x4 gq[2][2];
#pragma unroll
        for (int bj = 0; bj < 2; ++bj) { const int gcol = (wide ? 32 * bj : 0) + 8 * fq; gq[bj][0] = *(const f32x4*)(gp + gcol); gq[bj][1] = *(const f32x4*)(gp + gcol + 4); }
#pragma unroll
        for (int ai = 0; ai < 2; ++ai)
#pragma unroll
            for (int m = 0; m < 4; ++m) { float sg[2];
#pragma unroll
                for (int bj = 0; bj < 2; ++bj) { const f32x4 a = acc[ai][bj][m][0], b = acc[ai][bj][m][1];
                    float s = (a[0] * a[0] + a[1] * a[1]) + (a[2] * a[2] + a[3] * a[3]) + (b[0] * b[0] + b[1] * b[1]) + (b[2] * b[2] + b[3] * b[3]);
                    s += __shfl_xor(s, 16); s += __shfl_xor(s, 32); sg[bj] = s; }
                const float tot = sg[0] + sg[1];
#pragma unroll
                for (int bj = 0; bj < 2; ++bj) { const float r = __builtin_amdgcn_rsqf((wide ? tot : sg[bj]) * inv_n + 1e-6f);
                    const f32x4 v0 = acc[ai][bj][m][0] * gq[bj][0] * r, v1 = acc[ai][bj][m][1] * gq[bj][1] * r;
                    u32x4 w; w.x = cvt_pk_bf16(v0[0], v0[1]); w.y = cvt_pk_bf16(v0[2], v0[3]); w.z = cvt_pk_bf16(v1[0], v1[1]); w.w = cvt_pk_bf16(v1[2], v1[3]);
                    INPROJ_PUT(bj, w); }
                INPROJ_FLUSH(ai, m); }
#undef INPROJ_PUT
#undef INPROJ_FLUSH
    }
};
template <class Epi, class Sched, bool ALIGN_EPI = false, bool SP2 = false>
__device__ __forceinline__ void gemm_phase(PG8_LAS unsigned char* lds, const Gemm g, const Sched& S, const Epi& E) {
    int tid_ = threadIdx.x; asm volatile("" : "+v"(tid_));
    const int tid = tid_, wid = __builtin_amdgcn_readfirstlane(tid >> 6), lane = tid & 63, wr = wid >> 2, wc = wid & 3, fr = lane & 15, fq = lane >> 4;
    const int K = g.K, nt = K / BK;
    unsigned voffA[2], voffB[2];
#pragma unroll
    for (int i = 0; i < 2; ++i) { int R, C; stage_rc(tid * 16 + i * 8192, R, C); const int Rb = Epi::SWZ ? ((R >> 5) * 64 + perm32(R & 31)) : Epi::PERM ? ((R & ~31) + perm32(R & 31)) : R;
        voffA[i] = (unsigned)(R * K + C) * 2u; voffB[i] = (unsigned)(Rb * K + C) * 2u; }
    const size_t kstep = (size_t)(BK * 2);
    const size_t hstep = (size_t)HALF * K * 2;
    const size_t hstepB = Epi::SWZ ? (size_t)32 * K * 2 : hstep;
    const size_t tstep = 2 * hstep;
    const unsigned ldsw = (unsigned)wid * 1024u;
    const int aoff = lds_byte(wr * 64 + fr, fq * 8), boff = lds_byte(wc * 32 + fr, fq * 8);
#define PG8_SA(b, h) (((b) * 2 + (h)) * HTB)
#define PG8_SB(b, h) ((4 + (b) * 2 + (h)) * HTB)
#define PG8_STAGE(bufoff, gbase, voff) do { _Pragma("unroll") for (int _i = 0; _i < 2; ++_i) \
        __builtin_amdgcn_global_load_lds((const unsigned*)((const char*)(gbase) + (voff)[_i]), (PG8_LAS unsigned*)(lds + (bufoff) + ldsw + _i * 8192), 16, 0, 0); } while (0)
#define PG8_LDA(dst, b, h) do { _Pragma("unroll") for (int m = 0; m < 4; ++m) _Pragma("unroll") for (int k = 0; k < 2; ++k) dst[m][k] = *(const PG8_LAS bf16x8*)(lds + PG8_SA(b, h) + aoff + m * 2048 + k * 1024); } while (0)
#define PG8_LDB(dst, b, h) do { _Pragma("unroll") for (int n = 0; n < 2; ++n) _Pragma("unroll") for (int k = 0; k < 2; ++k) dst[n][k] = *(const PG8_LAS bf16x8*)(lds + PG8_SB(b, h) + boff + n * 2048 + k * 1024); } while (0)
#define PG8_MMA(ai, bj, At, Bt) do { __builtin_amdgcn_s_setprio(1); _Pragma("unroll") for (int m = 0; m < 4; ++m) _Pragma("unroll") for (int n = 0; n < 2; ++n) _Pragma("unroll") for (int k = 0; k < 2; ++k) \
        acc[ai][bj][m][n] = __builtin_amdgcn_mfma_f32_16x16x32_bf16(Bt[n][k], At[m][k], acc[ai][bj][m][n], 0, 0, 0); __builtin_amdgcn_s_setprio(0); } while (0)
#define PG8_WAIT_V(n) asm volatile("s_waitcnt vmcnt(" #n ")" ::: "memory")
#define PG8_WAIT_L(n) asm volatile("s_waitcnt lgkmcnt(" #n ")" ::: "memory")
#define PG8_BAR __builtin_amdgcn_s_barrier()
#define PG8_SCHED __builtin_amdgcn_sched_barrier(0)
    Unit cur, nxt; int ui = 0;
    if (!S.next(0, cur)) return;
    f32x4 acc[2][2][4][2];
#pragma unroll
    for (int a = 0; a < 2; ++a)
#pragma unroll
        for (int b = 0; b < 2; ++b)
#pragma unroll
            for (int m = 0; m < 4; ++m)
#pragma unroll
                for (int n = 0; n < 2; ++n) acc[a][b][m][n] = (f32x4){0.f, 0.f, 0.f, 0.f};
    bf16x8 At[4][2], B0[2][2], B1[2][2];
    const char* cA = (const char*)g.A + (size_t)cur.pm * tstep; const char* cB = (const char*)g.Bt + (size_t)cur.pn * tstep;
    S.a_ready(cur);
    if constexpr (SP2) {
        PG8_STAGE(PG8_SB(0, 0), cB, voffB); PG8_STAGE(PG8_SB(0, 1), cB + hstepB, voffB); PG8_STAGE(PG8_SA(0, 0), cA, voffA); PG8_STAGE(PG8_SA(0, 1), cA + hstep, voffA);
        if (wr == 1) PG8_BAR;
        PG8_WAIT_V(2); PG8_BAR;
        PG8_STAGE(PG8_SB(1, 0), cB + kstep, voffB); PG8_STAGE(PG8_SA(1, 0), cA + kstep, voffA); PG8_STAGE(PG8_SB(1, 1), cB + hstepB + kstep, voffB);
        PG8_WAIT_V(6); PG8_BAR;
    } else {
        PG8_STAGE(PG8_SB(0, 0), cB, voffB); PG8_STAGE(PG8_SA(0, 0), cA, voffA); PG8_STAGE(PG8_SB(0, 1), cB + hstepB, voffB); PG8_STAGE(PG8_SA(0, 1), cA + hstep, voffA);
        if (wr == 1) PG8_BAR;
        PG8_WAIT_V(4); PG8_BAR;
        PG8_STAGE(PG8_SB(1, 0), cB + kstep, voffB); PG8_STAGE(PG8_SA(1, 0), cA + kstep, voffA); PG8_STAGE(PG8_SB(1, 1), cB + hstepB + kstep, voffB);
        PG8_WAIT_V(6); PG8_BAR;
    }
    for (;;) {
        const bool has_next = S.next(ui + 1, nxt);
        const char* nA = has_next ? (const char*)g.A + (size_t)nxt.pm * tstep : cA; const char* nB = has_next ? (const char*)g.Bt + (size_t)nxt.pn * tstep : cB;
        for (int t = 0; t < nt; t += 2) {
            const bool last = (t == nt - 2);
            const char* a1 = cA + (size_t)(t + 1) * kstep;
            const char* a2 = last ? nA : cA + (size_t)(t + 2) * kstep; const char* b2 = last ? nB : cB + (size_t)(t + 2) * kstep;
            const char* a3 = a2 + kstep; const char* b3 = b2 + kstep;
            if (last && has_next) S.a_ready(nxt);
            if constexpr (SP2) {
            PG8_LDB(B0, 0, 0); PG8_LDB(B1, 0, 1); PG8_SCHED; PG8_LDA(At, 0, 0); PG8_STAGE(PG8_SA(1, 1), a1 + hstep, voffA);
            PG8_WAIT_V(8); PG8_WAIT_L(0); PG8_BAR; PG8_MMA(0, 0, At, B0); PG8_MMA(0, 1, At, B1); PG8_BAR; PG8_SCHED;
            PG8_LDA(At, 0, 1); PG8_STAGE(PG8_SB(0, 0), b2, voffB); PG8_STAGE(PG8_SB(0, 1), b2 + hstepB, voffB); PG8_STAGE(PG8_SA(0, 0), a2, voffA);
            PG8_WAIT_V(8); PG8_WAIT_L(0); PG8_BAR; PG8_MMA(1, 0, At, B0); PG8_MMA(1, 1, At, B1); PG8_BAR; PG8_SCHED;
            PG8_LDB(B0, 1, 0); PG8_LDB(B1, 1, 1); PG8_SCHED; PG8_LDA(At, 1, 0); PG8_STAGE(PG8_SA(0, 1), a2 + hstep, voffA);
            PG8_WAIT_V(8); PG8_WAIT_L(0); PG8_BAR; PG8_MMA(0, 0, At, B0); PG8_MMA(0, 1, At, B1); PG8_BAR; PG8_SCHED;
            PG8_LDA(At, 1, 1); PG8_STAGE(PG8_SB(1, 0), b3, voffB); PG8_STAGE(PG8_SB(1, 1), b3 + hstepB, voffB); PG8_STAGE(PG8_SA(1, 0), a3, voffA);
            PG8_WAIT_V(8); PG8_WAIT_L(0); PG8_BAR; PG8_MMA(1, 0, At, B0); PG8_MMA(1, 1, At, B1); PG8_BAR; PG8_SCHED;
            } else {
            PG8_LDB(B0, 0, 0); PG8_SCHED; PG8_LDA(At, 0, 0); PG8_STAGE(PG8_SA(1, 1), a1 + hstep, voffA);
            PG8_WAIT_L(8); PG8_BAR; PG8_WAIT_L(0); PG8_MMA(0, 0, At, B0); PG8_BAR; PG8_SCHED;
            PG8_LDB(B1, 0, 1); PG8_STAGE(PG8_SB(0, 0), b2, voffB);
            PG8_BAR; PG8_WAIT_L(0); PG8_MMA(0, 1, At, B1); PG8_BAR;
            PG8_LDA(At, 0, 1); PG8_STAGE(PG8_SA(0, 0), a2, voffA);
            PG8_BAR; PG8_WAIT_L(0); PG8_MMA(1, 0, At, B0); PG8_BAR; PG8_SCHED;
            PG8_STAGE(PG8_SB(0, 1), b2 + hstepB, voffB);
            PG8_WAIT_V(6); PG8_BAR; PG8_MMA(1, 1, At, B1); PG8_BAR;
            PG8_LDB(B0, 1, 0); PG8_SCHED; PG8_LDA(At, 1, 0); PG8_STAGE(PG8_SA(0, 1), a2 + hstep, voffA);
            PG8_WAIT_L(8); PG8_BAR; PG8_WAIT_L(0); PG8_MMA(0, 0, At, B0); PG8_BAR; PG8_SCHED;
            PG8_LDB(B1, 1, 1); PG8_STAGE(PG8_SB(1, 0), b3, voffB);
            PG8_BAR; PG8_WAIT_L(0); PG8_MMA(0, 1, At, B1); PG8_BAR;
            PG8_LDA(At, 1, 1); PG8_STAGE(PG8_SA(1, 0), a3, voffA);
            PG8_BAR; PG8_WAIT_L(0); PG8_MMA(1, 0, At, B0); PG8_BAR; PG8_SCHED;
            PG8_STAGE(PG8_SB(1, 1), b3 + hstepB, voffB);
            PG8_WAIT_V(6); PG8_BAR; PG8_MMA(1, 1, At, B1); PG8_BAR;
            }
        }
        if constexpr (ALIGN_EPI) { if (wr == 0) PG8_BAR; }
        if constexpr (!Epi::AFTER_DRAIN) { E(acc, cur, wr, wc, fr, fq); S.done(cur); }
        if (!has_next) break;
#pragma unroll
        for (int a = 0; a < 2; ++a)
#pragma unroll
            for (int b = 0; b < 2; ++b)
#pragma unroll
                for (int m = 0; m < 4; ++m)
#pragma unroll
                    for (int n = 0; n < 2; ++n) acc[a][b][m][n] = (f32x4){0.f, 0.f, 0.f, 0.f};
        cur = nxt; cA = nA; cB = nB; ++ui;
        if constexpr (ALIGN_EPI) { if (wr == 1) PG8_BAR; }
    }
    PG8_WAIT_V(0);
    if constexpr (!ALIGN_EPI) { if (wr == 0) PG8_BAR; }
    PG8_BAR;
    if constexpr (Epi::AFTER_DRAIN) { E.fused(acc, cur, wr, wc, fr, fq, lds, wid, lane); S.done(cur); }
#undef PG8_SA
#undef PG8_SB
#undef PG8_STAGE
#undef PG8_LDA
#undef PG8_LDB
#undef PG8_MMA
#undef PG8_WAIT_V
#undef PG8_WAIT_L
#undef PG8_BAR
#undef PG8_SCHED
}
}
#define GAS __attribute__((address_space(1)))
#define LAS __attribute__((address_space(3)))
typedef unsigned short bf16;
typedef unsigned v4u __attribute__((ext_vector_type(4)));
typedef float f32x4 __attribute__((ext_vector_type(4)));
typedef short bf16x8 __attribute__((ext_vector_type(8)));
typedef GAS unsigned gu32;
typedef GAS unsigned long long gu64;
#define RLX_AGENT __ATOMIC_RELAXED, __HIP_MEMORY_SCOPE_AGENT
#define LDS_WAIT() asm volatile("s_waitcnt lgkmcnt(0)" ::: "memory")
#define VM_WAIT() asm volatile("s_waitcnt vmcnt(0)" ::: "memory")
__device__ __forceinline__ unsigned long long rt() { return __builtin_amdgcn_s_memrealtime(); }
__device__ __forceinline__ unsigned f2bf(float f) { unsigned u = __builtin_bit_cast(unsigned, f); return (u + 0x7fffu + ((u >> 16) & 1u)) >> 16; }
__device__ __forceinline__ unsigned pk2(float lo, float hi) { return f2bf(lo) | (f2bf(hi) << 16); }

#define XB_TMO      128
#define XB_XCNT(j)  (256  + 64 * (j))
#define XB_XSUB(j)  (1280 + 64 * (j))
#define XB_XGEN(j)  (2304 + 64 * (j))
#define XB_TOP      3328
#define XB_TOPGEN   3392
#define XCD_BAR_WORDS 3456
#define XB_SPIN_CAP (1u << 18)

__device__ __forceinline__ unsigned xb_ld(unsigned* p)              { return __hip_atomic_load(p, __ATOMIC_RELAXED, __HIP_MEMORY_SCOPE_AGENT); }
__device__ __forceinline__ unsigned xb_add(unsigned* p, unsigned v) { return __hip_atomic_fetch_add(p, v, __ATOMIC_RELAXED, __HIP_MEMORY_SCOPE_AGENT); }
__device__ __forceinline__ unsigned xb_xcc_id() { return (unsigned)__builtin_amdgcn_s_getreg((3 << 11) | 20) & 0xFu; }
#define XB_SPIN(cond, bar) do { unsigned _sp = 0; while (cond) { __builtin_amdgcn_s_sleep(1); \
    if ((++_sp & 255u) == 0u) { if (xb_ld(&(bar)[XB_TMO])) break; if (_sp > XB_SPIN_CAP) { atomicAdd(&(bar)[XB_TMO], 1u); break; } } } } while (0)

struct XcdBarrier {
    unsigned* bar; unsigned x;
    volatile LAS unsigned* st;
};

__device__ __forceinline__ XcdBarrier xcd_barrier_post(unsigned* bar, volatile LAS unsigned* st) {
    XcdBarrier b; b.bar = bar; b.x = xb_xcc_id(); b.st = st;
    if (threadIdx.x == 0) (void)xb_add(&bar[XB_XCNT(b.x)], 1u);
    return b;
}
__device__ __forceinline__ void xcd_barrier_complete(unsigned* bar, unsigned x, unsigned& nloc, unsigned& nx) {
    const unsigned G = gridDim.x * gridDim.y * gridDim.z;
    unsigned sum, cnt, mine, sp = 0u;
    for (;;) {
        sum = 0u; cnt = 0u; mine = 0u;
#pragma unroll
        for (unsigned j = 0; j < 16; ++j) { const unsigned c = xb_ld(&bar[XB_XCNT(j)]); sum += c; cnt += (c > 0u) ? 1u : 0u; mine = (j == x) ? c : mine; }
        if (sum == G) break;
        __builtin_amdgcn_s_sleep(1);
        if ((++sp & 255u) == 0u) { if (xb_ld(&bar[XB_TMO])) break; if (sp > XB_SPIN_CAP) { atomicAdd(&bar[XB_TMO], 1u); break; } }
    }
    nloc = mine > 0u ? mine : 1u; nx = cnt > 0u ? cnt : 1u;
}

__device__ __forceinline__ void xcd_barrier(const XcdBarrier& b) {
    asm volatile("s_waitcnt vmcnt(0)" ::: "memory");
    __syncthreads();
    if (threadIdx.x == 0) {
        unsigned* bar = b.bar;
        __builtin_amdgcn_s_waitcnt(0);
        unsigned nloc = b.st[0], nx = b.st[1];
        if (nloc == 0u) { xcd_barrier_complete(bar, b.x, nloc, nx); b.st[0] = nloc; b.st[1] = nx; }
        const unsigned old = xb_add(&bar[XB_XSUB(b.x)], 1u);
        const unsigned gen = old / nloc;
        if (old + 1u == (gen + 1u) * nloc) {
            __builtin_amdgcn_fence(__ATOMIC_RELEASE, "agent");
            asm volatile("s_waitcnt vmcnt(0)" ::: "memory");
            const unsigned og = xb_add(&bar[XB_TOP], 1u);
            const unsigned tg = og / nx;
            if (og + 1u == (tg + 1u) * nx) xb_add(&bar[XB_TOPGEN], 1u);
            else XB_SPIN(xb_ld(&bar[XB_TOPGEN]) == tg, bar);
            __builtin_amdgcn_fence(__ATOMIC_ACQUIRE, "agent");
            xb_add(&bar[XB_XGEN(b.x)], 1u);
            asm volatile("s_waitcnt vmcnt(0)" ::: "memory");
        } else {
            XB_SPIN(xb_ld(&bar[XB_XGEN(b.x)]) == gen, bar);
            __builtin_amdgcn_fence(__ATOMIC_ACQUIRE, "agent");
            asm volatile("s_waitcnt vmcnt(0)" ::: "memory");
        }
    }
    __syncthreads();
}
constexpr int NWAVES = 8;
constexpr int BATCH = 8, SEQ = 4096, D = 1024, FF = 4096, DEPTH = 2, T = BATCH * SEQ, NH = 4, HD = 64;
constexpr int INC = 3852, ZP = 3840, NMOD = 6 * D;
constexpr float EPS = 1e-6f;
constexpr int ZC_HQ = 0, ZC_HF = 256, ZC_HI = 512, ZC_HG = 768, ZC_DQ = 1024, ZC_DK = 1280, ZC_DV = 1536, ZC_FQ = 1792, ZC_FK = 2048, ZC_FV = 2304, ZC_FG = 2560, ZC_MQ = 2816, ZC_MK = 3072, ZC_MV = 3328, ZC_MO = 3584;
constexpr size_t MiB = 1u << 20;
constexpr size_t WS_CTL = 0, CTL_ZERO_BYTES = 1 * MiB;
constexpr size_t WS_MOD = 1 * MiB;
constexpr size_t WS_WG = 1 * MiB + 512 * 1024;
constexpr size_t WS_QKG = 1 * MiB + 768 * 1024;
constexpr size_t WS_SMAX = 1 * MiB + 896 * 1024;
constexpr size_t WS_SCHED = 1 * MiB + 904 * 1024;
constexpr size_t WS_KST = 1 * MiB + 900 * 1024;
constexpr size_t WS_FGT = 3 * MiB + 512 * 1024;
constexpr size_t WS_GATES = 2 * MiB;
constexpr size_t WS_FCUM = 4 * MiB;
constexpr size_t WS_GM1 = 4 * MiB + 768 * 1024;
constexpr size_t WS_BIAS1 = 7 * MiB;
constexpr size_t WS_SS1 = 6 * MiB + 512 * 1024;
constexpr size_t WS_GM2 = 4 * MiB + 512 * 1024;
constexpr size_t WS_BIAS2 = 5 * MiB;
constexpr size_t WS_SSQ = 6 * MiB;
constexpr size_t WS_WIN = 8 * MiB, WS_WOUT = 24 * MiB, WS_W1 = 28 * MiB, WS_W2 = 44 * MiB;
constexpr size_t WS_HN = 64 * MiB;
constexpr size_t WS_Z = 128 * MiB;
constexpr size_t WS_H = 128 * MiB;
constexpr size_t WS_XB = 384 * MiB;
constexpr size_t WS_Y = 448 * MiB;
constexpr size_t WS_DECH = 7 * MiB + 512 * 1024, WS_DECM = 7 * MiB + 800 * 1024;
constexpr size_t WS_END = 512 * MiB;
constexpr size_t WS_IMGH = WS_HN, WS_IMGM = WS_HN + 16 * MiB;
static_assert(16 * MiB + (size_t)32 * 32 * 4160 * 4 <= 64 * MiB, "state images fit HN");
static_assert(WS_Z + (size_t)T * ZP * 2 <= WS_XB && WS_H + (size_t)T * FF * 2 <= WS_XB && WS_XB + (size_t)T * D * 2 <= WS_Y && WS_Y + (size_t)T * D * 2 <= WS_END, "ws map");
constexpr int CW_TMO = 0, CW_BAR = 4096;
constexpr int RING_OFF = 0, RING_BYTES = 131072, LDS_BYTES = 152576, LDSCTL_OFF = LDS_BYTES - 1024, MISC_OFF = LDSCTL_OFF + 320, XCH_OFF = RING_BYTES;
constexpr float LOG2E = 1.4426950408889634f;
static_assert(XCH_OFF + 256 * 8 * 4 <= LDSCTL_OFF && XCH_OFF + 4096 + 8 * 2048 <= LDSCTL_OFF, "exchange / store-staging area");
constexpr int PH_PRO = 0, PH_PER_LAYER = 8, NPH = 1 + 2 * PH_PER_LAYER;
constexpr int PL_NORM1 = 0, PL_INPROJ = 1, PL_MIXA = 2, PL_MIXB = 3, PL_MIXC = 4, PL_OUTPROJ = 5, PL_FF1 = 6, PL_FF2 = 7;

struct Frame {
    LAS unsigned char* lds; volatile LAS unsigned* MISC; gu32* ctl;
    int tid, lane, wave, vcu, G;
};
__device__ __forceinline__ float wave_sum(float v) {
#pragma unroll
    for (int o = 1; o < 64; o <<= 1) v += __shfl_xor(v, o);
    return v;
}
__device__ __forceinline__ float bf2f(bf16 v) { return __builtin_bit_cast(float, (unsigned)v << 16); }
__device__ __forceinline__ float sigmoidf_(float x) { return 1.f / (1.f + __expf(-x)); }
__device__ __forceinline__ float logsigmoidf_(float x) { return fminf(x, 0.f) - log1pf(expf(-fabsf(x))); }

__device__ __forceinline__ void p0_transpose_item(const float* W, int K, int pitch, int nblk, bf16* WT, LAS float* scr, int item, int lane) {
    const int kb = item / nblk, nb = item % nblk, k0 = 64 * kb, n0 = 32 * nb;
    f32x4 v_[8];
#pragma unroll
    for (int i = 0; i < 8; ++i) v_[i] = *(const GAS f32x4*)(W + (size_t)(k0 + 8 * i + (lane >> 3)) * pitch + n0 + 4 * (lane & 7));
#pragma unroll
    for (int i = 0; i < 8; ++i) { LAS float* d_ = scr + (8 * i + (lane >> 3)) * 33 + 4 * (lane & 7); d_[0] = v_[i][0]; d_[1] = v_[i][1]; d_[2] = v_[i][2]; d_[3] = v_[i][3]; }
    LDS_WAIT(); asm volatile("" ::: "memory");
    const int c = lane & 7;
#pragma unroll
    for (int j = 0; j < 4; ++j) { const int n = (lane >> 3) + 8 * j; const LAS float* s = scr + (8 * c) * 33 + n;
        v4u o; o.x = pk2(s[0 * 33], s[1 * 33]); o.y = pk2(s[2 * 33], s[3 * 33]); o.z = pk2(s[4 * 33], s[5 * 33]); o.w = pk2(s[6 * 33], s[7 * 33]);
        *(GAS v4u*)(WT + (size_t)(n0 + n) * K + k0 + 8 * c) = o; }
    LDS_WAIT(); asm volatile("" ::: "memory");
}

struct Args { const float* in[22]; float* out; unsigned char* ws; int ph_lo, ph_hi, li, pad; };

__device__ __forceinline__ void p0_transposes(Frame& F0, const Args& A, int it0, int it1, int gw, int NGW) {
    Frame F = F0; { int t_ = threadIdx.x; asm volatile("" : "+v"(t_)); F.tid = t_; F.lane = t_ & 63; }
    unsigned char* ws = A.ws; const float* w_in = A.in[6];
    LAS float* scr = (LAS float*)(F.lds + RING_OFF + F.wave * 16384);
    constexpr int I_A = 16 * 88, I_B = 16 * 32, I_O = 16 * 32, I_1 = 16 * 128, I_2 = 64 * 32, I_L = I_A + I_B + I_O + I_1 + I_2;
    bf16* Win_t = (bf16*)(ws + WS_WIN); bf16* Wout_t = (bf16*)(ws + WS_WOUT); bf16* W1_t = (bf16*)(ws + WS_W1); bf16* W2_t = (bf16*)(ws + WS_W2);
    for (int it = it0 + gw; it < it1; it += NGW) {
        const int l = it / I_L; int r = it % I_L;
        if (r < I_A) { p0_transpose_item(w_in + (size_t)l * 1024 * INC, 1024, INC, 88, Win_t + (size_t)l * 4096 * 1024, scr, r, F.lane); continue; } r -= I_A;
        if (r < I_B) { p0_transpose_item(w_in + (size_t)l * 1024 * INC + 2820, 1024, INC, 32, Win_t + (size_t)l * 4096 * 1024 + (size_t)2816 * 1024, scr, r, F.lane); continue; } r -= I_B;
        if (r < I_O) { p0_transpose_item(A.in[7] + (size_t)l * 1024 * 1024, 1024, 1024, 32, Wout_t + (size_t)l * 1024 * 1024, scr, r, F.lane); continue; } r -= I_O;
        if (r < I_1) { p0_transpose_item(A.in[20] + (size_t)l * 1024 * 4096, 1024, 4096, 128, W1_t + (size_t)l * 4096 * 1024, scr, r, F.lane); continue; } r -= I_1;
        p0_transpose_item(A.in[21] + (size_t)l * 4096 * 1024, 4096, 1024, 32, W2_t + (size_t)l * 1024 * 4096, scr, r, F.lane);
    }
}
constexpr int TR_ITEMS_L = 16 * 88 + 16 * 32 + 16 * 32 + 16 * 128 + 64 * 32;


__device__ __forceinline__ void p0_prologue(Frame& F0, const Args& A) {
    Frame F = F0; { int t_ = threadIdx.x; asm volatile("" : "+v"(t_)); F.tid = t_; F.lane = t_ & 63; }
    unsigned char* ws = A.ws;
    const float* c_in = A.in[1]; const float* w_ada = A.in[2]; const float* b_ada = A.in[3]; const float* w_in = A.in[6];
    float* mod = (float*)(ws + WS_MOD); float* wg = (float*)(ws + WS_WG);
    {
        LAS float* cact = (LAS float*)(F.lds); LAS float* red = (LAS float*)(F.lds + 32768);
        bool staged = false;
        for (int unit = blockIdx.x; unit < 192; unit += F.G) {
            if (!staged) { for (int i = F.tid; i < 8192; i += NWAVES * 64) { const int b = i >> 10, k = i & 1023; const float v = c_in[b * 1024 + k]; cact[k * 8 + b] = v / (1.f + expf(-v)); } staged = true; }
            __syncthreads();
            const int l = unit / 96, n0 = (unit % 96) * 64;
            const float* W = w_ada + (size_t)l * 1024 * NMOD + n0 + F.lane;
            float acc[8];
#pragma unroll
            for (int b = 0; b < 8; ++b) acc[b] = 0.f;
            const int k0 = F.wave * 128;
#pragma unroll 32
            for (int kk = 0; kk < 128; ++kk) { const int k = k0 + kk; const float w = W[(size_t)k * NMOD];
                const f32x4 c0 = *(const LAS f32x4*)(cact + k * 8), c1 = *(const LAS f32x4*)(cact + k * 8 + 4);
                acc[0] += w * c0[0]; acc[1] += w * c0[1]; acc[2] += w * c0[2]; acc[3] += w * c0[3]; acc[4] += w * c1[0]; acc[5] += w * c1[1]; acc[6] += w * c1[2]; acc[7] += w * c1[3]; }
#pragma unroll
            for (int b = 0; b < 8; ++b) red[(F.wave * 8 + b) * 64 + F.lane] = acc[b];
            __syncthreads();
            { const int b = F.tid >> 6, col = F.tid & 63; float s = b_ada[l * NMOD + n0 + col];
#pragma unroll
              for (int w = 0; w < 8; ++w) s += red[(w * 8 + b) * 64 + col];
              mod[(size_t)(l * 8 + b) * NMOD + n0 + col] = s;
              if (n0 >= 1 * D && n0 < 2 * D) ((float*)(ws + WS_GM1))[(size_t)(l * 8 + b) * D + (n0 - 1 * D) + col] = A.in[4][l * D + (n0 - 1 * D) + col] * (1.f + s);
              if (n0 >= 4 * D && n0 < 5 * D) ((float*)(ws + WS_GM2))[(size_t)(l * 8 + b) * D + (n0 - 4 * D) + col] = A.in[5][l * D + (n0 - 4 * D) + col] * (1.f + s); }
            __syncthreads();
        }
    }
    __syncthreads();
    for (int idx = blockIdx.x * (NWAVES * 64) + F.tid; idx < 2 * 12 * 1024; idx += F.G * NWAVES * 64) {
        const int l = idx / 12288, r = idx % 12288, j = r >> 10, k = r & 1023;
        const int col = (j < 4) ? 2816 + j : (j < 8 ? 3844 + (j - 4) : 3848 + (j - 8));
        const float wv = w_in[(size_t)l * 1024 * INC + (size_t)k * INC + col]; wg[idx] = wv;
        ((bf16*)(ws + WS_WIN))[(size_t)l * 4096 * 1024 + (size_t)(3840 + j) * 1024 + k] = (bf16)f2bf(wv);
    }
    for (int idx = blockIdx.x * (NWAVES * 64) + F.tid; idx < 2 * 244 * 1024 / 8; idx += F.G * NWAVES * 64) {
        const int l = idx / (244 * 128), r = idx % (244 * 128);
        ((GAS v4u*)((bf16*)(ws + WS_WIN) + (size_t)l * 4096 * 1024 + (size_t)3852 * 1024))[r] = (v4u){0u, 0u, 0u, 0u};
    }
    if (blockIdx.x == F.G - 1 && F.tid < 2 * 4 * 64) {
        const int l = F.tid >> 8, k = (F.tid >> 6) & 3, d = F.tid & 63; float v;
        if (k == 0) v = A.in[10][l * 32 + (d & 31)] * (0.17677669529663687f * LOG2E);
        else if (k == 1) v = A.in[11][l * 32 + (d & 31)];
        else if (k == 2) v = A.in[14][l * 64 + d] * (0.125f * LOG2E);
        else v = A.in[15][l * 64 + d];
        ((float*)(ws + WS_QKG))[F.tid] = v;
    }
    if (blockIdx.x == F.G - 2 && F.tid < 4) {
        const int l = F.tid >> 1, k = F.tid & 1; float mq = 0.f, mk = 0.f;
        if (k == 0) { for (int d = 0; d < 64; ++d) { mq = fmaxf(mq, fabsf(A.in[14][l * 64 + d])); mk = fmaxf(mk, fabsf(A.in[15][l * 64 + d])); } }
        else { for (int d = 0; d < 32; ++d) { mq = fmaxf(mq, fabsf(A.in[10][l * 32 + d])); mk = fmaxf(mk, fabsf(A.in[11][l * 32 + d])); } }
        ((float*)(ws + WS_SMAX))[F.tid] = (k == 0 ? 8.0f : 5.656854249f) * LOG2E * mq * mk * 1.02f + 0.5f;
    }
    if (F.G == 256) { constexpr int N1 = 192 * NWAVES * 6;
        if (blockIdx.x < 192) p0_transposes(F, A, 0, N1, (int)blockIdx.x * NWAVES + F.wave, 192 * NWAVES);
        else p0_transposes(F, A, N1, 2 * TR_ITEMS_L, ((int)blockIdx.x - 192) * NWAVES + F.wave, 64 * NWAVES); }
    else p0_transposes(F, A, 0, 2 * TR_ITEMS_L, F.vcu * NWAVES + F.wave, F.G * NWAVES);
}

__device__ __forceinline__ void norm_phase(Frame& F0, const float* xsrc, const float* gain, const float* modl, int shift_slot, bf16* hn, const float* wg, float* gates, float* fgt) {
    Frame F = F0; { int t_ = threadIdx.x; asm volatile("" : "+v"(t_)); F.tid = t_; F.lane = t_ & 63; }
    LAS float* wgl = (LAS float*)(F.lds);
    if (wg) { for (int i = F.tid; i < 12 * 1024 / 4; i += NWAVES * 64) ((LAS f32x4*)wgl)[i] = ((const GAS f32x4*)wg)[i]; }
    __syncthreads();
    const int gw = F.vcu * NWAVES + F.wave, NGW = F.G * NWAVES;
    for (int m0 = gw * 16; m0 < T; m0 += NGW * 16) {
        const int b = m0 >> 12;
        f32x4 gm[4], sh[4];
        { const GAS f32x4* g4 = (const GAS f32x4*)gain + F.lane;
          const GAS f32x4* sh4 = (const GAS f32x4*)(modl + (size_t)b * NMOD + shift_slot * D) + F.lane;
          const GAS f32x4* sc4 = (const GAS f32x4*)(modl + (size_t)b * NMOD + (shift_slot + 1) * D) + F.lane;
#pragma unroll
          for (int j = 0; j < 4; ++j) { gm[j] = g4[64 * j] * (sc4[64 * j] + 1.0f); sh[j] = sh4[64 * j]; } }
#pragma unroll 1
        for (int rb = 0; rb < 16; rb += 4) {
            f32x4 v[4][4]; float s[4];
#pragma unroll
            for (int r = 0; r < 4; ++r) { const GAS f32x4* xr = (const GAS f32x4*)(xsrc + (size_t)(m0 + rb + r) * D) + F.lane;
#pragma unroll
                for (int j = 0; j < 4; ++j) v[r][j] = xr[64 * j]; }
#pragma unroll
            for (int r = 0; r < 4; ++r) { float a = 0.f;
#pragma unroll
                for (int j = 0; j < 4; ++j) a += (v[r][j].x * v[r][j].x + v[r][j].y * v[r][j].y) + (v[r][j].z * v[r][j].z + v[r][j].w * v[r][j].w);
                s[r] = a; }
#pragma unroll
            for (int o = 1; o < 64; o <<= 1) {
#pragma unroll
                for (int r = 0; r < 4; ++r) s[r] += __shfl_xor(s[r], o); }
#pragma unroll
            for (int r = 0; r < 4; ++r) { const float rstd = __builtin_amdgcn_rsqf(s[r] * (1.f / D) + EPS);
                GAS unsigned long long* o8 = (GAS unsigned long long*)(hn + (size_t)(m0 + rb + r) * D) + F.lane;
#pragma unroll
                for (int j = 0; j < 4; ++j) { v[r][j] = (v[r][j] * rstd) * gm[j] + sh[j];
                    o8[64 * j] = (unsigned long long)pk2(v[r][j].x, v[r][j].y) | ((unsigned long long)pk2(v[r][j].z, v[r][j].w) << 32); } }
            if (wg) {
                float mine[4] = {0.f, 0.f, 0.f, 0.f};
#pragma unroll 1
                for (int g = 0; g < 12; ++g) { float d[4] = {0.f, 0.f, 0.f, 0.f};
#pragma unroll
                    for (int j = 0; j < 4; ++j) { const f32x4 w = ((const LAS f32x4*)(wgl + g * 1024))[F.lane + 64 * j];
#pragma unroll
                        for (int r = 0; r < 4; ++r) d[r] += (v[r][j].x * w.x + v[r][j].y * w.y) + (v[r][j].z * w.z + v[r][j].w * w.w); }
#pragma unroll
                    for (int o = 1; o < 64; o <<= 1) {
#pragma unroll
                        for (int r = 0; r < 4; ++r) d[r] += __shfl_xor(d[r], o); }
#pragma unroll
                    for (int r = 0; r < 4; ++r) mine[r] = (F.lane == g) ? d[r] : mine[r]; }
                if (F.lane < 12) {
#pragma unroll
                    for (int r = 0; r < 4; ++r) gates[(size_t)(m0 + rb + r) * 12 + F.lane] = mine[r]; }
                if (F.lane < 4) {
#pragma unroll
                    for (int r = 0; r < 4; ++r) fgt[(size_t)(b * NH + F.lane) * SEQ + ((m0 + rb + r) & (SEQ - 1))] = mine[r]; }
            }
        }
    }
}
__device__ __forceinline__ void fox_scan_wave(const float* fgt, const float* fbias, float* Fcum, int* kst, float smax, int bh, int lane_) {
    int lane = lane_; asm volatile("" : "+v"(lane));
    const int h = bh & 3; const float fb = fbias[h]; const GAS f32x4* g4 = (const GAS f32x4*)(fgt + (size_t)bh * SEQ + lane * 64);
    f32x4 lf[16]; float s = 0.f;
#pragma unroll
    for (int i = 0; i < 16; ++i) lf[i] = g4[i];
#pragma unroll
    for (int i = 0; i < 16; ++i) {
#pragma unroll
        for (int e = 0; e < 4; ++e) { lf[i][e] = logsigmoidf_(lf[i][e] + fb); s += lf[i][e]; } }
    float incl = s;
#pragma unroll
    for (int o = 1; o < 64; o <<= 1) { const float v = __shfl_up(incl, o); if (lane >= o) incl += v; }
    float run = incl - s; GAS f32x4* Fo = (GAS f32x4*)(Fcum + (size_t)bh * SEQ + lane * 64); float ffirst = 0.f;
#pragma unroll
    for (int i = 0; i < 16; ++i) { f32x4 o4;
#pragma unroll
        for (int e = 0; e < 4; ++e) { run += lf[i][e]; o4[e] = run; if (i == 0 && e == 0) ffirst = run; }
        Fo[i] = o4; }
    const float blast = -run * LOG2E;
    for (int qb = 0; qb < 16; ++qb) { const float bq0 = -__shfl(ffirst, 4 * qb) * LOG2E;
        const unsigned long long m = __ballot(blast < bq0 - 152.0f - 2.0f * smax);
        int ks = (int)__builtin_ctzll(~m); const int nt = 4 * qb + 4; ks = ks < nt - 4 ? ks : nt - 4; ks &= ~1;
        if (lane == 0) kst[bh * 16 + qb] = ks; }
}

__device__ __forceinline__ void fox_scan_block(const float* fgt, const float* fbias, float* Fcum, int* kst, float smax, int bh, LAS unsigned char* lds) {
    int tid_ = threadIdx.x; asm volatile("" : "+v"(tid_)); const int tid = tid_, lane = tid & 63, wave = tid >> 6;
    LAS float* Fl = (LAS float*)lds; LAS float* part = Fl + SEQ;
    const int h = bh & 3; const float fb = fbias[h];
    const GAS f32x4* g4 = (const GAS f32x4*)(fgt + (size_t)bh * SEQ + tid * 8);
    const f32x4 a = g4[0], b = g4[1];
    float v[8] = {a[0], a[1], a[2], a[3], b[0], b[1], b[2], b[3]}; float s = 0.f;
#pragma unroll
    for (int e = 0; e < 8; ++e) { s += logsigmoidf_(v[e] + fb); v[e] = s; }
    float incl = s;
#pragma unroll
    for (int o = 1; o < 64; o <<= 1) { const float t = __shfl_up(incl, o); if (lane >= o) incl += t; }
    if (lane == 63) part[wave] = incl;
    __syncthreads();
    float base = incl - s;
    for (int w = 0; w < wave; ++w) base += part[w];
    f32x4 o0, o1;
#pragma unroll
    for (int e = 0; e < 4; ++e) { o0[e] = base + v[e]; o1[e] = base + v[4 + e]; }
    GAS f32x4* Fo = (GAS f32x4*)(Fcum + (size_t)bh * SEQ + tid * 8); Fo[0] = o0; Fo[1] = o1;
    *(LAS f32x4*)(Fl + tid * 8) = o0; *(LAS f32x4*)(Fl + tid * 8 + 4) = o1;
    __syncthreads();
    if (wave == 0) {
        const float blast = -Fl[64 * lane + 63] * LOG2E;
        for (int qb = 0; qb < 16; ++qb) { const float bq0 = -Fl[256 * qb] * LOG2E;
            const unsigned long long m = __ballot(blast < bq0 - 152.0f - 2.0f * smax);
            int ks = (int)__builtin_ctzll(~m); const int nt = 4 * qb + 4; ks = ks < nt - 4 ? ks : nt - 4; ks &= ~1;
            if (lane == 0) kst[bh * 16 + qb] = ks; }
    }
    __syncthreads();
}

__device__ __forceinline__ void bias_gemv(Frame& F0, const bf16* Wt, int N, const float* shift, int sstride, float* out) {
    Frame F = F0; { int t_ = threadIdx.x; asm volatile("" : "+v"(t_)); F.tid = t_; F.lane = t_ & 63; }
    LAS float* sl = (LAS float*)(F.lds);
    __syncthreads();
    for (int i = F.tid; i < 8 * 1024; i += NWAVES * 64) sl[i] = shift[(size_t)(i >> 10) * sstride + (i & 1023)];
    __syncthreads();
    const int gw = F.vcu * NWAVES + F.wave, NGW = F.G * NWAVES;
    for (int n = gw; n < N; n += NGW) {
        float w[16];
#pragma unroll
        for (int j = 0; j < 4; ++j) { const unsigned long long q = *(const GAS unsigned long long*)(Wt + (size_t)n * 1024 + 256 * j + F.lane * 4);
#pragma unroll
            for (int e = 0; e < 4; ++e) w[j * 4 + e] = __builtin_bit_cast(float, (unsigned)((q >> (16 * e)) & 0xffffu) << 16); }
        float mine = 0.f;
#pragma unroll 1
        for (int b = 0; b < 8; ++b) { float d = 0.f;
#pragma unroll
            for (int j = 0; j < 4; ++j) { const f32x4 s4 = *(const LAS f32x4*)(sl + b * 1024 + 256 * j + F.lane * 4); d += (w[j * 4] * s4[0] + w[j * 4 + 1] * s4[1]) + (w[j * 4 + 2] * s4[2] + w[j * 4 + 3] * s4[3]); }
            d = wave_sum(d); mine = (F.lane == b) ? d : mine; }
        if (F.lane < 8) out[(size_t)F.lane * N + n] = mine;
    }
    __syncthreads();
}

__device__ __forceinline__ void prenorm0_phase(Frame& F0, const float* xsrc, const float* gm, bf16* hn, float* ss) {
    Frame F = F0; { int t_ = threadIdx.x; asm volatile("" : "+v"(t_)); F.tid = t_; F.lane = t_ & 63; }
    const int gw = F.vcu * NWAVES + F.wave, NGW = F.G * NWAVES;
    for (int m0 = gw * 16; m0 < T; m0 += NGW * 16) {
        const int b = m0 >> 12; f32x4 g[4];
        { const GAS f32x4* g4 = (const GAS f32x4*)(gm + (size_t)b * D) + F.lane;
#pragma unroll
          for (int j = 0; j < 4; ++j) g[j] = g4[64 * j]; }
#pragma unroll 1
        for (int rb = 0; rb < 16; rb += 4) {
            f32x4 v[4][4]; float s[4];
#pragma unroll
            for (int r = 0; r < 4; ++r) { const GAS f32x4* xr = (const GAS f32x4*)(xsrc + (size_t)(m0 + rb + r) * D) + F.lane;
#pragma unroll
                for (int j = 0; j < 4; ++j) v[r][j] = xr[64 * j]; }
#pragma unroll
            for (int r = 0; r < 4; ++r) { float a = 0.f;
#pragma unroll
                for (int j = 0; j < 4; ++j) a += (v[r][j].x * v[r][j].x + v[r][j].y * v[r][j].y) + (v[r][j].z * v[r][j].z + v[r][j].w * v[r][j].w);
                s[r] = a;
                GAS unsigned long long* o8 = (GAS unsigned long long*)(hn + (size_t)(m0 + rb + r) * D) + F.lane;
#pragma unroll
                for (int j = 0; j < 4; ++j) { const f32x4 a4 = v[r][j] * g[j]; o8[64 * j] = (unsigned long long)pk2(a4.x, a4.y) | ((unsigned long long)pk2(a4.z, a4.w) << 32); } }
#pragma unroll
            for (int o = 1; o < 64; o <<= 1) {
#pragma unroll
                for (int r = 0; r < 4; ++r) s[r] += __shfl_xor(s[r], o); }
            if (F.lane < 4) { const float mine = (F.lane == 0) ? s[0] : (F.lane == 1 ? s[1] : (F.lane == 2 ? s[2] : s[3]));
                *(GAS f32x4*)(ss + (size_t)(m0 + rb + F.lane) * 4) = (f32x4){mine, 0.f, 0.f, 0.f}; }
        }
    }
}

__device__ __forceinline__ void bias_all(Frame& F0, const bf16* Win_t, const bf16* W1_t, const float* mod, float* bias1, float* bias2) {
    Frame F = F0; { int t_ = threadIdx.x; asm volatile("" : "+v"(t_)); F.tid = t_; F.lane = t_ & 63; }
    LAS float* sl = (LAS float*)(F.lds);
    __syncthreads();
    for (int i = F.tid; i < 4 * 8192; i += NWAVES * 64) { const int set = i >> 13, l = set & 1, slot = (set >> 1) ? 3 : 0, b = (i >> 10) & 7, k = i & 1023;
        sl[i] = mod[(size_t)(l * 8 + b) * NMOD + slot * 1024 + k]; }
    __syncthreads();
    const int gw = F.vcu * NWAVES + F.wave, NGW = F.G * NWAVES;
    for (int r = gw; r < 4 * 4096; r += NGW) {
        const int set = r >> 12, n = r & 4095, l = set & 1;
        const bf16* wrow = ((set >> 1) ? W1_t : Win_t) + (size_t)(l * 4096 + n) * 1024; float* out = ((set >> 1) ? bias2 : bias1) + (size_t)l * 8 * 4096;
        float w[16];
#pragma unroll
        for (int j = 0; j < 4; ++j) { const unsigned long long q = *(const GAS unsigned long long*)(wrow + 256 * j + F.lane * 4);
#pragma unroll
            for (int e = 0; e < 4; ++e) w[j * 4 + e] = __builtin_bit_cast(float, (unsigned)((q >> (16 * e)) & 0xffffu) << 16); }
        float d[8];
#pragma unroll
        for (int b = 0; b < 8; ++b) { float a = 0.f;
#pragma unroll
            for (int j = 0; j < 4; ++j) { const f32x4 s4 = *(const LAS f32x4*)(sl + set * 8192 + b * 1024 + 256 * j + F.lane * 4); a += (w[j * 4] * s4[0] + w[j * 4 + 1] * s4[1]) + (w[j * 4 + 2] * s4[2] + w[j * 4 + 3] * s4[3]); }
            d[b] = a; }
#pragma unroll
        for (int o = 1; o < 64; o <<= 1) {
#pragma unroll
            for (int b = 0; b < 8; ++b) d[b] += __shfl_xor(d[b], o); }
        float mine = d[0];
#pragma unroll
        for (int b = 1; b < 8; ++b) mine = (F.lane == b) ? d[b] : mine;
        if (F.lane < 8) out[(size_t)F.lane * 4096 + n] = mine;
    }
    __syncthreads();
}
namespace att {
using bf16x8 = __attribute__((ext_vector_type(8))) short;
using s16x4 = __attribute__((ext_vector_type(4))) short;
using f32x16 = __attribute__((ext_vector_type(16))) float;
using f32x4v = __attribute__((ext_vector_type(4))) float;
using u32x4 = __attribute__((ext_vector_type(4))) unsigned;
constexpr int NW = 8, QBLK = 32, QB = QBLK * NW, KVBLK = 64, NQB = SEQ / QB, PITCH = ZP;
constexpr int SLOTB = 8192, LDS_K = 0, LDS_V = 3 * SLOTB, LDS_WS = 6 * SLOTB, LDS_OST = LDS_WS + NW * 256, LDS_TBL = LDS_OST + NW * 8192, LDS_END = LDS_TBL + SEQ * 4 + 256;
static_assert(LDS_END <= LDSCTL_OFF, "attention LDS map");
constexpr int THR = 48;
#define SBAR() __builtin_amdgcn_sched_barrier(0)
#define PIN(x) asm volatile("" : "+v"(x))
#define MFMA(a, b, c) __builtin_amdgcn_mfma_f32_32x32x16_bf16(a, b, c, 0, 0, 0)
#define WAIT_BAR(N) asm volatile("s_waitcnt vmcnt(" #N ") lgkmcnt(0)\n\ts_barrier" ::: "memory")
__device__ __forceinline__ int crow(int r, int hi) { return (r & 3) + 8 * (r >> 2) + 4 * hi; }
__device__ __forceinline__ unsigned cvtpk(float lo, float hi) { unsigned r; asm("v_cvt_pk_bf16_f32 %0, %1, %2\n\ts_nop 1" : "=v"(r) : "v"(lo), "v"(hi)); return r; }
__device__ __forceinline__ unsigned cvtpk_b(float lo, float hi) { const pg8::cv_f32x2 v = {lo, hi}; return __builtin_bit_cast(unsigned, __builtin_convertvector(v, pg8::cv_bf16x2)); }
__device__ __forceinline__ void glds16(const void* g, unsigned lds_base) {
    unsigned sv; asm volatile("s_mov_b32 %0, m0\n\ts_mov_b32 m0, %2\n\ts_nop 0\n\tglobal_load_lds_dwordx4 %1, off\n\ts_mov_b32 m0, %0" : "=&s"(sv) : "v"(g), "s"(lds_base) : "memory"); }
typedef __attribute__((address_space(3))) const char* lds_cptr;
typedef short v4i16_t __attribute__((ext_vector_type(4)));
__device__ __forceinline__ void kload2(bf16x8* kf, lds_cptr kp, int d0, int ko) { kf[2 * d0] = *(const __attribute__((address_space(3))) bf16x8*)(kp + ko); kf[2 * d0 + 1] = *(const __attribute__((address_space(3))) bf16x8*)(kp + ko + 4096); }
__device__ __forceinline__ s16x4 vtr(lds_cptr p) { return __builtin_bit_cast(s16x4, __builtin_amdgcn_ds_read_tr16_b64_v4i16((__attribute__((address_space(3))) v4i16_t*)p)); }
__device__ __forceinline__ f32x16 ldbias(lds_cptr p) {
    const f32x4v a = *(const __attribute__((address_space(3))) f32x4v*)(p), b = *(const __attribute__((address_space(3))) f32x4v*)(p + 32), c = *(const __attribute__((address_space(3))) f32x4v*)(p + 64), d = *(const __attribute__((address_space(3))) f32x4v*)(p + 96);
    return (f32x16){a[0], a[1], a[2], a[3], b[0], b[1], b[2], b[3], c[0], c[1], c[2], c[3], d[0], d[1], d[2], d[3]}; }
#define MX3(a, b, c) __builtin_fmaxf(__builtin_fmaxf((a), (b)), (c))
__device__ __forceinline__ float rowmax(const f32x16& p0, const f32x16& p1) {
    float a = MX3(p0[0], p0[1], p1[0]), b = MX3(p0[2], p0[3], p1[1]); a = MX3(a, p1[2], p1[3]);
#pragma unroll
    for (int r = 4; r < 16; r += 4) { a = MX3(a, p0[r], p0[r + 1]); b = MX3(b, p0[r + 2], p0[r + 3]); a = MX3(a, p1[r], p1[r + 1]); b = MX3(b, p1[r + 2], p1[r + 3]); }
    float m = __builtin_fmaxf(a, b); auto rr = __builtin_amdgcn_permlane32_swap(__float_as_uint(m), __float_as_uint(m), false, false);
    return __builtin_fmaxf(__uint_as_float(rr[0]), __uint_as_float(rr[1])); }
__device__ __forceinline__ void cmask(f32x16& p0, f32x16& p1, int jb, int qrel, int hi) {
    const int kb = 64 * jb + 4 * hi;
#pragma unroll
    for (int r = 0; r < 16; ++r) { const int kv = kb + (r & 3) + 8 * (r >> 2); if (kv > qrel) p0[r] = -INFINITY; if (kv + 32 > qrel) p1[r] = -INFINITY; } }

template <int ND0>
__device__ __forceinline__ void attn_pass(int b, int qb, int kst, const bf16* Z, int qcol, int kcol, int vcol, int kcoff, char* lds, f32x16 (&o)[2], float& l_out) {
    int tid_ = threadIdx.x; asm volatile("" : "+v"(tid_));
    const int tid = tid_, lane = tid & 63, r32 = lane & 31, hi = lane >> 5; const int wid = __builtin_amdgcn_readfirstlane(tid >> 6);
    const long rowbase = (long)b * SEQ; const int q0 = qb * QB, NT = (q0 + QB) / KVBLK - kst;
    const bf16* Qw = Z + (rowbase + q0 + wid * QBLK) * PITCH + qcol;
    const unsigned lds0 = (unsigned)(uintptr_t)lds; float* wsf = (float*)(lds + LDS_WS) + wid * 64;
    const bf16* ksrc = Z + (rowbase + (long)kst * KVBLK + 8 * wid + (lane >> 3)) * PITCH + kcol + ((lane & 7) ^ ((4 * wid + (lane >> 4)) & 7)) * 8;
    const bf16* vsrc = Z + (rowbase + (long)kst * KVBLK) * PITCH + vcol + (long)(16 * (wid & 3) + (lane >> 2)) * PITCH + (wid >> 2) * 32 + (lane & 3) * 8;
    const unsigned kdst = lds0 + LDS_K + wid * 1024, vdst = lds0 + LDS_V + wid * 1024;
#define DMA_K(t, slot) glds16(ksrc + (long)(t) * KVBLK * PITCH, (unsigned)__builtin_amdgcn_readfirstlane(kdst + (slot)))
#define DMA_V(t, slot) glds16(vsrc + (long)(t) * KVBLK * PITCH, (unsigned)__builtin_amdgcn_readfirstlane(vdst + (slot)))
    const lds_cptr vp0 = (lds_cptr)lds + LDS_V + ((lane >> 4) & 1) * 32 + (lane & 3) * 8 + (4 * hi + ((lane & 15) >> 2)) * 64;
    const lds_cptr kp0 = (lds_cptr)lds + LDS_K + r32 * 128; const int kx = (((r32 >> 1) & 7) ^ hi) << 4, kc16 = (kcoff >> 10) << 4;
#define KOFF(d0) ((kc16 + 32 * (d0)) ^ kx)
    const lds_cptr tb0 = (lds_cptr)lds + LDS_TBL + hi * 16 + kst * 256;
    DMA_K(0, 0); DMA_V(0, 0); DMA_K(1, SLOTB);
    bf16x8 qr[ND0];
#pragma unroll
    for (int d0 = 0; d0 < ND0; ++d0) qr[d0] = *reinterpret_cast<const bf16x8*>(&Qw[(long)r32 * PITCH + d0 * 16 + hi * 8]);
    float mhat = 0.f, l_reg = 0.f; o[0] = f32x16{}; o[1] = f32x16{};
    const int qrel = wid * QBLK + r32; bool resc = false;
    f32x16 pA0, pA1, pB0, pB1; bf16x8 kf[2 * ND0]; s16x4 vlo[8], vhi[8]; u32x4 pw0, pw1, pw2, pw3;
    int sl_prev = 0, sl_cur = 0, sl_next = SLOTB;
#define ROT() do { sl_prev = sl_cur; sl_cur = sl_next; sl_next = (sl_next == 2 * SLOTB) ? 0 : sl_next + SLOTB; } while (0)
#define EX(v) __builtin_amdgcn_exp2f((v) + nmh)
#define RESC() do { if (resc) { _Pragma("unroll") for (int d_ = 0; d_ < 2; ++d_) _Pragma("unroll") for (int r = 0; r < 16; ++r) o[d_][r] *= wsf[crow(r, hi)]; } } while (0)
    DMA_K(2, 2 * SLOTB);
    WAIT_BAR(3);
    _Pragma("unroll") for (int d0 = 0; d0 < ND0; ++d0) kload2(kf, kp0, d0, KOFF(d0));
    pA0 = ldbias(tb0); pA1 = ldbias(tb0 + 128);
    _Pragma("unroll") for (int d0 = 0; d0 < ND0; ++d0) { pA0 = MFMA(kf[2 * d0], qr[d0], pA0); pA1 = MFMA(kf[2 * d0 + 1], qr[d0], pA1); }
    if (NT == 4) cmask(pA0, pA1, 0, qrel, hi);
    { const float rm = rowmax(pA0, pA1); mhat = rm; const float nmh = -mhat;
#pragma unroll
      for (int r = 0; r < 16; ++r) { pA0[r] = EX(pA0[r]); pA1[r] = EX(pA1[r]); } }
    pB0 = ldbias(tb0 + 256); pB1 = ldbias(tb0 + 256 + 128);
    WAIT_BAR(0);
    DMA_K(3, 0); DMA_V(1, SLOTB); ROT();
    _Pragma("unroll") for (int d0 = 0; d0 < ND0; ++d0) kload2(kf, kp0 + sl_cur, d0, KOFF(d0));
    WAIT_BAR(2);
#define PKW(P, i) cvtpk_b(P[i], P[i + 1])
#define PAF(k) __builtin_bit_cast(bf16x8, pw##k)
#define VFR(i) (bf16x8){vlo[i][0], vlo[i][1], vlo[i][2], vlo[i][3], vhi[i][0], vhi[i][1], vhi[i][2], vhi[i][3]}
#define VRD(i) do { vlo[i] = vtr(vp_ + (((i) >> 2) * 4096 + ((i) & 3) * 1024)); vhi[i] = vtr(vp_ + (((i) >> 2) * 4096 + ((i) & 3) * 1024 + 512)); } while (0)
#define KRD(G, d0) do { if ((G) && (d0) < ND0) { kload2(kf, kp0 + sl_next, d0, KOFF(d0)); SBAR(); } } while (0)
#define QK(C, i) do { if constexpr ((i) < 2 * ND0) { C = MFMA(kf[(i) < 2 * ND0 ? (i) : 0], qr[(i) < 2 * ND0 ? (i) / 2 : 0], C); } } while (0)
#define GAPA(MF, a0, a1, a2, a3, W0, W1, PW) do { MF; sacc += a0; sacc += a1; sacc += a2; sacc += a3; W0; W1; PIN(PW); PIN(sacc); SBAR(); } while (0)
#define GAPB(MF, X, i) do { MF; X[i] = EX(X[i]); X[i + 1] = EX(X[i + 1]); X[i + 2] = EX(X[i + 2]); X[i + 3] = EX(X[i + 3]); PIN(X); SBAR(); } while (0)
#define STEP(C0, C1, P0, P1, t, MASK, GK, GV, GL) do { SBAR(); \
    const lds_cptr vp_ = vp0 + sl_prev; \
    VRD(0); SBAR(); float sacc = P0[0] + P0[1]; \
                    GAPA(QK(C0, 0), P0[2], P0[3], P0[4], P0[5],     pw0[0] = PKW(P0, 0),  pw0[1] = PKW(P0, 2),  pw0); \
    VRD(4); SBAR(); GAPA(QK(C1, 1), P0[6], P0[7], P0[8], P0[9],     pw0[2] = PKW(P0, 4),  pw0[3] = PKW(P0, 6),  pw0); \
    VRD(1); SBAR(); GAPA(QK(C0, 2), P0[10], P0[11], P0[12], P0[13], pw1[0] = PKW(P0, 8),  pw1[1] = PKW(P0, 10), pw1); \
    VRD(5); SBAR(); GAPA(QK(C1, 3), P0[14], P0[15], P1[0], P1[1],   pw1[2] = PKW(P0, 12), pw1[3] = PKW(P0, 14), pw1); \
    VRD(2); SBAR(); GAPA(QK(C0, 4), P1[2], P1[3], P1[4], P1[5],     pw2[0] = PKW(P1, 0),  pw2[1] = PKW(P1, 2),  pw2); \
    VRD(6); SBAR(); GAPA(QK(C1, 5), P1[6], P1[7], P1[8], P1[9],     pw2[2] = PKW(P1, 4),  pw2[3] = PKW(P1, 6),  pw2); \
    VRD(3); SBAR(); GAPA(QK(C0, 6), P1[10], P1[11], P1[12], P1[13], pw3[0] = PKW(P1, 8),  pw3[1] = PKW(P1, 10), pw3); \
    VRD(7); SBAR(); GAPA(QK(C1, 7), P1[14], P1[15], 0.f, 0.f,       pw3[2] = PKW(P1, 12), pw3[3] = PKW(P1, 14), pw3); \
    l_reg += sacc; \
    if (GK) DMA_K((t) + 3, sl_cur); if (GV) DMA_V((t) + 1, sl_next); \
    if (MASK) cmask(C0, C1, (t) - (NT - 4), qrel, hi); \
    { const float rm = rowmax(C0, C1) - mhat; resc = false; \
      if (__builtin_expect(__any(rm > (float)THR), 0)) { const float dl = __builtin_fmaxf(rm, 0.f); mhat += dl; \
          const float f = __builtin_amdgcn_exp2f(-dl); l_reg *= f; if (hi == 0) wsf[r32] = f; resc = true; } } \
    const float nmh = -mhat; SBAR(); \
    if (GL) { P0 = ldbias(tb0 + ((t) + 1) * 256); P1 = ldbias(tb0 + ((t) + 1) * 256 + 128); } SBAR(); \
    GAPB(o[0] = MFMA(PAF(0), VFR(0), o[0]), C0, 0);              GAPB(o[1] = MFMA(PAF(0), VFR(4), o[1]), C0, 4); \
    KRD(GL, 0); GAPB(o[0] = MFMA(PAF(1), VFR(1), o[0]), C0, 8);  KRD(GL, 1); GAPB(o[1] = MFMA(PAF(1), VFR(5), o[1]), C0, 12); \
    KRD(GL, 2); GAPB(o[0] = MFMA(PAF(2), VFR(2), o[0]), C1, 0);  KRD(GL, 3); GAPB(o[1] = MFMA(PAF(2), VFR(6), o[1]), C1, 4); \
    GAPB(o[0] = MFMA(PAF(3), VFR(3), o[0]), C1, 8);              GAPB(o[1] = MFMA(PAF(3), VFR(7), o[1]), C1, 12); \
    if (GL) { PIN(P0); PIN(P1); } \
    } while (0)
    int t = 1;
    for (; t + 5 < NT; t += 2) {
        STEP(pB0, pB1, pA0, pA1, t, false, true, true, true);     WAIT_BAR(2); RESC(); ROT();
        STEP(pA0, pA1, pB0, pB1, t + 1, false, true, true, true); WAIT_BAR(2); RESC(); ROT();
    }
#define ENDW(tt) do { if ((tt) + 3 < NT) { WAIT_BAR(2); } else if ((tt) + 2 < NT) { WAIT_BAR(1); } else { WAIT_BAR(0); } } while (0)
    for (; t + 1 < NT; t += 2) {
        STEP(pB0, pB1, pA0, pA1, t, true, (t + 3 < NT), (t + 1 < NT), (t + 1 < NT));         ENDW(t);     RESC(); ROT();
        STEP(pA0, pA1, pB0, pB1, t + 1, true, (t + 4 < NT), (t + 2 < NT), (t + 2 < NT));     ENDW(t + 1); RESC(); ROT();
    }
    STEP(pB0, pB1, pA0, pA1, NT - 1, true, false, false, false); RESC();
    { float sacc = pB0[0] + pB0[1];
#pragma unroll
      for (int r = 2; r < 16; ++r) sacc += pB0[r];
#pragma unroll
      for (int r = 0; r < 16; ++r) sacc += pB1[r];
      l_reg += sacc;
      pw0 = (u32x4){PKW(pB0, 0), PKW(pB0, 2), PKW(pB0, 4), PKW(pB0, 6)}; pw1 = (u32x4){PKW(pB0, 8), PKW(pB0, 10), PKW(pB0, 12), PKW(pB0, 14)};
      pw2 = (u32x4){PKW(pB1, 0), PKW(pB1, 2), PKW(pB1, 4), PKW(pB1, 6)}; pw3 = (u32x4){PKW(pB1, 8), PKW(pB1, 10), PKW(pB1, 12), PKW(pB1, 14)};
      const lds_cptr vp_ = vp0 + sl_cur; _Pragma("unroll") for (int i = 0; i < 8; ++i) VRD(i);
      o[0] = MFMA(PAF(0), VFR(0), o[0]); o[1] = MFMA(PAF(0), VFR(4), o[1]); o[0] = MFMA(PAF(1), VFR(1), o[0]); o[1] = MFMA(PAF(1), VFR(5), o[1]);
      o[0] = MFMA(PAF(2), VFR(2), o[0]); o[1] = MFMA(PAF(2), VFR(6), o[1]); o[0] = MFMA(PAF(3), VFR(3), o[0]); o[1] = MFMA(PAF(3), VFR(7), o[1]); }
    { auto rr = __builtin_amdgcn_permlane32_swap(__float_as_uint(l_reg), __float_as_uint(l_reg), false, false); l_reg = __uint_as_float(rr[0]) + __uint_as_float(rr[1]); }
    l_out = l_reg;
#undef DMA_K
#undef KOFF
#undef DMA_V
#undef ROT
#undef EX
#undef RESC
#undef PKW
#undef PAF
#undef VFR
#undef VRD
#undef KRD
#undef QK
#undef ENDW
#undef GAPA
#undef GAPB
#undef STEP
}

__device__ __forceinline__ void row_scales(float l_reg, float extra, float* wsf, int r32, int hi, float (&rli)[16]) {
    if (hi == 0) wsf[32 + r32] = l_reg; asm volatile("s_waitcnt lgkmcnt(0)" ::: "memory");
#pragma unroll
    for (int r = 0; r < 16; ++r) rli[r] = extra * __builtin_amdgcn_rcpf(wsf[32 + crow(r, hi)]);
    asm volatile("s_waitcnt lgkmcnt(0)" ::: "memory");
}

__device__ __forceinline__ void fox_unit(int b, int h, int qb, int kst, const bf16* Z, bf16* Y, char* lds) {
    int tid_ = threadIdx.x; asm volatile("" : "+v"(tid_));
    const int tid = tid_, lane = tid & 63, r32 = lane & 31, hi = lane >> 5; const int wid = __builtin_amdgcn_readfirstlane(tid >> 6);
    f32x16 o[2]; float l_reg;
    attn_pass<4>(b, qb, kst, Z, ZC_FQ + h * 64, ZC_FK + h * 64, ZC_FV + h * 64, 0, lds, o, l_reg);
    float* wsf = (float*)(lds + LDS_WS) + wid * 64; float rli[16]; row_scales(l_reg, 1.f, wsf, r32, hi, rli);
    const long row0 = (long)b * SEQ + qb * QB + wid * QBLK;
    unsigned short* stg = (unsigned short*)(lds + LDS_OST) + wid * 4096;
#pragma unroll
    for (int r = 0; r < 16; ++r) { const int orow = crow(r, hi);
#pragma unroll
        for (int d0 = 0; d0 < 2; ++d0) stg[orow * 64 + d0 * 32 + r32] = (unsigned short)f2bf(o[d0][r] * rli[r]); }
    asm volatile("s_waitcnt lgkmcnt(0)" ::: "memory");
#pragma unroll
    for (int i = 0; i < 4; ++i) { const int row = i * 8 + (lane >> 3), ch = lane & 7;
        const u32x4 ov = *(const u32x4*)(stg + row * 64 + ch * 8); const u32x4 gv = *(const u32x4*)(Z + (row0 + row) * PITCH + ZC_FG + h * 64 + ch * 8);
        u32x4 w;
#pragma unroll
        for (int e = 0; e < 4; ++e) { const float o0 = __uint_as_float(ov[e] << 16), o1 = __uint_as_float(ov[e] & 0xffff0000u), g0 = __uint_as_float(gv[e] << 16), g1 = __uint_as_float(gv[e] & 0xffff0000u);
            w[e] = pk2(o0 / (1.f + __expf(-g0)), o1 / (1.f + __expf(-g1))); }
        *(u32x4*)(Y + (row0 + row) * D + 512 + h * 64 + ch * 8) = w; }
    asm volatile("s_waitcnt lgkmcnt(0)\n\ts_barrier" ::: "memory");
}

__device__ __forceinline__ void diff_unit(int b, int h, int qb, int kst, const bf16* Z, bf16* Y, float lam, float oscale, const float* subg, char* lds) {
    int tid_ = threadIdx.x; asm volatile("" : "+v"(tid_));
    const int tid = tid_, lane = tid & 63, r32 = lane & 31, hi = lane >> 5; const int wid = __builtin_amdgcn_readfirstlane(tid >> 6);
    float* wsf = (float*)(lds + LDS_WS) + wid * 64; float* stg = (float*)(lds + LDS_OST) + wid * 2048;
    const long row0 = (long)b * SEQ + qb * QB + wid * QBLK;
    for (int c = 0; c < 2; ++c) {
        f32x16 o[2]; float l_reg;
        attn_pass<2>(b, qb, kst, Z, ZC_DQ + h * 64 + c * 32, ZC_DK + h * 64, ZC_DV + h * 64, c * 4096, lds, o, l_reg);
        float rli[16]; row_scales(l_reg, c == 0 ? 1.f : -lam, wsf, r32, hi, rli);
#pragma unroll
        for (int r = 0; r < 16; ++r) { const int orow = crow(r, hi);
#pragma unroll
            for (int d0 = 0; d0 < 2; ++d0) { float* p = stg + orow * 64 + d0 * 32 + r32; const float v = o[d0][r] * rli[r]; *p = (c == 0) ? v : (*p + v); } }
        asm volatile("s_waitcnt lgkmcnt(0)\n\ts_barrier" ::: "memory");
    }
#pragma unroll
    for (int i = 0; i < 4; ++i) { const int row = i * 8 + (lane >> 3), ch = lane & 7;
        const f32x4v a = *(const f32x4v*)(stg + row * 64 + ch * 8), c4 = *(const f32x4v*)(stg + row * 64 + ch * 8 + 4);
        float ss = (a[0] * a[0] + a[1] * a[1]) + (a[2] * a[2] + a[3] * a[3]) + (c4[0] * c4[0] + c4[1] * c4[1]) + (c4[2] * c4[2] + c4[3] * c4[3]);
        ss += __shfl_xor(ss, 1); ss += __shfl_xor(ss, 2); ss += __shfl_xor(ss, 4);
        const float rs = oscale / sqrtf(ss * (1.f / 64.f) + EPS);
        const f32x4v g0 = *(const f32x4v*)(subg + ch * 8), g1 = *(const f32x4v*)(subg + ch * 8 + 4);
        u32x4 w; w[0] = pk2(a[0] * rs * g0[0], a[1] * rs * g0[1]); w[1] = pk2(a[2] * rs * g0[2], a[3] * rs * g0[3]); w[2] = pk2(c4[0] * rs * g1[0], c4[1] * rs * g1[1]); w[3] = pk2(c4[2] * rs * g1[2], c4[3] * rs * g1[3]);
        *(u32x4*)(Y + (row0 + row) * D + 256 + h * 64 + ch * 8) = w; }
    asm volatile("s_waitcnt lgkmcnt(0)\n\ts_barrier" ::: "memory");
}
#undef SBAR
#undef PIN
#undef MFMA
#undef WAIT_BAR
#undef MX3
}
namespace rec {
using att::bf16x8; using att::s16x4; using att::f32x16; using att::f32x4v; using att::u32x4;
typedef __attribute__((address_space(3))) char* lptr;
typedef short v4i16_t __attribute__((ext_vector_type(4)));
constexpr int SEGL = 128, NSEG = SEQ / SEGL, NBLK = SEGL / 32, TSTR = 136;
constexpr int W_Q = 0, W_K = 32 * TSTR, W_V = 2 * 32 * TSTR, W_TAB = 3 * 32 * TSTR, W_BYTES = W_TAB + 512;
static_assert(W_BYTES * NWAVES <= RING_BYTES && W_TAB % 16 == 0, "rec LDS map");
constexpr int IMG_H = 4 * 16 * 64, IMG_M = 6 * 16 * 64;
#define RMFMA(a, b, c) __builtin_amdgcn_mfma_f32_32x32x16_bf16(a, b, c, 0, 0, 0)
#define LFENCE() asm volatile("s_waitcnt lgkmcnt(0)" ::: "memory")
__device__ __forceinline__ float fsig(float x) { return __builtin_amdgcn_rcpf(1.f + __builtin_amdgcn_exp2f(x * -1.44269504f)); }
constexpr float EMIN = 1.8048514e-35f;
__device__ __forceinline__ bf16x8 join(s16x4 a, s16x4 b) { return (bf16x8){a[0], a[1], a[2], a[3], b[0], b[1], b[2], b[3]}; }
__device__ __forceinline__ s16x4 vtr(lptr p) { return __builtin_bit_cast(s16x4, __builtin_amdgcn_ds_read_tr16_b64_v4i16((__attribute__((address_space(3))) v4i16_t*)p)); }
__device__ __forceinline__ bf16x8 rowfrag(lptr tile, int r32, int hi, int ks) {
    const lptr p = tile + r32 * TSTR + (16 * ks + 4 * hi) * 2;
    return join(*(const __attribute__((address_space(3))) s16x4*)p, *(const __attribute__((address_space(3))) s16x4*)(p + 16)); }
__device__ __forceinline__ bf16x8 trfrag(lptr tile, int lane, int ct, int ks) {
    const int hi = lane >> 5, i = lane & 15, gb = (lane >> 4) & 1;
    const lptr p = tile + (16 * ks + 4 * hi + (i >> 2)) * TSTR + (32 * ct + 16 * gb + 4 * (i & 3)) * 2;
    return join(vtr(p), vtr(p + 8 * TSTR)); }
__device__ __forceinline__ bf16x8 accfrag(const f32x16& x, int ks) {
    u32x4 w; w[0] = att::cvtpk_b(x[8 * ks], x[8 * ks + 1]); w[1] = att::cvtpk_b(x[8 * ks + 2], x[8 * ks + 3]); w[2] = att::cvtpk_b(x[8 * ks + 4], x[8 * ks + 5]); w[3] = att::cvtpk_b(x[8 * ks + 6], x[8 * ks + 7]);
    return __builtin_bit_cast(bf16x8, w); }

struct RecPtrs { const bf16* Z; const float* gates; bf16* Y; float* imgH; float* imgM; float* decH; float* decM;
                 const float* lbl; const float* ng; const float* convw; const float* ibias; const float* fbias; int layer; };

template <bool ML, bool FULL>
__device__ __forceinline__ void rec_unit(const RecPtrs& P, int bh, int seg, char* wlds) {
    constexpr int NVT = ML ? 3 : 2, NT = 2 * NVT;
    int lane_ = threadIdx.x & 63; asm volatile("" : "+v"(lane_));
    const int lane = lane_, r32 = lane & 31, hi = lane >> 5, h = bh & 3, b = bh >> 2;
    const lptr wl = (lptr)wlds; const lptr tq = wl + W_Q, tk = wl + W_K, tv = wl + W_V;
    __attribute__((address_space(3))) float* tab = (__attribute__((address_space(3))) float*)(wl + W_TAB);
    f32x16 S[NT];
    float* img = ML ? P.imgM + (size_t)(bh * NSEG + seg) * IMG_M : P.imgH + (size_t)(bh * NSEG + seg) * IMG_H;
    if (FULL) {
#pragma unroll
        for (int t = 0; t < NT; ++t)
#pragma unroll
            for (int g4 = 0; g4 < 4; ++g4) { const f32x4v q_ = *(const f32x4v*)(img + (t * 4 + g4) * 256 + lane * 4); S[t][4 * g4] = q_[0]; S[t][4 * g4 + 1] = q_[1]; S[t][4 * g4 + 2] = q_[2]; S[t][4 * g4 + 3] = q_[3]; }
    } else {
#pragma unroll
        for (int t = 0; t < NT; ++t) S[t] = f32x16{};
    }
    float lb = 0.f, oml = 1.f, wq0 = 0.f, wq1 = 0.f, wq2 = 0.f, wq3 = 0.f, wk0 = 0.f, wk1 = 0.f, wk2 = 0.f, wk3 = 0.f, ib = 0.f, fb = 0.f;
    float q1 = 0.f, q2 = 0.f, q3 = 0.f, k1 = 0.f, k2 = 0.f, k3 = 0.f, dtot = 1.f;
    const int c = h * 64 + lane;
    const long rowS = (long)b * SEQ + seg * SEGL;
    if (!ML) {
        if (P.layer == 1) { const float a0 = P.lbl[c], a1 = P.lbl[256 + c]; const float mx = fmaxf(a0, a1); const float e0 = expf(a0 - mx), e1 = expf(a1 - mx); lb = e1 / (e0 + e1); }
        oml = 1.f - lb;
        if (FULL) tab[64 + lane] = P.ng[lane];
    } else {
        wk0 = P.convw[0 * 512 + 256 + c]; wk1 = P.convw[1 * 512 + 256 + c]; wk2 = P.convw[2 * 512 + 256 + c]; wk3 = P.convw[3 * 512 + 256 + c];
        if (FULL) { wq0 = P.convw[0 * 512 + c]; wq1 = P.convw[1 * 512 + c]; wq2 = P.convw[2 * 512 + c]; wq3 = P.convw[3 * 512 + c]; }
        ib = P.ibias[h]; fb = P.fbias[h];
        if (seg > 0) { const bf16* zp = P.Z + (rowS - 3) * ZP + c;
            k3 = bf2f(zp[ZC_MK]); k2 = bf2f(zp[ZP + ZC_MK]); k1 = bf2f(zp[2 * ZP + ZC_MK]);
            if (FULL) { q3 = bf2f(zp[ZC_MQ]); q2 = bf2f(zp[ZP + ZC_MQ]); q1 = bf2f(zp[2 * ZP + ZC_MQ]); } }
    }
    const bf16x8 ones = (r32 == 0) ? (bf16x8){0x3F80, 0x3F80, 0x3F80, 0x3F80, 0x3F80, 0x3F80, 0x3F80, 0x3F80} : (bf16x8){0, 0, 0, 0, 0, 0, 0, 0};
#define LOADV(VW, R0) do { _Pragma("unroll") for (int i_ = 0; i_ < 4; ++i_) VW[i_] = *(const u32x4*)(P.Z + ((R0) + (lane >> 3) + 8 * i_) * ZP + h * 64 + (lane & 7) * 8 + (ML ? ZC_MV : ZC_HI)); } while (0)
#define LOADG(GF, GI, R0) do { if (ML) { const float* gp_ = P.gates + (size_t)((R0) + (lane & 31)) * 12 + h; GF = gp_[8]; GI = gp_[4]; } } while (0)
#define RAWDMA(REGION, COL, R0) do { _Pragma("unroll") for (int j_ = 0; j_ < 4; ++j_) \
        __builtin_amdgcn_global_load_lds((const unsigned*)(P.Z + ((R0) + 8 * j_ + (lane >> 3)) * ZP + (COL) + h * 64 + (((lane & 7) ^ (lane >> 3)) * 8)), (__attribute__((address_space(3))) unsigned*)((REGION) + j_ * 1024), 16, 0, 0); } while (0)
#define WSTORE(TILE, W) do { _Pragma("unroll") for (int i_ = 0; i_ < 4; ++i_) { \
            __attribute__((address_space(3))) unsigned long long* dp_ = (__attribute__((address_space(3))) unsigned long long*)((TILE) + ((lane >> 3) + 8 * i_) * TSTR + (lane & 7) * 16); \
            dp_[0] = (unsigned long long)W[i_][0] | ((unsigned long long)W[i_][1] << 32); dp_[1] = (unsigned long long)W[i_][2] | ((unsigned long long)W[i_][3] << 32); } } while (0)
    const lptr rawK = tq, rawQ = tk;
    constexpr int COLK = ML ? ZC_MK : ZC_HF, COLQ = ML ? ZC_MQ : ZC_HQ;
    RAWDMA(rawK, COLK, rowS); if (FULL) RAWDMA(rawQ, COLQ, rowS);
    u32x4 vwN[4]; float glfN = 0.f, gliN = 0.f;
    if (!FULL) LOADV(vwN, rowS);
    LOADG(glfN, gliN, rowS);
    const int i16 = lane & 15, rr = i16 >> 2, pc = 2 * (lane >> 4) + ((i16 & 3) >> 1);
    const int troffE = rr * 128 + ((pc ^ rr) << 4) + (i16 & 1) * 8, troffO = rr * 128 + ((pc ^ (4 + rr)) << 4) + (i16 & 1) * 8;
    for (int blk = 0; blk < NBLK; ++blk) {
        const long row0 = rowS + blk * 32;
        u32x4 vw[4]; const float glf = glfN, gli = gliN;
        asm volatile("s_waitcnt vmcnt(0)" ::: "memory");
        if (FULL) LOADV(vw, row0);
        else {
#pragma unroll
            for (int i = 0; i < 4; ++i) vw[i] = vwN[i];
        }
        s16x4 ra4[8], rb4[8];
#pragma unroll
        for (int pb = 0; pb < 8; ++pb) { ra4[pb] = vtr(rawK + pb * 512 + ((pb & 1) ? troffO : troffE)); if (FULL) rb4[pb] = vtr(rawQ + pb * 512 + ((pb & 1) ? troffO : troffE)); }
        LFENCE();
        if (!FULL) { if (blk + 1 < NBLK) { RAWDMA(rawK, COLK, row0 + 32); LOADV(vwN, row0 + 32); LOADG(glfN, gliN, row0 + 32); }
            WSTORE(tv, vw); }
        float dec;
        if (!ML) {
            float E = 1.f;
#pragma unroll
            for (int t2 = 0; t2 < 16; ++t2) {
                float kq[2], qq[2];
#pragma unroll
                for (int u = 0; u < 2; ++u) { const int t = 2 * t2 + u;
                    const float f = lb + oml * fsig(bf2f((bf16)ra4[t >> 2][t & 3]));
                    E *= f; const float e = fmaxf(E, EMIN);
                    kq[u] = (1.f - f) * __builtin_amdgcn_rcpf(e);
                    if (FULL) qq[u] = bf2f((bf16)rb4[t >> 2][t & 3]) * e; }
                const unsigned wkk = att::cvtpk(kq[0], kq[1]);
                *(__attribute__((address_space(3))) bf16*)(tk + (2 * t2) * TSTR + lane * 2) = (bf16)(wkk & 0xffffu); *(__attribute__((address_space(3))) bf16*)(tk + (2 * t2 + 1) * TSTR + lane * 2) = (bf16)(wkk >> 16);
                if (FULL) { const unsigned wqq = att::cvtpk(qq[0], qq[1]);
                    *(__attribute__((address_space(3))) bf16*)(tq + (2 * t2) * TSTR + lane * 2) = (bf16)(wqq & 0xffffu); *(__attribute__((address_space(3))) bf16*)(tq + (2 * t2 + 1) * TSTR + lane * 2) = (bf16)(wqq >> 16); }
            }
            dec = fmaxf(E, EMIN);
            tab[lane] = dec;
        } else {
            float F = fsig(glf + fb);
            { float t_;
              t_ = __builtin_bit_cast(float, __builtin_amdgcn_update_dpp(0x3f800000, __builtin_bit_cast(int, F), 0x111, 0xf, 0xf, false)); F *= t_;
              t_ = __builtin_bit_cast(float, __builtin_amdgcn_update_dpp(0x3f800000, __builtin_bit_cast(int, F), 0x112, 0xf, 0xf, false)); F *= t_;
              t_ = __builtin_bit_cast(float, __builtin_amdgcn_update_dpp(0x3f800000, __builtin_bit_cast(int, F), 0x114, 0xf, 0xf, false)); F *= t_;
              t_ = __builtin_bit_cast(float, __builtin_amdgcn_update_dpp(0x3f800000, __builtin_bit_cast(int, F), 0x118, 0xf, 0xf, false)); F *= t_;
              const float r0 = __builtin_bit_cast(float, __builtin_amdgcn_readlane(__builtin_bit_cast(int, F), 15)); if (lane & 16) F *= r0; }
            const int ekb = __builtin_bit_cast(int, __builtin_amdgcn_exp2f((gli + ib) * LOG2E) * __builtin_amdgcn_rcpf(F)), eqb = __builtin_bit_cast(int, F * 0.125f);
            dec = fmaxf(__builtin_bit_cast(float, __builtin_amdgcn_readlane(__builtin_bit_cast(int, F), 31)), EMIN);
#pragma unroll
            for (int t2 = 0; t2 < 16; ++t2) {
                float kq[2], qq[2];
#pragma unroll
                for (int u = 0; u < 2; ++u) { const int t = 2 * t2 + u;
                    const float k0 = bf2f((bf16)ra4[t >> 2][t & 3]); float kc = wk3 * k0 + wk2 * k1 + wk1 * k2 + wk0 * k3; k3 = k2; k2 = k1; k1 = k0;
                    kq[u] = kc * fsig(kc) * __builtin_bit_cast(float, __builtin_amdgcn_readlane(ekb, t));
                    if (FULL) { const float q0 = bf2f((bf16)rb4[t >> 2][t & 3]); float qc = wq3 * q0 + wq2 * q1 + wq1 * q2 + wq0 * q3; q3 = q2; q2 = q1; q1 = q0;
                        qq[u] = qc * fsig(qc) * __builtin_bit_cast(float, __builtin_amdgcn_readlane(eqb, t)); } }
                const unsigned wkk = att::cvtpk(kq[0], kq[1]);
                *(__attribute__((address_space(3))) bf16*)(tk + (2 * t2) * TSTR + lane * 2) = (bf16)(wkk & 0xffffu); *(__attribute__((address_space(3))) bf16*)(tk + (2 * t2 + 1) * TSTR + lane * 2) = (bf16)(wkk >> 16);
                if (FULL) { const unsigned wqq = att::cvtpk(qq[0], qq[1]);
                    *(__attribute__((address_space(3))) bf16*)(tq + (2 * t2) * TSTR + lane * 2) = (bf16)(wqq & 0xffffu); *(__attribute__((address_space(3))) bf16*)(tq + (2 * t2 + 1) * TSTR + lane * 2) = (bf16)(wqq >> 16); }
            }
        }
        dtot *= dec;
        if (FULL) WSTORE(tv, vw);
        LFENCE();
        bf16x8 vf[NVT][2];
#pragma unroll
        for (int vt = 0; vt < 2; ++vt)
#pragma unroll
            for (int ks = 0; ks < 2; ++ks) vf[vt][ks] = trfrag(tv, lane, vt, ks);
        if (ML) { vf[NVT - 1][0] = ones; vf[NVT - 1][1] = ones; }
        if (FULL) {
            bf16x8 qf[4], kf[4];
#pragma unroll
            for (int ks = 0; ks < 4; ++ks) { qf[ks] = rowfrag(tq, r32, hi, ks); kf[ks] = rowfrag(tk, r32, hi, ks); }
            LFENCE();
            RAWDMA(tv, (ML ? ZC_MO : ZC_HG), row0);
            if (blk + 1 < NBLK) { RAWDMA(rawK, COLK, row0 + 32); LOADG(glfN, gliN, row0 + 32); }
            f32x16 x1 = f32x16{};
#pragma unroll
            for (int ks = 0; ks < 4; ++ks) x1 = RMFMA(kf[ks], qf[ks], x1);
#pragma unroll
            for (int g = 0; g < 16; ++g) if (att::crow(g, hi) > r32) x1[g] = 0.f;
            const bf16x8 xb0 = accfrag(x1, 0), xb1 = accfrag(x1, 1);
            f32x16 ot[NVT];
#pragma unroll
            for (int vt = 0; vt < NVT; ++vt) {
                ot[vt] = RMFMA(vf[vt][0], xb0, f32x16{}); ot[vt] = RMFMA(vf[vt][1], xb1, ot[vt]);
#pragma unroll
                for (int dt = 0; dt < 2; ++dt)
#pragma unroll
                    for (int ks = 0; ks < 2; ++ks) ot[vt] = RMFMA(accfrag(S[dt * NVT + vt], ks), qf[2 * dt + ks], ot[vt]);
            }
            asm volatile("s_waitcnt vmcnt(0)" ::: "memory");
            const lptr gy = tv + r32 * 128 + 8 * hi; const int gx = r32 & 7;
            float osc;
            if (!ML) {
                float ss = 0.f;
#pragma unroll
                for (int vt = 0; vt < 2; ++vt)
#pragma unroll
                    for (int g = 0; g < 16; ++g) ss += ot[vt][g] * ot[vt][g];
                { auto rr = __builtin_amdgcn_permlane32_swap(__float_as_uint(ss), __float_as_uint(ss), false, false); ss = __uint_as_float(rr[0]) + __uint_as_float(rr[1]); }
                osc = __builtin_amdgcn_rsqf(ss * (1.f / 64.f) + EPS);
            } else { const float den = __shfl(ot[NVT - 1][0], r32); osc = 1.f / fmaxf(fabsf(den), 1.f); }
#pragma unroll
            for (int vt = 0; vt < 2; ++vt)
#pragma unroll
                for (int g4 = 0; g4 < 4; ++g4) { const int v0 = 32 * vt + 8 * g4 + 4 * hi;
                    __attribute__((address_space(3))) unsigned long long* gp_ = (__attribute__((address_space(3))) unsigned long long*)(gy + (((4 * vt + g4) ^ gx) << 4));
                    const unsigned long long gw = *gp_;
                    float o4[4];
                    if (!ML) { const f32x4v gn = *(const __attribute__((address_space(3))) f32x4v*)(tab + 64 + v0);
#pragma unroll
                        for (int e = 0; e < 4; ++e) { const float gv = __uint_as_float((unsigned)((gw >> (16 * e)) & 0xffffu) << 16); o4[e] = ot[vt][4 * g4 + e] * osc * gn[e] * gv * fsig(gv); }
                    } else {
#pragma unroll
                        for (int e = 0; e < 4; ++e) { const float gv = __uint_as_float((unsigned)((gw >> (16 * e)) & 0xffffu) << 16); o4[e] = ot[vt][4 * g4 + e] * osc * fsig(gv); } }
                    *gp_ = (unsigned long long)att::cvtpk(o4[0], o4[1]) | ((unsigned long long)att::cvtpk(o4[2], o4[3]) << 32); }
            LFENCE();
#pragma unroll
            for (int j = 0; j < 4; ++j) { const int row = 8 * j + (lane >> 3), ch = lane & 7;
                const u32x4 yv = *(const __attribute__((address_space(3))) u32x4*)(tv + row * 128 + ((ch ^ (row & 7)) << 4));
                *(u32x4*)(P.Y + (row0 + row) * D + (ML ? 768 : 0) + h * 64 + ch * 8) = yv; }
        }
        {
            bf16x8 ktf[2][2];
#pragma unroll
            for (int dt = 0; dt < 2; ++dt)
#pragma unroll
                for (int ks = 0; ks < 2; ++ks) ktf[dt][ks] = trfrag(tk, lane, dt, ks);
            if (FULL) { LFENCE(); if (blk + 1 < NBLK) RAWDMA(rawQ, COLQ, row0 + 32); }
#pragma unroll
            for (int dt = 0; dt < 2; ++dt) {
                f32x4v dv[4];
                if (!ML) {
#pragma unroll
                    for (int g4 = 0; g4 < 4; ++g4) dv[g4] = *(const __attribute__((address_space(3))) f32x4v*)(tab + 32 * dt + 8 * g4 + 4 * hi);
                }
#pragma unroll
                for (int vt = 0; vt < NVT; ++vt) { f32x16 s = S[dt * NVT + vt];
                    s = RMFMA(ktf[dt][0], vf[vt][0], s); s = RMFMA(ktf[dt][1], vf[vt][1], s);
#pragma unroll
                    for (int g = 0; g < 16; ++g) s[g] *= ML ? dec : dv[g >> 2][g & 3];
                    S[dt * NVT + vt] = s; }
            }
        }
        LFENCE();
    }
    if (!FULL) {
#pragma unroll
        for (int t = 0; t < NT; ++t)
#pragma unroll
            for (int g4 = 0; g4 < 4; ++g4) *(f32x4v*)(img + (t * 4 + g4) * 256 + lane * 4) = (f32x4v){S[t][4 * g4], S[t][4 * g4 + 1], S[t][4 * g4 + 2], S[t][4 * g4 + 3]};
        if (!ML) P.decH[(size_t)(bh * NSEG + seg) * 64 + lane] = dtot;
        else if (lane == 0) P.decM[bh * NSEG + seg] = dtot;
    }
}

__device__ __forceinline__ void scan_items(const RecPtrs& P, int item0, int nitem_stride) {
    int tid_ = threadIdx.x; asm volatile("" : "+v"(tid_)); const int tid = tid_;
    constexpr int ITEMS_H = BATCH * NH * (IMG_H / 512), ITEMS_M = BATCH * NH * (IMG_M / 512), NIT = ITEMS_H + ITEMS_M;
    for (int it0 = item0; it0 < NIT; it0 += 2 * nitem_stride) {
        const bool two = it0 + nitem_stride < NIT;
        float* basev[2]; const float* dpv[2]; int iszv[2], dstrv[2];
#pragma unroll
        for (int q = 0; q < 2; ++q) { const int it = (q == 1 && two) ? it0 + nitem_stride : it0;
            const bool ml = it >= ITEMS_H; const int r = ml ? it - ITEMS_H : it; const int per = ml ? IMG_M / 512 : IMG_H / 512;
            const int bh = r / per, e = (r % per) * 512 + tid; const int isz = ml ? IMG_M : IMG_H;
            basev[q] = (ml ? P.imgM : P.imgH) + (size_t)bh * NSEG * isz + e; iszv[q] = isz;
            const int tile = e >> 10, g = ((e >> 8) & 3) * 4 + (e & 3), ln = (e >> 2) & 63; const int dt = ml ? tile / 3 : tile >> 1; const int d = 32 * dt + att::crow(g, ln >> 5);
            dpv[q] = ml ? P.decM + bh * NSEG : P.decH + (size_t)bh * NSEG * 64 + d; dstrv[q] = ml ? 1 : 64; }
        float u0[NSEG], p0[NSEG], u1[NSEG], p1[NSEG];
#pragma unroll
        for (int j = 0; j < NSEG; ++j) { u0[j] = basev[0][(size_t)j * iszv[0]]; p0[j] = dpv[0][j * dstrv[0]]; }
        if (two) {
#pragma unroll
            for (int j = 0; j < NSEG; ++j) { u1[j] = basev[1][(size_t)j * iszv[1]]; p1[j] = dpv[1][j * dstrv[1]]; } }
        { float s = 0.f;
#pragma unroll
          for (int j = 0; j < NSEG; ++j) { basev[0][(size_t)j * iszv[0]] = s; s = p0[j] * s + u0[j]; } }
        if (two) { float s = 0.f;
#pragma unroll
          for (int j = 0; j < NSEG; ++j) { basev[1][(size_t)j * iszv[1]] = s; s = p1[j] * s + u1[j]; } }
    }
}
#undef LOADV
#undef LOADG
#undef RAWDMA
#undef WSTORE
#undef RMFMA
#undef LFENCE
}
__global__ void __launch_bounds__(NWAVES * 64, 2) mk_fwd(Args args) {
    extern __shared__ __attribute__((aligned(16))) unsigned char lds[];
    Frame F;
    F.lds = (LAS unsigned char*)lds; F.MISC = (volatile LAS unsigned*)(F.lds + MISC_OFF);
    F.tid = threadIdx.x; F.lane = F.tid & 63; F.wave = __builtin_amdgcn_readfirstlane(F.tid >> 6);
    F.G = gridDim.x; { const int bx = blockIdx.x; F.vcu = (F.G % 8 == 0) ? (bx % 8) * (F.G / 8) + bx / 8 : bx; }
    unsigned char* ws = args.ws;
    F.ctl = (gu32*)(ws + WS_CTL);
    for (int u = F.tid; u < (LDS_BYTES - LDSCTL_OFF) / 4; u += NWAVES * 64) ((LAS unsigned*)(F.lds + LDSCTL_OFF))[u] = 0u;
    __syncthreads();
    XcdBarrier bar = xcd_barrier_post((unsigned*)(F.ctl + CW_BAR) + args.li * XCD_BAR_WORDS, F.MISC + 8);
    const int lo = args.ph_lo, hi = args.ph_hi;
#ifdef PROBE_GROUP
    unsigned long long t_prev = __builtin_amdgcn_s_memrealtime(); unsigned long long t_acc = 0ull;
#define STAMP(grp) do { const unsigned long long t_now = __builtin_amdgcn_s_memrealtime(); if ((grp) == PROBE_GROUP) t_acc += t_now - t_prev; t_prev = t_now; } while (0)
#else
#define STAMP(grp) do {} while (0)
#endif
#define IN(k) (lo <= (k) && (k) < hi)
#define SEAM(k) do { if (IN(k) && IN((k) + 1)) xcd_barrier(bar); } while (0)
    float* mod = (float*)(ws + WS_MOD); float* wgw = (float*)(ws + WS_WG); float* gates = (float*)(ws + WS_GATES);
    bf16* HN = (bf16*)(ws + WS_HN); bf16* Z = (bf16*)(ws + WS_Z); bf16* Y = (bf16*)(ws + WS_Y); bf16* HB = (bf16*)(ws + WS_H); bf16* XB = (bf16*)(ws + WS_XB);
    if (IN(PH_PRO)) { p0_prologue(F, args); }
    SEAM(PH_PRO); STAMP(5);
    for (int l = 0; l < DEPTH; ++l) {
        const int pb = 1 + PH_PER_LAYER * l;
        const float* modl = mod + (size_t)l * 8 * NMOD;
        const float* xin = (l == 0) ? args.in[0] : args.out;
        if (IN(pb + PL_NORM1) && l == 0) {
            bias_all(F, (const bf16*)(ws + WS_WIN), (const bf16*)(ws + WS_W1), mod, (float*)(ws + WS_BIAS1), (float*)(ws + WS_BIAS2)); STAMP(8);
            prenorm0_phase(F, xin, (const float*)(ws + WS_GM1), HN, (float*)(ws + WS_SS1));
        }
        if (l == 0) { SEAM(pb + PL_NORM1); } STAMP(4);
        if (IN(pb + PL_INPROJ)) {
            pg8::Gemm g{HN, (const bf16*)(ws + WS_WIN) + (size_t)l * 4096 * 1024, T, 4096, D}; pg8::StaticOrder S; S.init(T, 4096, F.G, (int)blockIdx.x);
            pg8::EpiInProj E{Z, ZP, (const float*)(ws + WS_QKG) + l * 256, (LAS unsigned char*)(F.lds + XCH_OFF), (const float*)(ws + WS_SS1), (const float*)(ws + WS_BIAS1) + (size_t)l * 8 * 4096, gates, (float*)(ws + WS_FGT)};
            pg8::gemm_phase<pg8::EpiInProj, pg8::StaticOrder, true, true>(F.lds + RING_OFF, g, S, E);
        }
        SEAM(pb + PL_INPROJ); STAMP(11);
        rec::RecPtrs RP{Z, gates, Y, (float*)(ws + WS_IMGH), (float*)(ws + WS_IMGM), (float*)(ws + WS_DECH), (float*)(ws + WS_DECM),
                        args.in[8], args.in[9] + l * HD, args.in[17] + (size_t)l * 4 * 512, args.in[18] + l * NH, args.in[19] + l * NH, l};
        char* al = (char*)lds + RING_OFF; float* tbl = (float*)(al + att::LDS_TBL);
        if (IN(pb + PL_MIXA)) {
            for (int bh = blockIdx.x; bh < BATCH * NH; bh += F.G) fox_scan_block((const float*)(ws + WS_FGT), args.in[16] + l * NH, (float*)(ws + WS_FCUM), (int*)(ws + WS_KST), ((const float*)(ws + WS_SMAX))[l * 2], bh, F.lds);
            for (int w = F.vcu * NWAVES + F.wave; w < 2048; w += F.G * NWAVES) { const int rem = w >> 1;
                if ((((w & 1) ^ (F.wave >> 2)) & 1) == 0) rec::rec_unit<false, false>(RP, rem >> 5, rem & 31, al + F.wave * rec::W_BYTES);
                else rec::rec_unit<true, false>(RP, rem >> 5, rem & 31, al + F.wave * rec::W_BYTES); }
        }
        SEAM(pb + PL_MIXA); STAMP(3);
        if (IN(pb + PL_MIXB)) {
            const bool sched_blk = (F.G == 256) && ((F.vcu & 31) == 0);
            if (!sched_blk) { if (F.G == 256) rec::scan_items(RP, F.vcu - (F.vcu >> 5) - 1, 248); else rec::scan_items(RP, (int)blockIdx.x, F.G); }
            for (int vc = F.vcu; vc < 256; vc += F.G) if ((vc & 31) == 0) {
                int mt_ = threadIdx.x; asm volatile("" : "+v"(mt_));
                const int x = vc >> 5; const int* kstF = (const int*)(ws + WS_KST); const float smax_d = ((const float*)(ws + WS_SMAX))[l * 2 + 1];
                LAS int* cst = (LAS int*)(F.lds);
                __syncthreads();
                if (mt_ < 128) { const int v = mt_, ty = v >> 6, hh = (v >> 4) & 3, qb = v & 15, nt = 4 * qb + 4; int ks, c;
                    if (ty == 0) { ks = kstF[(4 * x + hh) * 16 + qb]; c = (nt - ks + 4) * 100; }
                    else { const float slope2 = exp2f(-2.0f * (float)(hh + 1)) * LOG2E; const float jf = ((float)(256 * qb) - (152.0f + 2.0f * smax_d) / slope2 - 63.0f) * (1.0f / 64.0f);
                        ks = jf > 0.f ? (int)jf : 0; ks = ks < nt - 4 ? ks : nt - 4; ks &= ~1; c = (nt - ks + 4) * 215; }
                    cst[v] = c; cst[128 + v] = ks; }
                cst[512 + mt_] = -1; cst[512 + 512 + mt_] = -1;
                __syncthreads();
                if (mt_ < 128) { const int c = cst[mt_]; int rank = 0;
                    for (int v4 = 0; v4 < 32; ++v4) { const v4u cc = *(const LAS v4u*)(cst + 4 * v4);
                        rank += ((int)cc.x > c || ((int)cc.x == c && 4 * v4 + 0 < mt_)) + ((int)cc.y > c || ((int)cc.y == c && 4 * v4 + 1 < mt_)) + ((int)cc.z > c || ((int)cc.z == c && 4 * v4 + 2 < mt_)) + ((int)cc.w > c || ((int)cc.w == c && 4 * v4 + 3 < mt_)); }
                    cst[256 + rank] = mt_; }
                __syncthreads();
                if (F.wave == 0) {
                    const int ln = mt_ & 63; int load = 0, own_lo = 0, own_hi = 0;
                    const int c_lo = cst[cst[256 + ln]], c_hi = cst[cst[256 + 64 + ln]];
                    for (int r = 0; r < 128; ++r) {
                        const int c = (r < 64) ? __builtin_amdgcn_readlane(c_lo, r & 63) : __builtin_amdgcn_readlane(c_hi, r & 63);
                        int m = (ln < 32) ? ((load << 5) | ln) : 0x7fffffff;
                        { int t2;
                          t2 = __builtin_amdgcn_update_dpp(0x7fffffff, m, 0x111, 0xf, 0xf, false); m = t2 < m ? t2 : m;
                          t2 = __builtin_amdgcn_update_dpp(0x7fffffff, m, 0x112, 0xf, 0xf, false); m = t2 < m ? t2 : m;
                          t2 = __builtin_amdgcn_update_dpp(0x7fffffff, m, 0x114, 0xf, 0xf, false); m = t2 < m ? t2 : m;
                          t2 = __builtin_amdgcn_update_dpp(0x7fffffff, m, 0x118, 0xf, 0xf, false); m = t2 < m ? t2 : m; }
                        const int m0 = __builtin_amdgcn_readlane(m, 15), m1 = __builtin_amdgcn_readlane(m, 31); const int o = (m0 < m1 ? m0 : m1) & 31;
                        load += (ln == o) ? c : 0;
                        if (r < 64) own_lo = (ln == r) ? o : own_lo; else own_hi = (ln == (r - 64)) ? o : own_hi; }
                    cst[384 + ln] = own_lo; cst[384 + 64 + ln] = own_hi;
                }
                __syncthreads();
                if (mt_ < 128) { const int o = cst[384 + mt_]; int pos = 0;
                    for (int r4 = 0; r4 < 32; ++r4) { const v4u oo = *(const LAS v4u*)(cst + 384 + 4 * r4);
                        pos += ((int)oo.x == o && 4 * r4 + 0 < mt_) + ((int)oo.y == o && 4 * r4 + 1 < mt_) + ((int)oo.z == o && 4 * r4 + 2 < mt_) + ((int)oo.w == o && 4 * r4 + 3 < mt_); }
                    const int v = cst[256 + mt_]; if (pos < 32) cst[512 + o * 32 + pos] = v | (cst[128 + v] << 8); }
                __syncthreads();
                int* gl = (int*)(ws + WS_SCHED) + x * 1024;
                for (int i = mt_; i < 1024; i += NWAVES * 64) gl[i] = cst[512 + i];
                __syncthreads();
            }
        }
        SEAM(pb + PL_MIXB); STAMP(6);
        if (IN(pb + PL_MIXC)) {
            for (int w = F.vcu * NWAVES + F.wave; w < 2048; w += F.G * NWAVES) { const int rem = w >> 1;
                if ((((w & 1) ^ (F.wave >> 2)) & 1) == 0) rec::rec_unit<false, true>(RP, rem >> 5, rem & 31, al + F.wave * rec::W_BYTES);
                else rec::rec_unit<true, true>(RP, rem >> 5, rem & 31, al + F.wave * rec::W_BYTES); }
            __syncthreads(); STAMP(7);
            int mt_ = threadIdx.x; asm volatile("" : "+v"(mt_));
            const float* Fc = (const float*)(ws + WS_FCUM); const int* kstF = (const int*)(ws + WS_KST);
            const float smax_d = ((const float*)(ws + WS_SMAX))[l * 2 + 1];
            const float lam_init = 0.8f - 0.6f * expf(-0.3f * (float)l);
            float lam; { const float* lv = args.in[12] + l * 128; float d01 = 0.f, d23 = 0.f; for (int i = 0; i < 32; ++i) { d01 += lv[i] * lv[32 + i]; d23 += lv[64 + i] * lv[96 + i]; } lam = expf(d01) - expf(d23) + lam_init; }
            LAS int* cst = (LAS int*)(F.lds + 134144);
            static_assert(att::LDS_END <= 134144 && 134144 + (384 + 1024) * 4 <= LDSCTL_OFF, "unit table placement");
            for (int vc = F.vcu; vc < 256; vc += F.G) {
                const int x = vc >> 5, j = vc & 31; const int* myl = (const int*)(ws + WS_SCHED) + (x * 32 + j) * 32;
                for (int k2 = 0; k2 < 64; ++k2) {
                    const int e = myl[k2 & 31]; if (e < 0) continue;
                    const int v = e & 255, ks = e >> 8; if ((v >> 6) != (k2 >> 5)) continue;
                    const int ty = v >> 6, h = (v >> 4) & 3, qb = v & 15, b = x, bh = 4 * x + h;
                    if (ty == 0) {
                        for (int i = ks * 64 + mt_; i < 256 * qb + 256; i += NWAVES * 64) tbl[i] = -Fc[(size_t)bh * SEQ + i] * LOG2E;
                        att::fox_unit(b, h, qb, ks, Z, Y, al);
                    } else {
                        const float slope2 = exp2f(-2.0f * (float)(h + 1)) * LOG2E;
                        for (int i = ks * 64 + mt_; i < 256 * qb + 256; i += NWAVES * 64) tbl[i] = slope2 * (float)i;
                        att::diff_unit(b, h, qb, ks, Z, Y, lam, 1.f - lam_init, args.in[13] + l * HD, al);
                    }
                }
            }
        }
        SEAM(pb + PL_MIXC); STAMP(2);
        if (IN(pb + PL_OUTPROJ)) {
            pg8::Gemm g{Y, (const bf16*)(ws + WS_WOUT) + (size_t)l * 1024 * 1024, T, D, D}; pg8::StaticOrder S; S.init(T, D, F.G, (int)blockIdx.x);
            if (l == 0) { pg8::EpiResGateN<false, true> E{args.in[0], XB, modl + 2 * D, (const float*)(ws + WS_GM2) + (size_t)l * 8 * D, HN, (float*)(ws + WS_SSQ), (LAS float*)(F.lds + XCH_OFF), (LAS unsigned char*)(F.lds + XCH_OFF + 4096)};
                pg8::gemm_phase<pg8::EpiResGateN<false, true>, pg8::StaticOrder, true, true>(F.lds + RING_OFF, g, S, E); }
            else { pg8::EpiResGateN<true, true> E{XB, XB, modl + 2 * D, (const float*)(ws + WS_GM2) + (size_t)l * 8 * D, HN, (float*)(ws + WS_SSQ), (LAS float*)(F.lds + XCH_OFF), (LAS unsigned char*)(F.lds + XCH_OFF + 4096)};
                pg8::gemm_phase<pg8::EpiResGateN<true, true>, pg8::StaticOrder, true, true>(F.lds + RING_OFF, g, S, E); }
        }
        SEAM(pb + PL_OUTPROJ); STAMP(12);
        if (IN(pb + PL_FF1)) {
            pg8::Gemm g{HN, (const bf16*)(ws + WS_W1) + (size_t)l * 4096 * 1024, T, FF, D}; pg8::StaticOrder S; S.init(T, FF, F.G, (int)blockIdx.x);
            pg8::EpiFF1 E{HB, FF, (const float*)(ws + WS_SSQ), (const float*)(ws + WS_BIAS2) + (size_t)l * 8 * FF, (LAS unsigned char*)(F.lds + XCH_OFF)};
            pg8::gemm_phase<pg8::EpiFF1, pg8::StaticOrder, true, true>(F.lds + RING_OFF, g, S, E);
        }
        SEAM(pb + PL_FF1); STAMP(13);
        if (IN(pb + PL_FF2)) {
            pg8::Gemm g{HB, (const bf16*)(ws + WS_W2) + (size_t)l * 1024 * 4096, T, D, FF}; pg8::StaticOrder S; S.init(T, D, F.G, (int)blockIdx.x);
            if (l + 1 < DEPTH) { pg8::EpiResGateN<true, true> E{XB, XB, modl + 5 * D, (const float*)(ws + WS_GM1) + (size_t)(l + 1) * 8 * D, HN, (float*)(ws + WS_SS1), (LAS float*)(F.lds + XCH_OFF), (LAS unsigned char*)(F.lds + XCH_OFF + 4096)};
                pg8::gemm_phase<pg8::EpiResGateN<true, true>, pg8::StaticOrder, true, true>(F.lds + RING_OFF, g, S, E); }
            else { pg8::EpiResGate<true, false> E{XB, args.out, modl + 5 * D, (LAS unsigned char*)(F.lds + XCH_OFF)};
                pg8::gemm_phase<pg8::EpiResGate<true, false>, pg8::StaticOrder, true, true>(F.lds + RING_OFF, g, S, E); }
        }
        SEAM(pb + PL_FF2); STAMP(14);
    }
#ifdef PROBE_GROUP
    if (blockIdx.x == 0) { const unsigned long long t_end = __builtin_amdgcn_s_memrealtime() + 4ull * t_acc; while (__builtin_amdgcn_s_memrealtime() < t_end) __builtin_amdgcn_s_sleep(8); }
#endif
#undef IN
#undef SEAM
}

extern "C" void kernel_launch(void* const* d_in, const int* in_sizes, int n_in, void* d_out, int out_size, void* d_ws, size_t ws_size, hipStream_t stream) {
    static int grid = 0;
    if (grid == 0) {
        if (n_in != 22 || in_sizes[0] != T * D || out_size != T * D || ws_size < WS_END) { fprintf(stderr, "kernel_launch: unexpected shapes (n_in %d, in0 %d, out %d, ws %zu)\n", n_in, n_in > 0 ? in_sizes[0] : -1, out_size, ws_size); grid = -1; return; }
        int dev = 0, cus = 0;
        if (hipGetDevice(&dev) != hipSuccess || hipDeviceGetAttribute(&cus, hipDeviceAttributeMultiprocessorCount, dev) != hipSuccess) { grid = -1; return; }
        if (hipFuncSetAttribute((const void*)mk_fwd, hipFuncAttributeMaxDynamicSharedMemorySize, LDS_BYTES) != hipSuccess) { fprintf(stderr, "kernel_launch: hipFuncSetAttribute failed\n"); grid = -1; return; }
        (void)hipGetLastError();
        grid = cus;
    }
    if (grid < 0) return;
    (void)hipMemsetAsync((char*)d_ws + WS_CTL, 0, CTL_ZERO_BYTES, stream);
    Args a{};
    for (int i = 0; i < 22; ++i) a.in[i] = (const float*)d_in[i];
    a.out = (float*)d_out; a.ws = (unsigned char*)d_ws;
    a.ph_lo = 0; a.ph_hi = NPH; a.li = 0;
    hipLaunchKernelGGL(mk_fwd, dim3(grid), dim3(NWAVES * 64), LDS_BYTES, stream, a);
}
```
